# Optimizing an MI355X kernel written in HIP

```python
import jax
import jax.numpy as jnp
from jax import lax
import numpy as np

D_MODEL = 2048
BATCH = 2
SEQ = 16384
DEPTH = 2

GRID_W = 64
CTX_LEN = 256
N_SUB = 3
N_MOD = 3 * N_SUB
D_FF = 5632
FFN_RES = 0.5
NORM_EPS = 1e-6
ROPE_BASE = 10000.0
Q_BLOCK = 128

MLA_HEADS = 4
MLA_Q_LORA = 512
MLA_KV_LORA = 256
MLA_NOPE = 128
MLA_ROPE = 64
MLA_V = 128
MLA_SCALE = (MLA_NOPE + MLA_ROPE) ** -0.5

RG_WIDTH = 512
RG_BLOCKS = 4
RG_BLOCK = RG_WIDTH // RG_BLOCKS
RG_CONV = 4
RG_C = 8.0

DIFF_HEADS = 4
DIFF_QK = 64
DIFF_V = 2 * DIFF_QK
DIFF_SCALE = DIFF_QK ** -0.5

HGRN_HEADS = 4
HGRN_K = 128
HGRN_V = 128
HGRN_CHUNK = 64

N_BRANCH = 4
BRANCH_W = 512
IN_SIZES = (MLA_Q_LORA, MLA_KV_LORA, MLA_ROPE, RG_WIDTH, RG_WIDTH,
            DIFF_HEADS * 2 * DIFF_QK, DIFF_HEADS * 2 * DIFF_QK, DIFF_HEADS * DIFF_V,
            HGRN_HEADS * HGRN_K, HGRN_HEADS * HGRN_K, HGRN_HEADS * HGRN_K,
            HGRN_HEADS * HGRN_V, HGRN_HEADS * HGRN_V, N_BRANCH * D_MODEL)
D_IN = sum(IN_SIZES)
F32 = jnp.float32

kernel_name = 'hybrid_diffusion_parallel_mixer_trunk'


def rmsnorm(x, g):
    xf = x.astype(F32)
    y = xf * lax.rsqrt(jnp.mean(xf * xf, axis=-1, keepdims=True) + NORM_EPS)
    return (y * g.astype(F32)).astype(x.dtype)


def modulated_prenorm(x, mod, j, g):
    return rmsnorm(x, g) * (1.0 + mod[:, 3 * j + 1, None]) + mod[:, 3 * j, None]


def gated_residual(x, y, mod, j, g, weight):
    return x + weight * mod[:, 3 * j + 2, None] * rmsnorm(y, g)


def ffn_sublayer(x, mod, j, pre_g, post_g, w_gate, w_up, w_down):
    h = modulated_prenorm(x, mod, j, pre_g)
    y = (jax.nn.silu(h @ w_gate) * (h @ w_up)) @ w_down
    return gated_residual(x, y, mod, j, post_g, FFN_RES)


def flip(t):
    return jnp.flip(t, axis=1)


def split_combined(u):
    cuts = np.cumsum(IN_SIZES)[:-1].tolist()
    return jnp.split(u, cuts, axis=-1)


def grid_rope_tables(n_tok, rot_dim, dtype):
    n_rows = n_tok // GRID_W
    row = jnp.repeat(jnp.arange(n_rows, dtype=F32), GRID_W)
    col = jnp.tile(jnp.arange(GRID_W, dtype=F32), n_rows)
    axis_dim = rot_dim // 2
    inv_freq = ROPE_BASE ** (-jnp.arange(0, axis_dim, 2, dtype=F32) / axis_dim)
    ang = jnp.concatenate([row[:, None] * inv_freq, col[:, None] * inv_freq], axis=-1)
    return jnp.cos(ang).astype(dtype), jnp.sin(ang).astype(dtype)


def apply_grid_rope(x, cos, sin):
    B, T, H, R = x.shape
    xs = x.reshape(B, T, H, 2, 2, R // 4)
    x1, x2 = xs[..., 0, :], xs[..., 1, :]
    cs = cos.reshape(1, T, 1, 2, R // 4)
    sn = sin.reshape(1, T, 1, 2, R // 4)
    out = jnp.stack([x1 * cs - x2 * sn, x1 * sn + x2 * cs], axis=-2)
    return out.reshape(B, T, H, R)


def attend(q, k, v, scale):
    s = jnp.einsum('bqhd,bkhd->bhqk', q, k).astype(F32) * scale
    p = jax.nn.softmax(s, axis=-1).astype(v.dtype)
    return jnp.einsum('bhqk,bkhd->bqhd', p, v)


def sweep_query_blocks(fn, qs):
    B, T = qs[0].shape[:2]
    nb = T // Q_BLOCK
    blocks = tuple(jnp.swapaxes(q.reshape((B, nb, Q_BLOCK) + q.shape[2:]), 0, 1) for q in qs)
    out = lax.map(lambda qb: fn(*qb), blocks)
    out = jnp.swapaxes(out, 0, 1)
    return out.reshape((B, T) + out.shape[3:])


def mla_queries(uq, q_norm, w_uq, rope):
    B, T, _ = uq.shape
    q = (rmsnorm(uq, q_norm) @ w_uq).reshape(B, T, MLA_HEADS, MLA_NOPE + MLA_ROPE)
    q_nope, q_rope = q[..., :MLA_NOPE], q[..., MLA_NOPE:]
    if rope is not None:
        q_rope = apply_grid_rope(q_rope, *rope)
    return jnp.concatenate([q_nope, q_rope], axis=-1)


def mla_keys_values(ukv, ukr, kv_norm, w_ukv, rope):
    B, T, _ = ukv.shape
    kv = (rmsnorm(ukv, kv_norm) @ w_ukv).reshape(B, T, MLA_HEADS, MLA_NOPE + MLA_V)
    k_nope, v = kv[..., :MLA_NOPE], kv[..., MLA_NOPE:]
    k_rope = ukr[:, :, None, :]
    if rope is not None:
        k_rope = apply_grid_rope(k_rope, *rope)
    k = jnp.concatenate([k_nope, jnp.broadcast_to(k_rope, (B, T, MLA_HEADS, MLA_ROPE))], axis=-1)
    return k, v


def mla_mixer(lat, ctx, q_norm, w_uq, kv_norm, w_ukv, rope, need_ctx):
    uq, ukv, ukr = lat
    cq, ckv, ckr = ctx
    k_c, v_c = mla_keys_values(ckv, ckr, kv_norm, w_ukv, None)
    k_l, v_l = mla_keys_values(ukv, ukr, kv_norm, w_ukv, rope)
    k_all = jnp.concatenate([k_c, k_l], axis=1)
    v_all = jnp.concatenate([v_c, v_l], axis=1)
    q_l = mla_queries(uq, q_norm, w_uq, rope)
    y = sweep_query_blocks(lambda qb: attend(qb, k_all, v_all, MLA_SCALE), (q_l,))
    B, S = y.shape[:2]
    y = y.reshape(B, S, MLA_HEADS * MLA_V)
    yc = None
    if need_ctx:
        q_c = mla_queries(cq, q_norm, w_uq, None)
        yc = attend(q_c, k_c, v_c, MLA_SCALE).reshape(B, ckv.shape[1], MLA_HEADS * MLA_V)
    return y, yc


def centred_depthwise_conv(x, w, b):
    left = RG_CONV // 2
    right = RG_CONV - 1 - left
    y = lax.conv_general_dilated(x, w[:, None, :], window_strides=(1,), padding=[(left, right)],
                                 dimension_numbers=('NWC', 'WIO', 'NWC'),
                                 feature_group_count=x.shape[-1])
    return y + b


def rglru_coeffs(xc, w_r, b_r, w_i, b_i, lam):
    B, T, W = xc.shape
    xb = xc.reshape(B, T, RG_BLOCKS, RG_BLOCK)
    r = jax.nn.sigmoid(jnp.einsum('btnj,njk->btnk', xb, w_r).reshape(B, T, W) + b_r).astype(F32)
    i = jax.nn.sigmoid(jnp.einsum('btnj,njk->btnk', xb, w_i).reshape(B, T, W) + b_i).astype(F32)
    log_a = -RG_C * r * jax.nn.softplus(-lam.astype(F32))
    a = jnp.exp(log_a)
    b = jnp.sqrt(-jnp.expm1(2.0 * log_a)) * (i * xc.astype(F32))
    return a, b


def linear_scan(a, b, h0):
    b = b.at[:, 0].add(a[:, 0] * h0)
    def combine(lhs, rhs):
        return lhs[0] * rhs[0], rhs[0] * lhs[1] + rhs[1]
    _, h = lax.associative_scan(combine, (a, b), axis=1)
    return h


def directional_scan(a, b, h0, reverse):
    if reverse:
        return flip(linear_scan(flip(a), flip(b), h0))
    return linear_scan(a, b, h0)


def rglru_mixer(lat, ctx, conv_w, conv_b, w_r, b_r, w_i, b_i, lam, need_ctx):
    x_l, gate_l = lat
    x_c, gate_c = ctx
    xl = centred_depthwise_conv(x_l, conv_w, conv_b)
    xcv = centred_depthwise_conv(x_c, conv_w, conv_b)
    h0 = jnp.zeros((x_c.shape[0], RG_WIDTH), F32)
    h_lat, h_ctx = [], []
    for d, reverse in enumerate((False, True)):
        a_c, b_c = rglru_coeffs(xcv, w_r[d], b_r[d], w_i[d], b_i[d], lam[d])
        hc = directional_scan(a_c, b_c, h0, reverse)
        h_init = hc[:, 0] if reverse else hc[:, -1]
        a_l, b_l = rglru_coeffs(xl, w_r[d], b_r[d], w_i[d], b_i[d], lam[d])
        h_lat.append(directional_scan(a_l, b_l, h_init, reverse))
        h_ctx.append(hc)
    y = (h_lat[0] + h_lat[1]).astype(x_l.dtype) * jax.nn.gelu(gate_l)
    yc = None
    if need_ctx:
        yc = (h_ctx[0] + h_ctx[1]).astype(x_c.dtype) * jax.nn.gelu(gate_c)
    return y, yc


def diff_split_qk(u, rope):
    B, T, _ = u.shape
    t = u.reshape(B, T, DIFF_HEADS * 2, DIFF_QK)
    if rope is not None:
        t = apply_grid_rope(t, *rope)
    return t.reshape(B, T, DIFF_HEADS, 2, DIFF_QK)


def diff_attend(q, k, v, lam):
    s = jnp.einsum('bqhcd,bkhcd->bchqk', q, k).astype(F32) * DIFF_SCALE
    p = jax.nn.softmax(s, axis=-1)
    a = (p[:, 0] - lam * p[:, 1]).astype(v.dtype)
    return jnp.einsum('bhqk,bkhd->bqhd', a, v)


def diff_mixer(lat, ctx, lam_vecs, subln, lam_init, rope, need_ctx):
    uq, uk, uv = lat
    cq, ck, cv = ctx
    lv = lam_vecs.astype(F32)
    lam = jnp.exp(jnp.sum(lv[0] * lv[1])) - jnp.exp(jnp.sum(lv[2] * lv[3])) + lam_init
    B, S, _ = uq.shape
    Bc, Tc, _ = cq.shape
    k_c = diff_split_qk(ck, None)
    v_c = cv.reshape(Bc, Tc, DIFF_HEADS, DIFF_V)
    k_all = jnp.concatenate([k_c, diff_split_qk(uk, rope)], axis=1)
    v_all = jnp.concatenate([v_c, uv.reshape(B, S, DIFF_HEADS, DIFF_V)], axis=1)
    q_l = diff_split_qk(uq, rope)
    o = sweep_query_blocks(lambda qb: diff_attend(qb, k_all, v_all, lam), (q_l,))
    y = (rmsnorm(o, subln) * (1.0 - lam_init)).reshape(B, S, DIFF_HEADS * DIFF_V)
    yc = None
    if need_ctx:
        oc = diff_attend(diff_split_qk(cq, None), k_c, v_c, lam)
        yc = (rmsnorm(oc, subln) * (1.0 - lam_init)).reshape(Bc, Tc, DIFF_HEADS * DIFF_V)
    return y, yc


def hgrn_query(uq):
    B, T, _ = uq.shape
    return jax.nn.silu(uq).reshape(B, T, HGRN_HEADS, HGRN_K).astype(F32)


def hgrn_forget(uf, lb):
    B, T, _ = uf.shape
    z = uf.reshape(B, T, HGRN_HEADS, HGRN_K).astype(F32)
    lbh = lb.reshape(HGRN_HEADS, HGRN_K)
    f = lbh + (1.0 - lbh) * jax.nn.sigmoid(z)
    return (1.0 - lbh) * jax.nn.sigmoid(-z), jnp.log(f)


def hgrn_values(ui):
    B, T, _ = ui.shape
    return ui.reshape(B, T, HGRN_HEADS, HGRN_V).astype(F32)


def chunk_gla(q, k, v, g, s0):
    B, T, H, K = q.shape
    V = v.shape[-1]
    N, C = T // HGRN_CHUNK, HGRN_CHUNK
    def to_chunks(t):
        return t.reshape(B, N, C, H, t.shape[-1]).transpose(1, 0, 3, 2, 4)
    lower = jnp.tril(jnp.ones((C, C), dtype=bool))[:, :, None]
    def step(S, inp):
        qc, kc, vc, gc = inp
        G = jnp.cumsum(gc, axis=2)
        o_inter = jnp.einsum('bhck,bhkv->bhcv', qc * jnp.exp(G), S)
        rel = jnp.where(lower, G[:, :, :, None, :] - G[:, :, None, :, :], -jnp.inf)
        A = jnp.einsum('bhtk,bhsk,bhtsk->bhts', qc, kc, jnp.exp(rel))
        o_intra = jnp.einsum('bhts,bhsv->bhtv', A, vc)
        G_last = G[:, :, -1]
        S_new = jnp.exp(G_last)[..., None] * S + jnp.einsum(
            'bhck,bhcv->bhkv', kc * jnp.exp(G_last[:, :, None] - G), vc)
        return S_new, o_inter + o_intra
    S_fin, o = lax.scan(step, s0, (to_chunks(q), to_chunks(k), to_chunks(v), to_chunks(g)))
    return o.transpose(1, 0, 3, 2, 4).reshape(B, T, H, V), S_fin


def gla_state(k, v, g):
    G = jnp.cumsum(g, axis=1)
    return jnp.einsum('bthk,bthv->bhkv', k * jnp.exp(G[:, -1:] - G), v)


def hgrn_readout(o, og, g_norm):
    B, T = o.shape[:2]
    return rmsnorm(o, g_norm).reshape(B, T, HGRN_HEADS * HGRN_V).astype(og.dtype) * jax.nn.silu(og)


def hgrn_mixer(lat, ctx, lb, g_norm, need_ctx):
    uq, uff, ufb, ui, og = lat
    cq, cff, cfb, ci, cog = ctx
    kc_f, gc_f = hgrn_forget(cff, lb)
    kc_b, gc_b = hgrn_forget(cfb, lb)
    vc = hgrn_values(ci)
    yc = None
    if need_ctx:
        zero = jnp.zeros((vc.shape[0], HGRN_HEADS, HGRN_K, HGRN_V), F32)
        qc = hgrn_query(cq)
        oc_f, s_f = chunk_gla(qc, kc_f, vc, gc_f, zero)
        oc_b, s_b = chunk_gla(flip(qc), flip(kc_b), flip(vc), flip(gc_b), zero)
        yc = hgrn_readout(oc_f + flip(oc_b), cog, g_norm)
    else:
        s_f = gla_state(kc_f, vc, gc_f)
        s_b = gla_state(flip(kc_b), flip(vc), flip(gc_b))
    q = hgrn_query(uq)
    v = hgrn_values(ui)
    k_f, g_f = hgrn_forget(uff, lb)
    k_b, g_b = hgrn_forget(ufb, lb)
    o_f, _ = chunk_gla(q, k_f, v, g_f, s_f)
    o_b, _ = chunk_gla(flip(q), flip(k_b), flip(v), flip(g_b), s_b)
    return hgrn_readout(o_f + flip(o_b), og, g_norm), yc


def merge_branches(ys, gate_u, merge_b, w_branch, w_out):
    B, T, _ = gate_u.shape
    g = jax.nn.sigmoid(gate_u.reshape(B, T, N_BRANCH, D_MODEL) + merge_b)
    merged = g[:, :, 0] * (ys[0] @ w_branch[0])
    for n in range(1, N_BRANCH):
        merged = merged + g[:, :, n] * (ys[n] @ w_branch[n])
    return merged @ w_out


def setup_inputs(seed: int = 0) -> dict:
    key = jax.random.key(seed)
    keys = jax.random.split(key, 32)
    def nrm(i, shape, scale):
        return jax.random.normal(keys[i], shape, F32) * scale
    def gain(i, shape):
        return 1.0 + nrm(i, shape, 0.02)
    L = DEPTH
    a_target = jax.random.uniform(keys[22], (L, 2, RG_WIDTH), F32, 0.9, 0.999)
    p = a_target ** (1.0 / RG_C)
    return {
        'x': nrm(0, (BATCH, SEQ, D_MODEL), 1.0),
        'c': nrm(1, (BATCH, D_MODEL), 1.0),
        'ctx': nrm(2, (BATCH, CTX_LEN, D_MODEL), 1.0),
        'c_ctx': nrm(3, (D_MODEL,), 1.0),
        'ada_w': nrm(4, (L, D_MODEL, N_MOD * D_MODEL), 0.5 * D_MODEL ** -0.5),
        'ada_b': nrm(5, (L, N_MOD * D_MODEL), 0.02),
        'pre_norm': gain(6, (L, N_SUB, D_MODEL)),
        'post_norm': gain(7, (L, N_SUB, D_MODEL)),
        'ffn_w_gate': nrm(8, (L, 2, D_MODEL, D_FF), D_MODEL ** -0.5),
        'ffn_w_up': nrm(9, (L, 2, D_MODEL, D_FF), D_MODEL ** -0.5),
        'ffn_w_down': nrm(10, (L, 2, D_FF, D_MODEL), D_FF ** -0.5),
        'w_in': nrm(11, (L, D_MODEL, D_IN), D_MODEL ** -0.5),
        'mla_q_norm': gain(12, (L, MLA_Q_LORA)),
        'mla_w_uq': nrm(13, (L, MLA_Q_LORA, MLA_HEADS * (MLA_NOPE + MLA_ROPE)), MLA_Q_LORA ** -0.5),
        'mla_kv_norm': gain(14, (L, MLA_KV_LORA)),
        'mla_w_ukv': nrm(15, (L, MLA_KV_LORA, MLA_HEADS * (MLA_NOPE + MLA_V)), MLA_KV_LORA ** -0.5),
        'rg_conv_w': nrm(16, (L, RG_CONV, RG_WIDTH), RG_CONV ** -0.5),
        'rg_conv_b': nrm(17, (L, RG_WIDTH), 0.02),
        'rg_w_r': nrm(18, (L, 2, RG_BLOCKS, RG_BLOCK, RG_BLOCK), RG_BLOCK ** -0.5),
        'rg_b_r': nrm(19, (L, 2, RG_WIDTH), 0.02),
        'rg_w_i': nrm(20, (L, 2, RG_BLOCKS, RG_BLOCK, RG_BLOCK), RG_BLOCK ** -0.5),
        'rg_b_i': nrm(21, (L, 2, RG_WIDTH), 0.02),
        'rg_lambda': jnp.log(p) - jnp.log1p(-p),
        'diff_lambda': nrm(23, (L, 4, DIFF_QK), 0.1),
        'diff_subln': gain(24, (L, DIFF_V)),
        'hgrn_lb_logits': nrm(25, (L, HGRN_HEADS * HGRN_K), 0.5),
        'hgrn_norm': gain(26, (L, HGRN_V)),
        'merge_b': nrm(27, (L, N_BRANCH, D_MODEL), 0.02),
        'w_branch': nrm(28, (L, N_BRANCH, BRANCH_W, D_MODEL), BRANCH_W ** -0.5),
        'w_out': nrm(29, (L, D_MODEL, D_MODEL), D_MODEL ** -0.5),
    }


def reference(x, c, ctx, c_ctx, ada_w, ada_b, pre_norm, post_norm, ffn_w_gate, ffn_w_up,
              ffn_w_down, w_in, mla_q_norm, mla_w_uq, mla_kv_norm, mla_w_ukv, rg_conv_w,
              rg_conv_b, rg_w_r, rg_b_r, rg_w_i, rg_b_i, rg_lambda, diff_lambda, diff_subln,
              hgrn_lb_logits, hgrn_norm, merge_b, w_branch, w_out):
    B, S, _ = x.shape
    rope_mla = grid_rope_tables(S, MLA_ROPE, x.dtype)
    rope_diff = grid_rope_tables(S, DIFF_QK, x.dtype)
    lb_soft = jax.nn.softmax(hgrn_lb_logits.astype(F32), axis=0)
    hgrn_lb = jnp.cumsum(lb_soft, axis=0) - lb_soft[0]
    cond_lat = jax.nn.silu(c)
    cond_ctx = jax.nn.silu(c_ctx)[None]
    xc = ctx
    for l in range(DEPTH):
        need_ctx = l < DEPTH - 1
        mod = (cond_lat @ ada_w[l] + ada_b[l]).reshape(B, N_MOD, D_MODEL)
        mod_c = (cond_ctx @ ada_w[l] + ada_b[l]).reshape(1, N_MOD, D_MODEL)
        lam_init = 0.8 - 0.6 * float(np.exp(-0.3 * l))

        x = ffn_sublayer(x, mod, 0, pre_norm[l, 0], post_norm[l, 0],
                         ffn_w_gate[l, 0], ffn_w_up[l, 0], ffn_w_down[l, 0])
        xc = ffn_sublayer(xc, mod_c, 0, pre_norm[l, 0], post_norm[l, 0],
                          ffn_w_gate[l, 0], ffn_w_up[l, 0], ffn_w_down[l, 0])

        (a_q, a_kv, a_kr, b_x, b_g, c_q, c_k, c_v, d_q, d_ff, d_fb, d_i, d_g, gts) = split_combined(
            modulated_prenorm(x, mod, 1, pre_norm[l, 1]) @ w_in[l])
        (a_q_c, a_kv_c, a_kr_c, b_x_c, b_g_c, c_q_c, c_k_c, c_v_c, d_q_c, d_ff_c, d_fb_c, d_i_c, d_g_c,
         gts_c) = split_combined(modulated_prenorm(xc, mod_c, 1, pre_norm[l, 1]) @ w_in[l])

        y_a, y_a_c = mla_mixer((a_q, a_kv, a_kr), (a_q_c, a_kv_c, a_kr_c), mla_q_norm[l], mla_w_uq[l],
                               mla_kv_norm[l], mla_w_ukv[l], rope_mla, need_ctx)
        y_b, y_b_c = rglru_mixer((b_x, b_g), (b_x_c, b_g_c), rg_conv_w[l], rg_conv_b[l], rg_w_r[l],
                                 rg_b_r[l], rg_w_i[l], rg_b_i[l], rg_lambda[l], need_ctx)
        y_c, y_c_c = diff_mixer((c_q, c_k, c_v), (c_q_c, c_k_c, c_v_c), diff_lambda[l], diff_subln[l],
                                lam_init, rope_diff, need_ctx)
        y_d, y_d_c = hgrn_mixer((d_q, d_ff, d_fb, d_i, d_g), (d_q_c, d_ff_c, d_fb_c, d_i_c, d_g_c),
                                hgrn_lb[l], hgrn_norm[l], need_ctx)

        mix = merge_branches((y_a, y_b, y_c, y_d), gts, merge_b[l], w_branch[l], w_out[l])
        x = gated_residual(x, mix, mod, 1, post_norm[l, 1], 1.0)
        if need_ctx:
            mix_c = merge_branches((y_a_c, y_b_c, y_c_c, y_d_c), gts_c, merge_b[l], w_branch[l], w_out[l])
            xc = gated_residual(xc, mix_c, mod_c, 1, post_norm[l, 1], 1.0)
            xc = ffn_sublayer(xc, mod_c, 2, pre_norm[l, 2], post_norm[l, 2],
                              ffn_w_gate[l, 1], ffn_w_up[l, 1], ffn_w_down[l, 1])

        x = ffn_sublayer(x, mod, 2, pre_norm[l, 2], post_norm[l, 2],
                         ffn_w_gate[l, 1], ffn_w_up[l, 1], ffn_w_down[l, 1])
    return x
```

```cpp
#include <hip/hip_runtime.h>
#include <stdint.h>
#include <stdio.h>

#define LAS __attribute__((address_space(3)))
typedef unsigned short bf16_t;
typedef short bf16x8 __attribute__((ext_vector_type(8)));
typedef short s16x4 __attribute__((ext_vector_type(4)));
typedef float f32x2 __attribute__((ext_vector_type(2)));
typedef float f32x4 __attribute__((ext_vector_type(4)));
typedef float f32x16 __attribute__((ext_vector_type(16)));
typedef unsigned u32x2 __attribute__((ext_vector_type(2)));
typedef unsigned u32x4 __attribute__((ext_vector_type(4)));
typedef int i32x4 __attribute__((ext_vector_type(4)));

constexpr int DM = 2048, NB = 2, SEQ = 16384, NL = 2, CTXL = 256, DFF = 5632, NMOD = 9;
constexpr int MLAT = NB * SEQ, MCTX = NB * CTXL, MALL = MLAT + MCTX;
constexpr int NRT = MALL / 256;
constexpr int DIN = 14144, NU = 6144;
constexpr float EPS = 1e-6f;
constexpr int U_AQ = 0, U_BX = 512, U_BG = 1024, U_CQ = 1536, U_CK = 2048, U_CV = 2560, U_DQ = 3072, U_DFF = 3584, U_DFB = 4096, U_DI = 4608, U_DG = 5120, U_AKV = 5632, U_AKR = 5888;

constexpr size_t al256(size_t x) { return (x + 255) / 256 * 256; }
constexpr size_t WS_CTL = 0;
constexpr size_t WS_CMAX = 16384;
constexpr size_t WS_CMAX2 = WS_CMAX + (size_t)NL * 2 * 2 * 5632 * 4;
constexpr size_t WS_ZERO_BYTES = 524288;
static_assert(WS_CMAX2 + (size_t)NL * 14336 * 4 <= WS_ZERO_BYTES, "column maxima inside the zeroed region");
constexpr size_t WS_MOD = 524288;
constexpr size_t WS_ROPE = WS_MOD + al256((size_t)NL * 3 * NMOD * DM * 4);
constexpr size_t WS_SCAL = WS_ROPE + 32768;
constexpr size_t WS_RSQ = WS_SCAL + 32768;
constexpr size_t WS_RGS = WS_RSQ + al256((size_t)MALL * 8);
constexpr size_t WS_HD = WS_RGS + al256((size_t)NRT * 2 * 512 * 8);
constexpr size_t WS_XC = WS_HD + al256((size_t)520 * 4 * 2 * 128 * 4);
constexpr size_t WS_WGU = WS_XC + (size_t)MCTX * DM * 4;
constexpr size_t WS_WD = WS_WGU + (size_t)2 * 11264 * 2048 * 2;
constexpr size_t WS_WIN = WS_WD + (size_t)2 * 2048 * 5632 * 2;
constexpr size_t WS_WUQ = WS_WIN + (size_t)14336 * 2048 * 2;
constexpr size_t WS_WUKV = WS_WUQ + (size_t)768 * 512 * 2;
constexpr size_t WS_WRG = WS_WUKV + (size_t)1024 * 256 * 2;
constexpr size_t WS_WBR = WS_WRG + (size_t)2048 * 512 * 2;
constexpr size_t WS_WOUT = WS_WBR + (size_t)4 * 2048 * 512 * 2;
constexpr size_t WS_HBUF = WS_WOUT + (size_t)2048 * 2048 * 2;
constexpr size_t WS_R1 = WS_HBUF + (size_t)MALL * DM * 2;
constexpr size_t WS_YBUF = WS_R1 + (size_t)MALL * NU * 2;
constexpr size_t WS_QM = WS_YBUF + (size_t)MALL * DM * 2;
constexpr size_t WS_KM = WS_QM + (size_t)MALL * 768 * 2;
constexpr size_t WS_VM = WS_KM + (size_t)MALL * 768 * 2;
constexpr size_t WS_YBR = WS_VM + (size_t)MALL * 512 * 2;
constexpr size_t WS_XCV = WS_YBR + (size_t)4 * MALL * 512 * 2;
constexpr size_t WS_LA = WS_XCV + (size_t)MALL * 512 * 2;
constexpr size_t WS_BB = WS_LA + (size_t)MALL * 1024 * 2;
constexpr size_t WS_WSC = WS_BB + (size_t)MALL * 1024 * 2;
constexpr size_t WS_HSC = WS_WSC + al256((size_t)2 * 11264 * 4);
constexpr size_t WS_HSC2 = WS_HSC + al256((size_t)MALL * 4);
constexpr size_t WS_WGS = WS_HSC2 + al256((size_t)MALL * 4);
constexpr size_t WS_WPS = WS_WGS + 32768;
constexpr size_t WS_H8 = WS_WPS + 32768;
constexpr size_t WS_END = WS_H8 + (size_t)MALL * DM;

constexpr int NTHR = 512;
constexpr int LDS_BYTES = 147456;
constexpr int LDS_MISC = 147456 - 64;

typedef __bf16 bf16x2n __attribute__((ext_vector_type(2)));
__device__ __forceinline__ unsigned cvt_pk_bf16(float lo, float hi) { const f32x2 v = {lo, hi}; const bf16x2n b = __builtin_convertvector(v, bf16x2n); return __builtin_bit_cast(unsigned, b); }
__device__ __forceinline__ bf16_t f2bf(float x) { return (bf16_t)(cvt_pk_bf16(x, 0.f) & 0xffffu); }
__device__ __forceinline__ float bf2f(bf16_t b) { return __uint_as_float(((unsigned)b) << 16); }
__device__ __forceinline__ float bflo(unsigned w) { return __uint_as_float(w << 16); }
__device__ __forceinline__ float bfhi(unsigned w) { return __uint_as_float(w & 0xffff0000u); }
__device__ __forceinline__ float frcp(float x) { return __builtin_amdgcn_rcpf(x); }
__device__ __forceinline__ float flog(float x) { return __builtin_amdgcn_logf(x) * 0.6931471805599453f; }
__device__ __forceinline__ float sigmoidf_(float x) { return frcp(1.0f + __expf(-x)); }
__device__ __forceinline__ float siluf_(float x) { return x * sigmoidf_(x); }
__device__ __forceinline__ float gelu_tanh(float x) { const float u = 0.7978845608028654f * (x + 0.044715f * x * x * x); const float t = 1.0f - 2.0f * frcp(1.0f + __expf(2.0f * u)); return 0.5f * x * (1.0f + t); }
__device__ __forceinline__ float shx(float v, int mask, int lane) { return __int_as_float(__builtin_amdgcn_ds_bpermute((lane ^ mask) << 2, __float_as_int(v))); }
__device__ __forceinline__ float wave_sum(float v, int lane) {
#pragma unroll
    for (int o = 32; o >= 1; o >>= 1) v += shx(v, o, lane);
    return v;
}
__device__ __forceinline__ int obid() { int b = blockIdx.x; asm volatile("" : "+s"(b)); return b; }
__device__ __forceinline__ int otid() { int t = threadIdx.x; asm volatile("" : "+v"(t)); return t; }
#define WAIT_VM0() asm volatile("s_waitcnt vmcnt(0)" ::: "memory")
#define WAIT_LGKM0() asm volatile("s_waitcnt lgkmcnt(0)" ::: "memory")

#define XB_TMO      128
#define XB_XCNT(j)  (256  + 64 * (j))
#define XB_XSUB(j)  (1280 + 64 * (j))
#define XB_XGEN(j)  (2304 + 64 * (j))
#define XB_TOP      3328
#define XB_TOPGEN   3392
#define XCD_BAR_WORDS 3456
#define XB_SPIN_CAP (1u << 22)
__device__ __forceinline__ unsigned xb_ld(unsigned* p)              { return __hip_atomic_load(p, __ATOMIC_RELAXED, __HIP_MEMORY_SCOPE_AGENT); }
__device__ __forceinline__ unsigned xb_add(unsigned* p, unsigned v) { return __hip_atomic_fetch_add(p, v, __ATOMIC_RELAXED, __HIP_MEMORY_SCOPE_AGENT); }
__device__ __forceinline__ unsigned xb_xcc_id() { return (unsigned)__builtin_amdgcn_s_getreg((3 << 11) | 20) & 0xFu; }
#define XB_SPIN(cond, bar) do { unsigned _sp = 0; while (cond) { __builtin_amdgcn_s_sleep(1); \
    if ((++_sp & 255u) == 0u) { if (xb_ld(&(bar)[XB_TMO])) break; if (_sp > XB_SPIN_CAP) { atomicAdd(&(bar)[XB_TMO], 1u); break; } } } } while (0)
struct XcdBarrier { unsigned* bar; unsigned x; volatile LAS unsigned* st; };
__device__ __forceinline__ XcdBarrier xcd_barrier_post(unsigned* bar, volatile LAS unsigned* st) {
    XcdBarrier b; b.bar = bar; b.x = xb_xcc_id(); b.st = st;
    if (threadIdx.x == 0) (void)xb_add(&bar[XB_XCNT(b.x)], 1u);
    return b;
}
__device__ __forceinline__ void xcd_barrier_complete(unsigned* bar, unsigned x, unsigned& nloc, unsigned& nx) {
    const unsigned G = gridDim.x * gridDim.y * gridDim.z;
    unsigned sum, cnt, mine, sp = 0u;
    for (;;) {
        sum = 0u; cnt = 0u; mine = 0u;
#pragma unroll 1
        for (unsigned j = 0; j < 16; ++j) { const unsigned c = xb_ld(&bar[XB_XCNT(j)]); sum += c; cnt += (c > 0u) ? 1u : 0u; mine = (j == x) ? c : mine; }
        if (sum == G) break;
        __builtin_amdgcn_s_sleep(1);
        if ((++sp & 255u) == 0u) { if (xb_ld(&bar[XB_TMO])) break; if (sp > XB_SPIN_CAP) { atomicAdd(&bar[XB_TMO], 1u); break; } }
    }
    nloc = mine > 0u ? mine : 1u; nx = cnt > 0u ? cnt : 1u;
}
__device__ __forceinline__ void xcd_barrier(const XcdBarrier& b) {
    asm volatile("s_waitcnt vmcnt(0)" ::: "memory");
    __syncthreads();
    if (threadIdx.x == 0) {
        unsigned* bar = b.bar; unsigned bx = b.x;
        asm volatile("" : "+s"(bar), "+s"(bx));
        __builtin_amdgcn_s_waitcnt(0);
        unsigned nloc = b.st[0], nx = b.st[1];
        if (nloc == 0u) { xcd_barrier_complete(bar, bx, nloc, nx); b.st[0] = nloc; b.st[1] = nx; }
        const unsigned old = xb_add(&bar[XB_XSUB(bx)], 1u);
        const unsigned gen = old / nloc;
        if (old + 1u == (gen + 1u) * nloc) {
            __builtin_amdgcn_fence(__ATOMIC_RELEASE, "agent");
            asm volatile("s_waitcnt vmcnt(0)" ::: "memory");
            const unsigned og = xb_add(&bar[XB_TOP], 1u);
            const unsigned tg = og / nx;
            if (og + 1u == (tg + 1u) * nx) xb_add(&bar[XB_TOPGEN], 1u);
            else XB_SPIN(xb_ld(&bar[XB_TOPGEN]) == tg, bar);
            __builtin_amdgcn_fence(__ATOMIC_ACQUIRE, "agent");
            xb_add(&bar[XB_XGEN(bx)], 1u);
            asm volatile("s_waitcnt vmcnt(0)" ::: "memory");
        } else {
            XB_SPIN(xb_ld(&bar[XB_XGEN(bx)]) == gen, bar);
            __builtin_amdgcn_fence(__ATOMIC_ACQUIRE, "agent");
            asm volatile("s_waitcnt vmcnt(0)" ::: "memory");
        }
    }
    __syncthreads();
}

constexpr float MLA_QC = 0.07216878364870322f * 1.4426950408889634f, DIFF_QC = 0.125f * 1.4426950408889634f;
namespace gm {
constexpr int BM = 256, BK = 64, HALF = 128, HTB = HALF * BK * 2, STAGE_BYTES = 8 * HTB;
__device__ __forceinline__ int lds_byte(int r, int c) { const int st = (r >> 4) * 2 + (c >> 5), rr = r & 15, cc = c & 31, ob = rr * 64 + cc * 2; return st * 1024 + (ob ^ (((ob >> 9) & 1) << 5)); }
__device__ __forceinline__ void stage_rc(int b, int& R, int& C) { const int st = b / 1024, sb = b % 1024, swz = sb ^ (((sb >> 9) & 1) << 5); R = (st >> 1) * 16 + swz / 64; C = (st & 1) * 32 + (swz % 64) / 2; }
__device__ __forceinline__ int perm32(int rho) { const int n = rho >> 4, i = rho & 15; return 8 * (i >> 2) + 4 * n + (i & 3); }

struct Unit { const char* A; const char* B; unsigned lda2, ldb2; int nt; int pm, pn, tag; };

struct TileOrder {
    int nM, nN, nwg, G, c;
    __device__ __forceinline__ void init(int nM_, int nN_, int G_, int c_) { nM = nM_; nN = nN_; nwg = nM * nN; G = G_; c = c_; }
    __device__ __forceinline__ bool tile(int i, int& pm, int& pn) const {
        const long L = (long)i * G + c; if (L >= nwg) return false;
        int wgid = (int)L; { const int q = nwg / 8, r = nwg % 8, xcd = wgid % 8, off = wgid / 8; wgid = (xcd < r ? xcd * (q + 1) : r * (q + 1) + (xcd - r) * q) + off; }
        const int nig = 8 * nN, gid = wgid / nig, fm = gid * 8, gsz = (nM - fm) < 8 ? (nM - fm) : 8;
        pm = fm + ((wgid % nig) % gsz); pn = (wgid % nig) / gsz; return true;
    }
};

typedef i32x4 AccI[2][2][4][2];
__device__ __forceinline__ void zero_acc(AccI& acc) {
#pragma unroll
    for (int a = 0; a < 2; ++a)
#pragma unroll
        for (int b = 0; b < 2; ++b)
#pragma unroll
            for (int m = 0; m < 4; ++m)
#pragma unroll
                for (int n = 0; n < 2; ++n) acc[a][b][m][n] = (i32x4){0, 0, 0, 0};
}
template <class E> struct is_mixed { static constexpr bool v = false; };
typedef f32x4 Acc[2][2][4][2];
__device__ __forceinline__ void zero_acc(Acc& acc) {
#pragma unroll
    for (int a = 0; a < 2; ++a)
#pragma unroll
        for (int b = 0; b < 2; ++b)
#pragma unroll
            for (int m = 0; m < 4; ++m)
#pragma unroll
                for (int n = 0; n < 2; ++n) acc[a][b][m][n] = (f32x4){0.f, 0.f, 0.f, 0.f};
}

template <bool HALFN, class Sched, class Epi>
__device__ __forceinline__ void gemm_stream(LAS unsigned char* lds, const Sched& S, Epi& E) {
    const int tid = otid(), wid = __builtin_amdgcn_readfirstlane(tid >> 6), lane = tid & 63, wr = wid >> 2, wc = wid & 3, fr = lane & 15, fq = lane >> 4;
    int R0, C0; stage_rc(tid * 16, R0, C0);
    const int Rb0 = Epi::PERM ? ((R0 & ~31) + perm32(R0 & 31)) : R0;
    const unsigned ldsw = (unsigned)wid * 1024u;
    const int aoff = lds_byte(wr * 64 + fr, fq * 8), boff = lds_byte(wc * 32 + fr, fq * 8);
#define GM_SA(b, h) (((b) * 2 + (h)) * HTB)
#define GM_SB(b, h) ((4 + (b) * 2 + (h)) * HTB)
#define GM_STAGE(bufoff, gbase, voff, ld2) do { _Pragma("unroll") for (int _i = 0; _i < 2; ++_i) \
        __builtin_amdgcn_global_load_lds((const unsigned*)((const char*)(gbase) + (size_t)_i * 64 * (ld2) + (voff)), (LAS unsigned*)(lds + (bufoff) + ldsw + _i * 8192), 16, 0, 0); } while (0)
#define GM_LDA(dst, b, h) do { _Pragma("unroll") for (int m = 0; m < 4; ++m) _Pragma("unroll") for (int k = 0; k < 2; ++k) dst[m][k] = *(const LAS bf16x8*)(lds + GM_SA(b, h) + aoff + m * 2048 + k * 1024); } while (0)
#define GM_LDB(dst, b, h) do { _Pragma("unroll") for (int n = 0; n < 2; ++n) _Pragma("unroll") for (int k = 0; k < 2; ++k) dst[n][k] = *(const LAS bf16x8*)(lds + GM_SB(b, h) + boff + n * 2048 + k * 1024); } while (0)
#define GM_MMA_I8(ai, bj, At, Bt) do { _Pragma("unroll") for (int m = 0; m < 4; ++m) _Pragma("unroll") for (int n = 0; n < 2; ++n) _Pragma("unroll") for (int k = 0; k < 2; ++k) \
        acc[ai][bj][m][n] = __builtin_bit_cast(typename Epi::AccT_elem, __builtin_amdgcn_mfma_i32_16x16x64_i8(__builtin_bit_cast(i32x4, Bt[n][k]), __builtin_bit_cast(i32x4, At[m][k]), __builtin_bit_cast(i32x4, acc[ai][bj][m][n]), 0, 0, 0)); } while (0)
#define GM_MMA_BF(ai, bj, At, Bt) do { _Pragma("unroll") for (int m = 0; m < 4; ++m) _Pragma("unroll") for (int n = 0; n < 2; ++n) _Pragma("unroll") for (int k = 0; k < 2; ++k) \
        acc[ai][bj][m][n] = __builtin_bit_cast(typename Epi::AccT_elem, __builtin_amdgcn_mfma_f32_16x16x32_bf16(Bt[n][k], At[m][k], __builtin_bit_cast(f32x4, acc[ai][bj][m][n]), 0, 0, 0)); } while (0)
#define GM_MMA(ai, bj, At, Bt) do { __builtin_amdgcn_s_setprio(1); \
        if constexpr (is_mixed<Epi>::v) { if (cur_i8) GM_MMA_I8(ai, bj, At, Bt); else GM_MMA_BF(ai, bj, At, Bt); } \
        else if constexpr (Epi::I8) GM_MMA_I8(ai, bj, At, Bt); else GM_MMA_BF(ai, bj, At, Bt); \
        __builtin_amdgcn_s_setprio(0); } while (0)
#define GM_WAIT_V(n) asm volatile("s_waitcnt vmcnt(" #n ")" ::: "memory")
#define GM_WAIT_L(n) asm volatile("s_waitcnt lgkmcnt(" #n ")" ::: "memory")
#define GM_BAR __builtin_amdgcn_s_barrier()
#define GM_SCHED __builtin_amdgcn_sched_barrier(0)
    Unit cur, nxt; int ui = 0;
    if (!S.next(0, cur)) return;
    typename Epi::AccT acc;
    bf16x8 At[4][2], B0[2][2], B1[2][2];
    unsigned voffA = (unsigned)R0 * cur.lda2 + (unsigned)C0 * 2u, voffB = (unsigned)Rb0 * cur.ldb2 + (unsigned)C0 * 2u;
    const char* cA = cur.A; const char* cB = cur.B;
    {
        const size_t hA = (size_t)HALF * cur.lda2, hB = (size_t)HALF * cur.ldb2;
        GM_STAGE(GM_SB(0, 0), cB, voffB, cur.ldb2); GM_STAGE(GM_SA(0, 0), cA, voffA, cur.lda2);
        if constexpr (!HALFN) GM_STAGE(GM_SB(0, 1), cB + hB, voffB, cur.ldb2);
        GM_STAGE(GM_SA(0, 1), cA + hA, voffA, cur.lda2);
        if (wr == 1) GM_BAR;
        if constexpr (HALFN) GM_WAIT_V(2); else GM_WAIT_V(4);
        GM_BAR;
        GM_STAGE(GM_SB(1, 0), cB + 128, voffB, cur.ldb2); GM_STAGE(GM_SA(1, 0), cA + 128, voffA, cur.lda2);
        if constexpr (!HALFN) GM_STAGE(GM_SB(1, 1), cB + hB + 128, voffB, cur.ldb2);
        if constexpr (HALFN) GM_WAIT_V(4); else GM_WAIT_V(6);
        GM_BAR;
    }
#define GM_UNIT(BJ) { \
        if constexpr (HALFN) { _Pragma("unroll") for (int _a = 0; _a < 2; ++_a) _Pragma("unroll") for (int _m = 0; _m < 4; ++_m) _Pragma("unroll") for (int _n = 0; _n < 2; ++_n) acc[_a][0][_m][_n] = (f32x4){0.f, 0.f, 0.f, 0.f}; } \
        else zero_acc(acc); \
        const bool cur_i8 = (cur.tag & 1) == 0; (void)cur_i8; \
        const bool has_next = S.next(ui + 1, nxt); \
        const char* nA = has_next ? nxt.A : cA; const char* nB = has_next ? nxt.B : cB; \
        const unsigned nlda2 = has_next ? nxt.lda2 : cur.lda2, nldb2 = has_next ? nxt.ldb2 : cur.ldb2; \
        const unsigned nvoffA = (unsigned)R0 * nlda2 + (unsigned)C0 * 2u, nvoffB = (unsigned)Rb0 * nldb2 + (unsigned)C0 * 2u; \
        const size_t hA = (size_t)HALF * cur.lda2, hB = (size_t)HALF * cur.ldb2, nhA = (size_t)HALF * nlda2, nhB = (size_t)HALF * nldb2; \
        const int nt = cur.nt; \
        for (int t = 0; t < nt; t += 2) { \
            const bool last = (t == nt - 2); \
            if constexpr (Epi::PREF) { if (last) { const int tz_ = otid(); const int wz_ = __builtin_amdgcn_readfirstlane(tz_ >> 6), lz_ = tz_ & 63; E.prefetch(cur, wz_ >> 2, wz_ & 3, lz_ & 15, lz_ >> 4); } } \
            const char* a1 = cA + (size_t)(t + 1) * 128; \
            const char* a2 = last ? nA : cA + (size_t)(t + 2) * 128; const char* b2 = last ? nB : cB + (size_t)(t + 2) * 128; \
            const char* a3 = a2 + 128; const char* b3 = b2 + 128; \
            const unsigned vA2 = last ? nvoffA : voffA, vB2 = last ? nvoffB : voffB; \
            const unsigned lA2 = last ? nlda2 : cur.lda2, lB2 = last ? nldb2 : cur.ldb2; \
            const size_t hA2 = last ? nhA : hA, hB2 = last ? nhB : hB; \
              \
            GM_LDB(B0, 0, 0); GM_SCHED; GM_LDA(At, 0, 0); GM_STAGE(GM_SA(1, 1), a1 + hA, voffA, cur.lda2); \
            GM_WAIT_L(8); GM_BAR; GM_WAIT_L(0); GM_MMA(0, 0, At, B0); GM_BAR; GM_SCHED; \
              \
            if constexpr (!HALFN) GM_LDB(B1, 0, 1); \
            GM_STAGE(GM_SB(0, 0), b2, vB2, lB2); \
            GM_BAR; GM_WAIT_L(0); if constexpr (!HALFN) GM_MMA(0, 1, At, B1); GM_BAR; \
              \
            GM_LDA(At, 0, 1); GM_STAGE(GM_SA(0, 0), a2, vA2, lA2); \
            GM_BAR; GM_WAIT_L(0); GM_MMA(1, 0, At, B0); GM_BAR; GM_SCHED; \
              \
            if constexpr (!HALFN) { GM_STAGE(GM_SB(0, 1), b2 + hB2, vB2, lB2); GM_WAIT_V(6); } else { GM_WAIT_V(4); } \
            GM_BAR; if constexpr (!HALFN) GM_MMA(1, 1, At, B1); GM_BAR; \
              \
            GM_LDB(B0, 1, 0); GM_SCHED; GM_LDA(At, 1, 0); GM_STAGE(GM_SA(0, 1), a2 + hA2, vA2, lA2); \
            GM_WAIT_L(8); GM_BAR; GM_WAIT_L(0); GM_MMA(0, 0, At, B0); GM_BAR; GM_SCHED; \
              \
            if constexpr (!HALFN) GM_LDB(B1, 1, 1); \
            GM_STAGE(GM_SB(1, 0), b3, vB2, lB2); \
            GM_BAR; GM_WAIT_L(0); if constexpr (!HALFN) GM_MMA(0, 1, At, B1); GM_BAR; \
              \
            GM_LDA(At, 1, 1); GM_STAGE(GM_SA(1, 0), a3, vA2, lA2); \
            GM_BAR; GM_WAIT_L(0); GM_MMA(1, 0, At, B0); GM_BAR; GM_SCHED; \
              \
            if constexpr (!HALFN) { GM_STAGE(GM_SB(1, 1), b3 + hB2, vB2, lB2); GM_WAIT_V(6); } else { GM_WAIT_V(4); } \
            GM_BAR; if constexpr (!HALFN) GM_MMA(1, 1, At, B1); GM_BAR; \
        } \
        { const int tz_ = otid(); const int wz_ = __builtin_amdgcn_readfirstlane(tz_ >> 6), lz_ = tz_ & 63; E.template post<BJ>(acc, cur, wz_ >> 2, wz_ & 3, lz_ & 15, lz_ >> 4); } \
        if (!has_next) break; \
        cur = nxt; cA = nA; cB = nB; voffA = nvoffA; voffB = nvoffB; ++ui; \
    }
    for (;;) {
        GM_UNIT(0)
    }
    GM_WAIT_V(0);
    if (wr == 0) GM_BAR;
    GM_BAR;
#undef GM_UNIT
#undef GM_SA
#undef GM_SB
#undef GM_STAGE
#undef GM_LDA
#undef GM_LDB
#undef GM_MMA
#undef GM_MMA_I8
#undef GM_MMA_BF
#undef GM_WAIT_V
#undef GM_WAIT_L
#undef GM_BAR
#undef GM_SCHED
}
}

struct SchedPlain {
    gm::TileOrder T; const char* A; const char* B; unsigned lda2, ldb2; int nt;
    __device__ __forceinline__ bool next(int i, gm::Unit& u) const {
        int pm, pn; if (!T.tile(i, pm, pn)) return false;
        u.A = A + (size_t)pm * 256 * lda2; u.B = B + (size_t)pn * 256 * ldb2; u.lda2 = lda2; u.ldb2 = ldb2; u.nt = nt; u.pm = pm; u.pn = pn; u.tag = 0; return true;
    }
};
struct SchedSplitK {
    gm::TileOrder T; const char* A; const char* B; unsigned lda2, ldb2; int nt, xe;
    __device__ __forceinline__ bool next(int i, gm::Unit& u) const {
        int pm, pn; u.lda2 = lda2; u.ldb2 = ldb2;
        if (T.tile(i, pm, pn)) { u.A = A + (size_t)pm * 256 * lda2; u.B = B + (size_t)pn * 256 * ldb2; u.nt = nt; u.pm = pm; u.pn = pn; u.tag = 0; return true; }
        if (xe < 0 || i != 4) return false;
        const int e = xe >> 2, sl = xe & 3, ks = nt >> 2; pm = 128 + (e & 1); pn = e >> 1;
        u.A = A + (size_t)pm * 256 * lda2 + (size_t)sl * ks * 128; u.B = B + (size_t)pn * 256 * ldb2 + (size_t)sl * ks * 128; u.nt = ks; u.pm = pm; u.pn = pn; u.tag = 1 + sl; return true;
    }
};
struct SchedMergeG {
    gm::TileOrder T; const char* h8; const char* wg; int n, xe;
    __device__ __forceinline__ bool next(int i, gm::Unit& u) const {
        int pm, pn; if (!T.tile(i, pm, pn)) { if (xe < 0 || i != 4) return false; pm = 128 + (xe & 1); pn = xe >> 1; }
        u.A = h8 + (size_t)pm * 256 * 2048; u.lda2 = 2048; u.nt = 16; u.B = wg + ((size_t)n * 2048 + (size_t)pn * 256) * 2048; u.ldb2 = 2048; u.pm = pm; u.pn = pn; u.tag = n; return true;
    }
};
struct SchedMergeY {
    gm::TileOrder T; const char* ybr; const char* wbr; int n, xe;
    __device__ __forceinline__ bool next(int i, gm::Unit& u) const {
        int pm, pn; if (!T.tile(i, pm, pn)) { if (xe < 0 || i != 4) return false; pm = 128 + (xe & 1); pn = xe >> 1; }
        u.A = ybr + (size_t)n * MALL * 1024 + (size_t)pm * 256 * 1024; u.lda2 = 1024; u.nt = 8; u.B = wbr + ((size_t)n * 2048 + (size_t)pn * 256) * 1024; u.ldb2 = 1024; u.pm = pm; u.pn = pn; u.tag = n; return true;
    }
};

struct EpiGateUp {
    static constexpr bool PREF = false, PERM = true, I8 = false; typedef gm::Acc AccT; typedef f32x4 AccT_elem; bf16_t* act;
    template <int BJ> __device__ __forceinline__ void post(gm::Acc& acc, const gm::Unit& u, int wr, int wc, int fr, int fq) {
        const int row0 = u.pm * 256 + wr * 64 + fr, col0 = u.pn * 128 + wc * 32 + 8 * fq;
#pragma unroll
        for (int ai = 0; ai < 2; ++ai)
#pragma unroll
            for (int m = 0; m < 4; ++m) {
                float v[8];
#pragma unroll
                for (int n = 0; n < 2; ++n)
#pragma unroll
                    for (int j = 0; j < 4; ++j) v[n * 4 + j] = siluf_(acc[ai][0][m][n][j]) * acc[ai][1][m][n][j];
                u32x4 w; w.x = cvt_pk_bf16(v[0], v[1]); w.y = cvt_pk_bf16(v[2], v[3]); w.z = cvt_pk_bf16(v[4], v[5]); w.w = cvt_pk_bf16(v[6], v[7]);
                *(u32x4*)(act + (size_t)(row0 + ai * 128 + m * 16) * DFF + col0) = w;
            }
    }
};
struct EpiGateUpI8 {
    static constexpr bool PREF = true, PERM = true, I8 = true;
    __device__ __forceinline__ void prefetch(const gm::Unit& u, int wr, int wc, int fr, int fq) {
        const int row0 = u.pm * 256 + wr * 64 + fr, wrow = u.pn * 256 + wc * 32 + 8 * fq;
#pragma unroll
        for (int j = 0; j < 8; ++j) { sg[j] = wsc[wrow + j]; su[j] = wsc[wrow + 128 + j]; }
#pragma unroll
        for (int i = 0; i < 8; ++i) hsv[i] = hsc[row0 + (i >> 2) * 128 + (i & 3) * 16];
    } typedef gm::AccI AccT; typedef i32x4 AccT_elem; bf16_t* act; const float* hsc; const float* wsc;
    float hsv[8], sg[8], su[8];
    template <int BJ> __device__ __forceinline__ void post(gm::AccI& acc, const gm::Unit& u, int wr, int wc, int fr, int fq) {
        const int row0 = u.pm * 256 + wr * 64 + fr, col0 = u.pn * 128 + wc * 32 + 8 * fq;
#pragma unroll
        for (int ai = 0; ai < 2; ++ai)
#pragma unroll
            for (int m = 0; m < 4; ++m) {
                const int row = row0 + ai * 128 + m * 16; const float hs = hsv[ai * 4 + m];
                float v[8];
#pragma unroll
                for (int n = 0; n < 2; ++n)
#pragma unroll
                    for (int j = 0; j < 4; ++j) { const float g = (float)acc[ai][0][m][n][j] * (hs * sg[n * 4 + j]), up = (float)acc[ai][1][m][n][j] * (hs * su[n * 4 + j]); v[n * 4 + j] = siluf_(g) * up; }
                u32x4 w; w.x = cvt_pk_bf16(v[0], v[1]); w.y = cvt_pk_bf16(v[2], v[3]); w.z = cvt_pk_bf16(v[4], v[5]); w.w = cvt_pk_bf16(v[6], v[7]);
                *(u32x4*)(act + (size_t)row * DFF + col0) = w;
            }
    }
};
struct EpiStore {
    static constexpr bool PREF = false, PERM = true, I8 = false; typedef gm::Acc AccT; typedef f32x4 AccT_elem; bf16_t* O; int ldc;
    template <int BJ> __device__ __forceinline__ void post(gm::Acc& acc, const gm::Unit& u, int wr, int wc, int fr, int fq) {
        const int row0 = u.pm * 256 + wr * 64 + fr, col0 = u.pn * 256 + wc * 32 + 8 * fq;
#pragma unroll
        for (int ai = 0; ai < 2; ++ai)
#pragma unroll
            for (int m = 0; m < 4; ++m)
#pragma unroll
                for (int bj = 0; bj < 2; ++bj) {
                    const f32x4 a = acc[ai][bj][m][0], b = acc[ai][bj][m][1];
                    u32x4 w; w.x = cvt_pk_bf16(a[0], a[1]); w.y = cvt_pk_bf16(a[2], a[3]); w.z = cvt_pk_bf16(b[0], b[1]); w.w = cvt_pk_bf16(b[2], b[3]);
                    *(u32x4*)(O + (size_t)(row0 + ai * 128 + m * 16) * ldc + col0 + bj * 128) = w;
                }
    }
};
struct EpiStoreK {
    static constexpr bool PREF = false, PERM = true, I8 = false; typedef gm::Acc AccT; typedef f32x4 AccT_elem; bf16_t* O; float* yp;
    template <int BJ> __device__ __forceinline__ void post(gm::Acc& acc, const gm::Unit& u, int wr, int wc, int fr, int fq) {
        const int row0 = u.pm * 256 + wr * 64 + fr, col0 = u.pn * 256 + wc * 32 + 8 * fq;
        if (u.tag == 0) {
#pragma unroll
            for (int ai = 0; ai < 2; ++ai)
#pragma unroll
                for (int m = 0; m < 4; ++m)
#pragma unroll
                    for (int bj = 0; bj < 2; ++bj) {
                        const f32x4 a = acc[ai][bj][m][0], b = acc[ai][bj][m][1];
                        u32x4 w; w.x = cvt_pk_bf16(a[0], a[1]); w.y = cvt_pk_bf16(a[2], a[3]); w.z = cvt_pk_bf16(b[0], b[1]); w.w = cvt_pk_bf16(b[2], b[3]);
                        *(u32x4*)(O + (size_t)(row0 + ai * 128 + m * 16) * DM + col0 + bj * 128) = w;
                    }
        } else {
            float* base = yp + (size_t)(u.tag - 1) * MCTX * DM;
#pragma unroll
            for (int ai = 0; ai < 2; ++ai)
#pragma unroll
                for (int m = 0; m < 4; ++m)
#pragma unroll
                    for (int bj = 0; bj < 2; ++bj) { float* o = base + (size_t)(row0 - MLAT + ai * 128 + m * 16) * DM + col0 + bj * 128;
                        *(f32x4*)o = acc[ai][bj][m][0]; *(f32x4*)(o + 4) = acc[ai][bj][m][1]; }
        }
    }
};
__device__ __forceinline__ void job_splitk_reduce(const float* yp, bf16_t* y) {
    const int c = obid(), tid = otid(), G = gridDim.x;
    for (int idx = c * 512 + tid; idx < MCTX * 256; idx += G * 512) { const int row = idx >> 8, q = idx & 255; f32x4 a = {0.f, 0.f, 0.f, 0.f}, b = a;
#pragma unroll
        for (int sl = 0; sl < 4; ++sl) { const float* s = yp + ((size_t)sl * MCTX + row) * DM + q * 8; a += *(const f32x4*)s; b += *(const f32x4*)(s + 4); }
        u32x4 o; o.x = cvt_pk_bf16(a[0], a[1]); o.y = cvt_pk_bf16(a[2], a[3]); o.z = cvt_pk_bf16(b[0], b[1]); o.w = cvt_pk_bf16(b[2], b[3]);
        *(u32x4*)(y + (size_t)(MLAT + row) * DM + q * 8) = o; }
}
__device__ __forceinline__ void rope4(f32x4& x0, f32x4& x1, const float* rope, int pos, int fq) {
    const f32x4 t0 = *(const f32x4*)(rope + pos * 32 + 8 * fq), t1 = *(const f32x4*)(rope + pos * 32 + 8 * fq + 4);
    const float c[4] = {t0[0], t0[2], t1[0], t1[2]}, s[4] = {t0[1], t0[3], t1[1], t1[3]};
#pragma unroll
    for (int j = 0; j < 4; ++j) { const float a = x0[j], b = x1[j]; x0[j] = a * c[j] - b * s[j]; x1[j] = a * s[j] + b * c[j]; }
}
__device__ __forceinline__ void rope4v(f32x4& x0, f32x4& x1, const f32x4 t0, const f32x4 t1) {
    const float c[4] = {t0[0], t0[2], t1[0], t1[2]}, s[4] = {t0[1], t0[3], t1[1], t1[3]};
#pragma unroll
    for (int j = 0; j < 4; ++j) { const float a = x0[j], b = x1[j]; x0[j] = a * c[j] - b * s[j]; x1[j] = a * s[j] + b * c[j]; }
}
struct EpiProj {
    static constexpr bool PREF = false, PERM = false, I8 = true; typedef gm::AccI AccT; typedef i32x4 AccT_elem; bf16_t* ubuf; bf16_t* km; const float* rope; const float* hsc; const float* wps;
    template <int BJ> __device__ __forceinline__ void post(gm::AccI& acc, const gm::Unit& u, int wr, int wc, int fr, int fq) {
        const int pn = u.pn; const bool lat = u.pm < 128, ropet = (pn >= 6 && pn <= 9), akr = (pn == 23);
        const int row0 = u.pm * 256 + wr * 64 + fr;
        f32x4 wsv[2][2];
#pragma unroll
        for (int bj = 0; bj < 2; ++bj)
#pragma unroll
            for (int n = 0; n < 2; ++n) wsv[bj][n] = *(const f32x4*)(wps + pn * 256 + bj * 128 + wc * 32 + 16 * n + 4 * fq);
        float hsv[8];
#pragma unroll
        for (int i = 0; i < 8; ++i) hsv[i] = hsc[row0 + (i >> 2) * 128 + (i & 3) * 16];
        const bool dor = lat && (ropet || (akr && wc < 2));
#pragma unroll
        for (int ai = 0; ai < 2; ++ai) {
            f32x4 rt[4][2];
            if (dor) {
#pragma unroll
                for (int m = 0; m < 4; ++m) { const int s = (row0 + ai * 128 + m * 16) & (SEQ - 1), pos = (wc & 1) ? (s & 63) : (s >> 6);
                    rt[m][0] = *(const f32x4*)(rope + pos * 32 + 8 * fq); rt[m][1] = *(const f32x4*)(rope + pos * 32 + 8 * fq + 4); }
            }
#pragma unroll
            for (int m = 0; m < 4; ++m) {
                const int row = row0 + ai * 128 + m * 16; const float hs = hsv[ai * 4 + m] * ((pn == 6 || pn == 7) ? DIFF_QC : 1.0f);
#pragma unroll
                for (int bj = 0; bj < 2; ++bj) {
                    f32x4 x0, x1;
#pragma unroll
                    for (int j = 0; j < 4; ++j) { x0[j] = (float)acc[ai][bj][m][0][j] * (hs * wsv[bj][0][j]); x1[j] = (float)acc[ai][bj][m][1][j] * (hs * wsv[bj][1][j]); }
                    const bool akr_blk = akr && bj == 0 && wc < 2;
                    if (lat && (ropet || akr_blk)) rope4v(x0, x1, rt[m][0], rt[m][1]);
                    u32x2 w0, w1; w0.x = cvt_pk_bf16(x0[0], x0[1]); w0.y = cvt_pk_bf16(x0[2], x0[3]); w1.x = cvt_pk_bf16(x1[0], x1[1]); w1.y = cvt_pk_bf16(x1[2], x1[3]);
                    if (!akr) { bf16_t* o = ubuf + (size_t)row * NU + pn * 256 + bj * 128 + wc * 32 + 4 * fq; *(u32x2*)o = w0; *(u32x2*)(o + 16) = w1; }
                    else if (akr_blk) {
#pragma unroll
                        for (int h = 0; h < 4; ++h) { bf16_t* o = km + (size_t)row * 768 + h * 192 + 128 + wc * 32 + 4 * fq; *(u32x2*)o = w0; *(u32x2*)(o + 16) = w1; }
                    }
                }
            }
        }
    }
};
struct EpiQup {
    static constexpr bool PREF = false, PERM = false, I8 = false; typedef gm::Acc AccT; typedef f32x4 AccT_elem; bf16_t* qm; const float* rsq; const float* rope;
    template <int BJ> __device__ __forceinline__ void post(gm::Acc& acc, const gm::Unit& u, int wr, int wc, int fr, int fq) {
        const bool lat = u.pm < 128; const int row0 = u.pm * 256 + wr * 64 + fr;
        float rsv[8];
#pragma unroll
        for (int i = 0; i < 8; ++i) rsv[i] = rsq[row0 + (i >> 2) * 128 + (i & 3) * 16];
#pragma unroll
        for (int ai = 0; ai < 2; ++ai)
#pragma unroll
            for (int m = 0; m < 4; ++m) {
                const int row = row0 + ai * 128 + m * 16, s = row & (SEQ - 1); const float rs = rsv[ai * 4 + m] * MLA_QC;
#pragma unroll
                for (int bj = 0; bj < 2; ++bj) {
                    const int b32 = 8 * u.pn + 4 * bj + wc, m6 = b32 % 6;
                    f32x4 x0 = acc[ai][bj][m][0] * rs, x1 = acc[ai][bj][m][1] * rs;
                    if (lat && m6 >= 4) rope4(x0, x1, rope, (m6 == 5) ? (s & 63) : (s >> 6), fq);
                    u32x2 w0, w1; w0.x = cvt_pk_bf16(x0[0], x0[1]); w0.y = cvt_pk_bf16(x0[2], x0[3]); w1.x = cvt_pk_bf16(x1[0], x1[1]); w1.y = cvt_pk_bf16(x1[2], x1[3]);
                    bf16_t* o = qm + (size_t)row * 768 + b32 * 32 + 4 * fq; *(u32x2*)o = w0; *(u32x2*)(o + 16) = w1;
                }
            }
    }
};
struct EpiKVup {
    static constexpr bool PREF = false, PERM = true, I8 = false; typedef gm::Acc AccT; typedef f32x4 AccT_elem; bf16_t* km; bf16_t* vm; const float* rsk;
    template <int BJ> __device__ __forceinline__ void post(gm::Acc& acc, const gm::Unit& u, int wr, int wc, int fr, int fq) {
        const int row0 = u.pm * 256 + wr * 64 + fr, h = u.pn, c0 = wc * 32 + 8 * fq;
        float rsv[8];
#pragma unroll
        for (int i = 0; i < 8; ++i) rsv[i] = rsk[row0 + (i >> 2) * 128 + (i & 3) * 16];
#pragma unroll
        for (int ai = 0; ai < 2; ++ai)
#pragma unroll
            for (int m = 0; m < 4; ++m) {
                const int row = row0 + ai * 128 + m * 16; const float rs = rsv[ai * 4 + m];
#pragma unroll
                for (int bj = 0; bj < 2; ++bj) {
                    const f32x4 a = acc[ai][bj][m][0] * rs, b = acc[ai][bj][m][1] * rs;
                    u32x4 w; w.x = cvt_pk_bf16(a[0], a[1]); w.y = cvt_pk_bf16(a[2], a[3]); w.z = cvt_pk_bf16(b[0], b[1]); w.w = cvt_pk_bf16(b[2], b[3]);
                    if (bj == 0) *(u32x4*)(km + (size_t)row * 768 + h * 192 + c0) = w; else *(u32x4*)(vm + (size_t)row * 512 + h * 128 + c0) = w;
                }
            }
    }
};
struct EpiRG {
    static constexpr bool PREF = false, PERM = true, I8 = false; typedef gm::Acc AccT; typedef f32x4 AccT_elem; const bf16_t* xcv; bf16_t* la; bf16_t* bb; const float* b_r; const float* b_i; const float* sp;
    template <int BJ> __device__ __forceinline__ void post(gm::Acc& acc, const gm::Unit& u, int wr, int wc, int fr, int fq) {
        const int d = u.pn >> 2, w0 = (u.pn & 3) * 128 + wc * 32 + 8 * fq, row0 = u.pm * 256 + wr * 64 + fr;
        float br[8], bi[8], sv[8];
#pragma unroll
        for (int j = 0; j < 8; ++j) { br[j] = b_r[d * 512 + w0 + j]; bi[j] = b_i[d * 512 + w0 + j]; sv[j] = sp[d * 512 + w0 + j]; }
        u32x4 xwv[8];
#pragma unroll
        for (int i = 0; i < 8; ++i) xwv[i] = *(const u32x4*)(xcv + (size_t)(row0 + (i >> 2) * 128 + (i & 3) * 16) * 512 + w0);
#pragma unroll
        for (int ai = 0; ai < 2; ++ai)
#pragma unroll
            for (int m = 0; m < 4; ++m) {
                const int row = row0 + ai * 128 + m * 16;
                const u32x4 xw = xwv[ai * 4 + m];
                const float xv[8] = {bflo(xw.x), bfhi(xw.x), bflo(xw.y), bfhi(xw.y), bflo(xw.z), bfhi(xw.z), bflo(xw.w), bfhi(xw.w)};
                float lo[8], bo[8];
#pragma unroll
                for (int n = 0; n < 2; ++n)
#pragma unroll
                    for (int j = 0; j < 4; ++j) {
                        const int k = n * 4 + j;
                        const float r = sigmoidf_(acc[ai][0][m][n][j] + br[k]), ig = sigmoidf_(acc[ai][1][m][n][j] + bi[k]);
                        const float l_a = -8.0f * r * sv[k], x2 = 2.0f * l_a;
                        const float om = (x2 > -0.3f) ? (-x2 * (1.0f + x2 * (0.5f + x2 * (0.16666667f + x2 * (0.041666668f + x2 * 0.0083333338f))))) : (1.0f - __expf(x2));
                        lo[k] = l_a; bo[k] = __builtin_amdgcn_sqrtf(om) * ig * xv[k];
                    }
                u32x4 wl, wb;
                wl.x = cvt_pk_bf16(lo[0], lo[1]); wl.y = cvt_pk_bf16(lo[2], lo[3]); wl.z = cvt_pk_bf16(lo[4], lo[5]); wl.w = cvt_pk_bf16(lo[6], lo[7]);
                wb.x = cvt_pk_bf16(bo[0], bo[1]); wb.y = cvt_pk_bf16(bo[2], bo[3]); wb.z = cvt_pk_bf16(bo[4], bo[5]); wb.w = cvt_pk_bf16(bo[6], bo[7]);
                *(u32x4*)(la + (size_t)row * 1024 + d * 512 + w0) = wl; *(u32x4*)(bb + (size_t)row * 1024 + d * 512 + w0) = wb;
            }
    }
};
struct EpiMergeG {
    static constexpr bool PREF = false, PERM = true, I8 = true; typedef gm::AccI AccT; typedef i32x4 AccT_elem; bf16_t* gtmp; const float* mb; const float* hsc; const float* wgs; bool bal; bf16_t* gx;
    template <int BJ> __device__ __forceinline__ void post(gm::AccI& acc, const gm::Unit& u, int wr, int wc, int fr, int fq) {
        const int col0 = u.pn * 256 + wc * 32 + 8 * fq, row0 = u.pm * 256 + wr * 64 + fr, nbr = u.tag;
        const bool ex = bal && u.pm >= 128; bf16_t* go = ex ? gx : gtmp; const int orow0 = ex ? nbr * 512 + row0 - MLAT : row0;
        f32x4 bv[2][2], sv[2][2];
#pragma unroll
        for (int bj = 0; bj < 2; ++bj)
#pragma unroll
            for (int n = 0; n < 2; ++n) { bv[bj][n] = *(const f32x4*)(mb + nbr * DM + col0 + bj * 128 + 4 * n); sv[bj][n] = *(const f32x4*)(wgs + nbr * DM + col0 + bj * 128 + 4 * n); }
        float hsv[8];
#pragma unroll
        for (int i = 0; i < 8; ++i) hsv[i] = hsc[row0 + (i >> 2) * 128 + (i & 3) * 16];
#pragma unroll
        for (int ai = 0; ai < 2; ++ai)
#pragma unroll
            for (int m = 0; m < 4; ++m) { const float hs = hsv[ai * 4 + m];
#pragma unroll
                for (int bj = 0; bj < 2; ++bj) { float g[8];
#pragma unroll
                    for (int n = 0; n < 2; ++n)
#pragma unroll
                        for (int j = 0; j < 4; ++j) g[n * 4 + j] = sigmoidf_((float)acc[ai][bj][m][n][j] * (hs * sv[bj][n][j]) + bv[bj][n][j]);
                    u32x4 w; w.x = cvt_pk_bf16(g[0], g[1]); w.y = cvt_pk_bf16(g[2], g[3]); w.z = cvt_pk_bf16(g[4], g[5]); w.w = cvt_pk_bf16(g[6], g[7]);
                    *(u32x4*)(go + (size_t)(orow0 + ai * 128 + m * 16) * DM + col0 + bj * 128) = w; } }
    }
};
struct EpiMergeY {
    static constexpr bool PREF = false, PERM = true, I8 = false; typedef gm::Acc AccT; typedef f32x4 AccT_elem; bf16_t* mrg; const bf16_t* gtmp; bool bal; const bf16_t* gx; bf16_t* part;
    template <int BJ> __device__ __forceinline__ void post(gm::Acc& acc, const gm::Unit& u, int wr, int wc, int fr, int fq) {
        const int col0 = u.pn * 256 + wc * 32 + 8 * fq, row0 = u.pm * 256 + wr * 64 + fr, nbr = u.tag;
        const bool ex = bal && u.pm >= 128; const bf16_t* gi = ex ? gx : gtmp; bf16_t* mo = ex ? part : mrg; const int orow0 = ex ? nbr * 512 + row0 - MLAT : row0;
        const bool rd = nbr > 0 && !ex;
#pragma unroll
        for (int ai = 0; ai < 2; ++ai) {
            u32x4 gwv[4][2], mwv[4][2];
#pragma unroll
            for (int m = 0; m < 4; ++m)
#pragma unroll
                for (int bj = 0; bj < 2; ++bj) { const size_t off = (size_t)(orow0 + ai * 128 + m * 16) * DM + col0 + bj * 128;
                    gwv[m][bj] = *(const u32x4*)(gi + off); mwv[m][bj] = (u32x4){0u, 0u, 0u, 0u}; if (rd) mwv[m][bj] = *(const u32x4*)(mo + off); }
#pragma unroll
            for (int m = 0; m < 4; ++m)
#pragma unroll
                for (int bj = 0; bj < 2; ++bj) {
                    const size_t off = (size_t)(orow0 + ai * 128 + m * 16) * DM + col0 + bj * 128;
                    const u32x4 gw = gwv[m][bj], mw = mwv[m][bj];
                    const float g[8] = {bflo(gw.x), bfhi(gw.x), bflo(gw.y), bfhi(gw.y), bflo(gw.z), bfhi(gw.z), bflo(gw.w), bfhi(gw.w)};
                    float mm[8] = {bflo(mw.x), bfhi(mw.x), bflo(mw.y), bfhi(mw.y), bflo(mw.z), bfhi(mw.z), bflo(mw.w), bfhi(mw.w)};
#pragma unroll
                    for (int n = 0; n < 2; ++n)
#pragma unroll
                        for (int j = 0; j < 4; ++j) mm[n * 4 + j] += g[n * 4 + j] * acc[ai][bj][m][n][j];
                    u32x4 w; w.x = cvt_pk_bf16(mm[0], mm[1]); w.y = cvt_pk_bf16(mm[2], mm[3]); w.z = cvt_pk_bf16(mm[4], mm[5]); w.w = cvt_pk_bf16(mm[6], mm[7]);
                    *(u32x4*)(mo + off) = w;
                }
        }
    }
};


struct KP { const float* in[30]; float* out; unsigned char* ws; int ph_lo, ph_hi; };
typedef const __attribute__((address_space(4))) KP CKP;
__device__ __forceinline__ LAS unsigned char* lds_here(unsigned char* raw) { unsigned a = (unsigned)(uintptr_t)(LAS unsigned char*)raw; asm volatile("" : "+s"(a)); return (LAS unsigned char*)(uintptr_t)a; }
__device__ __forceinline__ CKP& kp_here() { CKP* q = (CKP*)__builtin_amdgcn_kernarg_segment_ptr(); asm volatile("" : "+s"(q)); return *q; }
enum { I_X = 0, I_C, I_CTX, I_CCTX, I_ADAW, I_ADAB, I_PRE, I_POST, I_WG, I_WU, I_WDN, I_WIN, I_QNORM, I_WUQ, I_KVNORM, I_WUKV, I_CONVW, I_CONVB, I_RGWR, I_RGBR, I_RGWI, I_RGBI, I_RGLAM,
       I_DLAM, I_SUBLN, I_HLB, I_HNORM, I_MB, I_WBR, I_WOUT };

__device__ __forceinline__ void job_mod(CKP& p, LAS unsigned char* lds) {
    LAS float* sl = (LAS float*)lds;
    LAS float* red = (LAS float*)(lds + 24576);
    const int tid = otid(), lane = tid & 63, wave = tid >> 6;
    for (int i = tid; i < 3 * DM; i += NTHR) { const int g = i / DM, k = i % DM; const float c = g < 2 ? p.in[I_C][g * DM + k] : p.in[I_CCTX][k]; sl[i] = siluf_(c); }
    __syncthreads();
    float* mod = (float*)(p.ws + WS_MOD);
    for (int u = obid(); u < NL * 288; u += gridDim.x) {
        const int l = u / 288, col = (u % 288) * 64 + lane;
        const float* w = p.in[I_ADAW] + (size_t)l * DM * (NMOD * DM) + col;
        float a0 = 0.f, a1 = 0.f, a2 = 0.f;
        const int k0 = wave * 256;
#pragma unroll 1
        for (int k1 = k0; k1 < k0 + 256; k1 += 32) { float wv[32];
#pragma unroll
            for (int q = 0; q < 32; ++q) wv[q] = w[(size_t)(k1 + q) * (NMOD * DM)];
            asm volatile("" ::: "memory");
#pragma unroll
            for (int q = 0; q < 32; ++q) { const int k = k1 + q; a0 += sl[k] * wv[q]; a1 += sl[DM + k] * wv[q]; a2 += sl[2 * DM + k] * wv[q]; } }
        red[(wave * 3 + 0) * 64 + lane] = a0; red[(wave * 3 + 1) * 64 + lane] = a1; red[(wave * 3 + 2) * 64 + lane] = a2;
        __syncthreads();
        if (tid < 192) { const int g = tid >> 6; float s = 0.f;
#pragma unroll
            for (int w8 = 0; w8 < 8; ++w8) s += red[(w8 * 3 + g) * 64 + lane];
            mod[(size_t)(l * 3 + g) * (NMOD * DM) + col] = s + p.in[I_ADAB][l * (NMOD * DM) + col]; }
        __syncthreads();
    }
}
__device__ __forceinline__ void job_tables(CKP& p) {
    const int tid = otid();
    if (obid() == 0) {
        float* rope = (float*)(p.ws + WS_ROPE);
        for (int i = tid; i < 4096; i += NTHR) { const int pos = i >> 4, f = i & 15; const float inv = powf(10000.0f, -(float)f / 16.0f); const float ang = (float)pos * inv; float s, c; sincosf(ang, &s, &c); rope[2 * i] = c; rope[2 * i + 1] = s; }
    }
    if (obid() == 1 % gridDim.x) {
        float* sc = (float*)(p.ws + WS_SCAL);
        if (tid < NL) { const float* lv = p.in[I_DLAM] + tid * 256; float s01 = 0.f, s23 = 0.f; for (int i = 0; i < 64; ++i) { s01 += lv[i] * lv[64 + i]; s23 += lv[128 + i] * lv[192 + i]; }
            sc[tid] = expf(s01) - expf(s23) + (0.8f - 0.6f * expf(-0.3f * (float)tid)); }
        for (int k = tid; k < 512; k += NTHR) {
            float mx = -1e30f; for (int l = 0; l < NL; ++l) mx = fmaxf(mx, p.in[I_HLB][l * 512 + k]);
            float den = 0.f; for (int l = 0; l < NL; ++l) den += expf(p.in[I_HLB][l * 512 + k] - mx);
            float cum = 0.f; for (int l = 0; l < NL; ++l) { if (l > 0) cum += expf(p.in[I_HLB][l * 512 + k] - mx) / den; sc[256 + l * 512 + k] = cum; }
        }
        for (int i = tid; i < NL * 1024; i += NTHR) { const float x = -p.in[I_RGLAM][i]; sc[2048 + i] = fmaxf(x, 0.f) + log1pf(expf(-fabsf(x))); }
    }
}

__device__ __forceinline__ void job_colmax(CKP& p) {
    unsigned* cmax = (unsigned*)(p.ws + WS_CMAX);
    const int tid = otid(), c4 = (tid & 63) * 4, wv = tid >> 6;
    for (int u = obid(); u < NL * 2 * 2 * 22 * 4; u += gridDim.x) {
        const int kc = u & 3, cb = (u >> 2) % 22, mat = u / (4 * 22), which = mat & 1, lf = mat >> 1;
        const float* w = (which ? p.in[I_WU] : p.in[I_WG]) + (size_t)lf * DM * DFF + (size_t)(kc * 512 + wv * 64) * DFF + cb * 256 + c4;
        u32x4 mx = {0u, 0u, 0u, 0u};
#pragma unroll 1
        for (int k0 = 0; k0 < 64; k0 += 16) { u32x4 v[16];
#pragma unroll
            for (int k = 0; k < 16; ++k) v[k] = *(const u32x4*)(w + (size_t)(k0 + k) * DFF);
            asm volatile("" ::: "memory");
#pragma unroll
            for (int k = 0; k < 16; ++k) { mx.x = max(mx.x, v[k].x & 0x7fffffffu); mx.y = max(mx.y, v[k].y & 0x7fffffffu); mx.z = max(mx.z, v[k].z & 0x7fffffffu); mx.w = max(mx.w, v[k].w & 0x7fffffffu); } }
        unsigned* dst = cmax + (size_t)(lf * 2 + which) * DFF + cb * 256 + c4;
        atomicMax(dst, mx.x); atomicMax(dst + 1, mx.y); atomicMax(dst + 2, mx.z); atomicMax(dst + 3, mx.w);
    }
    unsigned* cmax2 = (unsigned*)(p.ws + WS_CMAX2);
    for (int u = obid(); u < NL * 56 * 4; u += gridDim.x) {
        const int kc = u & 3, cb = (u >> 2) % 56, l = u / (4 * 56), cc = cb * 256 + c4;
        if (cc < DIN) {
            const float* w = p.in[I_WIN] + (size_t)l * DM * DIN + (size_t)(kc * 512 + wv * 64) * DIN + cc;
            u32x4 mx = {0u, 0u, 0u, 0u};
#pragma unroll 1
            for (int k0 = 0; k0 < 64; k0 += 16) { u32x4 v[16];
#pragma unroll
                for (int k = 0; k < 16; ++k) v[k] = *(const u32x4*)(w + (size_t)(k0 + k) * DIN);
                asm volatile("" ::: "memory");
#pragma unroll
                for (int k = 0; k < 16; ++k) { mx.x = max(mx.x, v[k].x & 0x7fffffffu); mx.y = max(mx.y, v[k].y & 0x7fffffffu); mx.z = max(mx.z, v[k].z & 0x7fffffffu); mx.w = max(mx.w, v[k].w & 0x7fffffffu); } }
            unsigned* dst = cmax2 + (size_t)l * 14336 + cc;
            atomicMax(dst, mx.x); atomicMax(dst + 1, mx.y); atomicMax(dst + 2, mx.z); atomicMax(dst + 3, mx.w);
        }
    }
}
struct CvtDesc { const float* src; const float* ks; bf16_t* dst; int ldsrc, c0, k0, lddst, n0; const unsigned* q8max; float* q8scale; };
__device__ __forceinline__ void cvt_load(const CvtDesc& d, int tid, f32x4 (&v)[2]) {
    const int r = tid >> 4, c4 = (tid & 15) * 4;
#pragma unroll
    for (int ps = 0; ps < 2; ++ps) { const int k = r + 32 * ps; v[ps] = (f32x4){0.f, 0.f, 0.f, 0.f};
        if (d.src) { v[ps] = *(const f32x4*)(d.src + (size_t)(d.k0 + k) * d.ldsrc + d.c0 + c4); if (d.ks) v[ps] = v[ps] * d.ks[d.k0 + k]; } }
}
__device__ __forceinline__ void cvt_store(LAS float* tile, const CvtDesc& d, int tid, const f32x4 (&v)[2]) {
    { const int r = tid >> 4, c4 = (tid & 15) * 4;
#pragma unroll
      for (int ps = 0; ps < 2; ++ps) { const int k = r + 32 * ps; tile[k * 65 + c4 + 0] = v[ps][0]; tile[k * 65 + c4 + 1] = v[ps][1]; tile[k * 65 + c4 + 2] = v[ps][2]; tile[k * 65 + c4 + 3] = v[ps][3]; } }
    __syncthreads();
    { const int n = tid >> 3, k8 = (tid & 7) * 8; float x[8];
#pragma unroll
      for (int i = 0; i < 8; ++i) x[i] = tile[(k8 + i) * 65 + n];
      if (d.q8max) {
          const float mx = fmaxf(__uint_as_float(d.q8max[n]), 1e-30f), inv = 127.0f / mx;
          int q[8];
#pragma unroll
          for (int i = 0; i < 8; ++i) q[i] = (int)rintf(x[i] * inv) & 0xff;
          u32x2 w; w.x = (unsigned)q[0] | ((unsigned)q[1] << 8) | ((unsigned)q[2] << 16) | ((unsigned)q[3] << 24); w.y = (unsigned)q[4] | ((unsigned)q[5] << 8) | ((unsigned)q[6] << 16) | ((unsigned)q[7] << 24);
          *(u32x2*)((signed char*)d.dst + (size_t)(d.n0 + n) * d.lddst + d.k0 + k8) = w;
          if (d.k0 == 0 && k8 == 0) d.q8scale[n] = mx * (1.0f / 127.0f);
      } else {
          u32x4 w; w.x = cvt_pk_bf16(x[0], x[1]); w.y = cvt_pk_bf16(x[2], x[3]); w.z = cvt_pk_bf16(x[4], x[5]); w.w = cvt_pk_bf16(x[6], x[7]);
          *(u32x4*)(d.dst + (size_t)(d.n0 + n) * d.lddst + d.k0 + k8) = w; } }
    __syncthreads();
}
constexpr int CV_N0 = 2 * 176 * 32, CV_N1 = 2 * 32 * 88, CV_N2 = 224 * 32, CV_N3 = 12 * 8, CV_N4 = 16 * 4, CV_N5 = 4 * 32 * 8, CV_N6 = 32 * 32, CV_N7 = 1024;
constexpr int CV_BLOCKS = CV_N0 + CV_N1 + CV_N2 + CV_N3 + CV_N4 + CV_N5 + CV_N6;
__device__ __forceinline__ CvtDesc cvt_desc(CKP& p, int l, int b) {
    unsigned char* ws = p.ws; CvtDesc d; d.ks = nullptr; d.q8max = nullptr; d.q8scale = nullptr;
    if (b < CV_N0) { const int f = b / (176 * 32), rem = b % (176 * 32), nb = rem / 32, kb = rem % 32, t = nb >> 2, q = nb & 3;
        d.src = (q < 2 ? p.in[I_WG] : p.in[I_WU]) + (size_t)(l * 2 + f) * DM * DFF; d.ldsrc = DFF; d.c0 = 128 * t + (q & 1) * 64; d.k0 = kb * 64; d.dst = (bf16_t*)(ws + WS_WGU + (size_t)f * 11264 * 2048); d.lddst = 2048; d.n0 = nb * 64;
        d.q8max = (const unsigned*)(ws + WS_CMAX) + (size_t)((l * 2 + f) * 2 + (q < 2 ? 0 : 1)) * DFF + d.c0; d.q8scale = (float*)(ws + WS_WSC) + (size_t)f * 11264 + d.n0; return d; }
    b -= CV_N0;
    if (b < CV_N1) { const int f = b / (32 * 88), rem = b % (32 * 88), nb = rem / 88, kb = rem % 88;
        d.src = p.in[I_WDN] + (size_t)(l * 2 + f) * DFF * DM; d.ldsrc = DM; d.c0 = nb * 64; d.k0 = kb * 64; d.dst = (bf16_t*)(ws + WS_WD) + (size_t)f * 2048 * 5632; d.lddst = 5632; d.n0 = nb * 64; return d; }
    b -= CV_N1;
    if (b < CV_N2) { const int nb = b / 32, kb = b % 32, j0 = nb * 64; int sc;
        if (j0 < 512) sc = j0; else if (j0 < 5632) sc = 832 + (j0 - 512); else if (j0 < 5888) sc = 512 + (j0 - 5632); else if (j0 < 5952) sc = 768 + (j0 - 5888); else if (j0 < 6144) sc = -1; else sc = 5952 + (j0 - 6144);
        d.src = sc < 0 ? nullptr : p.in[I_WIN] + (size_t)l * DM * DIN; d.ldsrc = DIN; d.c0 = sc < 0 ? 0 : sc; d.k0 = kb * 64; d.dst = (bf16_t*)(ws + WS_WIN); d.lddst = 2048; d.n0 = j0;
        d.q8max = (const unsigned*)(ws + WS_CMAX2) + (size_t)l * 14336 + (sc < 0 ? DIN : sc);
        d.q8scale = j0 < 6144 ? (float*)(ws + WS_WPS) + j0 : (float*)(ws + WS_WGS) + (j0 - 6144);
        return d; }
    b -= CV_N2;
    if (b < CV_N3) { const int nb = b / 8, kb = b % 8;
        d.src = p.in[I_WUQ] + (size_t)l * 512 * 768; d.ldsrc = 768; d.c0 = nb * 64; d.k0 = kb * 64; d.ks = p.in[I_QNORM] + l * 512; d.dst = (bf16_t*)(ws + WS_WUQ); d.lddst = 512; d.n0 = nb * 64; return d; }
    b -= CV_N3;
    if (b < CV_N4) { const int nb = b / 4, kb = b % 4;
        d.src = p.in[I_WUKV] + (size_t)l * 256 * 1024; d.ldsrc = 1024; d.c0 = nb * 64; d.k0 = kb * 64; d.ks = p.in[I_KVNORM] + l * 256; d.dst = (bf16_t*)(ws + WS_WUKV); d.lddst = 256; d.n0 = nb * 64; return d; }
    b -= CV_N4;
    if (b < CV_N5) { const int n = b / 256, rem = b % 256, nb = rem / 8, kb = rem % 8;
        d.src = p.in[I_WBR] + (size_t)(l * 4 + n) * 512 * DM; d.ldsrc = DM; d.c0 = nb * 64; d.k0 = kb * 64; d.dst = (bf16_t*)(ws + WS_WBR) + (size_t)n * 2048 * 512; d.lddst = 512; d.n0 = nb * 64; return d; }
    b -= CV_N5;
    { const int nb = b / 32, kb = b % 32;
        d.src = p.in[I_WOUT] + (size_t)l * DM * DM; d.ldsrc = DM; d.c0 = nb * 64; d.k0 = kb * 64; d.dst = (bf16_t*)(ws + WS_WOUT); d.lddst = 2048; d.n0 = nb * 64; return d; }
}
__device__ __forceinline__ void job_convert(CKP& p, LAS unsigned char* lds, int l) {
    LAS float* tile = (LAS float*)lds;
    const int tid = otid();
    {
        int u = obid();
        if (u < CV_BLOCKS) {
            f32x4 vc[2]; { const CvtDesc d0 = cvt_desc(p, l, u); cvt_load(d0, tid, vc); }
            for (;;) {
                const int un = u + gridDim.x; const bool more = un < CV_BLOCKS;
                f32x4 vn[2] = {vc[0], vc[1]};
                if (more) { const CvtDesc dn = cvt_desc(p, l, un); cvt_load(dn, tid, vn); }
                { const CvtDesc dc = cvt_desc(p, l, u); cvt_store(tile, dc, tid, vc); }
                if (!more) break;
                vc[0] = vn[0]; vc[1] = vn[1]; u = un;
            }
        }
    }
    for (int b = obid(); b < CV_N7; b += gridDim.x) {
        bf16_t* dst = (bf16_t*)(p.ws + WS_WRG);
#pragma unroll
        for (int e = 0; e < 2; ++e) { const int idx = b * 1024 + e * 512 + tid, o = idx >> 9, k = idx & 511;
            const int t8 = o >> 8, d = t8 >> 2, blk = t8 & 3, g = (o >> 7) & 1, i = o & 127, kin = k - blk * 128;
            float v = 0.f; if (kin >= 0 && kin < 128) v = (g ? p.in[I_RGWI] : p.in[I_RGWR])[((size_t)((l * 2 + d) * 4 + blk) * 128 + kin) * 128 + i];
            dst[idx] = f2bf(v); }
    }
}

struct RNArgs {
    const float* xs_lat; const float* xs_ctx; float* xd_lat; float* xd_ctx;
    const bf16_t* y; float wres;
    const float* modl_res; int jres; const float* postg;
    bool do_norm; const float* modl_norm; int jn; const float* preg; bf16_t* h; int nrows; signed char* h8; float* hsc;
};
__device__ __forceinline__ void job_resnorm(const RNArgs& a, LAS unsigned char* lds) {
    const int tid_ = otid(); const int lane = tid_ & 63, gw = obid() * 8 + (tid_ >> 6), nw = gridDim.x * 8;
    LAS float* PA = (LAS float*)lds; LAS float* PB = PA + 3 * DM; LAS float* PC = PB + 3 * DM;
    for (int i = tid_; i < 3 * DM; i += NTHR) { const int g = i / DM, c = i % DM;
        if (a.y) PA[i] = a.modl_res[(size_t)g * (NMOD * DM) + (3 * a.jres + 2) * DM + c] * a.postg[c];
        if (a.do_norm) { const float* sh = a.modl_norm + (size_t)g * (NMOD * DM) + (3 * a.jn) * DM; PB[i] = a.preg[c] * (sh[DM + c] + 1.0f); PC[i] = sh[c]; } }
    __syncthreads();
    f32x4 xq[8]; u32x2 yq[8];
#define RN_LOAD(R, X, Y) do { const int r_ = (R); const float* xs_ = r_ < MLAT ? a.xs_lat + (size_t)r_ * DM : a.xs_ctx + (size_t)(r_ - MLAT) * DM; \
        _Pragma("unroll") for (int i = 0; i < 8; ++i) X[i] = *(const f32x4*)(xs_ + i * 256 + lane * 4); \
        if (a.y) { _Pragma("unroll") for (int i = 0; i < 8; ++i) Y[i] = *(const u32x2*)(a.y + (size_t)r_ * DM + i * 256 + lane * 4); } } while (0)
    if (gw < a.nrows) RN_LOAD(gw, xq, yq);
    for (int r = gw; r < a.nrows; r += nw) {
        const int g = r < SEQ ? 0 : (r < MLAT ? 1 : 2); const bool lat = r < MLAT;
        f32x4 x[8]; u32x2 yr[8];
#pragma unroll
        for (int i = 0; i < 8; ++i) { x[i] = xq[i]; yr[i] = yq[i]; }
        RN_LOAD(r + nw < a.nrows ? r + nw : r, xq, yq);
        if (a.y) {
            f32x4 yv[8]; float ss = 0.f;
#pragma unroll
            for (int i = 0; i < 8; ++i) { const u32x2 w = yr[i]; yv[i] = (f32x4){bflo(w.x), bfhi(w.x), bflo(w.y), bfhi(w.y)}; ss += yv[i][0] * yv[i][0] + yv[i][1] * yv[i][1] + yv[i][2] * yv[i][2] + yv[i][3] * yv[i][3]; }
            ss = wave_sum(ss, lane);
            const float rr = a.wres * rsqrtf(ss * (1.0f / DM) + EPS);
            float* xd = lat ? a.xd_lat + (size_t)r * DM : a.xd_ctx + (size_t)(r - MLAT) * DM;
#pragma unroll
            for (int i = 0; i < 8; ++i) { const int c = i * 256 + lane * 4; const f32x4 gp = *(const LAS f32x4*)(PA + g * DM + c);
                x[i] = x[i] + gp * (yv[i] * rr); *(f32x4*)(xd + c) = x[i]; }
        }
        if (a.do_norm) {
            float ss = 0.f;
#pragma unroll
            for (int i = 0; i < 8; ++i) ss += x[i][0] * x[i][0] + x[i][1] * x[i][1] + x[i][2] * x[i][2] + x[i][3] * x[i][3];
            ss = wave_sum(ss, lane);
            const float rr = rsqrtf(ss * (1.0f / DM) + EPS);
            float mx = 0.f;
#pragma unroll
            for (int i = 0; i < 8; ++i) { const int c = i * 256 + lane * 4; const f32x4 ps = *(const LAS f32x4*)(PB + g * DM + c), hv = *(const LAS f32x4*)(PC + g * DM + c);
                x[i] = (x[i] * rr) * ps + hv; mx = fmaxf(mx, fmaxf(fmaxf(fabsf(x[i][0]), fabsf(x[i][1])), fmaxf(fabsf(x[i][2]), fabsf(x[i][3]))));
                if (a.h) { u32x2 w; w.x = cvt_pk_bf16(x[i][0], x[i][1]); w.y = cvt_pk_bf16(x[i][2], x[i][3]); *(u32x2*)(a.h + (size_t)r * DM + c) = w; } }
            if (a.h8) {
#pragma unroll
                for (int o = 32; o >= 1; o >>= 1) mx = fmaxf(mx, shx(mx, o, lane));
                mx = fmaxf(mx, 1e-30f); const float inv = 127.0f / mx;
                if (lane == 0) a.hsc[r] = mx * (1.0f / 127.0f);
#pragma unroll
                for (int i = 0; i < 8; ++i) { const unsigned q0 = (unsigned)((int)rintf(x[i][0] * inv) & 0xff), q1 = (unsigned)((int)rintf(x[i][1] * inv) & 0xff), q2 = (unsigned)((int)rintf(x[i][2] * inv) & 0xff), q3 = (unsigned)((int)rintf(x[i][3] * inv) & 0xff);
                    *(unsigned*)(a.h8 + (size_t)r * DM + i * 256 + lane * 4) = q0 | (q1 << 8) | (q2 << 16) | (q3 << 24); }
            }
        }
    }
    __syncthreads();
#undef RN_LOAD
}

__device__ __forceinline__ void job_stats_conv(CKP& p, int l) {
    const bf16_t* ubuf = (const bf16_t*)(p.ws + WS_R1); float* rsq = (float*)(p.ws + WS_RSQ); float* rsk = rsq + MALL; bf16_t* xcv = (bf16_t*)(p.ws + WS_XCV);
    const int tid_ = otid(); const int lane = tid_ & 63, gw = obid() * 8 + (tid_ >> 6), nw = gridDim.x * 8;
    float cw[4][8], cb[8];
#pragma unroll
    for (int j = 0; j < 4; ++j)
#pragma unroll
        for (int i = 0; i < 8; ++i) cw[j][i] = p.in[I_CONVW][(l * 4 + j) * 512 + lane * 8 + i];
#pragma unroll
    for (int i = 0; i < 8; ++i) cb[i] = p.in[I_CONVB][l * 512 + lane * 8 + i];
    for (int r = gw; r < MALL; r += nw) {
        const bf16_t* ur = ubuf + (size_t)r * NU;
        const bool lat = r < MLAT; const int s = lat ? (r & (SEQ - 1)) : ((r - MLAT) & (CTXL - 1)), len = lat ? SEQ : CTXL;
        const u32x4 w = *(const u32x4*)(ur + U_AQ + lane * 8); const u32x4 w2 = *(const u32x4*)(ur + U_AKV + (lane & 31) * 8);
        u32x4 wt[4]; float okf[4];
#pragma unroll
        for (int j = 0; j < 4; ++j) { const int sj = s + j - 2; const bool ok = sj >= 0 && sj < len; okf[j] = ok ? 1.0f : 0.0f;
            wt[j] = *(const u32x4*)(ur + (ptrdiff_t)(ok ? j - 2 : 0) * NU + U_BX + lane * 8); }
        asm volatile("" ::: "memory");
        {
            float ss = 0.f;
            { const float v[8] = {bflo(w.x), bfhi(w.x), bflo(w.y), bfhi(w.y), bflo(w.z), bfhi(w.z), bflo(w.w), bfhi(w.w)};
#pragma unroll
              for (int i = 0; i < 8; ++i) ss += v[i] * v[i]; }
            ss = wave_sum(ss, lane);
            float s2 = 0.f;
            { const float v[8] = {bflo(w2.x), bfhi(w2.x), bflo(w2.y), bfhi(w2.y), bflo(w2.z), bfhi(w2.z), bflo(w2.w), bfhi(w2.w)};
#pragma unroll
              for (int i = 0; i < 8; ++i) s2 += v[i] * v[i]; }
            s2 = lane < 32 ? s2 : 0.f;
            s2 = wave_sum(s2, lane);
            if (lane == 0) { rsq[r] = rsqrtf(ss * (1.0f / 512.0f) + EPS); rsk[r] = rsqrtf(s2 * (1.0f / 256.0f) + EPS); }
        }
        {
            float acc[8];
#pragma unroll
            for (int i = 0; i < 8; ++i) acc[i] = cb[i];
#pragma unroll
            for (int j = 0; j < 4; ++j) { const u32x4 wj = wt[j];
                const float v[8] = {bflo(wj.x), bfhi(wj.x), bflo(wj.y), bfhi(wj.y), bflo(wj.z), bfhi(wj.z), bflo(wj.w), bfhi(wj.w)};
#pragma unroll
                for (int i = 0; i < 8; ++i) acc[i] += (cw[j][i] * okf[j]) * v[i]; }
            u32x4 o; o.x = cvt_pk_bf16(acc[0], acc[1]); o.y = cvt_pk_bf16(acc[2], acc[3]); o.z = cvt_pk_bf16(acc[4], acc[5]); o.w = cvt_pk_bf16(acc[6], acc[7]);
            *(u32x4*)(xcv + (size_t)r * 512 + lane * 8) = o;
        }
    }
}

__device__ __forceinline__ void job_rg_scan1(CKP& p) {
    const bf16_t* la = (const bf16_t*)(p.ws + WS_LA); const bf16_t* bb = (const bf16_t*)(p.ws + WS_BB); f32x2* rgs = (f32x2*)(p.ws + WS_RGS);
    const int w = otid();
    for (int u = obid(); u < NRT * 2; u += gridDim.x) {
        const int pm = u >> 1, d = u & 1;
        const bf16_t* lp = la + (size_t)pm * 256 * 1024 + d * 512 + w; const bf16_t* bp = bb + (size_t)pm * 256 * 1024 + d * 512 + w;
        float H = 0.f, sl = 0.f;
#pragma unroll 1
        for (int i0 = 0; i0 < 256; i0 += 32) { bf16_t lr[32], br[32];
#pragma unroll
            for (int q = 0; q < 32; ++q) { const int t = d ? 255 - (i0 + q) : i0 + q; lr[q] = lp[(size_t)t * 1024]; br[q] = bp[(size_t)t * 1024]; }
            asm volatile("" ::: "memory");
#pragma unroll
            for (int q = 0; q < 32; ++q) { const float lv = bf2f(lr[q]); H = __expf(lv) * H + bf2f(br[q]); sl += lv; } }
        rgs[(size_t)u * 512 + w] = (f32x2){__expf(sl), H};
    }
}
__device__ __forceinline__ void job_rg_out(CKP& p, int ntiles) {
    const bf16_t* la = (const bf16_t*)(p.ws + WS_LA); const bf16_t* bb = (const bf16_t*)(p.ws + WS_BB); const f32x2* rgs = (const f32x2*)(p.ws + WS_RGS);
    bf16_t* hf = (bf16_t*)(p.ws + WS_XCV); const bf16_t* ubuf = (const bf16_t*)(p.ws + WS_R1); bf16_t* yb = (bf16_t*)(p.ws + WS_YBR) + (size_t)1 * MALL * 512;
    const int w = otid();
    for (int u = obid(); u < ntiles; u += gridDim.x) {
        const int pm = (int)gridDim.x > ntiles ? u : u;
        const bool isctx = pm >= 128; const int b = isctx ? pm - 128 : (pm >> 6);
        float h = 0.f;
        if (!isctx) { h = rgs[(size_t)((128 + b) * 2 + 0) * 512 + w][1];
#pragma unroll 8
            for (int q = b * 64; q < pm; ++q) { const f32x2 s = rgs[(size_t)(q * 2 + 0) * 512 + w]; h = s[0] * h + s[1]; } }
        const size_t r0 = (size_t)pm * 256;
#pragma unroll 1
        for (int t0 = 0; t0 < 256; t0 += 32) { bf16_t lr[32], br[32];
#pragma unroll
            for (int k = 0; k < 32; ++k) { lr[k] = la[(r0 + t0 + k) * 1024 + w]; br[k] = bb[(r0 + t0 + k) * 1024 + w]; }
#pragma unroll
            for (int k = 0; k < 32; ++k) { h = __expf(bf2f(lr[k])) * h + bf2f(br[k]); hf[(r0 + t0 + k) * 512 + w] = f2bf(h); } }
        float hb = 0.f;
        if (!isctx) { hb = rgs[(size_t)((128 + b) * 2 + 1) * 512 + w][1];
#pragma unroll 8
            for (int q = b * 64 + 63; q > pm; --q) { const f32x2 s = rgs[(size_t)(q * 2 + 1) * 512 + w]; hb = s[0] * hb + s[1]; } }
#pragma unroll 1
        for (int i0 = 0; i0 < 256; i0 += 32) { bf16_t lr[32], br[32], gr[32], fr[32];
#pragma unroll
            for (int k = 0; k < 32; ++k) { const size_t t = r0 + 255 - i0 - k; lr[k] = la[t * 1024 + 512 + w]; br[k] = bb[t * 1024 + 512 + w]; gr[k] = ubuf[t * NU + U_BG + w]; fr[k] = hf[t * 512 + w]; }
#pragma unroll
            for (int k = 0; k < 32; ++k) { const size_t t = r0 + 255 - i0 - k; hb = __expf(bf2f(lr[k])) * hb + bf2f(br[k]); yb[t * 512 + w] = f2bf((bf2f(fr[k]) + hb) * gelu_tanh(bf2f(gr[k]))); } }
    }
}

namespace at {
constexpr float THR2 = 8.f * 1.4426950408889634f;
__device__ __forceinline__ int crow(int r, int hi) { return (r & 3) + 8 * (r >> 2) + 4 * hi; }
__device__ __forceinline__ unsigned cvtpk(float lo, float hi) { return cvt_pk_bf16(lo, hi); }
__device__ __forceinline__ int v_rd_base(int lane) { return ((lane & 3) << 3) | (((lane >> 2) & 3) << 6) | (((lane >> 4) & 1) << 5) | (((lane >> 5) & 1) << 8); }
constexpr int v_rd_off(int d0, int ks, int half) { return d0 * 512 + ks * 4096 + half * 2048; }
template <int OFF> __device__ __forceinline__ s16x4 tr_read(unsigned vb) { s16x4 r; asm volatile("ds_read_b64_tr_b16 %0, %1 offset:%2" : "=&v"(r) : "v"(vb), "i"(OFF) : "memory"); return r; }
template <int D0> __device__ __forceinline__ void pv_one(f32x16& od, unsigned vb, bf16x8 pa0, bf16x8 pa1, bf16x8 pa2, bf16x8 pa3) {
    const s16x4 l0 = tr_read<v_rd_off(D0, 0, 0)>(vb), h0 = tr_read<v_rd_off(D0, 0, 1)>(vb), l1 = tr_read<v_rd_off(D0, 1, 0)>(vb), h1 = tr_read<v_rd_off(D0, 1, 1)>(vb);
    const s16x4 l2 = tr_read<v_rd_off(D0, 2, 0)>(vb), h2 = tr_read<v_rd_off(D0, 2, 1)>(vb), l3 = tr_read<v_rd_off(D0, 3, 0)>(vb), h3 = tr_read<v_rd_off(D0, 3, 1)>(vb);
    asm volatile("s_waitcnt lgkmcnt(0)" ::: "memory"); __builtin_amdgcn_sched_barrier(0);
#define AT_PK(L, H) (bf16x8){L[0], L[1], L[2], L[3], H[0], H[1], H[2], H[3]}
    od = __builtin_amdgcn_mfma_f32_32x32x16_bf16(pa0, AT_PK(l0, h0), od, 0, 0, 0);
    od = __builtin_amdgcn_mfma_f32_32x32x16_bf16(pa1, AT_PK(l1, h1), od, 0, 0, 0);
    od = __builtin_amdgcn_mfma_f32_32x32x16_bf16(pa2, AT_PK(l2, h2), od, 0, 0, 0);
    od = __builtin_amdgcn_mfma_f32_32x32x16_bf16(pa3, AT_PK(l3, h3), od, 0, 0, 0);
#undef AT_PK
}
struct VFrag { s16x4 l[4], h[4]; };
template <int D0> __device__ __forceinline__ void rd_v(VFrag& f, const LAS unsigned char* vbp) {
#pragma unroll
    for (int ks = 0; ks < 4; ++ks) {
        f.l[ks] = __builtin_amdgcn_ds_read_tr16_b64_v4i16((LAS s16x4*)(vbp + v_rd_off(D0, ks, 0)));
        f.h[ks] = __builtin_amdgcn_ds_read_tr16_b64_v4i16((LAS s16x4*)(vbp + v_rd_off(D0, ks, 1))); }
}
__device__ __forceinline__ void mm_pv(f32x16& od, const VFrag& f, bf16x8 pa0, bf16x8 pa1, bf16x8 pa2, bf16x8 pa3) {
#define AT_PK(L, H) (bf16x8){L[0], L[1], L[2], L[3], H[0], H[1], H[2], H[3]}
    od = __builtin_amdgcn_mfma_f32_32x32x16_bf16(pa0, AT_PK(f.l[0], f.h[0]), od, 0, 0, 0);
    od = __builtin_amdgcn_mfma_f32_32x32x16_bf16(pa1, AT_PK(f.l[1], f.h[1]), od, 0, 0, 0);
    od = __builtin_amdgcn_mfma_f32_32x32x16_bf16(pa2, AT_PK(f.l[2], f.h[2]), od, 0, 0, 0);
    od = __builtin_amdgcn_mfma_f32_32x32x16_bf16(pa3, AT_PK(f.l[3], f.h[3]), od, 0, 0, 0);
#undef AT_PK
}
__device__ __forceinline__ f32x16 mfma_srcc(bf16x8 a, bf16x8 b, const f32x16& c) { f32x16 d; asm("v_mfma_f32_32x32x16_bf16 %0, %1, %2, %3" : "=&v"(d) : "v"(a), "v"(b), "v"(c)); return d; }
struct KeyMap { int ctx_row0, lat_row0, nctx, nt; __device__ __forceinline__ int row(int j) const { return j < nctx ? ctx_row0 + 64 * j : lat_row0 + 64 * (j - nctx); } };

template <int DQK>
__device__ __forceinline__ void attn_body(LAS unsigned char* lds, const bf16_t* Qg, int ldq, int q0, const bf16_t* Kg, int ldk, const bf16_t* Vg, int ldv, const KeyMap km,
                                          f32x16 (&o)[4], float& l_out) {
    constexpr int RB = DQK * 2, CPR = RB / 16, NKI = 64 * RB / 8192, KBYTES = 64 * RB, VOFF = 3 * KBYTES, SCR = VOFF + 4 * 16384, ND0 = DQK / 16;
    static_assert(SCR + 2048 <= LDS_MISC, "attention LDS");
    const int tid = otid(), wid = __builtin_amdgcn_readfirstlane(tid >> 6), lane = tid & 63, r32 = lane & 31, hi = lane >> 5, half = wid >> 2;
    LAS float* wsl = (LAS float*)(lds + SCR) + wid * 64; LAS float* al_l = wsl;
    unsigned koff[NKI], voff[2];
#pragma unroll
    for (int i = 0; i < NKI; ++i) { const int q = i * 512 + wid * 64 + lane, row = q / CPR, cp = q % CPR, ch = cp ^ ((row >> 1) & 7); koff[i] = (unsigned)row * (unsigned)(ldk * 2) + (unsigned)ch * 16u; }
#pragma unroll
    for (int i = 0; i < 2; ++i) { const int q = i * 512 + wid * 64 + lane, sub = q >> 5, wi = q & 31, k = (sub >> 2) * 8 + (wi >> 2), c = (sub & 3) * 32 + (wi & 3) * 8;
        voff[i] = (unsigned)k * (unsigned)(ldv * 2) + (unsigned)c * 2u; }
    const int NT = km.nt;
#define AT_ISSUE(j, sk, sv) do { const int _j = (j) < NT ? (j) : NT - 1; const int _kr = km.row(_j); const char* _kb = (const char*)Kg + (size_t)_kr * ldk * 2; const char* _vb = (const char*)Vg + (size_t)_kr * ldv * 2; \
        _Pragma("unroll") for (int _i = 0; _i < NKI; ++_i) __builtin_amdgcn_global_load_lds((const unsigned*)(_kb + koff[_i]), (LAS unsigned*)(lds + (sk) * KBYTES + _i * 8192 + wid * 1024), 16, 0, 0); \
        _Pragma("unroll") for (int _i = 0; _i < 2; ++_i) __builtin_amdgcn_global_load_lds((const unsigned*)(_vb + voff[_i]), (LAS unsigned*)(lds + VOFF + (sv) * 16384 + _i * 8192 + wid * 1024), 16, 0, 0); } while (0)
    bf16x8 qr[ND0];
    { const bf16_t* Qw = Qg + (size_t)(q0 + wid * 32 + r32) * ldq + hi * 8;
#pragma unroll
      for (int d0 = 0; d0 < ND0; ++d0) qr[d0] = *(const bf16x8*)(Qw + d0 * 16); }
    float m_reg = 0.f, l_reg = 0.f;
    f32x16 cm;
#pragma unroll
    for (int r = 0; r < 16; ++r) cm[r] = 0.f;
#pragma unroll
    for (int d = 0; d < 4; ++d)
#pragma unroll
        for (int r = 0; r < 16; ++r) o[d][r] = 0.f;
    const unsigned ksw = (unsigned)((r32 >> 1) & 7), kb0 = (unsigned)r32 * RB, vrb = (unsigned)v_rd_base(lane);
    bf16x8 pa0, pa1, pa2, pa3;
#define AT_PV(sv) do { const unsigned vb = (unsigned)(uintptr_t)(lds + VOFF + (sv) * 16384) + vrb; \
        pv_one<0>(o[0], vb, pa0, pa1, pa2, pa3); pv_one<1>(o[1], vb, pa0, pa1, pa2, pa3); pv_one<2>(o[2], vb, pa0, pa1, pa2, pa3); pv_one<3>(o[3], vb, pa0, pa1, pa2, pa3); } while (0)
    AT_ISSUE(0, 0, 0); AT_ISSUE(1, 1, 1);
    if constexpr (NKI == 3) asm volatile("s_waitcnt vmcnt(5)" ::: "memory"); else asm volatile("s_waitcnt vmcnt(3)" ::: "memory");
    if (half) { __builtin_amdgcn_s_barrier(); }
    int sk = 0, sv = 0;
    for (int j = 0; j < NT; ++j) {
        __builtin_amdgcn_s_barrier(); asm volatile("" ::: "memory");
        __builtin_amdgcn_s_setprio(1);
#define AT_SB __builtin_amdgcn_sched_barrier(0)
#define AT_RK(d0, KF) do { const unsigned cb = (((unsigned)(2 * (d0) + hi)) ^ ksw) << 4; KF[0] = *(const LAS bf16x8*)(Ks + cb); KF[1] = *(const LAS bf16x8*)(Ks + 32 * RB + cb); } while (0)
        const LAS unsigned char* Ks = lds + sk * KBYTES + kb0;
        bf16x8 kf[2][2];
        if (j > 0) {
            const LAS unsigned char* vbp = lds + VOFF + ((sv + 3) & 3) * 16384 + vrb;
            VFrag fa, fb;
            rd_v<0>(fa, vbp); rd_v<1>(fb, vbp); AT_SB;
            mm_pv(o[0], fa, pa0, pa1, pa2, pa3); AT_SB;
            rd_v<2>(fa, vbp); AT_SB;
            mm_pv(o[1], fb, pa0, pa1, pa2, pa3); AT_SB;
            rd_v<3>(fb, vbp); AT_SB;
            mm_pv(o[2], fa, pa0, pa1, pa2, pa3); AT_SB;
            AT_RK(0, kf[0]); AT_SB;
            mm_pv(o[3], fb, pa0, pa1, pa2, pa3); AT_SB;
        } else { AT_RK(0, kf[0]); AT_SB; }
        f32x16 p0, p1;
        AT_RK(1, kf[1]); AT_SB;
        p0 = mfma_srcc(kf[0][0], qr[0], cm); p1 = mfma_srcc(kf[0][1], qr[0], cm); AT_SB;
#pragma unroll
        for (int d0 = 1; d0 < ND0; ++d0) {
            if (d0 + 1 < ND0) { AT_RK(d0 + 1, kf[(d0 + 1) & 1]); AT_SB; }
            p0 = __builtin_amdgcn_mfma_f32_32x32x16_bf16(kf[d0 & 1][0], qr[d0], p0, 0, 0, 0);
            p1 = __builtin_amdgcn_mfma_f32_32x32x16_bf16(kf[d0 & 1][1], qr[d0], p1, 0, 0, 0); AT_SB;
        }
#undef AT_RK
#undef AT_SB
        asm volatile("s_waitcnt vmcnt(0)" ::: "memory");
        __builtin_amdgcn_s_setprio(0);
        __builtin_amdgcn_s_barrier(); asm volatile("" ::: "memory");
        { const int sk2 = sk == 0 ? 2 : sk - 1; AT_ISSUE(j + 2, sk2, (sv + 2) & 3); }
        float pmax = p0[0];
#pragma unroll
        for (int r = 1; r < 16; ++r) pmax = fmaxf(pmax, p0[r]);
#pragma unroll
        for (int r = 0; r < 16; ++r) pmax = fmaxf(pmax, p1[r]);
        { auto rr = __builtin_amdgcn_permlane32_swap(__float_as_uint(pmax), __float_as_uint(pmax), false, false); pmax = fmaxf(__uint_as_float(rr[0]), __uint_as_float(rr[1])); }
        float alpha = 1.f;
        if (__builtin_expect(j == 0 || !__all(pmax <= THR2), 0)) {
            const float delta = j == 0 ? pmax : fmaxf(pmax, 0.f);
            if (j != 0) alpha = __builtin_amdgcn_exp2f(-delta);
            m_reg += delta;
#pragma unroll
            for (int r = 0; r < 16; ++r) { p0[r] -= delta; p1[r] -= delta; cm[r] = -m_reg; }
        }
#pragma unroll
        for (int r = 0; r < 16; ++r) { p0[r] = __builtin_amdgcn_exp2f(p0[r]); p1[r] = __builtin_amdgcn_exp2f(p1[r]); }
        float ps = 0.f;
#pragma unroll
        for (int r = 0; r < 16; ++r) ps += p0[r] + p1[r];
        l_reg = l_reg * alpha + ps;
#define AT_PK4(P, BASE, OUT) do { u32x4 w = {cvtpk(P[BASE + 0], P[BASE + 1]), cvtpk(P[BASE + 2], P[BASE + 3]), cvtpk(P[BASE + 4], P[BASE + 5]), cvtpk(P[BASE + 6], P[BASE + 7])}; OUT = *reinterpret_cast<bf16x8*>(&w); } while (0)
        AT_PK4(p0, 0, pa0); AT_PK4(p0, 8, pa1); AT_PK4(p1, 0, pa2); AT_PK4(p1, 8, pa3);
#undef AT_PK4
        if (__any(alpha < 1.f)) {
            if (hi == 0) al_l[r32] = alpha;
            asm volatile("s_waitcnt lgkmcnt(0)" ::: "memory");
            float av[16];
#pragma unroll
            for (int r = 0; r < 16; ++r) av[r] = al_l[crow(r, hi)];
#pragma unroll
            for (int d = 0; d < 4; ++d)
#pragma unroll
                for (int r = 0; r < 16; ++r) o[d][r] *= av[r];
        }
        sk = sk == 2 ? 0 : sk + 1; sv = (sv + 1) & 3;
    }
    __builtin_amdgcn_s_barrier(); asm volatile("" ::: "memory");
    AT_PV((sv + 3) & 3);
    if (!half) __builtin_amdgcn_s_barrier();
    asm volatile("s_waitcnt vmcnt(0)" ::: "memory");
    __builtin_amdgcn_s_barrier();
    asm volatile("" ::: "memory");
    { auto rr = __builtin_amdgcn_permlane32_swap(__float_as_uint(l_reg), __float_as_uint(l_reg), false, false); l_out = __uint_as_float(rr[0]) + __uint_as_float(rr[1]); }
#undef AT_ISSUE
#undef AT_PV
}
__device__ __forceinline__ void row_inv_l(LAS unsigned char* lds_scratch, float l_reg, float (&rli)[16]) {
    const int tid = otid(), wid = tid >> 6, lane = tid & 63, r32 = lane & 31, hi = lane >> 5;
    LAS float* li_l = (LAS float*)lds_scratch + wid * 64 + 32;
    if (hi == 0) li_l[r32] = l_reg;
    asm volatile("s_waitcnt lgkmcnt(0)" ::: "memory");
#pragma unroll
    for (int r = 0; r < 16; ++r) rli[r] = __builtin_amdgcn_rcpf(li_l[crow(r, hi)]);
}
}

__device__ __forceinline__ void attn_unit_mla(CKP& p, LAS unsigned char* lds, int q0, int h, const at::KeyMap km) {
    const bf16_t* qm = (const bf16_t*)(p.ws + WS_QM); const bf16_t* kmb = (const bf16_t*)(p.ws + WS_KM); const bf16_t* vmb = (const bf16_t*)(p.ws + WS_VM); bf16_t* ya = (bf16_t*)(p.ws + WS_YBR);
    f32x16 o[4]; float l;
    at::attn_body<192>(lds, qm + h * 192, 768, q0, kmb + h * 192, 768, vmb + h * 128, 512, km, o, l);
    float rli[16]; at::row_inv_l(lds + 3 * 64 * 384 + 4 * 16384, l, rli);
    const int tid_ = otid(); const int wid = tid_ >> 6, lane = tid_ & 63, r32 = lane & 31, hi = lane >> 5;
    bf16_t* yw = ya + (size_t)(q0 + wid * 32) * 512 + h * 128 + r32;
#pragma unroll
    for (int r = 0; r < 16; ++r) { const int orow = at::crow(r, hi);
#pragma unroll
        for (int d0 = 0; d0 < 4; ++d0) yw[(size_t)orow * 512 + d0 * 32] = f2bf(o[d0][r] * rli[r]); }
}
__device__ __forceinline__ void attn_unit_diff(CKP& p, LAS unsigned char* lds, int l_idx, int q0, int h, const at::KeyMap km) {
    const bf16_t* ubuf = (const bf16_t*)(p.ws + WS_R1); bf16_t* yc = (bf16_t*)(p.ws + WS_YBR) + (size_t)2 * MALL * 512;
    const float lam = ((const float*)(p.ws + WS_SCAL))[l_idx]; const float lam_init = 0.8f - 0.6f * expf(-0.3f * (float)l_idx);
    f32x16 o[4]; float l; float rli[16];
    at::attn_body<64>(lds, ubuf + U_CQ + (2 * h) * 64, NU, q0, ubuf + U_CK + (2 * h) * 64, NU, ubuf + U_CV + h * 128, NU, km, o, l);
    at::row_inv_l(lds + 3 * 64 * 128 + 4 * 16384, l, rli);
    const int tid_ = otid(); const int wid = tid_ >> 6, lane = tid_ & 63, r32 = lane & 31, hi = lane >> 5;
    bf16_t* yw = yc + (size_t)(q0 + wid * 32) * 512 + h * 128 + r32;
#pragma unroll
    for (int r = 0; r < 16; ++r) { const int orow = at::crow(r, hi);
#pragma unroll
        for (int d0 = 0; d0 < 4; ++d0) yw[(size_t)orow * 512 + d0 * 32] = f2bf(o[d0][r] * rli[r]); }
    at::attn_body<64>(lds, ubuf + U_CQ + (2 * h + 1) * 64, NU, q0, ubuf + U_CK + (2 * h + 1) * 64, NU, ubuf + U_CV + h * 128, NU, km, o, l);
    at::row_inv_l(lds + 3 * 64 * 128 + 4 * 16384, l, rli);
    { const int t2 = otid(); yw = yc + (size_t)(q0 + (t2 >> 6) * 32) * 512 + h * 128 + (t2 & 31); }
    float ss[16];
#pragma unroll
    for (int r = 0; r < 16; ++r) { const int orow = at::crow(r, hi); float s = 0.f;
#pragma unroll
        for (int d = 0; d < 4; ++d) { const float v = bf2f(yw[(size_t)orow * 512 + d * 32]) - lam * (o[d][r] * rli[r]); o[d][r] = v; s += v * v; }
        ss[r] = s; }
#pragma unroll
    for (int r = 0; r < 16; ++r) {
#pragma unroll
        for (int x = 16; x >= 1; x >>= 1) ss[r] += shx(ss[r], x, lane); }
    const float* sub = p.in[I_SUBLN] + l_idx * 128; float sg[4];
#pragma unroll
    for (int d = 0; d < 4; ++d) sg[d] = sub[d * 32 + r32] * (1.0f - lam_init);
#pragma unroll
    for (int r = 0; r < 16; ++r) { const int orow = at::crow(r, hi); const float rn = rsqrtf(ss[r] * (1.0f / 128.0f) + EPS);
#pragma unroll
        for (int d0 = 0; d0 < 4; ++d0) yw[(size_t)orow * 512 + d0 * 32] = f2bf(o[d0][r] * rn * sg[d0]); }
}

__device__ __forceinline__ void lds_barrier() { asm volatile("s_waitcnt lgkmcnt(0)" ::: "memory"); __builtin_amdgcn_s_barrier(); asm volatile("" ::: "memory"); }
namespace hg {
__device__ __forceinline__ bf16x8 gather8(const LAS bf16_t* p, int stride) { bf16x8 r;
#pragma unroll
    for (int i = 0; i < 8; ++i) r[i] = (short)p[i * stride];
    return r; }
__device__ __forceinline__ void gates16(const bf16_t* zp  , float lbk, int dd, float (&gi)[16], float (&kf)[16], float& tot) {
    float g[16];
#pragma unroll
    for (int i = 0; i < 16; ++i) { const float z = bf2f(zp[(size_t)i * NU]); const float sg = sigmoidf_(z); g[i] = flog(lbk + (1.0f - lbk) * sg); kf[i] = (1.0f - lbk) * frcp(1.0f + __expf(z)); }
    float run = 0.f;
    if (dd == 0) {
#pragma unroll
        for (int i = 0; i < 16; ++i) { run += g[i]; gi[i] = run; }
    } else {
#pragma unroll
        for (int i = 15; i >= 0; --i) { run += g[i]; gi[i] = run; }
    }
    tot = run;
}
__device__ __forceinline__ void gates16r(const bf16_t (&zr)[16], float lbk, int dd, float (&gi)[16], float (&kf)[16], float& tot) {
    float g[16];
#pragma unroll
    for (int i = 0; i < 16; ++i) { const float z = bf2f(zr[i]); const float sg = sigmoidf_(z); g[i] = flog(lbk + (1.0f - lbk) * sg); kf[i] = (1.0f - lbk) * frcp(1.0f + __expf(z)); }
    float run = 0.f;
    if (dd == 0) {
#pragma unroll
        for (int i = 0; i < 16; ++i) { run += g[i]; gi[i] = run; }
    } else {
#pragma unroll
        for (int i = 15; i >= 0; --i) { run += g[i]; gi[i] = run; }
    }
    tot = run;
}
__device__ __forceinline__ void pack16_store(LAS bf16_t* dst, const float (&v)[16]) {
    u32x4 a, b; a.x = cvt_pk_bf16(v[0], v[1]); a.y = cvt_pk_bf16(v[2], v[3]); a.z = cvt_pk_bf16(v[4], v[5]); a.w = cvt_pk_bf16(v[6], v[7]);
    b.x = cvt_pk_bf16(v[8], v[9]); b.y = cvt_pk_bf16(v[10], v[11]); b.z = cvt_pk_bf16(v[12], v[13]); b.w = cvt_pk_bf16(v[14], v[15]);
    *(LAS u32x4*)dst = a; *(LAS u32x4*)(dst + 8) = b;
}
__device__ __forceinline__ void stage_vT(LAS bf16_t* VsT, const bf16_t* vp  , int v, int part) {
    unsigned short h[16];
#pragma unroll
    for (int i = 0; i < 16; ++i) h[i] = vp[(size_t)i * NU];
    u32x4 a, b; a.x = h[0] | ((unsigned)h[1] << 16); a.y = h[2] | ((unsigned)h[3] << 16); a.z = h[4] | ((unsigned)h[5] << 16); a.w = h[6] | ((unsigned)h[7] << 16);
    b.x = h[8] | ((unsigned)h[9] << 16); b.y = h[10] | ((unsigned)h[11] << 16); b.z = h[12] | ((unsigned)h[13] << 16); b.w = h[14] | ((unsigned)h[15] << 16);
    *(LAS u32x4*)(VsT + v * 72 + part * 16) = a; *(LAS u32x4*)(VsT + v * 72 + part * 16 + 8) = b;
}
__device__ __forceinline__ void pass1_unit(CKP& p, LAS unsigned char* lds, const float* lb, int cid, int hh) {
    const bf16_t* ubuf = (const bf16_t*)(p.ws + WS_R1); bf16_t* HS = (bf16_t*)(p.ws + WS_YBUF); float* HD = (float*)(p.ws + WS_HD);
    LAS bf16_t* VsT = (LAS bf16_t*)lds; LAS bf16_t* KtT = (LAS bf16_t*)(lds + 18432); LAS float* ptot = (LAS float*)(lds + 36864);
    const int tid = otid(), wid = tid >> 6, lane = tid & 63, row0 = cid * 64;
    const int k = tid & 127, part = tid >> 7; const float lbk = lb[hh * 128 + k];
    bf16_t zf[16], zb[16];
    { const bf16_t* zp = ubuf + (size_t)(row0 + part * 16) * NU + hh * 128 + k;
#pragma unroll
      for (int i = 0; i < 16; ++i) { zf[i] = zp[(size_t)i * NU + U_DFF]; zb[i] = zp[(size_t)i * NU + U_DFB]; } }
    stage_vT(VsT, ubuf + (size_t)(row0 + part * 16) * NU + U_DI + hh * 128 + k, k, part);
#pragma unroll 1
    for (int dd = 0; dd < 2; ++dd) {
        float gi[16], kf[16], tot;
        { bf16_t zr[16];
#pragma unroll
          for (int i = 0; i < 16; ++i) zr[i] = dd ? zb[i] : zf[i];
          gates16r(zr, lbk, dd, gi, kf, tot); }
        ptot[part * 128 + k] = tot;
        lds_barrier();
        float off = 0.f, gt = 0.f;
#pragma unroll
        for (int q = 0; q < 4; ++q) { const float v = ptot[q * 128 + k]; gt += v; if (dd == 0 ? (q < part) : (q > part)) off += v; }
#pragma unroll
        for (int i = 0; i < 16; ++i) kf[i] = kf[i] * __expf(gt - (off + gi[i]));
        pack16_store(KtT + k * 72 + part * 16, kf);
        if (part == 0) HD[(size_t)((cid * 4 + hh) * 2 + dd) * 128 + k] = __expf(gt);
        lds_barrier();
        {
            const int l15 = lane & 15, kg = lane >> 4;
            bf16x8 vf[2];
#pragma unroll
            for (int ks = 0; ks < 2; ++ks) vf[ks] = *(const LAS bf16x8*)(VsT + (wid * 16 + l15) * 72 + ks * 32 + kg * 8);
            bf16_t* dst = HS + ((size_t)((cid * 4 + hh) * 2 + dd) * 128 + wid * 16 + l15) * 128;
#pragma unroll
            for (int kb = 0; kb < 8; ++kb) {
                f32x4 c = {0.f, 0.f, 0.f, 0.f};
#pragma unroll
                for (int ks = 0; ks < 2; ++ks) { const bf16x8 kfr = *(const LAS bf16x8*)(KtT + (kb * 16 + l15) * 72 + ks * 32 + kg * 8); c = __builtin_amdgcn_mfma_f32_16x16x32_bf16(kfr, vf[ks], c, 0, 0, 0); }
                u32x2 w; w.x = cvt_pk_bf16(c[0], c[1]); w.y = cvt_pk_bf16(c[2], c[3]);
                *(u32x2*)(dst + kb * 16 + kg * 4) = w;
            }
        }
        lds_barrier();
    }
}
__device__ __forceinline__ void carry_unit(CKP& p, int u) {
    bf16_t* HS = (bf16_t*)(p.ws + WS_YBUF); const float* HD = (const float*)(p.ws + WS_HD);
    const int combo = u >> 4, sub = u & 15, b = combo >> 3, hh = (combo >> 1) & 3, dd = combo & 1;
    const int tid_ = otid(); const int v = sub * 8 + (tid_ >> 6), k = 2 * (tid_ & 63);
    float s0 = 0.f, s1 = 0.f;
#pragma unroll 1
    for (int s0i = 0; s0i < 260; s0i += 20) {
        unsigned uw[20]; f32x2 d2[20];
#pragma unroll
        for (int q = 0; q < 20; ++q) { const int st = s0i + q;
            const int cid = dd == 0 ? (st < 4 ? 512 + b * 4 + st : b * 256 + (st - 4)) : (st < 4 ? 512 + b * 4 + (3 - st) : b * 256 + (259 - st));
            const size_t base = (size_t)((cid * 4 + hh) * 2 + dd) * 128;
            uw[q] = *(const unsigned*)(HS + (base + v) * 128 + k); d2[q] = *(const f32x2*)(HD + base + k); }
#pragma unroll
        for (int q = 0; q < 20; ++q) { const int st = s0i + q;
            const int cid = dd == 0 ? (st < 4 ? 512 + b * 4 + st : b * 256 + (st - 4)) : (st < 4 ? 512 + b * 4 + (3 - st) : b * 256 + (259 - st));
            const size_t base = (size_t)((cid * 4 + hh) * 2 + dd) * 128;
            *(unsigned*)(HS + (base + v) * 128 + k) = cvt_pk_bf16(s0, s1);
            s0 = d2[q][0] * s0 + bflo(uw[q]); s1 = d2[q][1] * s1 + bfhi(uw[q]); }
    }
}
constexpr int O_QS = 0, O_KF = 17408, O_VS = 34816, O_GS = 53248, O_ST = 87040, O_AS = 121856, O_R = 140288, O_PT = 142336, O_RS = 144384;
static_assert(O_RS + 512 <= LDS_MISC, "HGRN LDS");
__device__ __forceinline__ void out_unit(CKP& p, LAS unsigned char* lds, const float* lb, const float* gnorm, int cid, int hh) {
    const bf16_t* ubuf = (const bf16_t*)(p.ws + WS_R1); const bf16_t* HS = (const bf16_t*)(p.ws + WS_YBUF); bf16_t* yd = (bf16_t*)(p.ws + WS_YBR) + (size_t)3 * MALL * 512;
    LAS bf16_t* qs = (LAS bf16_t*)(lds + O_QS); LAS bf16_t* kfs = (LAS bf16_t*)(lds + O_KF); LAS bf16_t* Vs = (LAS bf16_t*)(lds + O_VS); LAS float* Gs = (LAS float*)(lds + O_GS);
    LAS bf16_t* St = (LAS bf16_t*)(lds + O_ST); LAS float* Rr = (LAS float*)(lds + O_R); LAS float* ptot = (LAS float*)(lds + O_PT); LAS float* rss = (LAS float*)(lds + O_RS);
    const int tid = otid(), wid = tid >> 6, lane = tid & 63, row0 = cid * 64, l15 = lane & 15, kg = lane >> 4;
    LAS bf16_t* Asc = (LAS bf16_t*)(lds + O_AS) + wid * (16 * 72);
    const int k = tid & 127, part = tid >> 7; const float lbk = lb[hh * 128 + k];
    bf16_t zf[16], zb[16]; u32x4 sin0[4], sin1[4];
    { const bf16_t* zp = ubuf + (size_t)(row0 + part * 16) * NU + hh * 128 + k;
#pragma unroll
      for (int i = 0; i < 16; ++i) { zf[i] = zp[(size_t)i * NU + U_DFF]; zb[i] = zp[(size_t)i * NU + U_DFB]; }
      const int v_ = tid >> 2, seg_ = tid & 3; const bf16_t* src = HS + ((size_t)((cid * 4 + hh) * 2) * 128 + v_) * 128 + seg_ * 32;
#pragma unroll
      for (int i = 0; i < 4; ++i) { sin0[i] = *(const u32x4*)(src + i * 8); sin1[i] = *(const u32x4*)(src + (size_t)128 * 128 + i * 8); } }
    stage_vT(Vs, ubuf + (size_t)(row0 + part * 16) * NU + U_DI + hh * 128 + k, k, part);
#pragma unroll
    for (int i = 0; i < 16; ++i) { const int t = part * 16 + i; qs[t * 136 + k] = f2bf(siluf_(bf2f(ubuf[(size_t)(row0 + t) * NU + U_DQ + hh * 128 + k]))); }
    const int bi = wid >> 1, vh = wid & 1;
    f32x4 o[4];
#pragma unroll
    for (int nb = 0; nb < 4; ++nb) o[nb] = (f32x4){0.f, 0.f, 0.f, 0.f};
#pragma unroll 1
    for (int dd = 0; dd < 2; ++dd) {
        {
            float gi[16], kf[16], tot;
            { bf16_t zr[16];
#pragma unroll
              for (int i = 0; i < 16; ++i) zr[i] = dd ? zb[i] : zf[i];
              gates16r(zr, lbk, dd, gi, kf, tot); }
            ptot[part * 128 + k] = tot;
            lds_barrier();
            float off = 0.f;
#pragma unroll
            for (int q = 0; q < 4; ++q) { const float v = ptot[q * 128 + k]; if (dd == 0 ? (q < part) : (q > part)) off += v; }
#pragma unroll
            for (int i = 0; i < 16; ++i) { const int t = part * 16 + i; Gs[t * 132 + k] = off + gi[i]; kfs[t * 136 + k] = f2bf(kf[i]); }
            Rr[part * 128 + k] = off;
        }
        {
            const int v = tid >> 2, seg = tid & 3;
#pragma unroll
            for (int i = 0; i < 4; ++i) *(LAS u32x4*)(St + v * 136 + seg * 32 + i * 8) = dd ? sin1[i] : sin0[i];
        }
        lds_barrier();
        const int ti = bi * 16 + l15;
#pragma unroll 1
        for (int j = 0; j < 4; ++j) {
            const bool use = dd == 0 ? (j <= bi) : (j >= bi);
            f32x4 c = {0.f, 0.f, 0.f, 0.f};
            if (use) {
                const int sj = j * 16 + l15;
#pragma unroll
                for (int ks = 0; ks < 4; ++ks) {
                    const int kc = ks * 32 + kg * 8;
                    const u32x4 qw = *(const LAS u32x4*)(qs + ti * 136 + kc), kw = *(const LAS u32x4*)(kfs + sj * 136 + kc);
                    const f32x4 g0 = *(const LAS f32x4*)(Gs + ti * 132 + kc), g1 = *(const LAS f32x4*)(Gs + ti * 132 + kc + 4), h0 = *(const LAS f32x4*)(Gs + sj * 132 + kc), h1 = *(const LAS f32x4*)(Gs + sj * 132 + kc + 4);
                    const f32x4 r0 = *(const LAS f32x4*)(Rr + bi * 128 + kc), r1 = *(const LAS f32x4*)(Rr + bi * 128 + kc + 4);
                    const float qv[8] = {bflo(qw.x), bfhi(qw.x), bflo(qw.y), bfhi(qw.y), bflo(qw.z), bfhi(qw.z), bflo(qw.w), bfhi(qw.w)};
                    const float kv[8] = {bflo(kw.x), bfhi(kw.x), bflo(kw.y), bfhi(kw.y), bflo(kw.z), bfhi(kw.z), bflo(kw.w), bfhi(kw.w)};
                    float qa[8], ka[8];
#pragma unroll
                    for (int e = 0; e < 4; ++e) { qa[e] = qv[e] * __expf(g0[e] - r0[e]); qa[4 + e] = qv[4 + e] * __expf(g1[e] - r1[e]); ka[e] = kv[e] * __expf(r0[e] - h0[e]); ka[4 + e] = kv[4 + e] * __expf(r1[e] - h1[e]); }
                    u32x4 aw, bw; aw.x = cvt_pk_bf16(qa[0], qa[1]); aw.y = cvt_pk_bf16(qa[2], qa[3]); aw.z = cvt_pk_bf16(qa[4], qa[5]); aw.w = cvt_pk_bf16(qa[6], qa[7]);
                    bw.x = cvt_pk_bf16(ka[0], ka[1]); bw.y = cvt_pk_bf16(ka[2], ka[3]); bw.z = cvt_pk_bf16(ka[4], ka[5]); bw.w = cvt_pk_bf16(ka[6], ka[7]);
                    c = __builtin_amdgcn_mfma_f32_16x16x32_bf16(*reinterpret_cast<bf16x8*>(&aw), *reinterpret_cast<bf16x8*>(&bw), c, 0, 0, 0);
                }
                if (j == bi) {
#pragma unroll
                    for (int e = 0; e < 4; ++e) { const int tl = 4 * kg + e; const bool keep = dd == 0 ? (l15 <= tl) : (l15 >= tl); c[e] = keep ? c[e] : 0.f; }
                }
            }
#pragma unroll
            for (int e = 0; e < 4; ++e) Asc[(4 * kg + e) * 72 + j * 16 + l15] = f2bf(c[e]);
        }
        bf16x8 af[2], qf[4];
#pragma unroll
        for (int ks = 0; ks < 2; ++ks) af[ks] = *(const LAS bf16x8*)(Asc + l15 * 72 + ks * 32 + kg * 8);
#pragma unroll
        for (int ks = 0; ks < 4; ++ks) { const int kc = ks * 32 + kg * 8;
            const u32x4 qw = *(const LAS u32x4*)(qs + ti * 136 + kc); const f32x4 g0 = *(const LAS f32x4*)(Gs + ti * 132 + kc), g1 = *(const LAS f32x4*)(Gs + ti * 132 + kc + 4);
            u32x4 aw; aw.x = cvt_pk_bf16(bflo(qw.x) * __expf(g0[0]), bfhi(qw.x) * __expf(g0[1])); aw.y = cvt_pk_bf16(bflo(qw.y) * __expf(g0[2]), bfhi(qw.y) * __expf(g0[3]));
            aw.z = cvt_pk_bf16(bflo(qw.z) * __expf(g1[0]), bfhi(qw.z) * __expf(g1[1])); aw.w = cvt_pk_bf16(bflo(qw.w) * __expf(g1[2]), bfhi(qw.w) * __expf(g1[3]));
            qf[ks] = *reinterpret_cast<bf16x8*>(&aw); }
#pragma unroll
        for (int nb = 0; nb < 4; ++nb) { const int vcol = vh * 64 + nb * 16 + l15;
#pragma unroll
            for (int ks = 0; ks < 2; ++ks) { const bf16x8 vf = *(const LAS bf16x8*)(Vs + vcol * 72 + ks * 32 + kg * 8); o[nb] = __builtin_amdgcn_mfma_f32_16x16x32_bf16(af[ks], vf, o[nb], 0, 0, 0); }
#pragma unroll
            for (int ks = 0; ks < 4; ++ks) { const bf16x8 sf = *(const LAS bf16x8*)(St + vcol * 136 + ks * 32 + kg * 8); o[nb] = __builtin_amdgcn_mfma_f32_16x16x32_bf16(qf[ks], sf, o[nb], 0, 0, 0); }
        }
        lds_barrier();
    }
    bf16_t ogr[4][4]; float gn[4];
#pragma unroll
    for (int e = 0; e < 4; ++e)
#pragma unroll
        for (int nb = 0; nb < 4; ++nb) ogr[e][nb] = ubuf[(size_t)(row0 + bi * 16 + 4 * kg + e) * NU + U_DG + hh * 128 + vh * 64 + nb * 16 + l15];
#pragma unroll
    for (int nb = 0; nb < 4; ++nb) gn[nb] = gnorm[vh * 64 + nb * 16 + l15];
    float ss[4];
#pragma unroll
    for (int e = 0; e < 4; ++e) { float s = 0.f;
#pragma unroll
        for (int nb = 0; nb < 4; ++nb) s += o[nb][e] * o[nb][e];
#pragma unroll
        for (int x = 8; x >= 1; x >>= 1) s += shx(s, x, lane);
        ss[e] = s; }
    if (l15 == 0) {
#pragma unroll
        for (int e = 0; e < 4; ++e) rss[vh * 64 + bi * 16 + 4 * kg + e] = ss[e]; }
    lds_barrier();
#pragma unroll
    for (int e = 0; e < 4; ++e) { const int tl = bi * 16 + 4 * kg + e; const float tot = rss[tl] + rss[64 + tl]; const float rn = rsqrtf(tot * (1.0f / 128.0f) + EPS);
        const size_t row = (size_t)(row0 + tl);
#pragma unroll
        for (int nb = 0; nb < 4; ++nb) { const int v = vh * 64 + nb * 16 + l15; const float og = bf2f(ogr[e][nb]);
            yd[row * 512 + hh * 128 + v] = f2bf(o[nb][e] * rn * gn[nb] * siluf_(og)); } }
    lds_barrier();
}
}

constexpr int PH_PER_LAYER = 14, N_PHASES = 1 + PH_PER_LAYER * NL + 1;
#ifndef MK_LAUNCHES
#define MK_LAUNCHES 1
#endif

__global__ void __launch_bounds__(NTHR, 2) fwd_kernel(KP karg) {
    extern __shared__ __attribute__((aligned(16))) unsigned char lds_raw[];
    LAS unsigned char* lds0 = (LAS unsigned char*)lds_raw;
    const int tid = otid(), G = gridDim.x, c = obid();
    volatile LAS unsigned* bst = (volatile LAS unsigned*)(lds0 + LDS_MISC);
    if (tid < 4) bst[tid] = 0u;
    __syncthreads();
    const int lo = karg.ph_lo, hi = karg.ph_hi;
    const bool fused = (MK_LAUNCHES == 1) || (hi - lo) > 1;
    XcdBarrier bar; bar.bar = (unsigned*)(karg.ws + WS_CTL); bar.x = 0; bar.st = bst;
    if (fused) bar = xcd_barrier_post((unsigned*)(karg.ws + WS_CTL), bst);
#ifndef ONLY_PH
#define ONLY_PH (-1)
#endif
#ifndef SUBMASK
#define SUBMASK 0xff
#endif
#define SUB(b) ((SUBMASK >> (b)) & 1)
#define EN(x) (ONLY_PH < 0 || ONLY_PH == (x))
#ifndef REPX
#define REPX (-1)
#define REPN 1
#endif
#define REPEAT(x) _Pragma("unroll 1") for (int rep_ = 0; rep_ < (REPX == (x) ? REPN : 1); ++rep_)
#define IN(k) ((MK_LAUNCHES == 1) || (lo <= (k) && (k) < hi))
#define INL(x) (EN(x) && IN(pb + (x)))
#define SEAM(k) do { if (IN((k) + 1)) xcd_barrier(bar); } while (0)

#define PH_LOCALS CKP& p = kp_here(); const int c = obid(); unsigned char* ws = p.ws; LAS unsigned char* lds = lds_here(lds_raw); \
    float* mod = (float*)(ws + WS_MOD); const float* rope = (const float*)(ws + WS_ROPE); const float* scal = (const float*)(ws + WS_SCAL); \
    bf16_t* hbuf = (bf16_t*)(ws + WS_HBUF); bf16_t* act = (bf16_t*)(ws + WS_R1); bf16_t* ubuf = (bf16_t*)(ws + WS_R1); bf16_t* mrg = (bf16_t*)(ws + WS_R1); bf16_t* ybuf = (bf16_t*)(ws + WS_YBUF); \
    float* xc = (float*)(ws + WS_XC); const float* modl = mod + (size_t)l * 3 * NMOD * DM; \
    (void)rope; (void)scal; (void)hbuf; (void)act; (void)ubuf; (void)mrg; (void)ybuf; (void)xc; (void)modl;

    if (EN(100) && IN(0)) { CKP& p = kp_here(); LAS unsigned char* lds = lds_here(lds_raw); job_tables(p); job_colmax(p); job_mod(p, lds); SEAM(0); }

#pragma unroll 1
    for (int l = 0; l < NL; ++l) {
        const int pb = 1 + PH_PER_LAYER * l; const bool need_ctx = l < NL - 1; const int nrt = need_ctx ? NRT : 128;
        if (INL(0)) { PH_LOCALS
            RNArgs a{};
            if (l == 0) { a.xs_lat = p.in[I_X]; a.xs_ctx = p.in[I_CTX]; a.xd_lat = p.out; a.xd_ctx = xc; a.y = nullptr; }
            else { a.xs_lat = p.out; a.xs_ctx = xc; a.xd_lat = p.out; a.xd_ctx = xc; a.y = ybuf; a.wres = 0.5f; a.modl_res = mod + (size_t)(l - 1) * 3 * NMOD * DM; a.jres = 2; a.postg = p.in[I_POST] + ((l - 1) * 3 + 2) * DM; }
            a.do_norm = true; a.modl_norm = modl; a.jn = 0; a.preg = p.in[I_PRE] + (l * 3 + 0) * DM; a.h = nullptr; a.h8 = (signed char*)hbuf; a.nrows = MALL; a.hsc = (float*)(ws + WS_HSC);
            job_resnorm(a, lds);
            job_convert(p, lds, l);
            SEAM(pb + 0);
        }
        if (INL(1)) { PH_LOCALS
            SchedPlain S; S.T.init(NRT, 44, G, c); S.A = (const char*)hbuf; S.B = (const char*)(ws + WS_WGU); S.lda2 = DM; S.ldb2 = DM; S.nt = DM / 128;
            REPEAT(1) { EpiGateUpI8 E{act, (const float*)(ws + WS_HSC), (const float*)(ws + WS_WSC)}; gm::gemm_stream<false>(lds, S, E); } SEAM(pb + 1);
        }
        if (INL(2)) { PH_LOCALS
            const bool spl = G == 256 && MK_LAUNCHES == 1; float* ypart = (float*)(ws + WS_R1 + (size_t)MALL * DFF * 2);
            SchedSplitK S; S.T.init(spl ? 128 : NRT, 8, G, c); S.A = (const char*)act; S.B = (const char*)(ws + WS_WD); S.lda2 = DFF * 2; S.ldb2 = DFF * 2; S.nt = DFF / 64; S.xe = (spl && c < 64) ? c : -1;
            REPEAT(2) { EpiStoreK E{ybuf, ypart}; gm::gemm_stream<false>(lds, S, E); } SEAM(pb + 2);
            if (spl) { job_splitk_reduce(ypart, ybuf); xcd_barrier(bar); }
        }
        if (INL(3)) { PH_LOCALS
            RNArgs a{};
            if (l == 0) { a.xs_lat = p.in[I_X]; a.xs_ctx = p.in[I_CTX]; } else { a.xs_lat = p.out; a.xs_ctx = xc; }
            a.xd_lat = p.out; a.xd_ctx = xc; a.y = ybuf; a.wres = 0.5f; a.modl_res = modl; a.jres = 0; a.postg = p.in[I_POST] + (l * 3 + 0) * DM;
            a.do_norm = true; a.modl_norm = modl; a.jn = 1; a.preg = p.in[I_PRE] + (l * 3 + 1) * DM; a.h = nullptr; a.h8 = (signed char*)(ws + WS_H8); a.hsc = (float*)(ws + WS_HSC2); a.nrows = MALL;
            job_resnorm(a, lds); SEAM(pb + 3);
        }
        if (INL(4)) { PH_LOCALS
            SchedPlain S; S.T.init(NRT, 24, G, c); S.A = (const char*)(ws + WS_H8); S.B = (const char*)(ws + WS_WIN); S.lda2 = DM; S.ldb2 = DM; S.nt = DM / 128;
            REPEAT(4) { EpiProj E{ubuf, (bf16_t*)(ws + WS_KM), rope, (const float*)(ws + WS_HSC2), (const float*)(ws + WS_WPS)}; gm::gemm_stream<false>(lds, S, E); } SEAM(pb + 4);
        }
        if (INL(5)) { PH_LOCALS job_stats_conv(p, l); SEAM(pb + 5); }
        if (INL(6)) { PH_LOCALS
            if (SUB(0)) { SchedPlain S; S.T.init(NRT, 3, G, c); S.A = (const char*)(ubuf + U_AQ); S.B = (const char*)(ws + WS_WUQ); S.lda2 = NU * 2; S.ldb2 = 512 * 2; S.nt = 8;
              EpiQup E{(bf16_t*)(ws + WS_QM), (const float*)(ws + WS_RSQ), rope}; gm::gemm_stream<false>(lds, S, E); }
            if (SUB(1)) { SchedPlain S; S.T.init(NRT, 4, G, G == 256 ? (c + 120) & 255 : c); S.A = (const char*)(ubuf + U_AKV); S.B = (const char*)(ws + WS_WUKV); S.lda2 = NU * 2; S.ldb2 = 256 * 2; S.nt = 4;
              EpiKVup E{(bf16_t*)(ws + WS_KM), (bf16_t*)(ws + WS_VM), (const float*)(ws + WS_RSQ) + MALL}; gm::gemm_stream<false>(lds, S, E); }
            if (SUB(2)) { SchedPlain S; S.T.init(NRT, 8, G, G == 256 ? (c + 112) & 255 : c); S.A = (const char*)(ws + WS_XCV); S.B = (const char*)(ws + WS_WRG); S.lda2 = 512 * 2; S.ldb2 = 512 * 2; S.nt = 8;
              EpiRG E{(const bf16_t*)(ws + WS_XCV), (bf16_t*)(ws + WS_LA), (bf16_t*)(ws + WS_BB), p.in[I_RGBR] + l * 1024, p.in[I_RGBI] + l * 1024, scal + 2048 + l * 1024}; gm::gemm_stream<false>(lds, S, E); }
            if (SUB(3)) for (int u = (G == 256 ? (c + 96) & 255 : c); u < 520 * 4; u += G) hg::pass1_unit(p, lds, scal + 256 + l * 512, u >> 2, u & 3);
            SEAM(pb + 6);
        }
        if (INL(7)) { PH_LOCALS job_rg_scan1(p); for (int u = c; u < 256; u += G) hg::carry_unit(p, u); SEAM(pb + 7); }
        if (INL(8)) { PH_LOCALS {
            REPEAT(81) if (SUB(0)) job_rg_out(p, nrt);
            REPEAT(82) if (SUB(1)) { const int ncu = need_ctx ? 520 * 4 : 512 * 4;
                if (G > nrt + 16) {
                    if (c < nrt) { for (int i = 0; i < 7; ++i) { const int u = c + i * nrt; hg::out_unit(p, lds, scal + 256 + l * 512, p.in[I_HNORM] + l * 128, u >> 2, u & 3); } }
                    else for (int u = 7 * nrt + (c - nrt); u < ncu; u += G - nrt) hg::out_unit(p, lds, scal + 256 + l * 512, p.in[I_HNORM] + l * 128, u >> 2, u & 3);
                } else for (int u = c; u < ncu; u += G) hg::out_unit(p, lds, scal + 256 + l * 512, p.in[I_HNORM] + l * 128, u >> 2, u & 3); }
            if (SUB(4) && need_ctx) for (int t = c; t < 16; t += G) { const int bh = t & 7, b = bh >> 2, h = bh & 3; at::KeyMap km{MLAT + b * CTXL, 0, 4, 4};
                if (t < 8) attn_unit_mla(p, lds, MLAT + b * CTXL, h, km); else attn_unit_diff(p, lds, l, MLAT + b * CTXL, h, km); }
            REPEAT(83) if (SUB(2)) for (int t = c; t < 512; t += G) { const int bh = t & 7, qb = t >> 3, b = bh >> 2, h = bh & 3; at::KeyMap km{MLAT + b * CTXL, b * SEQ, 4, 260}; attn_unit_mla(p, lds, b * SEQ + qb * 256, h, km); }
            REPEAT(84) if (SUB(3)) for (int t = c; t < 512; t += G) { const int bh = t & 7, qb = t >> 3, b = bh >> 2, h = bh & 3; at::KeyMap km{MLAT + b * CTXL, b * SEQ, 4, 260}; attn_unit_diff(p, lds, l, b * SEQ + qb * 256, h, km); }
            }
            SEAM(pb + 8);
        }
        if (INL(9)) { PH_LOCALS
            const bool bal = need_ctx && G == 256 && MK_LAUNCHES == 1;
            bf16_t* part = mrg + (size_t)2 * MALL * DM; bf16_t* gx = part + (size_t)4 * MCTX * DM;
            EpiMergeG EG{mrg + (size_t)MALL * DM, p.in[I_MB] + l * 4 * DM, (const float*)(ws + WS_HSC2), (const float*)(ws + WS_WGS), bal, gx};
            EpiMergeY EY{mrg, mrg + (size_t)MALL * DM, bal, gx, part};
            REPEAT(9) {
#pragma unroll 1
            for (int n = 0; n < 4; ++n) { const int xe = (bal && c >= 16 * n && c < 16 * n + 16) ? c - 16 * n : -1, nrm = bal ? 128 : nrt;
                { SchedMergeG S; S.T.init(nrm, 8, G, c); S.h8 = (const char*)(ws + WS_H8); S.wg = (const char*)(ws + WS_WIN) + (size_t)NU * DM; S.n = n; S.xe = xe; gm::gemm_stream<false>(lds, S, EG); }
                { SchedMergeY S; S.T.init(nrm, 8, G, c); S.ybr = (const char*)(ws + WS_YBR); S.wbr = (const char*)(ws + WS_WBR); S.n = n; S.xe = xe; gm::gemm_stream<false>(lds, S, EY); }
            } }
            SEAM(pb + 9);
            if (bal) {
                const int tid = otid();
                for (int idx = c * 512 + tid; idx < MCTX * 256; idx += G * 512) { const int row = idx >> 8, q = idx & 255; float sm[8] = {0.f, 0.f, 0.f, 0.f, 0.f, 0.f, 0.f, 0.f};
#pragma unroll
                    for (int n = 0; n < 4; ++n) { const u32x4 w = *(const u32x4*)(part + ((size_t)n * MCTX + row) * DM + q * 8);
                        sm[0] += bflo(w.x); sm[1] += bfhi(w.x); sm[2] += bflo(w.y); sm[3] += bfhi(w.y); sm[4] += bflo(w.z); sm[5] += bfhi(w.z); sm[6] += bflo(w.w); sm[7] += bfhi(w.w); }
                    u32x4 o; o.x = cvt_pk_bf16(sm[0], sm[1]); o.y = cvt_pk_bf16(sm[2], sm[3]); o.z = cvt_pk_bf16(sm[4], sm[5]); o.w = cvt_pk_bf16(sm[6], sm[7]);
                    *(u32x4*)(mrg + (size_t)(MLAT + row) * DM + q * 8) = o; }
                xcd_barrier(bar);
            }
        }
        if (INL(10)) { PH_LOCALS
            const bool spl = need_ctx && G == 256 && MK_LAUNCHES == 1; float* ypart = (float*)(ws + WS_R1 + (size_t)MALL * DFF * 2);
            SchedSplitK S; S.T.init(spl ? 128 : nrt, 8, G, c); S.A = (const char*)mrg; S.B = (const char*)(ws + WS_WOUT); S.lda2 = DM * 2; S.ldb2 = DM * 2; S.nt = DM / 64; S.xe = (spl && c < 64) ? c : -1;
            EpiStoreK E{ybuf, ypart}; gm::gemm_stream<false>(lds, S, E); SEAM(pb + 10);
            if (spl) { job_splitk_reduce(ypart, ybuf); xcd_barrier(bar); }
        }
        if (INL(11)) { PH_LOCALS
            RNArgs a{}; a.xs_lat = p.out; a.xs_ctx = xc; a.xd_lat = p.out; a.xd_ctx = xc; a.y = ybuf; a.wres = 1.0f; a.modl_res = modl; a.jres = 1; a.postg = p.in[I_POST] + (l * 3 + 1) * DM;
            a.do_norm = true; a.modl_norm = modl; a.jn = 2; a.preg = p.in[I_PRE] + (l * 3 + 2) * DM; a.h = nullptr; a.h8 = (signed char*)hbuf; a.nrows = nrt * 256; a.hsc = (float*)(ws + WS_HSC);
            job_resnorm(a, lds); SEAM(pb + 11);
        }
        if (INL(12)) { PH_LOCALS
            SchedPlain S; S.T.init(nrt, 44, G, c); S.A = (const char*)hbuf; S.B = (const char*)(ws + WS_WGU) + (size_t)11264 * 2048; S.lda2 = DM; S.ldb2 = DM; S.nt = DM / 128;
            EpiGateUpI8 E{act, (const float*)(ws + WS_HSC), (const float*)(ws + WS_WSC) + 11264}; gm::gemm_stream<false>(lds, S, E); SEAM(pb + 12);
        }
        if (INL(13)) { PH_LOCALS
            const bool spl = need_ctx && G == 256 && MK_LAUNCHES == 1; float* ypart = (float*)(ws + WS_R1 + (size_t)MALL * DFF * 2);
            SchedSplitK S; S.T.init(spl ? 128 : nrt, 8, G, c); S.A = (const char*)act; S.B = (const char*)(ws + WS_WD) + (size_t)2048 * 5632 * 2; S.lda2 = DFF * 2; S.ldb2 = DFF * 2; S.nt = DFF / 64; S.xe = (spl && c < 64) ? c : -1;
            EpiStoreK E{ybuf, ypart}; gm::gemm_stream<false>(lds, S, E); SEAM(pb + 13);
            if (spl) { job_splitk_reduce(ypart, ybuf); xcd_barrier(bar); }
        }
    }
    if (EN(101) && IN(N_PHASES - 1)) {
        const int l = NL - 1; PH_LOCALS
        RNArgs a{}; a.xs_lat = p.out; a.xs_ctx = xc; a.xd_lat = p.out; a.xd_ctx = xc; a.y = ybuf; a.wres = 0.5f; a.modl_res = mod + (size_t)l * 3 * NMOD * DM; a.jres = 2; a.postg = p.in[I_POST] + (l * 3 + 2) * DM;
        a.do_norm = false; a.modl_norm = a.modl_res; a.jn = 0; a.preg = nullptr; a.h = nullptr; a.nrows = MLAT;
        job_resnorm(a, lds);
    }
#undef PH_LOCALS
#undef IN
#undef INL
#undef EN
#undef SEAM
}


#ifdef DBG_K
__global__ void dbg_dump(float* out, const unsigned char* ws, size_t off, size_t nelem, int is_bf16) {
    const size_t N = (size_t)MLAT * DM;
    for (size_t i = (size_t)obid() * blockDim.x + threadIdx.x; i < N; i += (size_t)gridDim.x * blockDim.x) {
        float s = 0.f;
        for (size_t j = i; j < nelem; j += N) s += is_bf16 ? bf2f(((const bf16_t*)(ws + off))[j]) : ((const float*)(ws + off))[j];
        out[i] = (s - s == 0.f) ? s : 12345.0f;
    }
}
#endif

extern "C" void kernel_launch(void* const* d_in, const int* in_sizes, int n_in, void* d_out, int out_size, void* d_ws, size_t ws_size, hipStream_t stream) {
    static int grid = 0;
    if (grid == 0) {
        if (n_in != 30 || out_size != MLAT * DM || ws_size < WS_END) { fprintf(stderr, "kernel_launch: unexpected shapes: n_in %d out %d ws %zu (need %zu)\n", n_in, out_size, ws_size, (size_t)WS_END); grid = -1; return; }
        int dev = 0, cus = 0;
        if (hipGetDevice(&dev) != hipSuccess || hipDeviceGetAttribute(&cus, hipDeviceAttributeMultiprocessorCount, dev) != hipSuccess) { grid = -1; return; }
        if (hipFuncSetAttribute((const void*)fwd_kernel, hipFuncAttributeMaxDynamicSharedMemorySize, LDS_BYTES) != hipSuccess) { fprintf(stderr, "kernel_launch: hipFuncSetAttribute failed\n"); grid = -1; return; }
        int per_cu = 0; (void)hipOccupancyMaxActiveBlocksPerMultiprocessor(&per_cu, (const void*)fwd_kernel, NTHR, LDS_BYTES); (void)hipGetLastError();
        grid = cus;
    }
    if (grid < 0) return;
    (void)hipMemsetAsync((char*)d_ws + WS_CTL, 0, WS_ZERO_BYTES, stream);
    KP p{};
    for (int i = 0; i < 30; ++i) p.in[i] = (const float*)d_in[i];
    p.out = (float*)d_out; p.ws = (unsigned char*)d_ws;
#ifdef DBG_K
    for (int k = 0; k < DBG_K; ++k) { p.ph_lo = k; p.ph_hi = k + 1; hipLaunchKernelGGL(fwd_kernel, dim3(grid), dim3(NTHR), LDS_BYTES, stream, p); }
    hipLaunchKernelGGL(dbg_dump, dim3(2048), dim3(256), 0, stream, (float*)d_out, (const unsigned char*)d_ws, (size_t)(DBG_OFF), (size_t)(DBG_N), (int)(DBG_BF));
#elif MK_LAUNCHES == 1
    p.ph_lo = 0; p.ph_hi = N_PHASES;
    hipLaunchKernelGGL(fwd_kernel, dim3(grid), dim3(NTHR), LDS_BYTES, stream, p);
#else
    for (int k = 0; k < N_PHASES; ++k) { p.ph_lo = k; p.ph_hi = k + 1; hipLaunchKernelGGL(fwd_kernel, dim3(grid), dim3(NTHR), LDS_BYTES, stream, p); }
#endif
}
```

```cpp
#include <hip/hip_runtime.h>
#include <stdint.h>
#include <stdio.h>

#define LAS __attribute__((address_space(3)))
typedef unsigned short bf16_t;
typedef short bf16x8 __attribute__((ext_vector_type(8)));
typedef short s16x4 __attribute__((ext_vector_type(4)));
typedef float f32x2 __attribute__((ext_vector_type(2)));
typedef float f32x4 __attribute__((ext_vector_type(4)));
typedef float f32x16 __attribute__((ext_vector_type(16)));
typedef unsigned u32x2 __attribute__((ext_vector_type(2)));
typedef unsigned u32x4 __attribute__((ext_vector_type(4)));
typedef int i32x4 __attribute__((ext_vector_type(4)));

constexpr int DM = 2048, NB = 2, SEQ = 16384, NL = 2, CTXL = 256, DFF = 5632, NMOD = 9;
constexpr int MLAT = NB * SEQ, MCTX = NB * CTXL, MALL = MLAT + MCTX;
constexpr int NRT = MALL / 256;
constexpr int DIN = 14144, NU = 6144;
constexpr float EPS = 1e-6f;
constexpr int U_AQ = 0, U_BX = 512, U_BG = 1024, U_CQ = 1536, U_CK = 2048, U_CV = 2560, U_DQ = 3072, U_DFF = 3584, U_DFB = 4096, U_DI = 4608, U_DG = 5120, U_AKV = 5632, U_AKR = 5888;

constexpr size_t al256(size_t x) { return (x + 255) / 256 * 256; }
constexpr size_t WS_CTL = 0;
constexpr size_t WS_CMAX = 16384;
constexpr size_t WS_CMAX2 = WS_CMAX + (size_t)NL * 2 * 2 * 5632 * 4;
constexpr size_t WS_ZERO_BYTES = 524288;
static_assert(WS_CMAX2 + (size_t)NL * 14336 * 4 <= WS_ZERO_BYTES, "column maxima inside the zeroed region");
constexpr size_t WS_MOD = 524288;
constexpr size_t WS_ROPE = WS_MOD + al256((size_t)NL * 3 * NMOD * DM * 4);
constexpr size_t WS_SCAL = WS_ROPE + 32768;
constexpr size_t WS_RSQ = WS_SCAL + 32768;
constexpr size_t WS_RGS = WS_RSQ + al256((size_t)MALL * 8);
constexpr size_t WS_HD = WS_RGS + al256((size_t)NRT * 2 * 512 * 8);
constexpr size_t WS_XC = WS_HD + al256((size_t)520 * 4 * 2 * 128 * 4);
constexpr size_t WS_WGU = WS_XC + (size_t)MCTX * DM * 4;
constexpr size_t WS_WD = WS_WGU + (size_t)2 * 11264 * 2048 * 2;
constexpr size_t WS_WIN = WS_WD + (size_t)2 * 2048 * 5632 * 2;
constexpr size_t WS_WUQ = WS_WIN + (size_t)14336 * 2048 * 2;
constexpr size_t WS_WUKV = WS_WUQ + (size_t)768 * 512 * 2;
constexpr size_t WS_WRG = WS_WUKV + (size_t)1024 * 256 * 2;
constexpr size_t WS_WBR = WS_WRG + (size_t)2048 * 512 * 2;
constexpr size_t WS_WOUT = WS_WBR + (size_t)4 * 2048 * 512 * 2;
constexpr size_t WS_HBUF = WS_WOUT + (size_t)2048 * 2048 * 2;
constexpr size_t WS_R1 = WS_HBUF + (size_t)MALL * DM * 2;
constexpr size_t WS_YBUF = WS_R1 + (size_t)MALL * NU * 2;
constexpr size_t WS_QM = WS_YBUF + (size_t)MALL * DM * 2;
constexpr size_t WS_KM = WS_QM + (size_t)MALL * 768 * 2;
constexpr size_t WS_VM = WS_KM + (size_t)MALL * 768 * 2;
constexpr size_t WS_YBR = WS_VM + (size_t)MALL * 512 * 2;
constexpr size_t WS_XCV = WS_YBR + (size_t)4 * MALL * 512 * 2;
constexpr size_t WS_LA = WS_XCV + (size_t)MALL * 512 * 2;
constexpr size_t WS_BB = WS_LA + (size_t)MALL * 1024 * 2;
constexpr size_t WS_WSC = WS_BB + (size_t)MALL * 1024 * 2;
constexpr size_t WS_HSC = WS_WSC + al256((size_t)2 * 11264 * 4);
constexpr size_t WS_HSC2 = WS_HSC + al256((size_t)MALL * 4);
constexpr size_t WS_WGS = WS_HSC2 + al256((size_t)MALL * 4);
constexpr size_t WS_WPS = WS_WGS + 32768;
constexpr size_t WS_H8 = WS_WPS + 32768;
constexpr size_t WS_END = WS_H8 + (size_t)MALL * DM;

constexpr int NTHR = 512;
constexpr int LDS_BYTES = 147456;
constexpr int LDS_MISC = 147456 - 64;

typedef __bf16 bf16x2n __attribute__((ext_vector_type(2)));
__device__ __forceinline__ unsigned cvt_pk_bf16(float lo, float hi) { const f32x2 v = {lo, hi}; const bf16x2n b = __builtin_convertvector(v, bf16x2n); return __builtin_bit_cast(unsigned, b); }
__device__ __forceinline__ bf16_t f2bf(float x) { return (bf16_t)(cvt_pk_bf16(x, 0.f) & 0xffffu); }
__device__ __forceinline__ float bf2f(bf16_t b) { return __uint_as_float(((unsigned)b) << 16); }
__device__ __forceinline__ float bflo(unsigned w) { return __uint_as_float(w << 16); }
__device__ __forceinline__ float bfhi(unsigned w) { return __uint_as_float(w & 0xffff0000u); }
__device__ __forceinline__ float frcp(float x) { return __builtin_amdgcn_rcpf(x); }
__device__ __forceinline__ float flog(float x) { return __builtin_amdgcn_logf(x) * 0.6931471805599453f; }
__device__ __forceinline__ float sigmoidf_(float x) { return frcp(1.0f + __expf(-x)); }
__device__ __forceinline__ float siluf_(float x) { return x * sigmoidf_(x); }
__device__ __forceinline__ float gelu_tanh(float x) { const float u = 0.7978845608028654f * (x + 0.044715f * x * x * x); const float t = 1.0f - 2.0f * frcp(1.0f + __expf(2.0f * u)); return 0.5f * x * (1.0f + t); }
__device__ __forceinline__ float shx(float v, int mask, int lane) { return __int_as_float(__builtin_amdgcn_ds_bpermute((lane ^ mask) << 2, __float_as_int(v))); }
__device__ __forceinline__ float wave_sum(float v, int lane) {
#pragma unroll
    for (int o = 32; o >= 1; o >>= 1) v += shx(v, o, lane);
    return v;
}
__device__ __forceinline__ int obid() { int b = blockIdx.x; asm volatile("" : "+s"(b)); return b; }
__device__ __forceinline__ int otid() { int t = threadIdx.x; asm volatile("" : "+v"(t)); return t; }
#define WAIT_VM0() asm volatile("s_waitcnt vmcnt(0)" ::: "memory")
#define WAIT_LGKM0() asm volatile("s_waitcnt lgkmcnt(0)" ::: "memory")

#define XB_TMO      128
#define XB_XCNT(j)  (256  + 64 * (j))
#define XB_XSUB(j)  (1280 + 64 * (j))
#define XB_XGEN(j)  (2304 + 64 * (j))
#define XB_TOP      3328
#define XB_TOPGEN   3392
#define XCD_BAR_WORDS 3456
#define XB_SPIN_CAP (1u << 22)
__device__ __forceinline__ unsigned xb_ld(unsigned* p)              { return __hip_atomic_load(p, __ATOMIC_RELAXED, __HIP_MEMORY_SCOPE_AGENT); }
__device__ __forceinline__ unsigned xb_add(unsigned* p, unsigned v) { return __hip_atomic_fetch_add(p, v, __ATOMIC_RELAXED, __HIP_MEMORY_SCOPE_AGENT); }
__device__ __forceinline__ unsigned xb_xcc_id() { return (unsigned)__builtin_amdgcn_s_getreg((3 << 11) | 20) & 0xFu; }
#define XB_SPIN(cond, bar) do { unsigned _sp = 0; while (cond) { __builtin_amdgcn_s_sleep(1); \
    if ((++_sp & 255u) == 0u) { if (xb_ld(&(bar)[XB_TMO])) break; if (_sp > XB_SPIN_CAP) { atomicAdd(&(bar)[XB_TMO], 1u); break; } } } } while (0)
struct XcdBarrier { unsigned* bar; unsigned x; volatile LAS unsigned* st; };
__device__ __forceinline__ XcdBarrier xcd_barrier_post(unsigned* bar, volatile LAS unsigned* st) {
    XcdBarrier b; b.bar = bar; b.x = xb_xcc_id(); b.st = st;
    if (threadIdx.x == 0) (void)xb_add(&bar[XB_XCNT(b.x)], 1u);
    return b;
}
__device__ __forceinline__ void xcd_barrier_complete(unsigned* bar, unsigned x, unsigned& nloc, unsigned& nx) {
    const unsigned G = gridDim.x * gridDim.y * gridDim.z;
    unsigned sum, cnt, mine, sp = 0u;
    for (;;) {
        sum = 0u; cnt = 0u; mine = 0u;
#pragma unroll 1
        for (unsigned j = 0; j < 16; ++j) { const unsigned c = xb_ld(&bar[XB_XCNT(j)]); sum += c; cnt += (c > 0u) ? 1u : 0u; mine = (j == x) ? c : mine; }
        if (sum == G) break;
        __builtin_amdgcn_s_sleep(1);
        if ((++sp & 255u) == 0u) { if (xb_ld(&bar[XB_TMO])) break; if (sp > XB_SPIN_CAP) { atomicAdd(&bar[XB_TMO], 1u); break; } }
    }
    nloc = mine > 0u ? mine : 1u; nx = cnt > 0u ? cnt : 1u;
}
__device__ __forceinline__ void xcd_barrier(const XcdBarrier& b) {
    asm volatile("s_waitcnt vmcnt(0)" ::: "memory");
    __syncthreads();
    if (threadIdx.x == 0) {
        unsigned* bar = b.bar; unsigned bx = b.x;
        asm volatile("" : "+s"(bar), "+s"(bx));
        __builtin_amdgcn_s_waitcnt(0);
        unsigned nloc = b.st[0], nx = b.st[1];
        if (nloc == 0u) { xcd_barrier_complete(bar, bx, nloc, nx); b.st[0] = nloc; b.st[1] = nx; }
        const unsigned old = xb_add(&bar[XB_XSUB(bx)], 1u);
        const unsigned gen = old / nloc;
        if (old + 1u == (gen + 1u) * nloc) {
            __builtin_amdgcn_fence(__ATOMIC_RELEASE, "agent");
            asm volatile("s_waitcnt vmcnt(0)" ::: "memory");
            const unsigned og = xb_add(&bar[XB_TOP], 1u);
            const unsigned tg = og / nx;
            if (og + 1u == (tg + 1u) * nx) xb_add(&bar[XB_TOPGEN], 1u);
            else XB_SPIN(xb_ld(&bar[XB_TOPGEN]) == tg, bar);
            __builtin_amdgcn_fence(__ATOMIC_ACQUIRE, "agent");
            xb_add(&bar[XB_XGEN(bx)], 1u);
            asm volatile("s_waitcnt vmcnt(0)" ::: "memory");
        } else {
            XB_SPIN(xb_ld(&bar[XB_XGEN(bx)]) == gen, bar);
            __builtin_amdgcn_fence(__ATOMIC_ACQUIRE, "agent");
            asm volatile("s_waitcnt vmcnt(0)" ::: "memory");
        }
    }
    __syncthreads();
}

constexpr float MLA_QC = 0.07216878364870322f * 1.4426950408889634f, DIFF_QC = 0.125f * 1.4426950408889634f;
namespace gm {
constexpr int BM = 256, BK = 64, HALF = 128, HTB = HALF * BK * 2, STAGE_BYTES = 8 * HTB;
__device__ __forceinline__ int lds_byte(int r, int c) { const int st = (r >> 4) * 2 + (c >> 5), rr = r & 15, cc = c & 31, ob = rr * 64 + cc * 2; return st * 1024 + (ob ^ (((ob >> 9) & 1) << 5)); }
__device__ __forceinline__ void stage_rc(int b, int& R, int& C) { const int st = b / 1024, sb = b % 1024, swz = sb ^ (((sb >> 9) & 1) << 5); R = (st >> 1) * 16 + swz / 64; C = (st & 1) * 32 + (swz % 64) / 2; }
__device__ __forceinline__ int perm32(int rho) { const int n = rho >> 4, i = rho & 15; return 8 * (i >> 2) + 4 * n + (i & 3); }

struct Unit { const char* A; const char* B; unsigned lda2, ldb2; int nt; int pm, pn, tag; };

struct TileOrder {
    int nM, nN, nwg, G, c;
    __device__ __forceinline__ void init(int nM_, int nN_, int G_, int c_) { nM = nM_; nN = nN_; nwg = nM * nN; G = G_; c = c_; }
    __device__ __forceinline__ bool tile(int i, int& pm, int& pn) const {
        const long L = (long)i * G + c; if (L >= nwg) return false;
        int wgid = (int)L; { const int q = nwg / 8, r = nwg % 8, xcd = wgid % 8, off = wgid / 8; wgid = (xcd < r ? xcd * (q + 1) : r * (q + 1) + (xcd - r) * q) + off; }
        const int nig = 8 * nN, gid = wgid / nig, fm = gid * 8, gsz = (nM - fm) < 8 ? (nM - fm) : 8;
        pm = fm + ((wgid % nig) % gsz); pn = (wgid % nig) / gsz; return true;
    }
};

typedef i32x4 AccI[2][2][4][2];
__device__ __forceinline__ void zero_acc(AccI& acc) {
#pragma unroll
    for (int a = 0; a < 2; ++a)
#pragma unroll
        for (int b = 0; b < 2; ++b)
#pragma unroll
            for (int m = 0; m < 4; ++m)
#pragma unroll
                for (int n = 0; n < 2; ++n) acc[a][b][m][n] = (i32x4){0, 0, 0, 0};
}
template <class E> struct is_mixed { static constexpr bool v = false; };
typedef f32x4 Acc[2][2][4][2];
__device__ __forceinline__ void zero_acc(Acc& acc) {
#pragma unroll
    for (int a = 0; a < 2; ++a)
#pragma unroll
        for (int b = 0; b < 2; ++b)
#pragma unroll
            for (int m = 0; m < 4; ++m)
#pragma unroll
                for (int n = 0; n < 2; ++n) acc[a][b][m][n] = (f32x4){0.f, 0.f, 0.f, 0.f};
}

template <bool HALFN, class Sched, class Epi>
__device__ __forceinline__ void gemm_stream(LAS unsigned char* lds, const Sched& S, Epi& E) {
    const int tid = otid(), wid = __builtin_amdgcn_readfirstlane(tid >> 6), lane = tid & 63, wr = wid >> 2, wc = wid & 3, fr = lane & 15, fq = lane >> 4;
    int R0, C0; stage_rc(tid * 16, R0, C0);
    const int Rb0 = Epi::PERM ? ((R0 & ~31) + perm32(R0 & 31)) : R0;
    const unsigned ldsw = (unsigned)wid * 1024u;
    const int aoff = lds_byte(wr * 64 + fr, fq * 8), boff = lds_byte(wc * 32 + fr, fq * 8);
#define GM_SA(b, h) (((b) * 2 + (h)) * HTB)
#define GM_SB(b, h) ((4 + (b) * 2 + (h)) * HTB)
#define GM_STAGE(bufoff, gbase, voff, ld2) do { _Pragma("unroll") for (int _i = 0; _i < 2; ++_i) \
        __builtin_amdgcn_global_load_lds((const unsigned*)((const char*)(gbase) + (size_t)_i * 64 * (ld2) + (voff)), (LAS unsigned*)(lds + (bufoff) + ldsw + _i * 8192), 16, 0, 0); } while (0)
#define GM_LDA(dst, b, h) do { _Pragma("unroll") for (int m = 0; m < 4; ++m) _Pragma("unroll") for (int k = 0; k < 2; ++k) dst[m][k] = *(const LAS bf16x8*)(lds + GM_SA(b, h) + aoff + m * 2048 + k * 1024); } while (0)
#define GM_LDB(dst, b, h) do { _Pragma("unroll") for (int n = 0; n < 2; ++n) _Pragma("unroll") for (int k = 0; k < 2; ++k) dst[n][k] = *(const LAS bf16x8*)(lds + GM_SB(b, h) + boff + n * 2048 + k * 1024); } while (0)
#define GM_MMA_I8(ai, bj, At, Bt) do { _Pragma("unroll") for (int m = 0; m < 4; ++m) _Pragma("unroll") for (int n = 0; n < 2; ++n) _Pragma("unroll") for (int k = 0; k < 2; ++k) \
        acc[ai][bj][m][n] = __builtin_bit_cast(typename Epi::AccT_elem, __builtin_amdgcn_mfma_i32_16x16x64_i8(__builtin_bit_cast(i32x4, Bt[n][k]), __builtin_bit_cast(i32x4, At[m][k]), __builtin_bit_cast(i32x4, acc[ai][bj][m][n]), 0, 0, 0)); } while (0)
#define GM_MMA_BF(ai, bj, At, Bt) do { _Pragma("unroll") for (int m = 0; m < 4; ++m) _Pragma("unroll") for (int n = 0; n < 2; ++n) _Pragma("unroll") for (int k = 0; k < 2; ++k) \
        acc[ai][bj][m][n] = __builtin_bit_cast(typename Epi::AccT_elem, __builtin_amdgcn_mfma_f32_16x16x32_bf16(Bt[n][k], At[m][k], __builtin_bit_cast(f32x4, acc[ai][bj][m][n]), 0, 0, 0)); } while (0)
#define GM_MMA(ai, bj, At, Bt) do { __builtin_amdgcn_s_setprio(1); \
        if constexpr (is_mixed<Epi>::v) { if (cur_i8) GM_MMA_I8(ai, bj, At, Bt); else GM_MMA_BF(ai, bj, At, Bt); } \
        else if constexpr (Epi::I8) GM_MMA_I8(ai, bj, At, Bt); else GM_MMA_BF(ai, bj, At, Bt); \
        __builtin_amdgcn_s_setprio(0); } while (0)
#define GM_WAIT_V(n) asm volatile("s_waitcnt vmcnt(" #n ")" ::: "memory")
#define GM_WAIT_L(n) asm volatile("s_waitcnt lgkmcnt(" #n ")" ::: "memory")
#define GM_BAR __builtin_amdgcn_s_barrier()
#define GM_SCHED __builtin_amdgcn_sched_barrier(0)
    Unit cur, nxt; int ui = 0;
    if (!S.next(0, cur)) return;
    typename Epi::AccT acc;
    bf16x8 At[4][2], B0[2][2], B1[2][2];
    unsigned voffA = (unsigned)R0 * cur.lda2 + (unsigned)C0 * 2u, voffB = (unsigned)Rb0 * cur.ldb2 + (unsigned)C0 * 2u;
    const char* cA = cur.A; const char* cB = cur.B;
    {
        const size_t hA = (size_t)HALF * cur.lda2, hB = (size_t)HALF * cur.ldb2;
        GM_STAGE(GM_SB(0, 0), cB, voffB, cur.ldb2); GM_STAGE(GM_SA(0, 0), cA, voffA, cur.lda2);
        if constexpr (!HALFN) GM_STAGE(GM_SB(0, 1), cB + hB, voffB, cur.ldb2);
        GM_STAGE(GM_SA(0, 1), cA + hA, voffA, cur.lda2);
        if (wr == 1) GM_BAR;
        if constexpr (HALFN) GM_WAIT_V(2); else GM_WAIT_V(4);
        GM_BAR;
        GM_STAGE(GM_SB(1, 0), cB + 128, voffB, cur.ldb2); GM_STAGE(GM_SA(1, 0), cA + 128, voffA, cur.lda2);
        if constexpr (!HALFN) GM_STAGE(GM_SB(1, 1), cB + hB + 128, voffB, cur.ldb2);
        if constexpr (HALFN) GM_WAIT_V(4); else GM_WAIT_V(6);
        GM_BAR;
    }
#define GM_UNIT(BJ) { \
        if constexpr (HALFN) { _Pragma("unroll") for (int _a = 0; _a < 2; ++_a) _Pragma("unroll") for (int _m = 0; _m < 4; ++_m) _Pragma("unroll") for (int _n = 0; _n < 2; ++_n) acc[_a][0][_m][_n] = (f32x4){0.f, 0.f, 0.f, 0.f}; } \
        else zero_acc(acc); \
        const bool cur_i8 = (cur.tag & 1) == 0; (void)cur_i8; \
        const bool has_next = S.next(ui + 1, nxt); \
        const char* nA = has_next ? nxt.A : cA; const char* nB = has_next ? nxt.B : cB; \
        const unsigned nlda2 = has_next ? nxt.lda2 : cur.lda2, nldb2 = has_next ? nxt.ldb2 : cur.ldb2; \
        const unsigned nvoffA = (unsigned)R0 * nlda2 + (unsigned)C0 * 2u, nvoffB = (unsigned)Rb0 * nldb2 + (unsigned)C0 * 2u; \
        const size_t hA = (size_t)HALF * cur.lda2, hB = (size_t)HALF * cur.ldb2, nhA = (size_t)HALF * nlda2, nhB = (size_t)HALF * nldb2; \
        const int nt = cur.nt; \
        for (int t = 0; t < nt; t += 2) { \
            const bool last = (t == nt - 2); \
            const char* a1 = cA + (size_t)(t + 1) * 128; \
            const char* a2 = last ? nA : cA + (size_t)(t + 2) * 128; const char* b2 = last ? nB : cB + (size_t)(t + 2) * 128; \
            const char* a3 = a2 + 128; const char* b3 = b2 + 128; \
            const unsigned vA2 = last ? nvoffA : voffA, vB2 = last ? nvoffB : voffB; \
            const unsigned lA2 = last ? nlda2 : cur.lda2, lB2 = last ? nldb2 : cur.ldb2; \
            const size_t hA2 = last ? nhA : hA, hB2 = last ? nhB : hB; \
              \
            GM_LDB(B0, 0, 0); GM_SCHED; GM_LDA(At, 0, 0); GM_STAGE(GM_SA(1, 1), a1 + hA, voffA, cur.lda2); \
            GM_WAIT_L(8); GM_BAR; GM_WAIT_L(0); GM_MMA(0, 0, At, B0); GM_BAR; GM_SCHED; \
              \
            if constexpr (!HALFN) GM_LDB(B1, 0, 1); \
            GM_STAGE(GM_SB(0, 0), b2, vB2, lB2); \
            GM_BAR; GM_WAIT_L(0); if constexpr (!HALFN) GM_MMA(0, 1, At, B1); GM_BAR; \
              \
            GM_LDA(At, 0, 1); GM_STAGE(GM_SA(0, 0), a2, vA2, lA2); \
            GM_BAR; GM_WAIT_L(0); GM_MMA(1, 0, At, B0); GM_BAR; GM_SCHED; \
              \
            if constexpr (!HALFN) { GM_STAGE(GM_SB(0, 1), b2 + hB2, vB2, lB2); GM_WAIT_V(6); } else { GM_WAIT_V(4); } \
            GM_BAR; if constexpr (!HALFN) GM_MMA(1, 1, At, B1); GM_BAR; \
              \
            GM_LDB(B0, 1, 0); GM_SCHED; GM_LDA(At, 1, 0); GM_STAGE(GM_SA(0, 1), a2 + hA2, vA2, lA2); \
            GM_WAIT_L(8); GM_BAR; GM_WAIT_L(0); GM_MMA(0, 0, At, B0); GM_BAR; GM_SCHED; \
              \
            if constexpr (!HALFN) GM_LDB(B1, 1, 1); \
            GM_STAGE(GM_SB(1, 0), b3, vB2, lB2); \
            GM_BAR; GM_WAIT_L(0); if constexpr (!HALFN) GM_MMA(0, 1, At, B1); GM_BAR; \
              \
            GM_LDA(At, 1, 1); GM_STAGE(GM_SA(1, 0), a3, vA2, lA2); \
            GM_BAR; GM_WAIT_L(0); GM_MMA(1, 0, At, B0); GM_BAR; GM_SCHED; \
              \
            if constexpr (!HALFN) { GM_STAGE(GM_SB(1, 1), b3 + hB2, vB2, lB2); GM_WAIT_V(6); } else { GM_WAIT_V(4); } \
            GM_BAR; if constexpr (!HALFN) GM_MMA(1, 1, At, B1); GM_BAR; \
        } \
        { const int tz_ = otid(); const int wz_ = __builtin_amdgcn_readfirstlane(tz_ >> 6), lz_ = tz_ & 63; E.template post<BJ>(acc, cur, wz_ >> 2, wz_ & 3, lz_ & 15, lz_ >> 4); } \
        if (!has_next) break; \
        cur = nxt; cA = nA; cB = nB; voffA = nvoffA; voffB = nvoffB; ++ui; \
    }
    for (;;) {
        GM_UNIT(0)
    }
    GM_WAIT_V(0);
    if (wr == 0) GM_BAR;
    GM_BAR;
#undef GM_UNIT
#undef GM_SA
#undef GM_SB
#undef GM_STAGE
#undef GM_LDA
#undef GM_LDB
#undef GM_MMA
#undef GM_MMA_I8
#undef GM_MMA_BF
#undef GM_WAIT_V
#undef GM_WAIT_L
#undef GM_BAR
#undef GM_SCHED
}
}

struct SchedPlain {
    gm::TileOrder T; const char* A; const char* B; unsigned lda2, ldb2; int nt;
    __device__ __forceinline__ bool next(int i, gm::Unit& u) const {
        int pm, pn; if (!T.tile(i, pm, pn)) return false;
        u.A = A + (size_t)pm * 256 * lda2; u.B = B + (size_t)pn * 256 * ldb2; u.lda2 = lda2; u.ldb2 = ldb2; u.nt = nt; u.pm = pm; u.pn = pn; u.tag = 0; return true;
    }
};
struct SchedSplitK {
    gm::TileOrder T; const char* A; const char* B; unsigned lda2, ldb2; int nt, xe;
    __device__ __forceinline__ bool next(int i, gm::Unit& u) const {
        int pm, pn; u.lda2 = lda2; u.ldb2 = ldb2;
        if (T.tile(i, pm, pn)) { u.A = A + (size_t)pm * 256 * lda2; u.B = B + (size_t)pn * 256 * ldb2; u.nt = nt; u.pm = pm; u.pn = pn; u.tag = 0; return true; }
        if (xe < 0 || i != 4) return false;
        const int e = xe >> 2, sl = xe & 3, ks = nt >> 2; pm = 128 + (e & 1); pn = e >> 1;
        u.A = A + (size_t)pm * 256 * lda2 + (size_t)sl * ks * 128; u.B = B + (size_t)pn * 256 * ldb2 + (size_t)sl * ks * 128; u.nt = ks; u.pm = pm; u.pn = pn; u.tag = 1 + sl; return true;
    }
};
struct SchedMergeG {
    gm::TileOrder T; const char* h8; const char* wg; int n, xe;
    __device__ __forceinline__ bool next(int i, gm::Unit& u) const {
        int pm, pn; if (!T.tile(i, pm, pn)) { if (xe < 0 || i != 4) return false; pm = 128 + (xe & 1); pn = xe >> 1; }
        u.A = h8 + (size_t)pm * 256 * 2048; u.lda2 = 2048; u.nt = 16; u.B = wg + ((size_t)n * 2048 + (size_t)pn * 256) * 2048; u.ldb2 = 2048; u.pm = pm; u.pn = pn; u.tag = n; return true;
    }
};
struct SchedMergeY {
    gm::TileOrder T; const char* ybr; const char* wbr; int n, xe;
    __device__ __forceinline__ bool next(int i, gm::Unit& u) const {
        int pm, pn; if (!T.tile(i, pm, pn)) { if (xe < 0 || i != 4) return false; pm = 128 + (xe & 1); pn = xe >> 1; }
        u.A = ybr + (size_t)n * MALL * 1024 + (size_t)pm * 256 * 1024; u.lda2 = 1024; u.nt = 8; u.B = wbr + ((size_t)n * 2048 + (size_t)pn * 256) * 1024; u.ldb2 = 1024; u.pm = pm; u.pn = pn; u.tag = n; return true;
    }
};

struct EpiGateUp {
    static constexpr bool PERM = true, I8 = false; typedef gm::Acc AccT; typedef f32x4 AccT_elem; bf16_t* act;
    template <int BJ> __device__ __forceinline__ void post(gm::Acc& acc, const gm::Unit& u, int wr, int wc, int fr, int fq) {
        const int row0 = u.pm * 256 + wr * 64 + fr, col0 = u.pn * 128 + wc * 32 + 8 * fq;
#pragma unroll
        for (int ai = 0; ai < 2; ++ai)
#pragma unroll
            for (int m = 0; m < 4; ++m) {
                float v[8];
#pragma unroll
                for (int n = 0; n < 2; ++n)
#pragma unroll
                    for (int j = 0; j < 4; ++j) v[n * 4 + j] = siluf_(acc[ai][0][m][n][j]) * acc[ai][1][m][n][j];
                u32x4 w; w.x = cvt_pk_bf16(v[0], v[1]); w.y = cvt_pk_bf16(v[2], v[3]); w.z = cvt_pk_bf16(v[4], v[5]); w.w = cvt_pk_bf16(v[6], v[7]);
                *(u32x4*)(act + (size_t)(row0 + ai * 128 + m * 16) * DFF + col0) = w;
            }
    }
};
struct EpiGateUpI8 {
    static constexpr bool PERM = true, I8 = true; typedef gm::AccI AccT; typedef i32x4 AccT_elem; bf16_t* act; const float* hsc; const float* wsc;
    template <int BJ> __device__ __forceinline__ void post(gm::AccI& acc, const gm::Unit& u, int wr, int wc, int fr, int fq) {
        const int row0 = u.pm * 256 + wr * 64 + fr, col0 = u.pn * 128 + wc * 32 + 8 * fq, wrow = u.pn * 256 + wc * 32 + 8 * fq;
        float sg[8], su[8];
#pragma unroll
        for (int j = 0; j < 8; ++j) { sg[j] = wsc[wrow + j]; su[j] = wsc[wrow + 128 + j]; }
        float hsv[8];
#pragma unroll
        for (int i = 0; i < 8; ++i) hsv[i] = hsc[row0 + (i >> 2) * 128 + (i & 3) * 16];
#pragma unroll
        for (int ai = 0; ai < 2; ++ai)
#pragma unroll
            for (int m = 0; m < 4; ++m) {
                const int row = row0 + ai * 128 + m * 16; const float hs = hsv[ai * 4 + m];
                float v[8];
#pragma unroll
                for (int n = 0; n < 2; ++n)
#pragma unroll
                    for (int j = 0; j < 4; ++j) { const float g = (float)acc[ai][0][m][n][j] * (hs * sg[n * 4 + j]), up = (float)acc[ai][1][m][n][j] * (hs * su[n * 4 + j]); v[n * 4 + j] = siluf_(g) * up; }
                u32x4 w; w.x = cvt_pk_bf16(v[0], v[1]); w.y = cvt_pk_bf16(v[2], v[3]); w.z = cvt_pk_bf16(v[4], v[5]); w.w = cvt_pk_bf16(v[6], v[7]);
                *(u32x4*)(act + (size_t)row * DFF + col0) = w;
            }
    }
};
struct EpiStore {
    static constexpr bool PERM = true, I8 = false; typedef gm::Acc AccT; typedef f32x4 AccT_elem; bf16_t* O; int ldc;
    template <int BJ> __device__ __forceinline__ void post(gm::Acc& acc, const gm::Unit& u, int wr, int wc, int fr, int fq) {
        const int row0 = u.pm * 256 + wr * 64 + fr, col0 = u.pn * 256 + wc * 32 + 8 * fq;
#pragma unroll
        for (int ai = 0; ai < 2; ++ai)
#pragma unroll
            for (int m = 0; m < 4; ++m)
#pragma unroll
                for (int bj = 0; bj < 2; ++bj) {
                    const f32x4 a = acc[ai][bj][m][0], b = acc[ai][bj][m][1];
                    u32x4 w; w.x = cvt_pk_bf16(a[0], a[1]); w.y = cvt_pk_bf16(a[2], a[3]); w.z = cvt_pk_bf16(b[0], b[1]); w.w = cvt_pk_bf16(b[2], b[3]);
                    *(u32x4*)(O + (size_t)(row0 + ai * 128 + m * 16) * ldc + col0 + bj * 128) = w;
                }
    }
};
struct EpiStoreK {
    static constexpr bool PERM = true, I8 = false; typedef gm::Acc AccT; typedef f32x4 AccT_elem; bf16_t* O; float* yp;
    template <int BJ> __device__ __forceinline__ void post(gm::Acc& acc, const gm::Unit& u, int wr, int wc, int fr, int fq) {
        const int row0 = u.pm * 256 + wr * 64 + fr, col0 = u.pn * 256 + wc * 32 + 8 * fq;
        if (u.tag == 0) {
#pragma unroll
            for (int ai = 0; ai < 2; ++ai)
#pragma unroll
                for (int m = 0; m < 4; ++m)
#pragma unroll
                    for (int bj = 0; bj < 2; ++bj) {
                        const f32x4 a = acc[ai][bj][m][0], b = acc[ai][bj][m][1];
                        u32x4 w; w.x = cvt_pk_bf16(a[0], a[1]); w.y = cvt_pk_bf16(a[2], a[3]); w.z = cvt_pk_bf16(b[0], b[1]); w.w = cvt_pk_bf16(b[2], b[3]);
                        *(u32x4*)(O + (size_t)(row0 + ai * 128 + m * 16) * DM + col0 + bj * 128) = w;
                    }
        } else {
            float* base = yp + (size_t)(u.tag - 1) * MCTX * DM;
#pragma unroll
            for (int ai = 0; ai < 2; ++ai)
#pragma unroll
                for (int m = 0; m < 4; ++m)
#pragma unroll
                    for (int bj = 0; bj < 2; ++bj) { float* o = base + (size_t)(row0 - MLAT + ai * 128 + m * 16) * DM + col0 + bj * 128;
                        *(f32x4*)o = acc[ai][bj][m][0]; *(f32x4*)(o + 4) = acc[ai][bj][m][1]; }
        }
    }
};
__device__ __forceinline__ void job_splitk_reduce(const float* yp, bf16_t* y) {
    const int c = obid(), tid = otid(), G = gridDim.x;
    for (int idx = c * 512 + tid; idx < MCTX * 256; idx += G * 512) { const int row = idx >> 8, q = idx & 255; f32x4 a = {0.f, 0.f, 0.f, 0.f}, b = a;
#pragma unroll
        for (int sl = 0; sl < 4; ++sl) { const float* s = yp + ((size_t)sl * MCTX + row) * DM + q * 8; a += *(const f32x4*)s; b += *(const f32x4*)(s + 4); }
        u32x4 o; o.x = cvt_pk_bf16(a[0], a[1]); o.y = cvt_pk_bf16(a[2], a[3]); o.z = cvt_pk_bf16(b[0], b[1]); o.w = cvt_pk_bf16(b[2], b[3]);
        *(u32x4*)(y + (size_t)(MLAT + row) * DM + q * 8) = o; }
}
__device__ __forceinline__ void rope4(f32x4& x0, f32x4& x1, const float* rope, int pos, int fq) {
    const f32x4 t0 = *(const f32x4*)(rope + pos * 32 + 8 * fq), t1 = *(const f32x4*)(rope + pos * 32 + 8 * fq + 4);
    const float c[4] = {t0[0], t0[2], t1[0], t1[2]}, s[4] = {t0[1], t0[3], t1[1], t1[3]};
#pragma unroll
    for (int j = 0; j < 4; ++j) { const float a = x0[j], b = x1[j]; x0[j] = a * c[j] - b * s[j]; x1[j] = a * s[j] + b * c[j]; }
}
__device__ __forceinline__ void rope4v(f32x4& x0, f32x4& x1, const f32x4 t0, const f32x4 t1) {
    const float c[4] = {t0[0], t0[2], t1[0], t1[2]}, s[4] = {t0[1], t0[3], t1[1], t1[3]};
#pragma unroll
    for (int j = 0; j < 4; ++j) { const float a = x0[j], b = x1[j]; x0[j] = a * c[j] - b * s[j]; x1[j] = a * s[j] + b * c[j]; }
}
struct EpiProj {
    static constexpr bool PERM = false, I8 = true; typedef gm::AccI AccT; typedef i32x4 AccT_elem; bf16_t* ubuf; bf16_t* km; const float* rope; const float* hsc; const float* wps;
    template <int BJ> __device__ __forceinline__ void post(gm::AccI& acc, const gm::Unit& u, int wr, int wc, int fr, int fq) {
        const int pn = u.pn; const bool lat = u.pm < 128, ropet = (pn >= 6 && pn <= 9), akr = (pn == 23);
        const int row0 = u.pm * 256 + wr * 64 + fr;
        f32x4 wsv[2][2];
#pragma unroll
        for (int bj = 0; bj < 2; ++bj)
#pragma unroll
            for (int n = 0; n < 2; ++n) wsv[bj][n] = *(const f32x4*)(wps + pn * 256 + bj * 128 + wc * 32 + 16 * n + 4 * fq);
        float hsv[8];
#pragma unroll
        for (int i = 0; i < 8; ++i) hsv[i] = hsc[row0 + (i >> 2) * 128 + (i & 3) * 16];
        const bool dor = lat && (ropet || (akr && wc < 2));
#pragma unroll
        for (int ai = 0; ai < 2; ++ai) {
            f32x4 rt[4][2];
            if (dor) {
#pragma unroll
                for (int m = 0; m < 4; ++m) { const int s = (row0 + ai * 128 + m * 16) & (SEQ - 1), pos = (wc & 1) ? (s & 63) : (s >> 6);
                    rt[m][0] = *(const f32x4*)(rope + pos * 32 + 8 * fq); rt[m][1] = *(const f32x4*)(rope + pos * 32 + 8 * fq + 4); }
            }
#pragma unroll
            for (int m = 0; m < 4; ++m) {
                const int row = row0 + ai * 128 + m * 16; const float hs = hsv[ai * 4 + m] * ((pn == 6 || pn == 7) ? DIFF_QC : 1.0f);
#pragma unroll
                for (int bj = 0; bj < 2; ++bj) {
                    f32x4 x0, x1;
#pragma unroll
                    for (int j = 0; j < 4; ++j) { x0[j] = (float)acc[ai][bj][m][0][j] * (hs * wsv[bj][0][j]); x1[j] = (float)acc[ai][bj][m][1][j] * (hs * wsv[bj][1][j]); }
                    const bool akr_blk = akr && bj == 0 && wc < 2;
                    if (lat && (ropet || akr_blk)) rope4v(x0, x1, rt[m][0], rt[m][1]);
                    u32x2 w0, w1; w0.x = cvt_pk_bf16(x0[0], x0[1]); w0.y = cvt_pk_bf16(x0[2], x0[3]); w1.x = cvt_pk_bf16(x1[0], x1[1]); w1.y = cvt_pk_bf16(x1[2], x1[3]);
                    if (!akr) { bf16_t* o = ubuf + (size_t)row * NU + pn * 256 + bj * 128 + wc * 32 + 4 * fq; *(u32x2*)o = w0; *(u32x2*)(o + 16) = w1; }
                    else if (akr_blk) {
#pragma unroll
                        for (int h = 0; h < 4; ++h) { bf16_t* o = km + (size_t)row * 768 + h * 192 + 128 + wc * 32 + 4 * fq; *(u32x2*)o = w0; *(u32x2*)(o + 16) = w1; }
                    }
                }
            }
        }
    }
};
struct EpiQup {
    static constexpr bool PERM = false, I8 = false; typedef gm::Acc AccT; typedef f32x4 AccT_elem; bf16_t* qm; const float* rsq; const float* rope;
    template <int BJ> __device__ __forceinline__ void post(gm::Acc& acc, const gm::Unit& u, int wr, int wc, int fr, int fq) {
        const bool lat = u.pm < 128; const int row0 = u.pm * 256 + wr * 64 + fr;
        float rsv[8];
#pragma unroll
        for (int i = 0; i < 8; ++i) rsv[i] = rsq[row0 + (i >> 2) * 128 + (i & 3) * 16];
#pragma unroll
        for (int ai = 0; ai < 2; ++ai)
#pragma unroll
            for (int m = 0; m < 4; ++m) {
                const int row = row0 + ai * 128 + m * 16, s = row & (SEQ - 1); const float rs = rsv[ai * 4 + m] * MLA_QC;
#pragma unroll
                for (int bj = 0; bj < 2; ++bj) {
                    const int b32 = 8 * u.pn + 4 * bj + wc, m6 = b32 % 6;
                    f32x4 x0 = acc[ai][bj][m][0] * rs, x1 = acc[ai][bj][m][1] * rs;
                    if (lat && m6 >= 4) rope4(x0, x1, rope, (m6 == 5) ? (s & 63) : (s >> 6), fq);
                    u32x2 w0, w1; w0.x = cvt_pk_bf16(x0[0], x0[1]); w0.y = cvt_pk_bf16(x0[2], x0[3]); w1.x = cvt_pk_bf16(x1[0], x1[1]); w1.y = cvt_pk_bf16(x1[2], x1[3]);
                    bf16_t* o = qm + (size_t)row * 768 + b32 * 32 + 4 * fq; *(u32x2*)o = w0; *(u32x2*)(o + 16) = w1;
                }
            }
    }
};
struct EpiKVup {
    static constexpr bool PERM = true, I8 = false; typedef gm::Acc AccT; typedef f32x4 AccT_elem; bf16_t* km; bf16_t* vm; const float* rsk;
    template <int BJ> __device__ __forceinline__ void post(gm::Acc& acc, const gm::Unit& u, int wr, int wc, int fr, int fq) {
        const int row0 = u.pm * 256 + wr * 64 + fr, h = u.pn, c0 = wc * 32 + 8 * fq;
        float rsv[8];
#pragma unroll
        for (int i = 0; i < 8; ++i) rsv[i] = rsk[row0 + (i >> 2) * 128 + (i & 3) * 16];
#pragma unroll
        for (int ai = 0; ai < 2; ++ai)
#pragma unroll
            for (int m = 0; m < 4; ++m) {
                const int row = row0 + ai * 128 + m * 16; const float rs = rsv[ai * 4 + m];
#pragma unroll
                for (int bj = 0; bj < 2; ++bj) {
                    const f32x4 a = acc[ai][bj][m][0] * rs, b = acc[ai][bj][m][1] * rs;
                    u32x4 w; w.x = cvt_pk_bf16(a[0], a[1]); w.y = cvt_pk_bf16(a[2], a[3]); w.z = cvt_pk_bf16(b[0], b[1]); w.w = cvt_pk_bf16(b[2], b[3]);
                    if (bj == 0) *(u32x4*)(km + (size_t)row * 768 + h * 192 + c0) = w; else *(u32x4*)(vm + (size_t)row * 512 + h * 128 + c0) = w;
                }
            }
    }
};
struct EpiRG {
    static constexpr bool PERM = true, I8 = false; typedef gm::Acc AccT; typedef f32x4 AccT_elem; const bf16_t* xcv; bf16_t* la; bf16_t* bb; const float* b_r; const float* b_i; const float* sp;
    template <int BJ> __device__ __forceinline__ void post(gm::Acc& acc, const gm::Unit& u, int wr, int wc, int fr, int fq) {
        const int d = u.pn >> 2, w0 = (u.pn & 3) * 128 + wc * 32 + 8 * fq, row0 = u.pm * 256 + wr * 64 + fr;
        float br[8], bi[8], sv[8];
#pragma unroll
        for (int j = 0; j < 8; ++j) { br[j] = b_r[d * 512 + w0 + j]; bi[j] = b_i[d * 512 + w0 + j]; sv[j] = sp[d * 512 + w0 + j]; }
        u32x4 xwv[8];
#pragma unroll
        for (int i = 0; i < 8; ++i) xwv[i] = *(const u32x4*)(xcv + (size_t)(row0 + (i >> 2) * 128 + (i & 3) * 16) * 512 + w0);
#pragma unroll
        for (int ai = 0; ai < 2; ++ai)
#pragma unroll
            for (int m = 0; m < 4; ++m) {
                const int row = row0 + ai * 128 + m * 16;
                const u32x4 xw = xwv[ai * 4 + m];
                const float xv[8] = {bflo(xw.x), bfhi(xw.x), bflo(xw.y), bfhi(xw.y), bflo(xw.z), bfhi(xw.z), bflo(xw.w), bfhi(xw.w)};
                float lo[8], bo[8];
#pragma unroll
                for (int n = 0; n < 2; ++n)
#pragma unroll
                    for (int j = 0; j < 4; ++j) {
                        const int k = n * 4 + j;
                        const float r = sigmoidf_(acc[ai][0][m][n][j] + br[k]), ig = sigmoidf_(acc[ai][1][m][n][j] + bi[k]);
                        const float l_a = -8.0f * r * sv[k], x2 = 2.0f * l_a;
                        const float om = (x2 > -0.3f) ? (-x2 * (1.0f + x2 * (0.5f + x2 * (0.16666667f + x2 * (0.041666668f + x2 * 0.0083333338f))))) : (1.0f - __expf(x2));
                        lo[k] = l_a; bo[k] = __builtin_amdgcn_sqrtf(om) * ig * xv[k];
                    }
                u32x4 wl, wb;
                wl.x = cvt_pk_bf16(lo[0], lo[1]); wl.y = cvt_pk_bf16(lo[2], lo[3]); wl.z = cvt_pk_bf16(lo[4], lo[5]); wl.w = cvt_pk_bf16(lo[6], lo[7]);
                wb.x = cvt_pk_bf16(bo[0], bo[1]); wb.y = cvt_pk_bf16(bo[2], bo[3]); wb.z = cvt_pk_bf16(bo[4], bo[5]); wb.w = cvt_pk_bf16(bo[6], bo[7]);
                *(u32x4*)(la + (size_t)row * 1024 + d * 512 + w0) = wl; *(u32x4*)(bb + (size_t)row * 1024 + d * 512 + w0) = wb;
            }
    }
};
struct EpiMergeG {
    static constexpr bool PERM = true, I8 = true; typedef gm::AccI AccT; typedef i32x4 AccT_elem; bf16_t* gtmp; const float* mb; const float* hsc; const float* wgs; bool bal; bf16_t* gx;
    template <int BJ> __device__ __forceinline__ void post(gm::AccI& acc, const gm::Unit& u, int wr, int wc, int fr, int fq) {
        const int col0 = u.pn * 256 + wc * 32 + 8 * fq, row0 = u.pm * 256 + wr * 64 + fr, nbr = u.tag;
        const bool ex = bal && u.pm >= 128; bf16_t* go = ex ? gx : gtmp; const int orow0 = ex ? nbr * 512 + row0 - MLAT : row0;
        f32x4 bv[2][2], sv[2][2];
#pragma unroll
        for (int bj = 0; bj < 2; ++bj)
#pragma unroll
            for (int n = 0; n < 2; ++n) { bv[bj][n] = *(const f32x4*)(mb + nbr * DM + col0 + bj * 128 + 4 * n); sv[bj][n] = *(const f32x4*)(wgs + nbr * DM + col0 + bj * 128 + 4 * n); }
        float hsv[8];
#pragma unroll
        for (int i = 0; i < 8; ++i) hsv[i] = hsc[row0 + (i >> 2) * 128 + (i & 3) * 16];
#pragma unroll
        for (int ai = 0; ai < 2; ++ai)
#pragma unroll
            for (int m = 0; m < 4; ++m) { const float hs = hsv[ai * 4 + m];
#pragma unroll
                for (int bj = 0; bj < 2; ++bj) { float g[8];
#pragma unroll
                    for (int n = 0; n < 2; ++n)
#pragma unroll
                        for (int j = 0; j < 4; ++j) g[n * 4 + j] = sigmoidf_((float)acc[ai][bj][m][n][j] * (hs * sv[bj][n][j]) + bv[bj][n][j]);
                    u32x4 w; w.x = cvt_pk_bf16(g[0], g[1]); w.y = cvt_pk_bf16(g[2], g[3]); w.z = cvt_pk_bf16(g[4], g[5]); w.w = cvt_pk_bf16(g[6], g[7]);
                    *(u32x4*)(go + (size_t)(orow0 + ai * 128 + m * 16) * DM + col0 + bj * 128) = w; } }
    }
};
struct EpiMergeY {
    static constexpr bool PERM = true, I8 = false; typedef gm::Acc AccT; typedef f32x4 AccT_elem; bf16_t* mrg; const bf16_t* gtmp; bool bal; const bf16_t* gx; bf16_t* part;
    template <int BJ> __device__ __forceinline__ void post(gm::Acc& acc, const gm::Unit& u, int wr, int wc, int fr, int fq) {
        const int col0 = u.pn * 256 + wc * 32 + 8 * fq, row0 = u.pm * 256 + wr * 64 + fr, nbr = u.tag;
        const bool ex = bal && u.pm >= 128; const bf16_t* gi = ex ? gx : gtmp; bf16_t* mo = ex ? part : mrg; const int orow0 = ex ? nbr * 512 + row0 - MLAT : row0;
        const bool rd = nbr > 0 && !ex;
#pragma unroll
        for (int ai = 0; ai < 2; ++ai) {
            u32x4 gwv[4][2], mwv[4][2];
#pragma unroll
            for (int m = 0; m < 4; ++m)
#pragma unroll
                for (int bj = 0; bj < 2; ++bj) { const size_t off = (size_t)(orow0 + ai * 128 + m * 16) * DM + col0 + bj * 128;
                    gwv[m][bj] = *(const u32x4*)(gi + off); mwv[m][bj] = (u32x4){0u, 0u, 0u, 0u}; if (rd) mwv[m][bj] = *(const u32x4*)(mo + off); }
#pragma unroll
            for (int m = 0; m < 4; ++m)
#pragma unroll
                for (int bj = 0; bj < 2; ++bj) {
                    const size_t off = (size_t)(orow0 + ai * 128 + m * 16) * DM + col0 + bj * 128;
                    const u32x4 gw = gwv[m][bj], mw = mwv[m][bj];
                    const float g[8] = {bflo(gw.x), bfhi(gw.x), bflo(gw.y), bfhi(gw.y), bflo(gw.z), bfhi(gw.z), bflo(gw.w), bfhi(gw.w)};
                    float mm[8] = {bflo(mw.x), bfhi(mw.x), bflo(mw.y), bfhi(mw.y), bflo(mw.z), bfhi(mw.z), bflo(mw.w), bfhi(mw.w)};
#pragma unroll
                    for (int n = 0; n < 2; ++n)
#pragma unroll
                        for (int j = 0; j < 4; ++j) mm[n * 4 + j] += g[n * 4 + j] * acc[ai][bj][m][n][j];
                    u32x4 w; w.x = cvt_pk_bf16(mm[0], mm[1]); w.y = cvt_pk_bf16(mm[2], mm[3]); w.z = cvt_pk_bf16(mm[4], mm[5]); w.w = cvt_pk_bf16(mm[6], mm[7]);
                    *(u32x4*)(mo + off) = w;
                }
        }
    }
};


struct KP { const float* in[30]; float* out; unsigned char* ws; int ph_lo, ph_hi; };
typedef const __attribute__((address_space(4))) KP CKP;
__device__ __forceinline__ LAS unsigned char* lds_here(unsigned char* raw) { unsigned a = (unsigned)(uintptr_t)(LAS unsigned char*)raw; asm volatile("" : "+s"(a)); return (LAS unsigned char*)(uintptr_t)a; }
__device__ __forceinline__ CKP& kp_here() { CKP* q = (CKP*)__builtin_amdgcn_kernarg_segment_ptr(); asm volatile("" : "+s"(q)); return *q; }
enum { I_X = 0, I_C, I_CTX, I_CCTX, I_ADAW, I_ADAB, I_PRE, I_POST, I_WG, I_WU, I_WDN, I_WIN, I_QNORM, I_WUQ, I_KVNORM, I_WUKV, I_CONVW, I_CONVB, I_RGWR, I_RGBR, I_RGWI, I_RGBI, I_RGLAM,
       I_DLAM, I_SUBLN, I_HLB, I_HNORM, I_MB, I_WBR, I_WOUT };

__device__ __forceinline__ void job_mod(CKP& p, LAS unsigned char* lds) {
    LAS float* sl = (LAS float*)lds;
    LAS float* red = (LAS float*)(lds + 24576);
    const int tid = otid(), lane = tid & 63, wave = tid >> 6;
    for (int i = tid; i < 3 * DM; i += NTHR) { const int g = i / DM, k = i % DM; const float c = g < 2 ? p.in[I_C][g * DM + k] : p.in[I_CCTX][k]; sl[i] = siluf_(c); }
    __syncthreads();
    float* mod = (float*)(p.ws + WS_MOD);
    for (int u = obid(); u < NL * 288; u += gridDim.x) {
        const int l = u / 288, col = (u % 288) * 64 + lane;
        const float* w = p.in[I_ADAW] + (size_t)l * DM * (NMOD * DM) + col;
        float a0 = 0.f, a1 = 0.f, a2 = 0.f;
        const int k0 = wave * 256;
#pragma unroll 8
        for (int k = k0; k < k0 + 256; ++k) { const float wv = w[(size_t)k * (NMOD * DM)]; a0 += sl[k] * wv; a1 += sl[DM + k] * wv; a2 += sl[2 * DM + k] * wv; }
        red[(wave * 3 + 0) * 64 + lane] = a0; red[(wave * 3 + 1) * 64 + lane] = a1; red[(wave * 3 + 2) * 64 + lane] = a2;
        __syncthreads();
        if (tid < 192) { const int g = tid >> 6; float s = 0.f;
#pragma unroll
            for (int w8 = 0; w8 < 8; ++w8) s += red[(w8 * 3 + g) * 64 + lane];
            mod[(size_t)(l * 3 + g) * (NMOD * DM) + col] = s + p.in[I_ADAB][l * (NMOD * DM) + col]; }
        __syncthreads();
    }
}
__device__ __forceinline__ void job_tables(CKP& p) {
    const int tid = otid();
    if (obid() == 0) {
        float* rope = (float*)(p.ws + WS_ROPE);
        for (int i = tid; i < 4096; i += NTHR) { const int pos = i >> 4, f = i & 15; const float inv = powf(10000.0f, -(float)f / 16.0f); const float ang = (float)pos * inv; float s, c; sincosf(ang, &s, &c); rope[2 * i] = c; rope[2 * i + 1] = s; }
    }
    if (obid() == 1 % gridDim.x) {
        float* sc = (float*)(p.ws + WS_SCAL);
        if (tid < NL) { const float* lv = p.in[I_DLAM] + tid * 256; float s01 = 0.f, s23 = 0.f; for (int i = 0; i < 64; ++i) { s01 += lv[i] * lv[64 + i]; s23 += lv[128 + i] * lv[192 + i]; }
            sc[tid] = expf(s01) - expf(s23) + (0.8f - 0.6f * expf(-0.3f * (float)tid)); }
        for (int k = tid; k < 512; k += NTHR) {
            float mx = -1e30f; for (int l = 0; l < NL; ++l) mx = fmaxf(mx, p.in[I_HLB][l * 512 + k]);
            float den = 0.f; for (int l = 0; l < NL; ++l) den += expf(p.in[I_HLB][l * 512 + k] - mx);
            float cum = 0.f; for (int l = 0; l < NL; ++l) { if (l > 0) cum += expf(p.in[I_HLB][l * 512 + k] - mx) / den; sc[256 + l * 512 + k] = cum; }
        }
        for (int i = tid; i < NL * 1024; i += NTHR) { const float x = -p.in[I_RGLAM][i]; sc[2048 + i] = fmaxf(x, 0.f) + log1pf(expf(-fabsf(x))); }
    }
}

__device__ __forceinline__ void job_colmax(CKP& p) {
    unsigned* cmax = (unsigned*)(p.ws + WS_CMAX);
    const int tid = otid(), c4 = (tid & 63) * 4, wv = tid >> 6;
    for (int u = obid(); u < NL * 2 * 2 * 22 * 4; u += gridDim.x) {
        const int kc = u & 3, cb = (u >> 2) % 22, mat = u / (4 * 22), which = mat & 1, lf = mat >> 1;
        const float* w = (which ? p.in[I_WU] : p.in[I_WG]) + (size_t)lf * DM * DFF + (size_t)(kc * 512 + wv * 64) * DFF + cb * 256 + c4;
        u32x4 mx = {0u, 0u, 0u, 0u};
#pragma unroll 1
        for (int k0 = 0; k0 < 64; k0 += 16) { u32x4 v[16];
#pragma unroll
            for (int k = 0; k < 16; ++k) v[k] = *(const u32x4*)(w + (size_t)(k0 + k) * DFF);
            asm volatile("" ::: "memory");
#pragma unroll
            for (int k = 0; k < 16; ++k) { mx.x = max(mx.x, v[k].x & 0x7fffffffu); mx.y = max(mx.y, v[k].y & 0x7fffffffu); mx.z = max(mx.z, v[k].z & 0x7fffffffu); mx.w = max(mx.w, v[k].w & 0x7fffffffu); } }
        unsigned* dst = cmax + (size_t)(lf * 2 + which) * DFF + cb * 256 + c4;
        atomicMax(dst, mx.x); atomicMax(dst + 1, mx.y); atomicMax(dst + 2, mx.z); atomicMax(dst + 3, mx.w);
    }
    unsigned* cmax2 = (unsigned*)(p.ws + WS_CMAX2);
    for (int u = obid(); u < NL * 56 * 4; u += gridDim.x) {
        const int kc = u & 3, cb = (u >> 2) % 56, l = u / (4 * 56), cc = cb * 256 + c4;
        if (cc < DIN) {
            const float* w = p.in[I_WIN] + (size_t)l * DM * DIN + (size_t)(kc * 512 + wv * 64) * DIN + cc;
            u32x4 mx = {0u, 0u, 0u, 0u};
#pragma unroll 1
            for (int k0 = 0; k0 < 64; k0 += 16) { u32x4 v[16];
#pragma unroll
                for (int k = 0; k < 16; ++k) v[k] = *(const u32x4*)(w + (size_t)(k0 + k) * DIN);
                asm volatile("" ::: "memory");
#pragma unroll
                for (int k = 0; k < 16; ++k) { mx.x = max(mx.x, v[k].x & 0x7fffffffu); mx.y = max(mx.y, v[k].y & 0x7fffffffu); mx.z = max(mx.z, v[k].z & 0x7fffffffu); mx.w = max(mx.w, v[k].w & 0x7fffffffu); } }
            unsigned* dst = cmax2 + (size_t)l * 14336 + cc;
            atomicMax(dst, mx.x); atomicMax(dst + 1, mx.y); atomicMax(dst + 2, mx.z); atomicMax(dst + 3, mx.w);
        }
    }
}
struct CvtDesc { const float* src; const float* ks; bf16_t* dst; int ldsrc, c0, k0, lddst, n0; const unsigned* q8max; float* q8scale; };
__device__ __forceinline__ void cvt_load(const CvtDesc& d, int tid, f32x4 (&v)[2]) {
    const int r = tid >> 4, c4 = (tid & 15) * 4;
#pragma unroll
    for (int ps = 0; ps < 2; ++ps) { const int k = r + 32 * ps; v[ps] = (f32x4){0.f, 0.f, 0.f, 0.f};
        if (d.src) { v[ps] = *(const f32x4*)(d.src + (size_t)(d.k0 + k) * d.ldsrc + d.c0 + c4); if (d.ks) v[ps] = v[ps] * d.ks[d.k0 + k]; } }
}
__device__ __forceinline__ void cvt_store(LAS float* tile, const CvtDesc& d, int tid, const f32x4 (&v)[2]) {
    { const int r = tid >> 4, c4 = (tid & 15) * 4;
#pragma unroll
      for (int ps = 0; ps < 2; ++ps) { const int k = r + 32 * ps; tile[k * 65 + c4 + 0] = v[ps][0]; tile[k * 65 + c4 + 1] = v[ps][1]; tile[k * 65 + c4 + 2] = v[ps][2]; tile[k * 65 + c4 + 3] = v[ps][3]; } }
    __syncthreads();
    { const int n = tid >> 3, k8 = (tid & 7) * 8; float x[8];
#pragma unroll
      for (int i = 0; i < 8; ++i) x[i] = tile[(k8 + i) * 65 + n];
      if (d.q8max) {
          const float mx = fmaxf(__uint_as_float(d.q8max[n]), 1e-30f), inv = 127.0f / mx;
          int q[8];
#pragma unroll
          for (int i = 0; i < 8; ++i) q[i] = (int)rintf(x[i] * inv) & 0xff;
          u32x2 w; w.x = (unsigned)q[0] | ((unsigned)q[1] << 8) | ((unsigned)q[2] << 16) | ((unsigned)q[3] << 24); w.y = (unsigned)q[4] | ((unsigned)q[5] << 8) | ((unsigned)q[6] << 16) | ((unsigned)q[7] << 24);
          *(u32x2*)((signed char*)d.dst + (size_t)(d.n0 + n) * d.lddst + d.k0 + k8) = w;
          if (d.k0 == 0 && k8 == 0) d.q8scale[n] = mx * (1.0f / 127.0f);
      } else {
          u32x4 w; w.x = cvt_pk_bf16(x[0], x[1]); w.y = cvt_pk_bf16(x[2], x[3]); w.z = cvt_pk_bf16(x[4], x[5]); w.w = cvt_pk_bf16(x[6], x[7]);
          *(u32x4*)(d.dst + (size_t)(d.n0 + n) * d.lddst + d.k0 + k8) = w; } }
    __syncthreads();
}
constexpr int CV_N0 = 2 * 176 * 32, CV_N1 = 2 * 32 * 88, CV_N2 = 224 * 32, CV_N3 = 12 * 8, CV_N4 = 16 * 4, CV_N5 = 4 * 32 * 8, CV_N6 = 32 * 32, CV_N7 = 1024;
constexpr int CV_BLOCKS = CV_N0 + CV_N1 + CV_N2 + CV_N3 + CV_N4 + CV_N5 + CV_N6;
__device__ __forceinline__ CvtDesc cvt_desc(CKP& p, int l, int b) {
    unsigned char* ws = p.ws; CvtDesc d; d.ks = nullptr; d.q8max = nullptr; d.q8scale = nullptr;
    if (b < CV_N0) { const int f = b / (176 * 32), rem = b % (176 * 32), nb = rem / 32, kb = rem % 32, t = nb >> 2, q = nb & 3;
        d.src = (q < 2 ? p.in[I_WG] : p.in[I_WU]) + (size_t)(l * 2 + f) * DM * DFF; d.ldsrc = DFF; d.c0 = 128 * t + (q & 1) * 64; d.k0 = kb * 64; d.dst = (bf16_t*)(ws + WS_WGU + (size_t)f * 11264 * 2048); d.lddst = 2048; d.n0 = nb * 64;
        d.q8max = (const unsigned*)(ws + WS_CMAX) + (size_t)((l * 2 + f) * 2 + (q < 2 ? 0 : 1)) * DFF + d.c0; d.q8scale = (float*)(ws + WS_WSC) + (size_t)f * 11264 + d.n0; return d; }
    b -= CV_N0;
    if (b < CV_N1) { const int f = b / (32 * 88), rem = b % (32 * 88), nb = rem / 88, kb = rem % 88;
        d.src = p.in[I_WDN] + (size_t)(l * 2 + f) * DFF * DM; d.ldsrc = DM; d.c0 = nb * 64; d.k0 = kb * 64; d.dst = (bf16_t*)(ws + WS_WD) + (size_t)f * 2048 * 5632; d.lddst = 5632; d.n0 = nb * 64; return d; }
    b -= CV_N1;
    if (b < CV_N2) { const int nb = b / 32, kb = b % 32, j0 = nb * 64; int sc;
        if (j0 < 512) sc = j0; else if (j0 < 5632) sc = 832 + (j0 - 512); else if (j0 < 5888) sc = 512 + (j0 - 5632); else if (j0 < 5952) sc = 768 + (j0 - 5888); else if (j0 < 6144) sc = -1; else sc = 5952 + (j0 - 6144);
        d.src = sc < 0 ? nullptr : p.in[I_WIN] + (size_t)l * DM * DIN; d.ldsrc = DIN; d.c0 = sc < 0 ? 0 : sc; d.k0 = kb * 64; d.dst = (bf16_t*)(ws + WS_WIN); d.lddst = 2048; d.n0 = j0;
        d.q8max = (const unsigned*)(ws + WS_CMAX2) + (size_t)l * 14336 + (sc < 0 ? DIN : sc);
        d.q8scale = j0 < 6144 ? (float*)(ws + WS_WPS) + j0 : (float*)(ws + WS_WGS) + (j0 - 6144);
        return d; }
    b -= CV_N2;
    if (b < CV_N3) { const int nb = b / 8, kb = b % 8;
        d.src = p.in[I_WUQ] + (size_t)l * 512 * 768; d.ldsrc = 768; d.c0 = nb * 64; d.k0 = kb * 64; d.ks = p.in[I_QNORM] + l * 512; d.dst = (bf16_t*)(ws + WS_WUQ); d.lddst = 512; d.n0 = nb * 64; return d; }
    b -= CV_N3;
    if (b < CV_N4) { const int nb = b / 4, kb = b % 4;
        d.src = p.in[I_WUKV] + (size_t)l * 256 * 1024; d.ldsrc = 1024; d.c0 = nb * 64; d.k0 = kb * 64; d.ks = p.in[I_KVNORM] + l * 256; d.dst = (bf16_t*)(ws + WS_WUKV); d.lddst = 256; d.n0 = nb * 64; return d; }
    b -= CV_N4;
    if (b < CV_N5) { const int n = b / 256, rem = b % 256, nb = rem / 8, kb = rem % 8;
        d.src = p.in[I_WBR] + (size_t)(l * 4 + n) * 512 * DM; d.ldsrc = DM; d.c0 = nb * 64; d.k0 = kb * 64; d.dst = (bf16_t*)(ws + WS_WBR) + (size_t)n * 2048 * 512; d.lddst = 512; d.n0 = nb * 64; return d; }
    b -= CV_N5;
    { const int nb = b / 32, kb = b % 32;
        d.src = p.in[I_WOUT] + (size_t)l * DM * DM; d.ldsrc = DM; d.c0 = nb * 64; d.k0 = kb * 64; d.dst = (bf16_t*)(ws + WS_WOUT); d.lddst = 2048; d.n0 = nb * 64; return d; }
}
__device__ __forceinline__ void job_convert(CKP& p, LAS unsigned char* lds, int l) {
    LAS float* tile = (LAS float*)lds;
    const int tid = otid();
    {
        int u = obid();
        if (u < CV_BLOCKS) {
            f32x4 vc[2]; { const CvtDesc d0 = cvt_desc(p, l, u); cvt_load(d0, tid, vc); }
            for (;;) {
                const int un = u + gridDim.x; const bool more = un < CV_BLOCKS;
                f32x4 vn[2] = {vc[0], vc[1]};
                if (more) { const CvtDesc dn = cvt_desc(p, l, un); cvt_load(dn, tid, vn); }
                { const CvtDesc dc = cvt_desc(p, l, u); cvt_store(tile, dc, tid, vc); }
                if (!more) break;
                vc[0] = vn[0]; vc[1] = vn[1]; u = un;
            }
        }
    }
    for (int b = obid(); b < CV_N7; b += gridDim.x) {
        bf16_t* dst = (bf16_t*)(p.ws + WS_WRG);
#pragma unroll
        for (int e = 0; e < 2; ++e) { const int idx = b * 1024 + e * 512 + tid, o = idx >> 9, k = idx & 511;
            const int t8 = o >> 8, d = t8 >> 2, blk = t8 & 3, g = (o >> 7) & 1, i = o & 127, kin = k - blk * 128;
            float v = 0.f; if (kin >= 0 && kin < 128) v = (g ? p.in[I_RGWI] : p.in[I_RGWR])[((size_t)((l * 2 + d) * 4 + blk) * 128 + kin) * 128 + i];
            dst[idx] = f2bf(v); }
    }
}

struct RNArgs {
    const float* xs_lat; const float* xs_ctx; float* xd_lat; float* xd_ctx;
    const bf16_t* y; float wres;
    const float* modl_res; int jres; const float* postg;
    bool do_norm; const float* modl_norm; int jn; const float* preg; bf16_t* h; int nrows; signed char* h8; float* hsc;
};
__device__ __forceinline__ void job_resnorm(const RNArgs& a, LAS unsigned char* lds) {
    const int tid_ = otid(); const int lane = tid_ & 63, gw = obid() * 8 + (tid_ >> 6), nw = gridDim.x * 8;
    LAS float* PA = (LAS float*)lds; LAS float* PB = PA + 3 * DM; LAS float* PC = PB + 3 * DM;
    for (int i = tid_; i < 3 * DM; i += NTHR) { const int g = i / DM, c = i % DM;
        if (a.y) PA[i] = a.modl_res[(size_t)g * (NMOD * DM) + (3 * a.jres + 2) * DM + c] * a.postg[c];
        if (a.do_norm) { const float* sh = a.modl_norm + (size_t)g * (NMOD * DM) + (3 * a.jn) * DM; PB[i] = a.preg[c] * (sh[DM + c] + 1.0f); PC[i] = sh[c]; } }
    __syncthreads();
    f32x4 xq[8]; u32x2 yq[8];
#define RN_LOAD(R, X, Y) do { const int r_ = (R); const float* xs_ = r_ < MLAT ? a.xs_lat + (size_t)r_ * DM : a.xs_ctx + (size_t)(r_ - MLAT) * DM; \
        _Pragma("unroll") for (int i = 0; i < 8; ++i) X[i] = *(const f32x4*)(xs_ + i * 256 + lane * 4); \
        if (a.y) { _Pragma("unroll") for (int i = 0; i < 8; ++i) Y[i] = *(const u32x2*)(a.y + (size_t)r_ * DM + i * 256 + lane * 4); } } while (0)
    if (gw < a.nrows) RN_LOAD(gw, xq, yq);
    for (int r = gw; r < a.nrows; r += nw) {
        const int g = r < SEQ ? 0 : (r < MLAT ? 1 : 2); const bool lat = r < MLAT;
        f32x4 x[8]; u32x2 yr[8];
#pragma unroll
        for (int i = 0; i < 8; ++i) { x[i] = xq[i]; yr[i] = yq[i]; }
        RN_LOAD(r + nw < a.nrows ? r + nw : r, xq, yq);
        if (a.y) {
            f32x4 yv[8]; float ss = 0.f;
#pragma unroll
            for (int i = 0; i < 8; ++i) { const u32x2 w = yr[i]; yv[i] = (f32x4){bflo(w.x), bfhi(w.x), bflo(w.y), bfhi(w.y)}; ss += yv[i][0] * yv[i][0] + yv[i][1] * yv[i][1] + yv[i][2] * yv[i][2] + yv[i][3] * yv[i][3]; }
            ss = wave_sum(ss, lane);
            const float rr = a.wres * rsqrtf(ss * (1.0f / DM) + EPS);
            float* xd = lat ? a.xd_lat + (size_t)r * DM : a.xd_ctx + (size_t)(r - MLAT) * DM;
#pragma unroll
            for (int i = 0; i < 8; ++i) { const int c = i * 256 + lane * 4; const f32x4 gp = *(const LAS f32x4*)(PA + g * DM + c);
                x[i] = x[i] + gp * (yv[i] * rr); *(f32x4*)(xd + c) = x[i]; }
        }
        if (a.do_norm) {
            float ss = 0.f;
#pragma unroll
            for (int i = 0; i < 8; ++i) ss += x[i][0] * x[i][0] + x[i][1] * x[i][1] + x[i][2] * x[i][2] + x[i][3] * x[i][3];
            ss = wave_sum(ss, lane);
            const float rr = rsqrtf(ss * (1.0f / DM) + EPS);
            float mx = 0.f;
#pragma unroll
            for (int i = 0; i < 8; ++i) { const int c = i * 256 + lane * 4; const f32x4 ps = *(const LAS f32x4*)(PB + g * DM + c), hv = *(const LAS f32x4*)(PC + g * DM + c);
                x[i] = (x[i] * rr) * ps + hv; mx = fmaxf(mx, fmaxf(fmaxf(fabsf(x[i][0]), fabsf(x[i][1])), fmaxf(fabsf(x[i][2]), fabsf(x[i][3]))));
                if (a.h) { u32x2 w; w.x = cvt_pk_bf16(x[i][0], x[i][1]); w.y = cvt_pk_bf16(x[i][2], x[i][3]); *(u32x2*)(a.h + (size_t)r * DM + c) = w; } }
            if (a.h8) {
#pragma unroll
                for (int o = 32; o >= 1; o >>= 1) mx = fmaxf(mx, shx(mx, o, lane));
                mx = fmaxf(mx, 1e-30f); const float inv = 127.0f / mx;
                if (lane == 0) a.hsc[r] = mx * (1.0f / 127.0f);
#pragma unroll
                for (int i = 0; i < 8; ++i) { const unsigned q0 = (unsigned)((int)rintf(x[i][0] * inv) & 0xff), q1 = (unsigned)((int)rintf(x[i][1] * inv) & 0xff), q2 = (unsigned)((int)rintf(x[i][2] * inv) & 0xff), q3 = (unsigned)((int)rintf(x[i][3] * inv) & 0xff);
                    *(unsigned*)(a.h8 + (size_t)r * DM + i * 256 + lane * 4) = q0 | (q1 << 8) | (q2 << 16) | (q3 << 24); }
            }
        }
    }
    __syncthreads();
#undef RN_LOAD
}

__device__ __forceinline__ void job_stats_conv(CKP& p, int l) {
    const bf16_t* ubuf = (const bf16_t*)(p.ws + WS_R1); float* rsq = (float*)(p.ws + WS_RSQ); float* rsk = rsq + MALL; bf16_t* xcv = (bf16_t*)(p.ws + WS_XCV);
    const int tid_ = otid(); const int lane = tid_ & 63, gw = obid() * 8 + (tid_ >> 6), nw = gridDim.x * 8;
    float cw[4][8], cb[8];
#pragma unroll
    for (int j = 0; j < 4; ++j)
#pragma unroll
        for (int i = 0; i < 8; ++i) cw[j][i] = p.in[I_CONVW][(l * 4 + j) * 512 + lane * 8 + i];
#pragma unroll
    for (int i = 0; i < 8; ++i) cb[i] = p.in[I_CONVB][l * 512 + lane * 8 + i];
    for (int r = gw; r < MALL; r += nw) {
        const bf16_t* ur = ubuf + (size_t)r * NU;
        {
            const u32x4 w = *(const u32x4*)(ur + U_AQ + lane * 8); float ss = 0.f;
            { const float v[8] = {bflo(w.x), bfhi(w.x), bflo(w.y), bfhi(w.y), bflo(w.z), bfhi(w.z), bflo(w.w), bfhi(w.w)};
#pragma unroll
              for (int i = 0; i < 8; ++i) ss += v[i] * v[i]; }
            ss = wave_sum(ss, lane);
            float s2 = 0.f;
            if (lane < 32) { const u32x4 w2 = *(const u32x4*)(ur + U_AKV + lane * 8); const float v[8] = {bflo(w2.x), bfhi(w2.x), bflo(w2.y), bfhi(w2.y), bflo(w2.z), bfhi(w2.z), bflo(w2.w), bfhi(w2.w)};
#pragma unroll
              for (int i = 0; i < 8; ++i) s2 += v[i] * v[i]; }
            s2 = wave_sum(s2, lane);
            if (lane == 0) { rsq[r] = rsqrtf(ss * (1.0f / 512.0f) + EPS); rsk[r] = rsqrtf(s2 * (1.0f / 256.0f) + EPS); }
        }
        {
            const bool lat = r < MLAT; const int s = lat ? (r & (SEQ - 1)) : ((r - MLAT) & (CTXL - 1)), len = lat ? SEQ : CTXL;
            float acc[8];
#pragma unroll
            for (int i = 0; i < 8; ++i) acc[i] = cb[i];
#pragma unroll
            for (int j = 0; j < 4; ++j) { const int sj = s + j - 2;
                if (sj >= 0 && sj < len) { const u32x4 w = *(const u32x4*)(ur + (ptrdiff_t)(j - 2) * NU + U_BX + lane * 8);
                    const float v[8] = {bflo(w.x), bfhi(w.x), bflo(w.y), bfhi(w.y), bflo(w.z), bfhi(w.z), bflo(w.w), bfhi(w.w)};
#pragma unroll
                    for (int i = 0; i < 8; ++i) acc[i] += cw[j][i] * v[i]; } }
            u32x4 o; o.x = cvt_pk_bf16(acc[0], acc[1]); o.y = cvt_pk_bf16(acc[2], acc[3]); o.z = cvt_pk_bf16(acc[4], acc[5]); o.w = cvt_pk_bf16(acc[6], acc[7]);
            *(u32x4*)(xcv + (size_t)r * 512 + lane * 8) = o;
        }
    }
}

__device__ __forceinline__ void job_rg_scan1(CKP& p) {
    const bf16_t* la = (const bf16_t*)(p.ws + WS_LA); const bf16_t* bb = (const bf16_t*)(p.ws + WS_BB); f32x2* rgs = (f32x2*)(p.ws + WS_RGS);
    const int w = otid();
    for (int u = obid(); u < NRT * 2; u += gridDim.x) {
        const int pm = u >> 1, d = u & 1;
        const bf16_t* lp = la + (size_t)pm * 256 * 1024 + d * 512 + w; const bf16_t* bp = bb + (size_t)pm * 256 * 1024 + d * 512 + w;
        float H = 0.f, sl = 0.f;
#pragma unroll 1
        for (int i0 = 0; i0 < 256; i0 += 32) { bf16_t lr[32], br[32];
#pragma unroll
            for (int q = 0; q < 32; ++q) { const int t = d ? 255 - (i0 + q) : i0 + q; lr[q] = lp[(size_t)t * 1024]; br[q] = bp[(size_t)t * 1024]; }
            asm volatile("" ::: "memory");
#pragma unroll
            for (int q = 0; q < 32; ++q) { const float lv = bf2f(lr[q]); H = __expf(lv) * H + bf2f(br[q]); sl += lv; } }
        rgs[(size_t)u * 512 + w] = (f32x2){__expf(sl), H};
    }
}
__device__ __forceinline__ void job_rg_out(CKP& p, int ntiles) {
    const bf16_t* la = (const bf16_t*)(p.ws + WS_LA); const bf16_t* bb = (const bf16_t*)(p.ws + WS_BB); const f32x2* rgs = (const f32x2*)(p.ws + WS_RGS);
    bf16_t* hf = (bf16_t*)(p.ws + WS_XCV); const bf16_t* ubuf = (const bf16_t*)(p.ws + WS_R1); bf16_t* yb = (bf16_t*)(p.ws + WS_YBR) + (size_t)1 * MALL * 512;
    const int w = otid();
    for (int u = obid(); u < ntiles; u += gridDim.x) {
        const int pm = (int)gridDim.x > ntiles ? u : u;
        const bool isctx = pm >= 128; const int b = isctx ? pm - 128 : (pm >> 6);
        float h = 0.f;
        if (!isctx) { h = rgs[(size_t)((128 + b) * 2 + 0) * 512 + w][1];
#pragma unroll 8
            for (int q = b * 64; q < pm; ++q) { const f32x2 s = rgs[(size_t)(q * 2 + 0) * 512 + w]; h = s[0] * h + s[1]; } }
        const size_t r0 = (size_t)pm * 256;
#pragma unroll 1
        for (int t0 = 0; t0 < 256; t0 += 32) { bf16_t lr[32], br[32];
#pragma unroll
            for (int k = 0; k < 32; ++k) { lr[k] = la[(r0 + t0 + k) * 1024 + w]; br[k] = bb[(r0 + t0 + k) * 1024 + w]; }
#pragma unroll
            for (int k = 0; k < 32; ++k) { h = __expf(bf2f(lr[k])) * h + bf2f(br[k]); hf[(r0 + t0 + k) * 512 + w] = f2bf(h); } }
        float hb = 0.f;
        if (!isctx) { hb = rgs[(size_t)((128 + b) * 2 + 1) * 512 + w][1];
#pragma unroll 8
            for (int q = b * 64 + 63; q > pm; --q) { const f32x2 s = rgs[(size_t)(q * 2 + 1) * 512 + w]; hb = s[0] * hb + s[1]; } }
#pragma unroll 1
        for (int i0 = 0; i0 < 256; i0 += 32) { bf16_t lr[32], br[32], gr[32], fr[32];
#pragma unroll
            for (int k = 0; k < 32; ++k) { const size_t t = r0 + 255 - i0 - k; lr[k] = la[t * 1024 + 512 + w]; br[k] = bb[t * 1024 + 512 + w]; gr[k] = ubuf[t * NU + U_BG + w]; fr[k] = hf[t * 512 + w]; }
#pragma unroll
            for (int k = 0; k < 32; ++k) { const size_t t = r0 + 255 - i0 - k; hb = __expf(bf2f(lr[k])) * hb + bf2f(br[k]); yb[t * 512 + w] = f2bf((bf2f(fr[k]) + hb) * gelu_tanh(bf2f(gr[k]))); } }
    }
}

namespace at {
constexpr float THR2 = 8.f * 1.4426950408889634f;
__device__ __forceinline__ int crow(int r, int hi) { return (r & 3) + 8 * (r >> 2) + 4 * hi; }
__device__ __forceinline__ unsigned cvtpk(float lo, float hi) { return cvt_pk_bf16(lo, hi); }
__device__ __forceinline__ int v_rd_base(int lane) { return ((lane & 3) << 3) | (((lane >> 2) & 3) << 6) | (((lane >> 4) & 1) << 5) | (((lane >> 5) & 1) << 8); }
constexpr int v_rd_off(int d0, int ks, int half) { return d0 * 512 + ks * 4096 + half * 2048; }
template <int OFF> __device__ __forceinline__ s16x4 tr_read(unsigned vb) { s16x4 r; asm volatile("ds_read_b64_tr_b16 %0, %1 offset:%2" : "=&v"(r) : "v"(vb), "i"(OFF) : "memory"); return r; }
template <int D0> __device__ __forceinline__ void pv_one(f32x16& od, unsigned vb, bf16x8 pa0, bf16x8 pa1, bf16x8 pa2, bf16x8 pa3) {
    const s16x4 l0 = tr_read<v_rd_off(D0, 0, 0)>(vb), h0 = tr_read<v_rd_off(D0, 0, 1)>(vb), l1 = tr_read<v_rd_off(D0, 1, 0)>(vb), h1 = tr_read<v_rd_off(D0, 1, 1)>(vb);
    const s16x4 l2 = tr_read<v_rd_off(D0, 2, 0)>(vb), h2 = tr_read<v_rd_off(D0, 2, 1)>(vb), l3 = tr_read<v_rd_off(D0, 3, 0)>(vb), h3 = tr_read<v_rd_off(D0, 3, 1)>(vb);
    asm volatile("s_waitcnt lgkmcnt(0)" ::: "memory"); __builtin_amdgcn_sched_barrier(0);
#define AT_PK(L, H) (bf16x8){L[0], L[1], L[2], L[3], H[0], H[1], H[2], H[3]}
    od = __builtin_amdgcn_mfma_f32_32x32x16_bf16(pa0, AT_PK(l0, h0), od, 0, 0, 0);
    od = __builtin_amdgcn_mfma_f32_32x32x16_bf16(pa1, AT_PK(l1, h1), od, 0, 0, 0);
    od = __builtin_amdgcn_mfma_f32_32x32x16_bf16(pa2, AT_PK(l2, h2), od, 0, 0, 0);
    od = __builtin_amdgcn_mfma_f32_32x32x16_bf16(pa3, AT_PK(l3, h3), od, 0, 0, 0);
#undef AT_PK
}
struct VFrag { s16x4 l[4], h[4]; };
template <int D0> __device__ __forceinline__ void rd_v(VFrag& f, const LAS unsigned char* vbp) {
#pragma unroll
    for (int ks = 0; ks < 4; ++ks) {
        f.l[ks] = __builtin_amdgcn_ds_read_tr16_b64_v4i16((LAS s16x4*)(vbp + v_rd_off(D0, ks, 0)));
        f.h[ks] = __builtin_amdgcn_ds_read_tr16_b64_v4i16((LAS s16x4*)(vbp + v_rd_off(D0, ks, 1))); }
}
__device__ __forceinline__ void mm_pv(f32x16& od, const VFrag& f, bf16x8 pa0, bf16x8 pa1, bf16x8 pa2, bf16x8 pa3) {
#define AT_PK(L, H) (bf16x8){L[0], L[1], L[2], L[3], H[0], H[1], H[2], H[3]}
    od = __builtin_amdgcn_mfma_f32_32x32x16_bf16(pa0, AT_PK(f.l[0], f.h[0]), od, 0, 0, 0);
    od = __builtin_amdgcn_mfma_f32_32x32x16_bf16(pa1, AT_PK(f.l[1], f.h[1]), od, 0, 0, 0);
    od = __builtin_amdgcn_mfma_f32_32x32x16_bf16(pa2, AT_PK(f.l[2], f.h[2]), od, 0, 0, 0);
    od = __builtin_amdgcn_mfma_f32_32x32x16_bf16(pa3, AT_PK(f.l[3], f.h[3]), od, 0, 0, 0);
#undef AT_PK
}
__device__ __forceinline__ f32x16 mfma_srcc(bf16x8 a, bf16x8 b, const f32x16& c) { f32x16 d; asm("v_mfma_f32_32x32x16_bf16 %0, %1, %2, %3" : "=&v"(d) : "v"(a), "v"(b), "v"(c)); return d; }
struct KeyMap { int ctx_row0, lat_row0, nctx, nt; __device__ __forceinline__ int row(int j) const { return j < nctx ? ctx_row0 + 64 * j : lat_row0 + 64 * (j - nctx); } };

template <int DQK>
__device__ __forceinline__ void attn_body(LAS unsigned char* lds, const bf16_t* Qg, int ldq, int q0, const bf16_t* Kg, int ldk, const bf16_t* Vg, int ldv, const KeyMap km,
                                          f32x16 (&o)[4], float& l_out) {
    constexpr int RB = DQK * 2, CPR = RB / 16, NKI = 64 * RB / 8192, KBYTES = 64 * RB, VOFF = 3 * KBYTES, SCR = VOFF + 4 * 16384, ND0 = DQK / 16;
    static_assert(SCR + 2048 <= LDS_MISC, "attention LDS");
    const int tid = otid(), wid = __builtin_amdgcn_readfirstlane(tid >> 6), lane = tid & 63, r32 = lane & 31, hi = lane >> 5, half = wid >> 2;
    LAS float* wsl = (LAS float*)(lds + SCR) + wid * 64; LAS float* al_l = wsl;
    unsigned koff[NKI], voff[2];
#pragma unroll
    for (int i = 0; i < NKI; ++i) { const int q = i * 512 + wid * 64 + lane, row = q / CPR, cp = q % CPR, ch = cp ^ ((row >> 1) & 7); koff[i] = (unsigned)row * (unsigned)(ldk * 2) + (unsigned)ch * 16u; }
#pragma unroll
    for (int i = 0; i < 2; ++i) { const int q = i * 512 + wid * 64 + lane, sub = q >> 5, wi = q & 31, k = (sub >> 2) * 8 + (wi >> 2), c = (sub & 3) * 32 + (wi & 3) * 8;
        voff[i] = (unsigned)k * (unsigned)(ldv * 2) + (unsigned)c * 2u; }
    const int NT = km.nt;
#define AT_ISSUE(j, sk, sv) do { const int _j = (j) < NT ? (j) : NT - 1; const int _kr = km.row(_j); const char* _kb = (const char*)Kg + (size_t)_kr * ldk * 2; const char* _vb = (const char*)Vg + (size_t)_kr * ldv * 2; \
        _Pragma("unroll") for (int _i = 0; _i < NKI; ++_i) __builtin_amdgcn_global_load_lds((const unsigned*)(_kb + koff[_i]), (LAS unsigned*)(lds + (sk) * KBYTES + _i * 8192 + wid * 1024), 16, 0, 0); \
        _Pragma("unroll") for (int _i = 0; _i < 2; ++_i) __builtin_amdgcn_global_load_lds((const unsigned*)(_vb + voff[_i]), (LAS unsigned*)(lds + VOFF + (sv) * 16384 + _i * 8192 + wid * 1024), 16, 0, 0); } while (0)
    bf16x8 qr[ND0];
    { const bf16_t* Qw = Qg + (size_t)(q0 + wid * 32 + r32) * ldq + hi * 8;
#pragma unroll
      for (int d0 = 0; d0 < ND0; ++d0) qr[d0] = *(const bf16x8*)(Qw + d0 * 16); }
    float m_reg = 0.f, l_reg = 0.f;
    f32x16 cm;
#pragma unroll
    for (int r = 0; r < 16; ++r) cm[r] = 0.f;
#pragma unroll
    for (int d = 0; d < 4; ++d)
#pragma unroll
        for (int r = 0; r < 16; ++r) o[d][r] = 0.f;
    const unsigned ksw = (unsigned)((r32 >> 1) & 7), kb0 = (unsigned)r32 * RB, vrb = (unsigned)v_rd_base(lane);
    bf16x8 pa0, pa1, pa2, pa3;
#define AT_PV(sv) do { const unsigned vb = (unsigned)(uintptr_t)(lds + VOFF + (sv) * 16384) + vrb; \
        pv_one<0>(o[0], vb, pa0, pa1, pa2, pa3); pv_one<1>(o[1], vb, pa0, pa1, pa2, pa3); pv_one<2>(o[2], vb, pa0, pa1, pa2, pa3); pv_one<3>(o[3], vb, pa0, pa1, pa2, pa3); } while (0)
    AT_ISSUE(0, 0, 0); AT_ISSUE(1, 1, 1);
    if constexpr (NKI == 3) asm volatile("s_waitcnt vmcnt(5)" ::: "memory"); else asm volatile("s_waitcnt vmcnt(3)" ::: "memory");
    if (half) { __builtin_amdgcn_s_barrier(); }
    int sk = 0, sv = 0;
    for (int j = 0; j < NT; ++j) {
        __builtin_amdgcn_s_barrier(); asm volatile("" ::: "memory");
        __builtin_amdgcn_s_setprio(1);
#define AT_SB __builtin_amdgcn_sched_barrier(0)
#define AT_RK(d0, KF) do { const unsigned cb = (((unsigned)(2 * (d0) + hi)) ^ ksw) << 4; KF[0] = *(const LAS bf16x8*)(Ks + cb); KF[1] = *(const LAS bf16x8*)(Ks + 32 * RB + cb); } while (0)
        const LAS unsigned char* Ks = lds + sk * KBYTES + kb0;
        bf16x8 kf[2][2];
        if (j > 0) {
            const LAS unsigned char* vbp = lds + VOFF + ((sv + 3) & 3) * 16384 + vrb;
            VFrag fa, fb;
            rd_v<0>(fa, vbp); rd_v<1>(fb, vbp); AT_SB;
            mm_pv(o[0], fa, pa0, pa1, pa2, pa3); AT_SB;
            rd_v<2>(fa, vbp); AT_SB;
            mm_pv(o[1], fb, pa0, pa1, pa2, pa3); AT_SB;
            rd_v<3>(fb, vbp); AT_SB;
            mm_pv(o[2], fa, pa0, pa1, pa2, pa3); AT_SB;
            AT_RK(0, kf[0]); AT_SB;
            mm_pv(o[3], fb, pa0, pa1, pa2, pa3); AT_SB;
        } else { AT_RK(0, kf[0]); AT_SB; }
        f32x16 p0, p1;
        AT_RK(1, kf[1]); AT_SB;
        p0 = mfma_srcc(kf[0][0], qr[0], cm); p1 = mfma_srcc(kf[0][1], qr[0], cm); AT_SB;
#pragma unroll
        for (int d0 = 1; d0 < ND0; ++d0) {
            if (d0 + 1 < ND0) { AT_RK(d0 + 1, kf[(d0 + 1) & 1]); AT_SB; }
            p0 = __builtin_amdgcn_mfma_f32_32x32x16_bf16(kf[d0 & 1][0], qr[d0], p0, 0, 0, 0);
            p1 = __builtin_amdgcn_mfma_f32_32x32x16_bf16(kf[d0 & 1][1], qr[d0], p1, 0, 0, 0); AT_SB;
        }
#undef AT_RK
#undef AT_SB
        asm volatile("s_waitcnt vmcnt(0)" ::: "memory");
        __builtin_amdgcn_s_setprio(0);
        __builtin_amdgcn_s_barrier(); asm volatile("" ::: "memory");
        { const int sk2 = sk == 0 ? 2 : sk - 1; AT_ISSUE(j + 2, sk2, (sv + 2) & 3); }
        float pmax = p0[0];
#pragma unroll
        for (int r = 1; r < 16; ++r) pmax = fmaxf(pmax, p0[r]);
#pragma unroll
        for (int r = 0; r < 16; ++r) pmax = fmaxf(pmax, p1[r]);
        { auto rr = __builtin_amdgcn_permlane32_swap(__float_as_uint(pmax), __float_as_uint(pmax), false, false); pmax = fmaxf(__uint_as_float(rr[0]), __uint_as_float(rr[1])); }
        float alpha = 1.f;
        if (__builtin_expect(j == 0 || !__all(pmax <= THR2), 0)) {
            const float delta = j == 0 ? pmax : fmaxf(pmax, 0.f);
            if (j != 0) alpha = __builtin_amdgcn_exp2f(-delta);
            m_reg += delta;
#pragma unroll
            for (int r = 0; r < 16; ++r) { p0[r] -= delta; p1[r] -= delta; cm[r] = -m_reg; }
        }
#pragma unroll
        for (int r = 0; r < 16; ++r) { p0[r] = __builtin_amdgcn_exp2f(p0[r]); p1[r] = __builtin_amdgcn_exp2f(p1[r]); }
        float ps = 0.f;
#pragma unroll
        for (int r = 0; r < 16; ++r) ps += p0[r] + p1[r];
        l_reg = l_reg * alpha + ps;
#define AT_PK4(P, BASE, OUT) do { u32x4 w = {cvtpk(P[BASE + 0], P[BASE + 1]), cvtpk(P[BASE + 2], P[BASE + 3]), cvtpk(P[BASE + 4], P[BASE + 5]), cvtpk(P[BASE + 6], P[BASE + 7])}; OUT = *reinterpret_cast<bf16x8*>(&w); } while (0)
        AT_PK4(p0, 0, pa0); AT_PK4(p0, 8, pa1); AT_PK4(p1, 0, pa2); AT_PK4(p1, 8, pa3);
#undef AT_PK4
        if (__any(alpha < 1.f)) {
            if (hi == 0) al_l[r32] = alpha;
            asm volatile("s_waitcnt lgkmcnt(0)" ::: "memory");
            float av[16];
#pragma unroll
            for (int r = 0; r < 16; ++r) av[r] = al_l[crow(r, hi)];
#pragma unroll
            for (int d = 0; d < 4; ++d)
#pragma unroll
                for (int r = 0; r < 16; ++r) o[d][r] *= av[r];
        }
        sk = sk == 2 ? 0 : sk + 1; sv = (sv + 1) & 3;
    }
    __builtin_amdgcn_s_barrier(); asm volatile("" ::: "memory");
    AT_PV((sv + 3) & 3);
    if (!half) __builtin_amdgcn_s_barrier();
    asm volatile("s_waitcnt vmcnt(0)" ::: "memory");
    __builtin_amdgcn_s_barrier();
    asm volatile("" ::: "memory");
    { auto rr = __builtin_amdgcn_permlane32_swap(__float_as_uint(l_reg), __float_as_uint(l_reg), false, false); l_out = __uint_as_float(rr[0]) + __uint_as_float(rr[1]); }
#undef AT_ISSUE
#undef AT_PV
}
__device__ __forceinline__ void row_inv_l(LAS unsigned char* lds_scratch, float l_reg, float (&rli)[16]) {
    const int tid = otid(), wid = tid >> 6, lane = tid & 63, r32 = lane & 31, hi = lane >> 5;
    LAS float* li_l = (LAS float*)lds_scratch + wid * 64 + 32;
    if (hi == 0) li_l[r32] = l_reg;
    asm volatile("s_waitcnt lgkmcnt(0)" ::: "memory");
#pragma unroll
    for (int r = 0; r < 16; ++r) rli[r] = __builtin_amdgcn_rcpf(li_l[crow(r, hi)]);
}
}

__device__ __forceinline__ void attn_unit_mla(CKP& p, LAS unsigned char* lds, int q0, int h, const at::KeyMap km) {
    const bf16_t* qm = (const bf16_t*)(p.ws + WS_QM); const bf16_t* kmb = (const bf16_t*)(p.ws + WS_KM); const bf16_t* vmb = (const bf16_t*)(p.ws + WS_VM); bf16_t* ya = (bf16_t*)(p.ws + WS_YBR);
    f32x16 o[4]; float l;
    at::attn_body<192>(lds, qm + h * 192, 768, q0, kmb + h * 192, 768, vmb + h * 128, 512, km, o, l);
    float rli[16]; at::row_inv_l(lds + 3 * 64 * 384 + 4 * 16384, l, rli);
    const int tid_ = otid(); const int wid = tid_ >> 6, lane = tid_ & 63, r32 = lane & 31, hi = lane >> 5;
    bf16_t* yw = ya + (size_t)(q0 + wid * 32) * 512 + h * 128 + r32;
#pragma unroll
    for (int r = 0; r < 16; ++r) { const int orow = at::crow(r, hi);
#pragma unroll
        for (int d0 = 0; d0 < 4; ++d0) yw[(size_t)orow * 512 + d0 * 32] = f2bf(o[d0][r] * rli[r]); }
}
__device__ __forceinline__ void attn_unit_diff(CKP& p, LAS unsigned char* lds, int l_idx, int q0, int h, const at::KeyMap km) {
    const bf16_t* ubuf = (const bf16_t*)(p.ws + WS_R1); bf16_t* yc = (bf16_t*)(p.ws + WS_YBR) + (size_t)2 * MALL * 512;
    const float lam = ((const float*)(p.ws + WS_SCAL))[l_idx]; const float lam_init = 0.8f - 0.6f * expf(-0.3f * (float)l_idx);
    f32x16 o[4]; float l; float rli[16];
    at::attn_body<64>(lds, ubuf + U_CQ + (2 * h) * 64, NU, q0, ubuf + U_CK + (2 * h) * 64, NU, ubuf + U_CV + h * 128, NU, km, o, l);
    at::row_inv_l(lds + 3 * 64 * 128 + 4 * 16384, l, rli);
    const int tid_ = otid(); const int wid = tid_ >> 6, lane = tid_ & 63, r32 = lane & 31, hi = lane >> 5;
    bf16_t* yw = yc + (size_t)(q0 + wid * 32) * 512 + h * 128 + r32;
#pragma unroll
    for (int r = 0; r < 16; ++r) { const int orow = at::crow(r, hi);
#pragma unroll
        for (int d0 = 0; d0 < 4; ++d0) yw[(size_t)orow * 512 + d0 * 32] = f2bf(o[d0][r] * rli[r]); }
    at::attn_body<64>(lds, ubuf + U_CQ + (2 * h + 1) * 64, NU, q0, ubuf + U_CK + (2 * h + 1) * 64, NU, ubuf + U_CV + h * 128, NU, km, o, l);
    at::row_inv_l(lds + 3 * 64 * 128 + 4 * 16384, l, rli);
    { const int t2 = otid(); yw = yc + (size_t)(q0 + (t2 >> 6) * 32) * 512 + h * 128 + (t2 & 31); }
    float ss[16];
#pragma unroll
    for (int r = 0; r < 16; ++r) { const int orow = at::crow(r, hi); float s = 0.f;
#pragma unroll
        for (int d = 0; d < 4; ++d) { const float v = bf2f(yw[(size_t)orow * 512 + d * 32]) - lam * (o[d][r] * rli[r]); o[d][r] = v; s += v * v; }
        ss[r] = s; }
#pragma unroll
    for (int r = 0; r < 16; ++r) {
#pragma unroll
        for (int x = 16; x >= 1; x >>= 1) ss[r] += shx(ss[r], x, lane); }
    const float* sub = p.in[I_SUBLN] + l_idx * 128; float sg[4];
#pragma unroll
    for (int d = 0; d < 4; ++d) sg[d] = sub[d * 32 + r32] * (1.0f - lam_init);
#pragma unroll
    for (int r = 0; r < 16; ++r) { const int orow = at::crow(r, hi); const float rn = rsqrtf(ss[r] * (1.0f / 128.0f) + EPS);
#pragma unroll
        for (int d0 = 0; d0 < 4; ++d0) yw[(size_t)orow * 512 + d0 * 32] = f2bf(o[d0][r] * rn * sg[d0]); }
}

__device__ __forceinline__ void lds_barrier() { asm volatile("s_waitcnt lgkmcnt(0)" ::: "memory"); __builtin_amdgcn_s_barrier(); asm volatile("" ::: "memory"); }
namespace hg {
__device__ __forceinline__ bf16x8 gather8(const LAS bf16_t* p, int stride) { bf16x8 r;
#pragma unroll
    for (int i = 0; i < 8; ++i) r[i] = (short)p[i * stride];
    return r; }
__device__ __forceinline__ void gates16(const bf16_t* zp  , float lbk, int dd, float (&gi)[16], float (&kf)[16], float& tot) {
    float g[16];
#pragma unroll
    for (int i = 0; i < 16; ++i) { const float z = bf2f(zp[(size_t)i * NU]); const float sg = sigmoidf_(z); g[i] = flog(lbk + (1.0f - lbk) * sg); kf[i] = (1.0f - lbk) * frcp(1.0f + __expf(z)); }
    float run = 0.f;
    if (dd == 0) {
#pragma unroll
        for (int i = 0; i < 16; ++i) { run += g[i]; gi[i] = run; }
    } else {
#pragma unroll
        for (int i = 15; i >= 0; --i) { run += g[i]; gi[i] = run; }
    }
    tot = run;
}
__device__ __forceinline__ void gates16r(const bf16_t (&zr)[16], float lbk, int dd, float (&gi)[16], float (&kf)[16], float& tot) {
    float g[16];
#pragma unroll
    for (int i = 0; i < 16; ++i) { const float z = bf2f(zr[i]); const float sg = sigmoidf_(z); g[i] = flog(lbk + (1.0f - lbk) * sg); kf[i] = (1.0f - lbk) * frcp(1.0f + __expf(z)); }
    float run = 0.f;
    if (dd == 0) {
#pragma unroll
        for (int i = 0; i < 16; ++i) { run += g[i]; gi[i] = run; }
    } else {
#pragma unroll
        for (int i = 15; i >= 0; --i) { run += g[i]; gi[i] = run; }
    }
    tot = run;
}
__device__ __forceinline__ void pack16_store(LAS bf16_t* dst, const float (&v)[16]) {
    u32x4 a, b; a.x = cvt_pk_bf16(v[0], v[1]); a.y = cvt_pk_bf16(v[2], v[3]); a.z = cvt_pk_bf16(v[4], v[5]); a.w = cvt_pk_bf16(v[6], v[7]);
    b.x = cvt_pk_bf16(v[8], v[9]); b.y = cvt_pk_bf16(v[10], v[11]); b.z = cvt_pk_bf16(v[12], v[13]); b.w = cvt_pk_bf16(v[14], v[15]);
    *(LAS u32x4*)dst = a; *(LAS u32x4*)(dst + 8) = b;
}
__device__ __forceinline__ void stage_vT(LAS bf16_t* VsT, const bf16_t* vp  , int v, int part) {
    unsigned short h[16];
#pragma unroll
    for (int i = 0; i < 16; ++i) h[i] = vp[(size_t)i * NU];
    u32x4 a, b; a.x = h[0] | ((unsigned)h[1] << 16); a.y = h[2] | ((unsigned)h[3] << 16); a.z = h[4] | ((unsigned)h[5] << 16); a.w = h[6] | ((unsigned)h[7] << 16);
    b.x = h[8] | ((unsigned)h[9] << 16); b.y = h[10] | ((unsigned)h[11] << 16); b.z = h[12] | ((unsigned)h[13] << 16); b.w = h[14] | ((unsigned)h[15] << 16);
    *(LAS u32x4*)(VsT + v * 72 + part * 16) = a; *(LAS u32x4*)(VsT + v * 72 + part * 16 + 8) = b;
}
__device__ __forceinline__ void pass1_unit(CKP& p, LAS unsigned char* lds, const float* lb, int cid, int hh) {
    const bf16_t* ubuf = (const bf16_t*)(p.ws + WS_R1); bf16_t* HS = (bf16_t*)(p.ws + WS_YBUF); float* HD = (float*)(p.ws + WS_HD);
    LAS bf16_t* VsT = (LAS bf16_t*)lds; LAS bf16_t* KtT = (LAS bf16_t*)(lds + 18432); LAS float* ptot = (LAS float*)(lds + 36864);
    const int tid = otid(), wid = tid >> 6, lane = tid & 63, row0 = cid * 64;
    const int k = tid & 127, part = tid >> 7; const float lbk = lb[hh * 128 + k];
    bf16_t zf[16], zb[16];
    { const bf16_t* zp = ubuf + (size_t)(row0 + part * 16) * NU + hh * 128 + k;
#pragma unroll
      for (int i = 0; i < 16; ++i) { zf[i] = zp[(size_t)i * NU + U_DFF]; zb[i] = zp[(size_t)i * NU + U_DFB]; } }
    stage_vT(VsT, ubuf + (size_t)(row0 + part * 16) * NU + U_DI + hh * 128 + k, k, part);
#pragma unroll 1
    for (int dd = 0; dd < 2; ++dd) {
        float gi[16], kf[16], tot;
        { bf16_t zr[16];
#pragma unroll
          for (int i = 0; i < 16; ++i) zr[i] = dd ? zb[i] : zf[i];
          gates16r(zr, lbk, dd, gi, kf, tot); }
        ptot[part * 128 + k] = tot;
        lds_barrier();
        float off = 0.f, gt = 0.f;
#pragma unroll
        for (int q = 0; q < 4; ++q) { const float v = ptot[q * 128 + k]; gt += v; if (dd == 0 ? (q < part) : (q > part)) off += v; }
#pragma unroll
        for (int i = 0; i < 16; ++i) kf[i] = kf[i] * __expf(gt - (off + gi[i]));
        pack16_store(KtT + k * 72 + part * 16, kf);
        if (part == 0) HD[(size_t)((cid * 4 + hh) * 2 + dd) * 128 + k] = __expf(gt);
        lds_barrier();
        {
            const int l15 = lane & 15, kg = lane >> 4;
            bf16x8 vf[2];
#pragma unroll
            for (int ks = 0; ks < 2; ++ks) vf[ks] = *(const LAS bf16x8*)(VsT + (wid * 16 + l15) * 72 + ks * 32 + kg * 8);
            bf16_t* dst = HS + ((size_t)((cid * 4 + hh) * 2 + dd) * 128 + wid * 16 + l15) * 128;
#pragma unroll
            for (int kb = 0; kb < 8; ++kb) {
                f32x4 c = {0.f, 0.f, 0.f, 0.f};
#pragma unroll
                for (int ks = 0; ks < 2; ++ks) { const bf16x8 kfr = *(const LAS bf16x8*)(KtT + (kb * 16 + l15) * 72 + ks * 32 + kg * 8); c = __builtin_amdgcn_mfma_f32_16x16x32_bf16(kfr, vf[ks], c, 0, 0, 0); }
                u32x2 w; w.x = cvt_pk_bf16(c[0], c[1]); w.y = cvt_pk_bf16(c[2], c[3]);
                *(u32x2*)(dst + kb * 16 + kg * 4) = w;
            }
        }
        lds_barrier();
    }
}
__device__ __forceinline__ void carry_unit(CKP& p, int u) {
    bf16_t* HS = (bf16_t*)(p.ws + WS_YBUF); const float* HD = (const float*)(p.ws + WS_HD);
    const int combo = u >> 4, sub = u & 15, b = combo >> 3, hh = (combo >> 1) & 3, dd = combo & 1;
    const int tid_ = otid(); const int v = sub * 8 + (tid_ >> 6), k = 2 * (tid_ & 63);
    float s0 = 0.f, s1 = 0.f;
#pragma unroll 1
    for (int s0i = 0; s0i < 260; s0i += 20) {
        unsigned uw[20]; f32x2 d2[20];
#pragma unroll
        for (int q = 0; q < 20; ++q) { const int st = s0i + q;
            const int cid = dd == 0 ? (st < 4 ? 512 + b * 4 + st : b * 256 + (st - 4)) : (st < 4 ? 512 + b * 4 + (3 - st) : b * 256 + (259 - st));
            const size_t base = (size_t)((cid * 4 + hh) * 2 + dd) * 128;
            uw[q] = *(const unsigned*)(HS + (base + v) * 128 + k); d2[q] = *(const f32x2*)(HD + base + k); }
#pragma unroll
        for (int q = 0; q < 20; ++q) { const int st = s0i + q;
            const int cid = dd == 0 ? (st < 4 ? 512 + b * 4 + st : b * 256 + (st - 4)) : (st < 4 ? 512 + b * 4 + (3 - st) : b * 256 + (259 - st));
            const size_t base = (size_t)((cid * 4 + hh) * 2 + dd) * 128;
            *(unsigned*)(HS + (base + v) * 128 + k) = cvt_pk_bf16(s0, s1);
            s0 = d2[q][0] * s0 + bflo(uw[q]); s1 = d2[q][1] * s1 + bfhi(uw[q]); }
    }
}
constexpr int O_QS = 0, O_KF = 17408, O_VS = 34816, O_GS = 53248, O_ST = 87040, O_AS = 121856, O_R = 140288, O_PT = 142336, O_RS = 144384;
static_assert(O_RS + 512 <= LDS_MISC, "HGRN LDS");
__device__ __forceinline__ void out_unit(CKP& p, LAS unsigned char* lds, const float* lb, const float* gnorm, int cid, int hh) {
    const bf16_t* ubuf = (const bf16_t*)(p.ws + WS_R1); const bf16_t* HS = (const bf16_t*)(p.ws + WS_YBUF); bf16_t* yd = (bf16_t*)(p.ws + WS_YBR) + (size_t)3 * MALL * 512;
    LAS bf16_t* qs = (LAS bf16_t*)(lds + O_QS); LAS bf16_t* kfs = (LAS bf16_t*)(lds + O_KF); LAS bf16_t* Vs = (LAS bf16_t*)(lds + O_VS); LAS float* Gs = (LAS float*)(lds + O_GS);
    LAS bf16_t* St = (LAS bf16_t*)(lds + O_ST); LAS float* Rr = (LAS float*)(lds + O_R); LAS float* ptot = (LAS float*)(lds + O_PT); LAS float* rss = (LAS float*)(lds + O_RS);
    const int tid = otid(), wid = tid >> 6, lane = tid & 63, row0 = cid * 64, l15 = lane & 15, kg = lane >> 4;
    LAS bf16_t* Asc = (LAS bf16_t*)(lds + O_AS) + wid * (16 * 72);
    const int k = tid & 127, part = tid >> 7; const float lbk = lb[hh * 128 + k];
    bf16_t zf[16], zb[16]; u32x4 sin0[4], sin1[4];
    { const bf16_t* zp = ubuf + (size_t)(row0 + part * 16) * NU + hh * 128 + k;
#pragma unroll
      for (int i = 0; i < 16; ++i) { zf[i] = zp[(size_t)i * NU + U_DFF]; zb[i] = zp[(size_t)i * NU + U_DFB]; }
      const int v_ = tid >> 2, seg_ = tid & 3; const bf16_t* src = HS + ((size_t)((cid * 4 + hh) * 2) * 128 + v_) * 128 + seg_ * 32;
#pragma unroll
      for (int i = 0; i < 4; ++i) { sin0[i] = *(const u32x4*)(src + i * 8); sin1[i] = *(const u32x4*)(src + (size_t)128 * 128 + i * 8); } }
    stage_vT(Vs, ubuf + (size_t)(row0 + part * 16) * NU + U_DI + hh * 128 + k, k, part);
#pragma unroll
    for (int i = 0; i < 16; ++i) { const int t = part * 16 + i; qs[t * 136 + k] = f2bf(siluf_(bf2f(ubuf[(size_t)(row0 + t) * NU + U_DQ + hh * 128 + k]))); }
    const int bi = wid >> 1, vh = wid & 1;
    f32x4 o[4];
#pragma unroll
    for (int nb = 0; nb < 4; ++nb) o[nb] = (f32x4){0.f, 0.f, 0.f, 0.f};
#pragma unroll 1
    for (int dd = 0; dd < 2; ++dd) {
        {
            float gi[16], kf[16], tot;
            { bf16_t zr[16];
#pragma unroll
              for (int i = 0; i < 16; ++i) zr[i] = dd ? zb[i] : zf[i];
              gates16r(zr, lbk, dd, gi, kf, tot); }
            ptot[part * 128 + k] = tot;
            lds_barrier();
            float off = 0.f;
#pragma unroll
            for (int q = 0; q < 4; ++q) { const float v = ptot[q * 128 + k]; if (dd == 0 ? (q < part) : (q > part)) off += v; }
#pragma unroll
            for (int i = 0; i < 16; ++i) { const int t = part * 16 + i; Gs[t * 132 + k] = off + gi[i]; kfs[t * 136 + k] = f2bf(kf[i]); }
            Rr[part * 128 + k] = off;
        }
        {
            const int v = tid >> 2, seg = tid & 3;
#pragma unroll
            for (int i = 0; i < 4; ++i) *(LAS u32x4*)(St + v * 136 + seg * 32 + i * 8) = dd ? sin1[i] : sin0[i];
        }
        lds_barrier();
        const int ti = bi * 16 + l15;
        u32x4 awq[4];
#pragma unroll
        for (int ks = 0; ks < 4; ++ks) { const int kc = ks * 32 + kg * 8;
            const u32x4 qw = *(const LAS u32x4*)(qs + ti * 136 + kc);
            const f32x4 g0 = *(const LAS f32x4*)(Gs + ti * 132 + kc), g1 = *(const LAS f32x4*)(Gs + ti * 132 + kc + 4), r0 = *(const LAS f32x4*)(Rr + bi * 128 + kc), r1 = *(const LAS f32x4*)(Rr + bi * 128 + kc + 4);
            const float qv[8] = {bflo(qw.x), bfhi(qw.x), bflo(qw.y), bfhi(qw.y), bflo(qw.z), bfhi(qw.z), bflo(qw.w), bfhi(qw.w)}; float qa[8];
#pragma unroll
            for (int e = 0; e < 4; ++e) { qa[e] = qv[e] * __expf(g0[e] - r0[e]); qa[4 + e] = qv[4 + e] * __expf(g1[e] - r1[e]); }
            awq[ks].x = cvt_pk_bf16(qa[0], qa[1]); awq[ks].y = cvt_pk_bf16(qa[2], qa[3]); awq[ks].z = cvt_pk_bf16(qa[4], qa[5]); awq[ks].w = cvt_pk_bf16(qa[6], qa[7]); }
#pragma unroll 1
        for (int j = 0; j < 4; ++j) {
            const bool use = dd == 0 ? (j <= bi) : (j >= bi);
            f32x4 c = {0.f, 0.f, 0.f, 0.f};
            if (use) {
                const int sj = j * 16 + l15;
#pragma unroll
                for (int ks = 0; ks < 4; ++ks) {
                    const int kc = ks * 32 + kg * 8;
                    const u32x4 kw = *(const LAS u32x4*)(kfs + sj * 136 + kc);
                    const f32x4 h0 = *(const LAS f32x4*)(Gs + sj * 132 + kc), h1 = *(const LAS f32x4*)(Gs + sj * 132 + kc + 4);
                    const f32x4 r0 = *(const LAS f32x4*)(Rr + bi * 128 + kc), r1 = *(const LAS f32x4*)(Rr + bi * 128 + kc + 4);
                    const float kv[8] = {bflo(kw.x), bfhi(kw.x), bflo(kw.y), bfhi(kw.y), bflo(kw.z), bfhi(kw.z), bflo(kw.w), bfhi(kw.w)};
                    float ka[8];
#pragma unroll
                    for (int e = 0; e < 4; ++e) { ka[e] = kv[e] * __expf(r0[e] - h0[e]); ka[4 + e] = kv[4 + e] * __expf(r1[e] - h1[e]); }
                    u32x4 aw = awq[ks], bw;
                    bw.x = cvt_pk_bf16(ka[0], ka[1]); bw.y = cvt_pk_bf16(ka[2], ka[3]); bw.z = cvt_pk_bf16(ka[4], ka[5]); bw.w = cvt_pk_bf16(ka[6], ka[7]);
                    c = __builtin_amdgcn_mfma_f32_16x16x32_bf16(*reinterpret_cast<bf16x8*>(&aw), *reinterpret_cast<bf16x8*>(&bw), c, 0, 0, 0);
                }
                if (j == bi) {
#pragma unroll
                    for (int e = 0; e < 4; ++e) { const int tl = 4 * kg + e; const bool keep = dd == 0 ? (l15 <= tl) : (l15 >= tl); c[e] = keep ? c[e] : 0.f; }
                }
            }
#pragma unroll
            for (int e = 0; e < 4; ++e) Asc[(4 * kg + e) * 72 + j * 16 + l15] = f2bf(c[e]);
        }
        bf16x8 af[2], qf[4];
#pragma unroll
        for (int ks = 0; ks < 2; ++ks) af[ks] = *(const LAS bf16x8*)(Asc + l15 * 72 + ks * 32 + kg * 8);
#pragma unroll
        for (int ks = 0; ks < 4; ++ks) { const int kc = ks * 32 + kg * 8;
            const u32x4 qw = *(const LAS u32x4*)(qs + ti * 136 + kc); const f32x4 g0 = *(const LAS f32x4*)(Gs + ti * 132 + kc), g1 = *(const LAS f32x4*)(Gs + ti * 132 + kc + 4);
            u32x4 aw; aw.x = cvt_pk_bf16(bflo(qw.x) * __expf(g0[0]), bfhi(qw.x) * __expf(g0[1])); aw.y = cvt_pk_bf16(bflo(qw.y) * __expf(g0[2]), bfhi(qw.y) * __expf(g0[3]));
            aw.z = cvt_pk_bf16(bflo(qw.z) * __expf(g1[0]), bfhi(qw.z) * __expf(g1[1])); aw.w = cvt_pk_bf16(bflo(qw.w) * __expf(g1[2]), bfhi(qw.w) * __expf(g1[3]));
            qf[ks] = *reinterpret_cast<bf16x8*>(&aw); }
#pragma unroll
        for (int nb = 0; nb < 4; ++nb) { const int vcol = vh * 64 + nb * 16 + l15;
#pragma unroll
            for (int ks = 0; ks < 2; ++ks) { const bf16x8 vf = *(const LAS bf16x8*)(Vs + vcol * 72 + ks * 32 + kg * 8); o[nb] = __builtin_amdgcn_mfma_f32_16x16x32_bf16(af[ks], vf, o[nb], 0, 0, 0); }
#pragma unroll
            for (int ks = 0; ks < 4; ++ks) { const bf16x8 sf = *(const LAS bf16x8*)(St + vcol * 136 + ks * 32 + kg * 8); o[nb] = __builtin_amdgcn_mfma_f32_16x16x32_bf16(qf[ks], sf, o[nb], 0, 0, 0); }
        }
        lds_barrier();
    }
    bf16_t ogr[4][4]; float gn[4];
#pragma unroll
    for (int e = 0; e < 4; ++e)
#pragma unroll
        for (int nb = 0; nb < 4; ++nb) ogr[e][nb] = ubuf[(size_t)(row0 + bi * 16 + 4 * kg + e) * NU + U_DG + hh * 128 + vh * 64 + nb * 16 + l15];
#pragma unroll
    for (int nb = 0; nb < 4; ++nb) gn[nb] = gnorm[vh * 64 + nb * 16 + l15];
    float ss[4];
#pragma unroll
    for (int e = 0; e < 4; ++e) { float s = 0.f;
#pragma unroll
        for (int nb = 0; nb < 4; ++nb) s += o[nb][e] * o[nb][e];
#pragma unroll
        for (int x = 8; x >= 1; x >>= 1) s += shx(s, x, lane);
        ss[e] = s; }
    if (l15 == 0) {
#pragma unroll
        for (int e = 0; e < 4; ++e) rss[vh * 64 + bi * 16 + 4 * kg + e] = ss[e]; }
    lds_barrier();
#pragma unroll
    for (int e = 0; e < 4; ++e) { const int tl = bi * 16 + 4 * kg + e; const float tot = rss[tl] + rss[64 + tl]; const float rn = rsqrtf(tot * (1.0f / 128.0f) + EPS);
        const size_t row = (size_t)(row0 + tl);
#pragma unroll
        for (int nb = 0; nb < 4; ++nb) { const int v = vh * 64 + nb * 16 + l15; const float og = bf2f(ogr[e][nb]);
            yd[row * 512 + hh * 128 + v] = f2bf(o[nb][e] * rn * gn[nb] * siluf_(og)); } }
    lds_barrier();
}
}

constexpr int PH_PER_LAYER = 14, N_PHASES = 1 + PH_PER_LAYER * NL + 1;
#ifndef MK_LAUNCHES
#define MK_LAUNCHES 1
#endif

__global__ void __launch_bounds__(NTHR, 2) fwd_kernel(KP karg) {
    extern __shared__ __attribute__((aligned(16))) unsigned char lds_raw[];
    LAS unsigned char* lds0 = (LAS unsigned char*)lds_raw;
    const int tid = otid(), G = gridDim.x, c = obid();
    volatile LAS unsigned* bst = (volatile LAS unsigned*)(lds0 + LDS_MISC);
    if (tid < 4) bst[tid] = 0u;
    __syncthreads();
    const int lo = karg.ph_lo, hi = karg.ph_hi;
    const bool fused = (MK_LAUNCHES == 1) || (hi - lo) > 1;
    XcdBarrier bar; bar.bar = (unsigned*)(karg.ws + WS_CTL); bar.x = 0; bar.st = bst;
    if (fused) bar = xcd_barrier_post((unsigned*)(karg.ws + WS_CTL), bst);
#ifndef ONLY_PH
#define ONLY_PH (-1)
#endif
#ifndef SUBMASK
#define SUBMASK 0xff
#endif
#define SUB(b) ((SUBMASK >> (b)) & 1)
#define EN(x) (ONLY_PH < 0 || ONLY_PH == (x))
#ifndef REPX
#define REPX (-1)
#define REPN 1
#endif
#define REPEAT(x) _Pragma("unroll 1") for (int rep_ = 0; rep_ < (REPX == (x) ? REPN : 1); ++rep_)
#define IN(k) ((MK_LAUNCHES == 1) || (lo <= (k) && (k) < hi))
#define INL(x) (EN(x) && IN(pb + (x)))
#define SEAM(k) do { if (IN((k) + 1)) xcd_barrier(bar); } while (0)

#define PH_LOCALS CKP& p = kp_here(); const int c = obid(); unsigned char* ws = p.ws; LAS unsigned char* lds = lds_here(lds_raw); \
    float* mod = (float*)(ws + WS_MOD); const float* rope = (const float*)(ws + WS_ROPE); const float* scal = (const float*)(ws + WS_SCAL); \
    bf16_t* hbuf = (bf16_t*)(ws + WS_HBUF); bf16_t* act = (bf16_t*)(ws + WS_R1); bf16_t* ubuf = (bf16_t*)(ws + WS_R1); bf16_t* mrg = (bf16_t*)(ws + WS_R1); bf16_t* ybuf = (bf16_t*)(ws + WS_YBUF); \
    float* xc = (float*)(ws + WS_XC); const float* modl = mod + (size_t)l * 3 * NMOD * DM; \
    (void)rope; (void)scal; (void)hbuf; (void)act; (void)ubuf; (void)mrg; (void)ybuf; (void)xc; (void)modl;

    if (EN(100) && IN(0)) { CKP& p = kp_here(); LAS unsigned char* lds = lds_here(lds_raw); job_tables(p); job_colmax(p); job_mod(p, lds); SEAM(0); }

#pragma unroll 1
    for (int l = 0; l < NL; ++l) {
        const int pb = 1 + PH_PER_LAYER * l; const bool need_ctx = l < NL - 1; const int nrt = need_ctx ? NRT : 128;
        if (INL(0)) { PH_LOCALS
            RNArgs a{};
            if (l == 0) { a.xs_lat = p.in[I_X]; a.xs_ctx = p.in[I_CTX]; a.xd_lat = p.out; a.xd_ctx = xc; a.y = nullptr; }
            else { a.xs_lat = p.out; a.xs_ctx = xc; a.xd_lat = p.out; a.xd_ctx = xc; a.y = ybuf; a.wres = 0.5f; a.modl_res = mod + (size_t)(l - 1) * 3 * NMOD * DM; a.jres = 2; a.postg = p.in[I_POST] + ((l - 1) * 3 + 2) * DM; }
            a.do_norm = true; a.modl_norm = modl; a.jn = 0; a.preg = p.in[I_PRE] + (l * 3 + 0) * DM; a.h = nullptr; a.h8 = (signed char*)hbuf; a.nrows = MALL; a.hsc = (float*)(ws + WS_HSC);
            job_resnorm(a, lds);
            job_convert(p, lds, l);
            SEAM(pb + 0);
        }
        if (INL(1)) { PH_LOCALS
            SchedPlain S; S.T.init(NRT, 44, G, c); S.A = (const char*)hbuf; S.B = (const char*)(ws + WS_WGU); S.lda2 = DM; S.ldb2 = DM; S.nt = DM / 128;
            REPEAT(1) { EpiGateUpI8 E{act, (const float*)(ws + WS_HSC), (const float*)(ws + WS_WSC)}; gm::gemm_stream<false>(lds, S, E); } SEAM(pb + 1);
        }
        if (INL(2)) { PH_LOCALS
            const bool spl = G == 256 && MK_LAUNCHES == 1; float* ypart = (float*)(ws + WS_R1 + (size_t)MALL * DFF * 2);
            SchedSplitK S; S.T.init(spl ? 128 : NRT, 8, G, c); S.A = (const char*)act; S.B = (const char*)(ws + WS_WD); S.lda2 = DFF * 2; S.ldb2 = DFF * 2; S.nt = DFF / 64; S.xe = (spl && c < 64) ? c : -1;
            REPEAT(2) { EpiStoreK E{ybuf, ypart}; gm::gemm_stream<false>(lds, S, E); } SEAM(pb + 2);
            if (spl) { job_splitk_reduce(ypart, ybuf); xcd_barrier(bar); }
        }
        if (INL(3)) { PH_LOCALS
            RNArgs a{};
            if (l == 0) { a.xs_lat = p.in[I_X]; a.xs_ctx = p.in[I_CTX]; } else { a.xs_lat = p.out; a.xs_ctx = xc; }
            a.xd_lat = p.out; a.xd_ctx = xc; a.y = ybuf; a.wres = 0.5f; a.modl_res = modl; a.jres = 0; a.postg = p.in[I_POST] + (l * 3 + 0) * DM;
            a.do_norm = true; a.modl_norm = modl; a.jn = 1; a.preg = p.in[I_PRE] + (l * 3 + 1) * DM; a.h = nullptr; a.h8 = (signed char*)(ws + WS_H8); a.hsc = (float*)(ws + WS_HSC2); a.nrows = MALL;
            job_resnorm(a, lds); SEAM(pb + 3);
        }
        if (INL(4)) { PH_LOCALS
            SchedPlain S; S.T.init(NRT, 24, G, c); S.A = (const char*)(ws + WS_H8); S.B = (const char*)(ws + WS_WIN); S.lda2 = DM; S.ldb2 = DM; S.nt = DM / 128;
            REPEAT(4) { EpiProj E{ubuf, (bf16_t*)(ws + WS_KM), rope, (const float*)(ws + WS_HSC2), (const float*)(ws + WS_WPS)}; gm::gemm_stream<false>(lds, S, E); } SEAM(pb + 4);
        }
        if (INL(5)) { PH_LOCALS job_stats_conv(p, l); SEAM(pb + 5); }
        if (INL(6)) { PH_LOCALS
            if (SUB(0)) { SchedPlain S; S.T.init(NRT, 3, G, c); S.A = (const char*)(ubuf + U_AQ); S.B = (const char*)(ws + WS_WUQ); S.lda2 = NU * 2; S.ldb2 = 512 * 2; S.nt = 8;
              EpiQup E{(bf16_t*)(ws + WS_QM), (const float*)(ws + WS_RSQ), rope}; gm::gemm_stream<false>(lds, S, E); }
            if (SUB(1)) { SchedPlain S; S.T.init(NRT, 4, G, G == 256 ? (c + 120) & 255 : c); S.A = (const char*)(ubuf + U_AKV); S.B = (const char*)(ws + WS_WUKV); S.lda2 = NU * 2; S.ldb2 = 256 * 2; S.nt = 4;
              EpiKVup E{(bf16_t*)(ws + WS_KM), (bf16_t*)(ws + WS_VM), (const float*)(ws + WS_RSQ) + MALL}; gm::gemm_stream<false>(lds, S, E); }
            if (SUB(2)) { SchedPlain S; S.T.init(NRT, 8, G, G == 256 ? (c + 112) & 255 : c); S.A = (const char*)(ws + WS_XCV); S.B = (const char*)(ws + WS_WRG); S.lda2 = 512 * 2; S.ldb2 = 512 * 2; S.nt = 8;
              EpiRG E{(const bf16_t*)(ws + WS_XCV), (bf16_t*)(ws + WS_LA), (bf16_t*)(ws + WS_BB), p.in[I_RGBR] + l * 1024, p.in[I_RGBI] + l * 1024, scal + 2048 + l * 1024}; gm::gemm_stream<false>(lds, S, E); }
            if (SUB(3)) for (int u = (G == 256 ? (c + 96) & 255 : c); u < 520 * 4; u += G) hg::pass1_unit(p, lds, scal + 256 + l * 512, u >> 2, u & 3);
            SEAM(pb + 6);
        }
        if (INL(7)) { PH_LOCALS job_rg_scan1(p); for (int u = c; u < 256; u += G) hg::carry_unit(p, u); SEAM(pb + 7); }
        if (INL(8)) { PH_LOCALS {
            REPEAT(81) if (SUB(0)) job_rg_out(p, nrt);
            REPEAT(82) if (SUB(1)) { const int ncu = need_ctx ? 520 * 4 : 512 * 4;
                if (G > nrt + 16) {
                    if (c < nrt) { for (int i = 0; i < 7; ++i) { const int u = c + i * nrt; hg::out_unit(p, lds, scal + 256 + l * 512, p.in[I_HNORM] + l * 128, u >> 2, u & 3); } }
                    else for (int u = 7 * nrt + (c - nrt); u < ncu; u += G - nrt) hg::out_unit(p, lds, scal + 256 + l * 512, p.in[I_HNORM] + l * 128, u >> 2, u & 3);
                } else for (int u = c; u < ncu; u += G) hg::out_unit(p, lds, scal + 256 + l * 512, p.in[I_HNORM] + l * 128, u >> 2, u & 3); }
            if (SUB(4) && need_ctx) for (int t = c; t < 16; t += G) { const int bh = t & 7, b = bh >> 2, h = bh & 3; at::KeyMap km{MLAT + b * CTXL, 0, 4, 4};
                if (t < 8) attn_unit_mla(p, lds, MLAT + b * CTXL, h, km); else attn_unit_diff(p, lds, l, MLAT + b * CTXL, h, km); }
            REPEAT(83) if (SUB(2)) for (int t = c; t < 512; t += G) { const int bh = t & 7, qb = t >> 3, b = bh >> 2, h = bh & 3; at::KeyMap km{MLAT + b * CTXL, b * SEQ, 4, 260}; attn_unit_mla(p, lds, b * SEQ + qb * 256, h, km); }
            REPEAT(84) if (SUB(3)) for (int t = c; t < 512; t += G) { const int bh = t & 7, qb = t >> 3, b = bh >> 2, h = bh & 3; at::KeyMap km{MLAT + b * CTXL, b * SEQ, 4, 260}; attn_unit_diff(p, lds, l, b * SEQ + qb * 256, h, km); }
            }
            SEAM(pb + 8);
        }
        if (INL(9)) { PH_LOCALS
            const bool bal = need_ctx && G == 256 && MK_LAUNCHES == 1;
            bf16_t* part = mrg + (size_t)2 * MALL * DM; bf16_t* gx = part + (size_t)4 * MCTX * DM;
            EpiMergeG EG{mrg + (size_t)MALL * DM, p.in[I_MB] + l * 4 * DM, (const float*)(ws + WS_HSC2), (const float*)(ws + WS_WGS), bal, gx};
            EpiMergeY EY{mrg, mrg + (size_t)MALL * DM, bal, gx, part};
            REPEAT(9) {
#pragma unroll 1
            for (int n = 0; n < 4; ++n) { const int xe = (bal && c >= 16 * n && c < 16 * n + 16) ? c - 16 * n : -1, nrm = bal ? 128 : nrt;
                { SchedMergeG S; S.T.init(nrm, 8, G, c); S.h8 = (const char*)(ws + WS_H8); S.wg = (const char*)(ws + WS_WIN) + (size_t)NU * DM; S.n = n; S.xe = xe; gm::gemm_stream<false>(lds, S, EG); }
                { SchedMergeY S; S.T.init(nrm, 8, G, c); S.ybr = (const char*)(ws + WS_YBR); S.wbr = (const char*)(ws + WS_WBR); S.n = n; S.xe = xe; gm::gemm_stream<false>(lds, S, EY); }
            } }
            SEAM(pb + 9);
            if (bal) {
                const int tid = otid();
                for (int idx = c * 512 + tid; idx < MCTX * 256; idx += G * 512) { const int row = idx >> 8, q = idx & 255; float sm[8] = {0.f, 0.f, 0.f, 0.f, 0.f, 0.f, 0.f, 0.f};
#pragma unroll
                    for (int n = 0; n < 4; ++n) { const u32x4 w = *(const u32x4*)(part + ((size_t)n * MCTX + row) * DM + q * 8);
                        sm[0] += bflo(w.x); sm[1] += bfhi(w.x); sm[2] += bflo(w.y); sm[3] += bfhi(w.y); sm[4] += bflo(w.z); sm[5] += bfhi(w.z); sm[6] += bflo(w.w); sm[7] += bfhi(w.w); }
                    u32x4 o; o.x = cvt_pk_bf16(sm[0], sm[1]); o.y = cvt_pk_bf16(sm[2], sm[3]); o.z = cvt_pk_bf16(sm[4], sm[5]); o.w = cvt_pk_bf16(sm[6], sm[7]);
                    *(u32x4*)(mrg + (size_t)(MLAT + row) * DM + q * 8) = o; }
                xcd_barrier(bar);
            }
        }
        if (INL(10)) { PH_LOCALS
            const bool spl = need_ctx && G == 256 && MK_LAUNCHES == 1; float* ypart = (float*)(ws + WS_R1 + (size_t)MALL * DFF * 2);
            SchedSplitK S; S.T.init(spl ? 128 : nrt, 8, G, c); S.A = (const char*)mrg; S.B = (const char*)(ws + WS_WOUT); S.lda2 = DM * 2; S.ldb2 = DM * 2; S.nt = DM / 64; S.xe = (spl && c < 64) ? c : -1;
            EpiStoreK E{ybuf, ypart}; gm::gemm_stream<false>(lds, S, E); SEAM(pb + 10);
            if (spl) { job_splitk_reduce(ypart, ybuf); xcd_barrier(bar); }
        }
        if (INL(11)) { PH_LOCALS
            RNArgs a{}; a.xs_lat = p.out; a.xs_ctx = xc; a.xd_lat = p.out; a.xd_ctx = xc; a.y = ybuf; a.wres = 1.0f; a.modl_res = modl; a.jres = 1; a.postg = p.in[I_POST] + (l * 3 + 1) * DM;
            a.do_norm = true; a.modl_norm = modl; a.jn = 2; a.preg = p.in[I_PRE] + (l * 3 + 2) * DM; a.h = nullptr; a.h8 = (signed char*)hbuf; a.nrows = nrt * 256; a.hsc = (float*)(ws + WS_HSC);
            job_resnorm(a, lds); SEAM(pb + 11);
        }
        if (INL(12)) { PH_LOCALS
            SchedPlain S; S.T.init(nrt, 44, G, c); S.A = (const char*)hbuf; S.B = (const char*)(ws + WS_WGU) + (size_t)11264 * 2048; S.lda2 = DM; S.ldb2 = DM; S.nt = DM / 128;
            EpiGateUpI8 E{act, (const float*)(ws + WS_HSC), (const float*)(ws + WS_WSC) + 11264}; gm::gemm_stream<false>(lds, S, E); SEAM(pb + 12);
        }
        if (INL(13)) { PH_LOCALS
            const bool spl = need_ctx && G == 256 && MK_LAUNCHES == 1; float* ypart = (float*)(ws + WS_R1 + (size_t)MALL * DFF * 2);
            SchedSplitK S; S.T.init(spl ? 128 : nrt, 8, G, c); S.A = (const char*)act; S.B = (const char*)(ws + WS_WD) + (size_t)2048 * 5632 * 2; S.lda2 = DFF * 2; S.ldb2 = DFF * 2; S.nt = DFF / 64; S.xe = (spl && c < 64) ? c : -1;
            EpiStoreK E{ybuf, ypart}; gm::gemm_stream<false>(lds, S, E); SEAM(pb + 13);
            if (spl) { job_splitk_reduce(ypart, ybuf); xcd_barrier(bar); }
        }
    }
    if (EN(101) && IN(N_PHASES - 1)) {
        const int l = NL - 1; PH_LOCALS
        RNArgs a{}; a.xs_lat = p.out; a.xs_ctx = xc; a.xd_lat = p.out; a.xd_ctx = xc; a.y = ybuf; a.wres = 0.5f; a.modl_res = mod + (size_t)l * 3 * NMOD * DM; a.jres = 2; a.postg = p.in[I_POST] + (l * 3 + 2) * DM;
        a.do_norm = false; a.modl_norm = a.modl_res; a.jn = 0; a.preg = nullptr; a.h = nullptr; a.nrows = MLAT;
        job_resnorm(a, lds);
    }
#undef PH_LOCALS
#undef IN
#undef INL
#undef EN
#undef SEAM
}


#ifdef DBG_K
__global__ void dbg_dump(float* out, const unsigned char* ws, size_t off, size_t nelem, int is_bf16) {
    const size_t N = (size_t)MLAT * DM;
    for (size_t i = (size_t)obid() * blockDim.x + threadIdx.x; i < N; i += (size_t)gridDim.x * blockDim.x) {
        float s = 0.f;
        for (size_t j = i; j < nelem; j += N) s += is_bf16 ? bf2f(((const bf16_t*)(ws + off))[j]) : ((const float*)(ws + off))[j];
        out[i] = (s - s == 0.f) ? s : 12345.0f;
    }
}
#endif

extern "C" void kernel_launch(void* const* d_in, const int* in_sizes, int n_in, void* d_out, int out_size, void* d_ws, size_t ws_size, hipStream_t stream) {
    static int grid = 0;
    if (grid == 0) {
        if (n_in != 30 || out_size != MLAT * DM || ws_size < WS_END) { fprintf(stderr, "kernel_launch: unexpected shapes: n_in %d out %d ws %zu (need %zu)\n", n_in, out_size, ws_size, (size_t)WS_END); grid = -1; return; }
        int dev = 0, cus = 0;
        if (hipGetDevice(&dev) != hipSuccess || hipDeviceGetAttribute(&cus, hipDeviceAttributeMultiprocessorCount, dev) != hipSuccess) { grid = -1; return; }
        if (hipFuncSetAttribute((const void*)fwd_kernel, hipFuncAttributeMaxDynamicSharedMemorySize, LDS_BYTES) != hipSuccess) { fprintf(stderr, "kernel_launch: hipFuncSetAttribute failed\n"); grid = -1; return; }
        int per_cu = 0; (void)hipOccupancyMaxActiveBlocksPerMultiprocessor(&per_cu, (const void*)fwd_kernel, NTHR, LDS_BYTES); (void)hipGetLastError();
        grid = cus;
    }
    if (grid < 0) return;
    (void)hipMemsetAsync((char*)d_ws + WS_CTL, 0, WS_ZERO_BYTES, stream);
    KP p{};
    for (int i = 0; i < 30; ++i) p.in[i] = (const float*)d_in[i];
    p.out = (float*)d_out; p.ws = (unsigned char*)d_ws;
#ifdef DBG_K
    for (int k = 0; k < DBG_K; ++k) { p.ph_lo = k; p.ph_hi = k + 1; hipLaunchKernelGGL(fwd_kernel, dim3(grid), dim3(NTHR), LDS_BYTES, stream, p); }
    hipLaunchKernelGGL(dbg_dump, dim3(2048), dim3(256), 0, stream, (float*)d_out, (const unsigned char*)d_ws, (size_t)(DBG_OFF), (size_t)(DBG_N), (int)(DBG_BF));
#elif MK_LAUNCHES == 1
    p.ph_lo = 0; p.ph_hi = N_PHASES;
    hipLaunchKernelGGL(fwd_kernel, dim3(grid), dim3(NTHR), LDS_BYTES, stream, p);
#else
    for (int k = 0; k < N_PHASES; ++k) { p.ph_lo = k; p.ph_hi = k + 1; hipLaunchKernelGGL(fwd_kernel, dim3(grid), dim3(NTHR), LDS_BYTES, stream, p); }
#endif
}
```

```cpp
#include <hip/hip_runtime.h>
#include <stdint.h>
#include <stdio.h>

#define LAS __attribute__((address_space(3)))
typedef unsigned short bf16_t;
typedef short bf16x8 __attribute__((ext_vector_type(8)));
typedef short s16x4 __attribute__((ext_vector_type(4)));
typedef float f32x2 __attribute__((ext_vector_type(2)));
typedef float f32x4 __attribute__((ext_vector_type(4)));
typedef float f32x16 __attribute__((ext_vector_type(16)));
typedef unsigned u32x2 __attribute__((ext_vector_type(2)));
typedef unsigned u32x4 __attribute__((ext_vector_type(4)));
typedef int i32x4 __attribute__((ext_vector_type(4)));

constexpr int DM = 2048, NB = 2, SEQ = 16384, NL = 2, CTXL = 256, DFF = 5632, NMOD = 9;
constexpr int MLAT = NB * SEQ, MCTX = NB * CTXL, MALL = MLAT + MCTX;
constexpr int NRT = MALL / 256;
constexpr int DIN = 14144, NU = 6144;
constexpr float EPS = 1e-6f;
constexpr int U_AQ = 0, U_BX = 512, U_BG = 1024, U_CQ = 1536, U_CK = 2048, U_CV = 2560, U_DQ = 3072, U_DFF = 3584, U_DFB = 4096, U_DI = 4608, U_DG = 5120, U_AKV = 5632, U_AKR = 5888;

constexpr size_t al256(size_t x) { return (x + 255) / 256 * 256; }
constexpr size_t WS_CTL = 0;
constexpr size_t WS_CMAX = 16384;
constexpr size_t WS_CMAX2 = WS_CMAX + (size_t)NL * 2 * 2 * 5632 * 4;
constexpr size_t WS_ZERO_BYTES = 524288;
static_assert(WS_CMAX2 + (size_t)NL * 14336 * 4 <= WS_ZERO_BYTES, "column maxima inside the zeroed region");
constexpr size_t WS_MOD = 524288;
constexpr size_t WS_ROPE = WS_MOD + al256((size_t)NL * 3 * NMOD * DM * 4);
constexpr size_t WS_SCAL = WS_ROPE + 32768;
constexpr size_t WS_RSQ = WS_SCAL + 32768;
constexpr size_t WS_RGS = WS_RSQ + al256((size_t)MALL * 8);
constexpr size_t WS_HD = WS_RGS + al256((size_t)NRT * 2 * 512 * 8);
constexpr size_t WS_XC = WS_HD + al256((size_t)520 * 4 * 2 * 128 * 4);
constexpr size_t WS_WGU = WS_XC + (size_t)MCTX * DM * 4;
constexpr size_t WS_WD = WS_WGU + (size_t)2 * 11264 * 2048 * 2;
constexpr size_t WS_WIN = WS_WD + (size_t)2 * 2048 * 5632 * 2;
constexpr size_t WS_WUQ = WS_WIN + (size_t)14336 * 2048 * 2;
constexpr size_t WS_WUKV = WS_WUQ + (size_t)768 * 512 * 2;
constexpr size_t WS_WRG = WS_WUKV + (size_t)1024 * 256 * 2;
constexpr size_t WS_WBR = WS_WRG + (size_t)2048 * 512 * 2;
constexpr size_t WS_WOUT = WS_WBR + (size_t)4 * 2048 * 512 * 2;
constexpr size_t WS_HBUF = WS_WOUT + (size_t)2048 * 2048 * 2;
constexpr size_t WS_R1 = WS_HBUF + (size_t)MALL * DM * 2;
constexpr size_t WS_YBUF = WS_R1 + (size_t)MALL * NU * 2;
constexpr size_t WS_QM = WS_YBUF + (size_t)MALL * DM * 2;
constexpr size_t WS_KM = WS_QM + (size_t)MALL * 768 * 2;
constexpr size_t WS_VM = WS_KM + (size_t)MALL * 768 * 2;
constexpr size_t WS_YBR = WS_VM + (size_t)MALL * 512 * 2;
constexpr size_t WS_XCV = WS_YBR + (size_t)4 * MALL * 512 * 2;
constexpr size_t WS_LA = WS_XCV + (size_t)MALL * 512 * 2;
constexpr size_t WS_BB = WS_LA + (size_t)MALL * 1024 * 2;
constexpr size_t WS_WSC = WS_BB + (size_t)MALL * 1024 * 2;
constexpr size_t WS_HSC = WS_WSC + al256((size_t)2 * 11264 * 4);
constexpr size_t WS_HSC2 = WS_HSC + al256((size_t)MALL * 4);
constexpr size_t WS_WGS = WS_HSC2 + al256((size_t)MALL * 4);
constexpr size_t WS_WPS = WS_WGS + 32768;
constexpr size_t WS_H8 = WS_WPS + 32768;
constexpr size_t WS_END = WS_H8 + (size_t)MALL * DM;

constexpr int NTHR = 512;
constexpr int LDS_BYTES = 147456;
constexpr int LDS_MISC = 147456 - 64;

typedef __bf16 bf16x2n __attribute__((ext_vector_type(2)));
__device__ __forceinline__ unsigned cvt_pk_bf16(float lo, float hi) { const f32x2 v = {lo, hi}; const bf16x2n b = __builtin_convertvector(v, bf16x2n); return __builtin_bit_cast(unsigned, b); }
__device__ __forceinline__ bf16_t f2bf(float x) { return (bf16_t)(cvt_pk_bf16(x, 0.f) & 0xffffu); }
__device__ __forceinline__ float bf2f(bf16_t b) { return __uint_as_float(((unsigned)b) << 16); }
__device__ __forceinline__ float bflo(unsigned w) { return __uint_as_float(w << 16); }
__device__ __forceinline__ float bfhi(unsigned w) { return __uint_as_float(w & 0xffff0000u); }
__device__ __forceinline__ float frcp(float x) { return __builtin_amdgcn_rcpf(x); }
__device__ __forceinline__ float flog(float x) { return __builtin_amdgcn_logf(x) * 0.6931471805599453f; }
__device__ __forceinline__ float sigmoidf_(float x) { return frcp(1.0f + __expf(-x)); }
__device__ __forceinline__ float siluf_(float x) { return x * sigmoidf_(x); }
__device__ __forceinline__ float gelu_tanh(float x) { const float u = 0.7978845608028654f * (x + 0.044715f * x * x * x); const float t = 1.0f - 2.0f * frcp(1.0f + __expf(2.0f * u)); return 0.5f * x * (1.0f + t); }
__device__ __forceinline__ float shx(float v, int mask, int lane) { return __int_as_float(__builtin_amdgcn_ds_bpermute((lane ^ mask) << 2, __float_as_int(v))); }
__device__ __forceinline__ float wave_sum(float v, int lane) {
#pragma unroll
    for (int o = 32; o >= 1; o >>= 1) v += shx(v, o, lane);
    return v;
}
__device__ __forceinline__ int obid() { int b = blockIdx.x; asm volatile("" : "+s"(b)); return b; }
__device__ __forceinline__ int otid() { int t = threadIdx.x; asm volatile("" : "+v"(t)); return t; }
#define WAIT_VM0() asm volatile("s_waitcnt vmcnt(0)" ::: "memory")
#define WAIT_LGKM0() asm volatile("s_waitcnt lgkmcnt(0)" ::: "memory")

#define XB_TMO      128
#define XB_XCNT(j)  (256  + 64 * (j))
#define XB_XSUB(j)  (1280 + 64 * (j))
#define XB_XGEN(j)  (2304 + 64 * (j))
#define XB_TOP      3328
#define XB_TOPGEN   3392
#define XCD_BAR_WORDS 3456
#define XB_SPIN_CAP (1u << 22)
__device__ __forceinline__ unsigned xb_ld(unsigned* p)              { return __hip_atomic_load(p, __ATOMIC_RELAXED, __HIP_MEMORY_SCOPE_AGENT); }
__device__ __forceinline__ unsigned xb_add(unsigned* p, unsigned v) { return __hip_atomic_fetch_add(p, v, __ATOMIC_RELAXED, __HIP_MEMORY_SCOPE_AGENT); }
__device__ __forceinline__ unsigned xb_xcc_id() { return (unsigned)__builtin_amdgcn_s_getreg((3 << 11) | 20) & 0xFu; }
#define XB_SPIN(cond, bar) do { unsigned _sp = 0; while (cond) { __builtin_amdgcn_s_sleep(1); \
    if ((++_sp & 255u) == 0u) { if (xb_ld(&(bar)[XB_TMO])) break; if (_sp > XB_SPIN_CAP) { atomicAdd(&(bar)[XB_TMO], 1u); break; } } } } while (0)
struct XcdBarrier { unsigned* bar; unsigned x; volatile LAS unsigned* st; };
__device__ __forceinline__ XcdBarrier xcd_barrier_post(unsigned* bar, volatile LAS unsigned* st) {
    XcdBarrier b; b.bar = bar; b.x = xb_xcc_id(); b.st = st;
    if (threadIdx.x == 0) (void)xb_add(&bar[XB_XCNT(b.x)], 1u);
    return b;
}
__device__ __forceinline__ void xcd_barrier_complete(unsigned* bar, unsigned x, unsigned& nloc, unsigned& nx) {
    const unsigned G = gridDim.x * gridDim.y * gridDim.z;
    unsigned sum, cnt, mine, sp = 0u;
    for (;;) {
        sum = 0u; cnt = 0u; mine = 0u;
#pragma unroll 1
        for (unsigned j = 0; j < 16; ++j) { const unsigned c = xb_ld(&bar[XB_XCNT(j)]); sum += c; cnt += (c > 0u) ? 1u : 0u; mine = (j == x) ? c : mine; }
        if (sum == G) break;
        __builtin_amdgcn_s_sleep(1);
        if ((++sp & 255u) == 0u) { if (xb_ld(&bar[XB_TMO])) break; if (sp > XB_SPIN_CAP) { atomicAdd(&bar[XB_TMO], 1u); break; } }
    }
    nloc = mine > 0u ? mine : 1u; nx = cnt > 0u ? cnt : 1u;
}
__device__ __forceinline__ void xcd_barrier(const XcdBarrier& b) {
    asm volatile("s_waitcnt vmcnt(0)" ::: "memory");
    __syncthreads();
    if (threadIdx.x == 0) {
        unsigned* bar = b.bar; unsigned bx = b.x;
        asm volatile("" : "+s"(bar), "+s"(bx));
        __builtin_amdgcn_s_waitcnt(0);
        unsigned nloc = b.st[0], nx = b.st[1];
        if (nloc == 0u) { xcd_barrier_complete(bar, bx, nloc, nx); b.st[0] = nloc; b.st[1] = nx; }
        const unsigned old = xb_add(&bar[XB_XSUB(bx)], 1u);
        const unsigned gen = old / nloc;
        if (old + 1u == (gen + 1u) * nloc) {
            __builtin_amdgcn_fence(__ATOMIC_RELEASE, "agent");
            asm volatile("s_waitcnt vmcnt(0)" ::: "memory");
            const unsigned og = xb_add(&bar[XB_TOP], 1u);
            const unsigned tg = og / nx;
            if (og + 1u == (tg + 1u) * nx) xb_add(&bar[XB_TOPGEN], 1u);
            else XB_SPIN(xb_ld(&bar[XB_TOPGEN]) == tg, bar);
            __builtin_amdgcn_fence(__ATOMIC_ACQUIRE, "agent");
            xb_add(&bar[XB_XGEN(bx)], 1u);
            asm volatile("s_waitcnt vmcnt(0)" ::: "memory");
        } else {
            XB_SPIN(xb_ld(&bar[XB_XGEN(bx)]) == gen, bar);
            __builtin_amdgcn_fence(__ATOMIC_ACQUIRE, "agent");
            asm volatile("s_waitcnt vmcnt(0)" ::: "memory");
        }
    }
    __syncthreads();
}

constexpr float MLA_QC = 0.07216878364870322f * 1.4426950408889634f, DIFF_QC = 0.125f * 1.4426950408889634f;
namespace gm {
constexpr int BM = 256, BK = 64, HALF = 128, HTB = HALF * BK * 2, STAGE_BYTES = 8 * HTB;
__device__ __forceinline__ int lds_byte(int r, int c) { const int st = (r >> 4) * 2 + (c >> 5), rr = r & 15, cc = c & 31, ob = rr * 64 + cc * 2; return st * 1024 + (ob ^ (((ob >> 9) & 1) << 5)); }
__device__ __forceinline__ void stage_rc(int b, int& R, int& C) { const int st = b / 1024, sb = b % 1024, swz = sb ^ (((sb >> 9) & 1) << 5); R = (st >> 1) * 16 + swz / 64; C = (st & 1) * 32 + (swz % 64) / 2; }
__device__ __forceinline__ int perm32(int rho) { const int n = rho >> 4, i = rho & 15; return 8 * (i >> 2) + 4 * n + (i & 3); }

struct Unit { const char* A; const char* B; unsigned lda2, ldb2; int nt; int pm, pn, tag; };

struct TileOrder {
    int nM, nN, nwg, G, c;
    __device__ __forceinline__ void init(int nM_, int nN_, int G_, int c_) { nM = nM_; nN = nN_; nwg = nM * nN; G = G_; c = c_; }
    __device__ __forceinline__ bool tile(int i, int& pm, int& pn) const {
        const long L = (long)i * G + c; if (L >= nwg) return false;
        int wgid = (int)L; { const int q = nwg / 8, r = nwg % 8, xcd = wgid % 8, off = wgid / 8; wgid = (xcd < r ? xcd * (q + 1) : r * (q + 1) + (xcd - r) * q) + off; }
        const int nig = 8 * nN, gid = wgid / nig, fm = gid * 8, gsz = (nM - fm) < 8 ? (nM - fm) : 8;
        pm = fm + ((wgid % nig) % gsz); pn = (wgid % nig) / gsz; return true;
    }
};

typedef i32x4 AccI[2][2][4][2];
__device__ __forceinline__ void zero_acc(AccI& acc) {
#pragma unroll
    for (int a = 0; a < 2; ++a)
#pragma unroll
        for (int b = 0; b < 2; ++b)
#pragma unroll
            for (int m = 0; m < 4; ++m)
#pragma unroll
                for (int n = 0; n < 2; ++n) acc[a][b][m][n] = (i32x4){0, 0, 0, 0};
}
template <class E> struct is_mixed { static constexpr bool v = false; };
typedef f32x4 Acc[2][2][4][2];
__device__ __forceinline__ void zero_acc(Acc& acc) {
#pragma unroll
    for (int a = 0; a < 2; ++a)
#pragma unroll
        for (int b = 0; b < 2; ++b)
#pragma unroll
            for (int m = 0; m < 4; ++m)
#pragma unroll
                for (int n = 0; n < 2; ++n) acc[a][b][m][n] = (f32x4){0.f, 0.f, 0.f, 0.f};
}

template <bool HALFN, class Sched, class Epi>
__device__ __forceinline__ void gemm_stream(LAS unsigned char* lds, const Sched& S, Epi& E) {
    const int tid = otid(), wid = __builtin_amdgcn_readfirstlane(tid >> 6), lane = tid & 63, wr = wid >> 2, wc = wid & 3, fr = lane & 15, fq = lane >> 4;
    int R0, C0; stage_rc(tid * 16, R0, C0);
    const int Rb0 = Epi::PERM ? ((R0 & ~31) + perm32(R0 & 31)) : R0;
    const unsigned ldsw = (unsigned)wid * 1024u;
    const int aoff = lds_byte(wr * 64 + fr, fq * 8), boff = lds_byte(wc * 32 + fr, fq * 8);
#define GM_SA(b, h) (((b) * 2 + (h)) * HTB)
#define GM_SB(b, h) ((4 + (b) * 2 + (h)) * HTB)
#define GM_STAGE(bufoff, gbase, voff, ld2) do { _Pragma("unroll") for (int _i = 0; _i < 2; ++_i) \
        __builtin_amdgcn_global_load_lds((const unsigned*)((const char*)(gbase) + (size_t)_i * 64 * (ld2) + (voff)), (LAS unsigned*)(lds + (bufoff) + ldsw + _i * 8192), 16, 0, 0); } while (0)
#define GM_LDA(dst, b, h) do { _Pragma("unroll") for (int m = 0; m < 4; ++m) _Pragma("unroll") for (int k = 0; k < 2; ++k) dst[m][k] = *(const LAS bf16x8*)(lds + GM_SA(b, h) + aoff + m * 2048 + k * 1024); } while (0)
#define GM_LDB(dst, b, h) do { _Pragma("unroll") for (int n = 0; n < 2; ++n) _Pragma("unroll") for (int k = 0; k < 2; ++k) dst[n][k] = *(const LAS bf16x8*)(lds + GM_SB(b, h) + boff + n * 2048 + k * 1024); } while (0)
#define GM_MMA_I8(ai, bj, At, Bt) do { _Pragma("unroll") for (int m = 0; m < 4; ++m) _Pragma("unroll") for (int n = 0; n < 2; ++n) _Pragma("unroll") for (int k = 0; k < 2; ++k) \
        acc[ai][bj][m][n] = __builtin_bit_cast(typename Epi::AccT_elem, __builtin_amdgcn_mfma_i32_16x16x64_i8(__builtin_bit_cast(i32x4, Bt[n][k]), __builtin_bit_cast(i32x4, At[m][k]), __builtin_bit_cast(i32x4, acc[ai][bj][m][n]), 0, 0, 0)); } while (0)
#define GM_MMA_BF(ai, bj, At, Bt) do { _Pragma("unroll") for (int m = 0; m < 4; ++m) _Pragma("unroll") for (int n = 0; n < 2; ++n) _Pragma("unroll") for (int k = 0; k < 2; ++k) \
        acc[ai][bj][m][n] = __builtin_bit_cast(typename Epi::AccT_elem, __builtin_amdgcn_mfma_f32_16x16x32_bf16(Bt[n][k], At[m][k], __builtin_bit_cast(f32x4, acc[ai][bj][m][n]), 0, 0, 0)); } while (0)
#define GM_MMA(ai, bj, At, Bt) do { __builtin_amdgcn_s_setprio(1); \
        if constexpr (is_mixed<Epi>::v) { if (cur_i8) GM_MMA_I8(ai, bj, At, Bt); else GM_MMA_BF(ai, bj, At, Bt); } \
        else if constexpr (Epi::I8) GM_MMA_I8(ai, bj, At, Bt); else GM_MMA_BF(ai, bj, At, Bt); \
        __builtin_amdgcn_s_setprio(0); } while (0)
#define GM_WAIT_V(n) asm volatile("s_waitcnt vmcnt(" #n ")" ::: "memory")
#define GM_WAIT_L(n) asm volatile("s_waitcnt lgkmcnt(" #n ")" ::: "memory")
#define GM_BAR __builtin_amdgcn_s_barrier()
#define GM_SCHED __builtin_amdgcn_sched_barrier(0)
    Unit cur, nxt; int ui = 0;
    if (!S.next(0, cur)) return;
    typename Epi::AccT acc;
    bf16x8 At[4][2], B0[2][2], B1[2][2];
    unsigned voffA = (unsigned)R0 * cur.lda2 + (unsigned)C0 * 2u, voffB = (unsigned)Rb0 * cur.ldb2 + (unsigned)C0 * 2u;
    const char* cA = cur.A; const char* cB = cur.B;
    {
        const size_t hA = (size_t)HALF * cur.lda2, hB = (size_t)HALF * cur.ldb2;
        GM_STAGE(GM_SB(0, 0), cB, voffB, cur.ldb2); GM_STAGE(GM_SA(0, 0), cA, voffA, cur.lda2);
        if constexpr (!HALFN) GM_STAGE(GM_SB(0, 1), cB + hB, voffB, cur.ldb2);
        GM_STAGE(GM_SA(0, 1), cA + hA, voffA, cur.lda2);
        if (wr == 1) GM_BAR;
        if constexpr (HALFN) GM_WAIT_V(2); else GM_WAIT_V(4);
        GM_BAR;
        GM_STAGE(GM_SB(1, 0), cB + 128, voffB, cur.ldb2); GM_STAGE(GM_SA(1, 0), cA + 128, voffA, cur.lda2);
        if constexpr (!HALFN) GM_STAGE(GM_SB(1, 1), cB + hB + 128, voffB, cur.ldb2);
        if constexpr (HALFN) GM_WAIT_V(4); else GM_WAIT_V(6);
        GM_BAR;
    }
#define GM_UNIT(BJ) { \
        if constexpr (HALFN) { _Pragma("unroll") for (int _a = 0; _a < 2; ++_a) _Pragma("unroll") for (int _m = 0; _m < 4; ++_m) _Pragma("unroll") for (int _n = 0; _n < 2; ++_n) acc[_a][0][_m][_n] = (f32x4){0.f, 0.f, 0.f, 0.f}; } \
        else zero_acc(acc); \
        const bool cur_i8 = (cur.tag & 1) == 0; (void)cur_i8; \
        const bool has_next = S.next(ui + 1, nxt); \
        const char* nA = has_next ? nxt.A : cA; const char* nB = has_next ? nxt.B : cB; \
        const unsigned nlda2 = has_next ? nxt.lda2 : cur.lda2, nldb2 = has_next ? nxt.ldb2 : cur.ldb2; \
        const unsigned nvoffA = (unsigned)R0 * nlda2 + (unsigned)C0 * 2u, nvoffB = (unsigned)Rb0 * nldb2 + (unsigned)C0 * 2u; \
        const size_t hA = (size_t)HALF * cur.lda2, hB = (size_t)HALF * cur.ldb2, nhA = (size_t)HALF * nlda2, nhB = (size_t)HALF * nldb2; \
        const int nt = cur.nt; \
        for (int t = 0; t < nt; t += 2) { \
            const bool last = (t == nt - 2); \
            const char* a1 = cA + (size_t)(t + 1) * 128; \
            const char* a2 = last ? nA : cA + (size_t)(t + 2) * 128; const char* b2 = last ? nB : cB + (size_t)(t + 2) * 128; \
            const char* a3 = a2 + 128; const char* b3 = b2 + 128; \
            const unsigned vA2 = last ? nvoffA : voffA, vB2 = last ? nvoffB : voffB; \
            const unsigned lA2 = last ? nlda2 : cur.lda2, lB2 = last ? nldb2 : cur.ldb2; \
            const size_t hA2 = last ? nhA : hA, hB2 = last ? nhB : hB; \
              \
            GM_LDB(B0, 0, 0); GM_SCHED; GM_LDA(At, 0, 0); GM_STAGE(GM_SA(1, 1), a1 + hA, voffA, cur.lda2); \
            GM_WAIT_L(8); GM_BAR; GM_WAIT_L(0); GM_MMA(0, 0, At, B0); GM_BAR; GM_SCHED; \
              \
            if constexpr (!HALFN) GM_LDB(B1, 0, 1); \
            GM_STAGE(GM_SB(0, 0), b2, vB2, lB2); \
            GM_BAR; GM_WAIT_L(0); if constexpr (!HALFN) GM_MMA(0, 1, At, B1); GM_BAR; \
              \
            GM_LDA(At, 0, 1); GM_STAGE(GM_SA(0, 0), a2, vA2, lA2); \
            GM_BAR; GM_WAIT_L(0); GM_MMA(1, 0, At, B0); GM_BAR; GM_SCHED; \
              \
            if constexpr (!HALFN) { GM_STAGE(GM_SB(0, 1), b2 + hB2, vB2, lB2); GM_WAIT_V(6); } else { GM_WAIT_V(4); } \
            GM_BAR; if constexpr (!HALFN) GM_MMA(1, 1, At, B1); GM_BAR; \
              \
            GM_LDB(B0, 1, 0); GM_SCHED; GM_LDA(At, 1, 0); GM_STAGE(GM_SA(0, 1), a2 + hA2, vA2, lA2); \
            GM_WAIT_L(8); GM_BAR; GM_WAIT_L(0); GM_MMA(0, 0, At, B0); GM_BAR; GM_SCHED; \
              \
            if constexpr (!HALFN) GM_LDB(B1, 1, 1); \
            GM_STAGE(GM_SB(1, 0), b3, vB2, lB2); \
            GM_BAR; GM_WAIT_L(0); if constexpr (!HALFN) GM_MMA(0, 1, At, B1); GM_BAR; \
              \
            GM_LDA(At, 1, 1); GM_STAGE(GM_SA(1, 0), a3, vA2, lA2); \
            GM_BAR; GM_WAIT_L(0); GM_MMA(1, 0, At, B0); GM_BAR; GM_SCHED; \
              \
            if constexpr (!HALFN) { GM_STAGE(GM_SB(1, 1), b3 + hB2, vB2, lB2); GM_WAIT_V(6); } else { GM_WAIT_V(4); } \
            GM_BAR; if constexpr (!HALFN) GM_MMA(1, 1, At, B1); GM_BAR; \
        } \
        { const int tz_ = otid(); const int wz_ = __builtin_amdgcn_readfirstlane(tz_ >> 6), lz_ = tz_ & 63; E.template post<BJ>(acc, cur, wz_ >> 2, wz_ & 3, lz_ & 15, lz_ >> 4); } \
        if (!has_next) break; \
        cur = nxt; cA = nA; cB = nB; voffA = nvoffA; voffB = nvoffB; ++ui; \
    }
    for (;;) {
        GM_UNIT(0)
    }
    GM_WAIT_V(0);
    if (wr == 0) GM_BAR;
    GM_BAR;
#undef GM_UNIT
#undef GM_SA
#undef GM_SB
#undef GM_STAGE
#undef GM_LDA
#undef GM_LDB
#undef GM_MMA
#undef GM_MMA_I8
#undef GM_MMA_BF
#undef GM_WAIT_V
#undef GM_WAIT_L
#undef GM_BAR
#undef GM_SCHED
}
}

struct SchedPlain {
    gm::TileOrder T; const char* A; const char* B; unsigned lda2, ldb2; int nt;
    __device__ __forceinline__ bool next(int i, gm::Unit& u) const {
        int pm, pn; if (!T.tile(i, pm, pn)) return false;
        u.A = A + (size_t)pm * 256 * lda2; u.B = B + (size_t)pn * 256 * ldb2; u.lda2 = lda2; u.ldb2 = ldb2; u.nt = nt; u.pm = pm; u.pn = pn; u.tag = 0; return true;
    }
};
struct SchedSplitK {
    gm::TileOrder T; const char* A; const char* B; unsigned lda2, ldb2; int nt, xe;
    __device__ __forceinline__ bool next(int i, gm::Unit& u) const {
        int pm, pn; u.lda2 = lda2; u.ldb2 = ldb2;
        if (T.tile(i, pm, pn)) { u.A = A + (size_t)pm * 256 * lda2; u.B = B + (size_t)pn * 256 * ldb2; u.nt = nt; u.pm = pm; u.pn = pn; u.tag = 0; return true; }
        if (xe < 0 || i != 4) return false;
        const int e = xe >> 2, sl = xe & 3, ks = nt >> 2; pm = 128 + (e & 1); pn = e >> 1;
        u.A = A + (size_t)pm * 256 * lda2 + (size_t)sl * ks * 128; u.B = B + (size_t)pn * 256 * ldb2 + (size_t)sl * ks * 128; u.nt = ks; u.pm = pm; u.pn = pn; u.tag = 1 + sl; return true;
    }
};
struct SchedMergeG {
    gm::TileOrder T; const char* h8; const char* wg; int n, xe;
    __device__ __forceinline__ bool next(int i, gm::Unit& u) const {
        int pm, pn; if (!T.tile(i, pm, pn)) { if (xe < 0 || i != 4) return false; pm = 128 + (xe & 1); pn = xe >> 1; }
        u.A = h8 + (size_t)pm * 256 * 2048; u.lda2 = 2048; u.nt = 16; u.B = wg + ((size_t)n * 2048 + (size_t)pn * 256) * 2048; u.ldb2 = 2048; u.pm = pm; u.pn = pn; u.tag = n; return true;
    }
};
struct SchedMergeY {
    gm::TileOrder T; const char* ybr; const char* wbr; int n, xe;
    __device__ __forceinline__ bool next(int i, gm::Unit& u) const {
        int pm, pn; if (!T.tile(i, pm, pn)) { if (xe < 0 || i != 4) return false; pm = 128 + (xe & 1); pn = xe >> 1; }
        u.A = ybr + (size_t)n * MALL * 1024 + (size_t)pm * 256 * 1024; u.lda2 = 1024; u.nt = 8; u.B = wbr + ((size_t)n * 2048 + (size_t)pn * 256) * 1024; u.ldb2 = 1024; u.pm = pm; u.pn = pn; u.tag = n; return true;
    }
};

struct EpiGateUp {
    static constexpr bool PERM = true, I8 = false; typedef gm::Acc AccT; typedef f32x4 AccT_elem; bf16_t* act;
    template <int BJ> __device__ __forceinline__ void post(gm::Acc& acc, const gm::Unit& u, int wr, int wc, int fr, int fq) {
        const int row0 = u.pm * 256 + wr * 64 + fr, col0 = u.pn * 128 + wc * 32 + 8 * fq;
#pragma unroll
        for (int ai = 0; ai < 2; ++ai)
#pragma unroll
            for (int m = 0; m < 4; ++m) {
                float v[8];
#pragma unroll
                for (int n = 0; n < 2; ++n)
#pragma unroll
                    for (int j = 0; j < 4; ++j) v[n * 4 + j] = siluf_(acc[ai][0][m][n][j]) * acc[ai][1][m][n][j];
                u32x4 w; w.x = cvt_pk_bf16(v[0], v[1]); w.y = cvt_pk_bf16(v[2], v[3]); w.z = cvt_pk_bf16(v[4], v[5]); w.w = cvt_pk_bf16(v[6], v[7]);
                *(u32x4*)(act + (size_t)(row0 + ai * 128 + m * 16) * DFF + col0) = w;
            }
    }
};
struct EpiGateUpI8 {
    static constexpr bool PERM = true, I8 = true; typedef gm::AccI AccT; typedef i32x4 AccT_elem; bf16_t* act; const float* hsc; const float* wsc;
    template <int BJ> __device__ __forceinline__ void post(gm::AccI& acc, const gm::Unit& u, int wr, int wc, int fr, int fq) {
        const int row0 = u.pm * 256 + wr * 64 + fr, col0 = u.pn * 128 + wc * 32 + 8 * fq, wrow = u.pn * 256 + wc * 32 + 8 * fq;
        float sg[8], su[8];
#pragma unroll
        for (int j = 0; j < 8; ++j) { sg[j] = wsc[wrow + j]; su[j] = wsc[wrow + 128 + j]; }
        float hsv[8];
#pragma unroll
        for (int i = 0; i < 8; ++i) hsv[i] = hsc[row0 + (i >> 2) * 128 + (i & 3) * 16];
#pragma unroll
        for (int ai = 0; ai < 2; ++ai)
#pragma unroll
            for (int m = 0; m < 4; ++m) {
                const int row = row0 + ai * 128 + m * 16; const float hs = hsv[ai * 4 + m];
                float v[8];
#pragma unroll
                for (int n = 0; n < 2; ++n)
#pragma unroll
                    for (int j = 0; j < 4; ++j) { const float g = (float)acc[ai][0][m][n][j] * (hs * sg[n * 4 + j]), up = (float)acc[ai][1][m][n][j] * (hs * su[n * 4 + j]); v[n * 4 + j] = siluf_(g) * up; }
                u32x4 w; w.x = cvt_pk_bf16(v[0], v[1]); w.y = cvt_pk_bf16(v[2], v[3]); w.z = cvt_pk_bf16(v[4], v[5]); w.w = cvt_pk_bf16(v[6], v[7]);
                *(u32x4*)(act + (size_t)row * DFF + col0) = w;
            }
    }
};
struct EpiStore {
    static constexpr bool PERM = true, I8 = false; typedef gm::Acc AccT; typedef f32x4 AccT_elem; bf16_t* O; int ldc;
    template <int BJ> __device__ __forceinline__ void post(gm::Acc& acc, const gm::Unit& u, int wr, int wc, int fr, int fq) {
        const int row0 = u.pm * 256 + wr * 64 + fr, col0 = u.pn * 256 + wc * 32 + 8 * fq;
#pragma unroll
        for (int ai = 0; ai < 2; ++ai)
#pragma unroll
            for (int m = 0; m < 4; ++m)
#pragma unroll
                for (int bj = 0; bj < 2; ++bj) {
                    const f32x4 a = acc[ai][bj][m][0], b = acc[ai][bj][m][1];
                    u32x4 w; w.x = cvt_pk_bf16(a[0], a[1]); w.y = cvt_pk_bf16(a[2], a[3]); w.z = cvt_pk_bf16(b[0], b[1]); w.w = cvt_pk_bf16(b[2], b[3]);
                    *(u32x4*)(O + (size_t)(row0 + ai * 128 + m * 16) * ldc + col0 + bj * 128) = w;
                }
    }
};
struct EpiStoreK {
    static constexpr bool PERM = true, I8 = false; typedef gm::Acc AccT; typedef f32x4 AccT_elem; bf16_t* O; float* yp;
    template <int BJ> __device__ __forceinline__ void post(gm::Acc& acc, const gm::Unit& u, int wr, int wc, int fr, int fq) {
        const int row0 = u.pm * 256 + wr * 64 + fr, col0 = u.pn * 256 + wc * 32 + 8 * fq;
        if (u.tag == 0) {
#pragma unroll
            for (int ai = 0; ai < 2; ++ai)
#pragma unroll
                for (int m = 0; m < 4; ++m)
#pragma unroll
                    for (int bj = 0; bj < 2; ++bj) {
                        const f32x4 a = acc[ai][bj][m][0], b = acc[ai][bj][m][1];
                        u32x4 w; w.x = cvt_pk_bf16(a[0], a[1]); w.y = cvt_pk_bf16(a[2], a[3]); w.z = cvt_pk_bf16(b[0], b[1]); w.w = cvt_pk_bf16(b[2], b[3]);
                        *(u32x4*)(O + (size_t)(row0 + ai * 128 + m * 16) * DM + col0 + bj * 128) = w;
                    }
        } else {
            float* base = yp + (size_t)(u.tag - 1) * MCTX * DM;
#pragma unroll
            for (int ai = 0; ai < 2; ++ai)
#pragma unroll
                for (int m = 0; m < 4; ++m)
#pragma unroll
                    for (int bj = 0; bj < 2; ++bj) { float* o = base + (size_t)(row0 - MLAT + ai * 128 + m * 16) * DM + col0 + bj * 128;
                        *(f32x4*)o = acc[ai][bj][m][0]; *(f32x4*)(o + 4) = acc[ai][bj][m][1]; }
        }
    }
};
__device__ __forceinline__ void job_splitk_reduce(const float* yp, bf16_t* y) {
    const int c = obid(), tid = otid(), G = gridDim.x;
    for (int idx = c * 512 + tid; idx < MCTX * 256; idx += G * 512) { const int row = idx >> 8, q = idx & 255; f32x4 a = {0.f, 0.f, 0.f, 0.f}, b = a;
#pragma unroll
        for (int sl = 0; sl < 4; ++sl) { const float* s = yp + ((size_t)sl * MCTX + row) * DM + q * 8; a += *(const f32x4*)s; b += *(const f32x4*)(s + 4); }
        u32x4 o; o.x = cvt_pk_bf16(a[0], a[1]); o.y = cvt_pk_bf16(a[2], a[3]); o.z = cvt_pk_bf16(b[0], b[1]); o.w = cvt_pk_bf16(b[2], b[3]);
        *(u32x4*)(y + (size_t)(MLAT + row) * DM + q * 8) = o; }
}
__device__ __forceinline__ void rope4(f32x4& x0, f32x4& x1, const float* rope, int pos, int fq) {
    const f32x4 t0 = *(const f32x4*)(rope + pos * 32 + 8 * fq), t1 = *(const f32x4*)(rope + pos * 32 + 8 * fq + 4);
    const float c[4] = {t0[0], t0[2], t1[0], t1[2]}, s[4] = {t0[1], t0[3], t1[1], t1[3]};
#pragma unroll
    for (int j = 0; j < 4; ++j) { const float a = x0[j], b = x1[j]; x0[j] = a * c[j] - b * s[j]; x1[j] = a * s[j] + b * c[j]; }
}
__device__ __forceinline__ void rope4v(f32x4& x0, f32x4& x1, const f32x4 t0, const f32x4 t1) {
    const float c[4] = {t0[0], t0[2], t1[0], t1[2]}, s[4] = {t0[1], t0[3], t1[1], t1[3]};
#pragma unroll
    for (int j = 0; j < 4; ++j) { const float a = x0[j], b = x1[j]; x0[j] = a * c[j] - b * s[j]; x1[j] = a * s[j] + b * c[j]; }
}
struct EpiProj {
    static constexpr bool PERM = false, I8 = true; typedef gm::AccI AccT; typedef i32x4 AccT_elem; bf16_t* ubuf; bf16_t* km; const float* rope; const float* hsc; const float* wps;
    template <int BJ> __device__ __forceinline__ void post(gm::AccI& acc, const gm::Unit& u, int wr, int wc, int fr, int fq) {
        const int pn = u.pn; const bool lat = u.pm < 128, ropet = (pn >= 6 && pn <= 9), akr = (pn == 23);
        const int row0 = u.pm * 256 + wr * 64 + fr;
        f32x4 wsv[2][2];
#pragma unroll
        for (int bj = 0; bj < 2; ++bj)
#pragma unroll
            for (int n = 0; n < 2; ++n) wsv[bj][n] = *(const f32x4*)(wps + pn * 256 + bj * 128 + wc * 32 + 16 * n + 4 * fq);
        float hsv[8];
#pragma unroll
        for (int i = 0; i < 8; ++i) hsv[i] = hsc[row0 + (i >> 2) * 128 + (i & 3) * 16];
        const bool dor = lat && (ropet || (akr && wc < 2));
#pragma unroll
        for (int ai = 0; ai < 2; ++ai) {
            f32x4 rt[4][2];
            if (dor) {
#pragma unroll
                for (int m = 0; m < 4; ++m) { const int s = (row0 + ai * 128 + m * 16) & (SEQ - 1), pos = (wc & 1) ? (s & 63) : (s >> 6);
                    rt[m][0] = *(const f32x4*)(rope + pos * 32 + 8 * fq); rt[m][1] = *(const f32x4*)(rope + pos * 32 + 8 * fq + 4); }
            }
#pragma unroll
            for (int m = 0; m < 4; ++m) {
                const int row = row0 + ai * 128 + m * 16; const float hs = hsv[ai * 4 + m] * ((pn == 6 || pn == 7) ? DIFF_QC : 1.0f);
#pragma unroll
                for (int bj = 0; bj < 2; ++bj) {
                    f32x4 x0, x1;
#pragma unroll
                    for (int j = 0; j < 4; ++j) { x0[j] = (float)acc[ai][bj][m][0][j] * (hs * wsv[bj][0][j]); x1[j] = (float)acc[ai][bj][m][1][j] * (hs * wsv[bj][1][j]); }
                    const bool akr_blk = akr && bj == 0 && wc < 2;
                    if (lat && (ropet || akr_blk)) rope4v(x0, x1, rt[m][0], rt[m][1]);
                    u32x2 w0, w1; w0.x = cvt_pk_bf16(x0[0], x0[1]); w0.y = cvt_pk_bf16(x0[2], x0[3]); w1.x = cvt_pk_bf16(x1[0], x1[1]); w1.y = cvt_pk_bf16(x1[2], x1[3]);
                    if (!akr) { bf16_t* o = ubuf + (size_t)row * NU + pn * 256 + bj * 128 + wc * 32 + 4 * fq; *(u32x2*)o = w0; *(u32x2*)(o + 16) = w1; }
                    else if (akr_blk) {
#pragma unroll
                        for (int h = 0; h < 4; ++h) { bf16_t* o = km + (size_t)row * 768 + h * 192 + 128 + wc * 32 + 4 * fq; *(u32x2*)o = w0; *(u32x2*)(o + 16) = w1; }
                    }
                }
            }
        }
    }
};
struct EpiQup {
    static constexpr bool PERM = false, I8 = false; typedef gm::Acc AccT; typedef f32x4 AccT_elem; bf16_t* qm; const float* rsq; const float* rope;
    template <int BJ> __device__ __forceinline__ void post(gm::Acc& acc, const gm::Unit& u, int wr, int wc, int fr, int fq) {
        const bool lat = u.pm < 128; const int row0 = u.pm * 256 + wr * 64 + fr;
        float rsv[8];
#pragma unroll
        for (int i = 0; i < 8; ++i) rsv[i] = rsq[row0 + (i >> 2) * 128 + (i & 3) * 16];
#pragma unroll
        for (int ai = 0; ai < 2; ++ai)
#pragma unroll
            for (int m = 0; m < 4; ++m) {
                const int row = row0 + ai * 128 + m * 16, s = row & (SEQ - 1); const float rs = rsv[ai * 4 + m] * MLA_QC;
#pragma unroll
                for (int bj = 0; bj < 2; ++bj) {
                    const int b32 = 8 * u.pn + 4 * bj + wc, m6 = b32 % 6;
                    f32x4 x0 = acc[ai][bj][m][0] * rs, x1 = acc[ai][bj][m][1] * rs;
                    if (lat && m6 >= 4) rope4(x0, x1, rope, (m6 == 5) ? (s & 63) : (s >> 6), fq);
                    u32x2 w0, w1; w0.x = cvt_pk_bf16(x0[0], x0[1]); w0.y = cvt_pk_bf16(x0[2], x0[3]); w1.x = cvt_pk_bf16(x1[0], x1[1]); w1.y = cvt_pk_bf16(x1[2], x1[3]);
                    bf16_t* o = qm + (size_t)row * 768 + b32 * 32 + 4 * fq; *(u32x2*)o = w0; *(u32x2*)(o + 16) = w1;
                }
            }
    }
};
struct EpiKVup {
    static constexpr bool PERM = true, I8 = false; typedef gm::Acc AccT; typedef f32x4 AccT_elem; bf16_t* km; bf16_t* vm; const float* rsk;
    template <int BJ> __device__ __forceinline__ void post(gm::Acc& acc, const gm::Unit& u, int wr, int wc, int fr, int fq) {
        const int row0 = u.pm * 256 + wr * 64 + fr, h = u.pn, c0 = wc * 32 + 8 * fq;
        float rsv[8];
#pragma unroll
        for (int i = 0; i < 8; ++i) rsv[i] = rsk[row0 + (i >> 2) * 128 + (i & 3) * 16];
#pragma unroll
        for (int ai = 0; ai < 2; ++ai)
#pragma unroll
            for (int m = 0; m < 4; ++m) {
                const int row = row0 + ai * 128 + m * 16; const float rs = rsv[ai * 4 + m];
#pragma unroll
                for (int bj = 0; bj < 2; ++bj) {
                    const f32x4 a = acc[ai][bj][m][0] * rs, b = acc[ai][bj][m][1] * rs;
                    u32x4 w; w.x = cvt_pk_bf16(a[0], a[1]); w.y = cvt_pk_bf16(a[2], a[3]); w.z = cvt_pk_bf16(b[0], b[1]); w.w = cvt_pk_bf16(b[2], b[3]);
                    if (bj == 0) *(u32x4*)(km + (size_t)row * 768 + h * 192 + c0) = w; else *(u32x4*)(vm + (size_t)row * 512 + h * 128 + c0) = w;
                }
            }
    }
};
struct EpiRG {
    static constexpr bool PERM = true, I8 = false; typedef gm::Acc AccT; typedef f32x4 AccT_elem; const bf16_t* xcv; bf16_t* la; bf16_t* bb; const float* b_r; const float* b_i; const float* sp;
    template <int BJ> __device__ __forceinline__ void post(gm::Acc& acc, const gm::Unit& u, int wr, int wc, int fr, int fq) {
        const int d = u.pn >> 2, w0 = (u.pn & 3) * 128 + wc * 32 + 8 * fq, row0 = u.pm * 256 + wr * 64 + fr;
        float br[8], bi[8], sv[8];
#pragma unroll
        for (int j = 0; j < 8; ++j) { br[j] = b_r[d * 512 + w0 + j]; bi[j] = b_i[d * 512 + w0 + j]; sv[j] = sp[d * 512 + w0 + j]; }
        u32x4 xwv[8];
#pragma unroll
        for (int i = 0; i < 8; ++i) xwv[i] = *(const u32x4*)(xcv + (size_t)(row0 + (i >> 2) * 128 + (i & 3) * 16) * 512 + w0);
#pragma unroll
        for (int ai = 0; ai < 2; ++ai)
#pragma unroll
            for (int m = 0; m < 4; ++m) {
                const int row = row0 + ai * 128 + m * 16;
                const u32x4 xw = xwv[ai * 4 + m];
                const float xv[8] = {bflo(xw.x), bfhi(xw.x), bflo(xw.y), bfhi(xw.y), bflo(xw.z), bfhi(xw.z), bflo(xw.w), bfhi(xw.w)};
                float lo[8], bo[8];
#pragma unroll
                for (int n = 0; n < 2; ++n)
#pragma unroll
                    for (int j = 0; j < 4; ++j) {
                        const int k = n * 4 + j;
                        const float r = sigmoidf_(acc[ai][0][m][n][j] + br[k]), ig = sigmoidf_(acc[ai][1][m][n][j] + bi[k]);
                        const float l_a = -8.0f * r * sv[k], x2 = 2.0f * l_a;
                        const float om = (x2 > -0.3f) ? (-x2 * (1.0f + x2 * (0.5f + x2 * (0.16666667f + x2 * (0.041666668f + x2 * 0.0083333338f))))) : (1.0f - __expf(x2));
                        lo[k] = l_a; bo[k] = __builtin_amdgcn_sqrtf(om) * ig * xv[k];
                    }
                u32x4 wl, wb;
                wl.x = cvt_pk_bf16(lo[0], lo[1]); wl.y = cvt_pk_bf16(lo[2], lo[3]); wl.z = cvt_pk_bf16(lo[4], lo[5]); wl.w = cvt_pk_bf16(lo[6], lo[7]);
                wb.x = cvt_pk_bf16(bo[0], bo[1]); wb.y = cvt_pk_bf16(bo[2], bo[3]); wb.z = cvt_pk_bf16(bo[4], bo[5]); wb.w = cvt_pk_bf16(bo[6], bo[7]);
                *(u32x4*)(la + (size_t)row * 1024 + d * 512 + w0) = wl; *(u32x4*)(bb + (size_t)row * 1024 + d * 512 + w0) = wb;
            }
    }
};
struct EpiMergeG {
    static constexpr bool PERM = true, I8 = true; typedef gm::AccI AccT; typedef i32x4 AccT_elem; bf16_t* gtmp; const float* mb; const float* hsc; const float* wgs; bool bal; bf16_t* gx;
    template <int BJ> __device__ __forceinline__ void post(gm::AccI& acc, const gm::Unit& u, int wr, int wc, int fr, int fq) {
        const int col0 = u.pn * 256 + wc * 32 + 8 * fq, row0 = u.pm * 256 + wr * 64 + fr, nbr = u.tag;
        const bool ex = bal && u.pm >= 128; bf16_t* go = ex ? gx : gtmp; const int orow0 = ex ? nbr * 512 + row0 - MLAT : row0;
        f32x4 bv[2][2], sv[2][2];
#pragma unroll
        for (int bj = 0; bj < 2; ++bj)
#pragma unroll
            for (int n = 0; n < 2; ++n) { bv[bj][n] = *(const f32x4*)(mb + nbr * DM + col0 + bj * 128 + 4 * n); sv[bj][n] = *(const f32x4*)(wgs + nbr * DM + col0 + bj * 128 + 4 * n); }
        float hsv[8];
#pragma unroll
        for (int i = 0; i < 8; ++i) hsv[i] = hsc[row0 + (i >> 2) * 128 + (i & 3) * 16];
#pragma unroll
        for (int ai = 0; ai < 2; ++ai)
#pragma unroll
            for (int m = 0; m < 4; ++m) { const float hs = hsv[ai * 4 + m];
#pragma unroll
                for (int bj = 0; bj < 2; ++bj) { float g[8];
#pragma unroll
                    for (int n = 0; n < 2; ++n)
#pragma unroll
                        for (int j = 0; j < 4; ++j) g[n * 4 + j] = sigmoidf_((float)acc[ai][bj][m][n][j] * (hs * sv[bj][n][j]) + bv[bj][n][j]);
                    u32x4 w; w.x = cvt_pk_bf16(g[0], g[1]); w.y = cvt_pk_bf16(g[2], g[3]); w.z = cvt_pk_bf16(g[4], g[5]); w.w = cvt_pk_bf16(g[6], g[7]);
                    *(u32x4*)(go + (size_t)(orow0 + ai * 128 + m * 16) * DM + col0 + bj * 128) = w; } }
    }
};
struct EpiMergeY {
    static constexpr bool PERM = true, I8 = false; typedef gm::Acc AccT; typedef f32x4 AccT_elem; bf16_t* mrg; const bf16_t* gtmp; bool bal; const bf16_t* gx; bf16_t* part;
    template <int BJ> __device__ __forceinline__ void post(gm::Acc& acc, const gm::Unit& u, int wr, int wc, int fr, int fq) {
        const int col0 = u.pn * 256 + wc * 32 + 8 * fq, row0 = u.pm * 256 + wr * 64 + fr, nbr = u.tag;
        const bool ex = bal && u.pm >= 128; const bf16_t* gi = ex ? gx : gtmp; bf16_t* mo = ex ? part : mrg; const int orow0 = ex ? nbr * 512 + row0 - MLAT : row0;
        const bool rd = nbr > 0 && !ex;
#pragma unroll
        for (int ai = 0; ai < 2; ++ai) {
            u32x4 gwv[4][2], mwv[4][2];
#pragma unroll
            for (int m = 0; m < 4; ++m)
#pragma unroll
                for (int bj = 0; bj < 2; ++bj) { const size_t off = (size_t)(orow0 + ai * 128 + m * 16) * DM + col0 + bj * 128;
                    gwv[m][bj] = *(const u32x4*)(gi + off); mwv[m][bj] = (u32x4){0u, 0u, 0u, 0u}; if (rd) mwv[m][bj] = *(const u32x4*)(mo + off); }
#pragma unroll
            for (int m = 0; m < 4; ++m)
#pragma unroll
                for (int bj = 0; bj < 2; ++bj) {
                    const size_t off = (size_t)(orow0 + ai * 128 + m * 16) * DM + col0 + bj * 128;
                    const u32x4 gw = gwv[m][bj], mw = mwv[m][bj];
                    const float g[8] = {bflo(gw.x), bfhi(gw.x), bflo(gw.y), bfhi(gw.y), bflo(gw.z), bfhi(gw.z), bflo(gw.w), bfhi(gw.w)};
                    float mm[8] = {bflo(mw.x), bfhi(mw.x), bflo(mw.y), bfhi(mw.y), bflo(mw.z), bfhi(mw.z), bflo(mw.w), bfhi(mw.w)};
#pragma unroll
                    for (int n = 0; n < 2; ++n)
#pragma unroll
                        for (int j = 0; j < 4; ++j) mm[n * 4 + j] += g[n * 4 + j] * acc[ai][bj][m][n][j];
                    u32x4 w; w.x = cvt_pk_bf16(mm[0], mm[1]); w.y = cvt_pk_bf16(mm[2], mm[3]); w.z = cvt_pk_bf16(mm[4], mm[5]); w.w = cvt_pk_bf16(mm[6], mm[7]);
                    *(u32x4*)(mo + off) = w;
                }
        }
    }
};


struct KP { const float* in[30]; float* out; unsigned char* ws; int ph_lo, ph_hi; };
typedef const __attribute__((address_space(4))) KP CKP;
__device__ __forceinline__ LAS unsigned char* lds_here(unsigned char* raw) { unsigned a = (unsigned)(uintptr_t)(LAS unsigned char*)raw; asm volatile("" : "+s"(a)); return (LAS unsigned char*)(uintptr_t)a; }
__device__ __forceinline__ CKP& kp_here() { CKP* q = (CKP*)__builtin_amdgcn_kernarg_segment_ptr(); asm volatile("" : "+s"(q)); return *q; }
enum { I_X = 0, I_C, I_CTX, I_CCTX, I_ADAW, I_ADAB, I_PRE, I_POST, I_WG, I_WU, I_WDN, I_WIN, I_QNORM, I_WUQ, I_KVNORM, I_WUKV, I_CONVW, I_CONVB, I_RGWR, I_RGBR, I_RGWI, I_RGBI, I_RGLAM,
       I_DLAM, I_SUBLN, I_HLB, I_HNORM, I_MB, I_WBR, I_WOUT };

__device__ __forceinline__ void job_mod(CKP& p, LAS unsigned char* lds) {
    LAS float* sl = (LAS float*)lds;
    LAS float* red = (LAS float*)(lds + 24576);
    const int tid = otid(), lane = tid & 63, wave = tid >> 6;
    for (int i = tid; i < 3 * DM; i += NTHR) { const int g = i / DM, k = i % DM; const float c = g < 2 ? p.in[I_C][g * DM + k] : p.in[I_CCTX][k]; sl[i] = siluf_(c); }
    __syncthreads();
    float* mod = (float*)(p.ws + WS_MOD);
    for (int u = obid(); u < NL * 288; u += gridDim.x) {
        const int l = u / 288, col = (u % 288) * 64 + lane;
        const float* w = p.in[I_ADAW] + (size_t)l * DM * (NMOD * DM) + col;
        float a0 = 0.f, a1 = 0.f, a2 = 0.f;
        const int k0 = wave * 256;
#pragma unroll 8
        for (int k = k0; k < k0 + 256; ++k) { const float wv = w[(size_t)k * (NMOD * DM)]; a0 += sl[k] * wv; a1 += sl[DM + k] * wv; a2 += sl[2 * DM + k] * wv; }
        red[(wave * 3 + 0) * 64 + lane] = a0; red[(wave * 3 + 1) * 64 + lane] = a1; red[(wave * 3 + 2) * 64 + lane] = a2;
        __syncthreads();
        if (tid < 192) { const int g = tid >> 6; float s = 0.f;
#pragma unroll
            for (int w8 = 0; w8 < 8; ++w8) s += red[(w8 * 3 + g) * 64 + lane];
            mod[(size_t)(l * 3 + g) * (NMOD * DM) + col] = s + p.in[I_ADAB][l * (NMOD * DM) + col]; }
        __syncthreads();
    }
}
__device__ __forceinline__ void job_tables(CKP& p) {
    const int tid = otid();
    if (obid() == 0) {
        float* rope = (float*)(p.ws + WS_ROPE);
        for (int i = tid; i < 4096; i += NTHR) { const int pos = i >> 4, f = i & 15; const float inv = powf(10000.0f, -(float)f / 16.0f); const float ang = (float)pos * inv; float s, c; sincosf(ang, &s, &c); rope[2 * i] = c; rope[2 * i + 1] = s; }
    }
    if (obid() == 1 % gridDim.x) {
        float* sc = (float*)(p.ws + WS_SCAL);
        if (tid < NL) { const float* lv = p.in[I_DLAM] + tid * 256; float s01 = 0.f, s23 = 0.f; for (int i = 0; i < 64; ++i) { s01 += lv[i] * lv[64 + i]; s23 += lv[128 + i] * lv[192 + i]; }
            sc[tid] = expf(s01) - expf(s23) + (0.8f - 0.6f * expf(-0.3f * (float)tid)); }
        for (int k = tid; k < 512; k += NTHR) {
            float mx = -1e30f; for (int l = 0; l < NL; ++l) mx = fmaxf(mx, p.in[I_HLB][l * 512 + k]);
            float den = 0.f; for (int l = 0; l < NL; ++l) den += expf(p.in[I_HLB][l * 512 + k] - mx);
            float cum = 0.f; for (int l = 0; l < NL; ++l) { if (l > 0) cum += expf(p.in[I_HLB][l * 512 + k] - mx) / den; sc[256 + l * 512 + k] = cum; }
        }
        for (int i = tid; i < NL * 1024; i += NTHR) { const float x = -p.in[I_RGLAM][i]; sc[2048 + i] = fmaxf(x, 0.f) + log1pf(expf(-fabsf(x))); }
    }
}

__device__ __forceinline__ void job_colmax(CKP& p) {
    unsigned* cmax = (unsigned*)(p.ws + WS_CMAX);
    const int tid = otid(), c4 = (tid & 63) * 4, wv = tid >> 6;
    for (int u = obid(); u < NL * 2 * 2 * 22 * 4; u += gridDim.x) {
        const int kc = u & 3, cb = (u >> 2) % 22, mat = u / (4 * 22), which = mat & 1, lf = mat >> 1;
        const float* w = (which ? p.in[I_WU] : p.in[I_WG]) + (size_t)lf * DM * DFF + (size_t)(kc * 512 + wv * 64) * DFF + cb * 256 + c4;
        u32x4 mx = {0u, 0u, 0u, 0u};
#pragma unroll 1
        for (int k0 = 0; k0 < 64; k0 += 16) { u32x4 v[16];
#pragma unroll
            for (int k = 0; k < 16; ++k) v[k] = *(const u32x4*)(w + (size_t)(k0 + k) * DFF);
            asm volatile("" ::: "memory");
#pragma unroll
            for (int k = 0; k < 16; ++k) { mx.x = max(mx.x, v[k].x & 0x7fffffffu); mx.y = max(mx.y, v[k].y & 0x7fffffffu); mx.z = max(mx.z, v[k].z & 0x7fffffffu); mx.w = max(mx.w, v[k].w & 0x7fffffffu); } }
        unsigned* dst = cmax + (size_t)(lf * 2 + which) * DFF + cb * 256 + c4;
        atomicMax(dst, mx.x); atomicMax(dst + 1, mx.y); atomicMax(dst + 2, mx.z); atomicMax(dst + 3, mx.w);
    }
    unsigned* cmax2 = (unsigned*)(p.ws + WS_CMAX2);
    for (int u = obid(); u < NL * 56 * 4; u += gridDim.x) {
        const int kc = u & 3, cb = (u >> 2) % 56, l = u / (4 * 56), cc = cb * 256 + c4;
        if (cc < DIN) {
            const float* w = p.in[I_WIN] + (size_t)l * DM * DIN + (size_t)(kc * 512 + wv * 64) * DIN + cc;
            u32x4 mx = {0u, 0u, 0u, 0u};
#pragma unroll 1
            for (int k0 = 0; k0 < 64; k0 += 16) { u32x4 v[16];
#pragma unroll
                for (int k = 0; k < 16; ++k) v[k] = *(const u32x4*)(w + (size_t)(k0 + k) * DIN);
                asm volatile("" ::: "memory");
#pragma unroll
                for (int k = 0; k < 16; ++k) { mx.x = max(mx.x, v[k].x & 0x7fffffffu); mx.y = max(mx.y, v[k].y & 0x7fffffffu); mx.z = max(mx.z, v[k].z & 0x7fffffffu); mx.w = max(mx.w, v[k].w & 0x7fffffffu); } }
            unsigned* dst = cmax2 + (size_t)l * 14336 + cc;
            atomicMax(dst, mx.x); atomicMax(dst + 1, mx.y); atomicMax(dst + 2, mx.z); atomicMax(dst + 3, mx.w);
        }
    }
}
struct CvtDesc { const float* src; const float* ks; bf16_t* dst; int ldsrc, c0, k0, lddst, n0; const unsigned* q8max; float* q8scale; };
__device__ __forceinline__ void cvt_load(const CvtDesc& d, int tid, f32x4 (&v)[2]) {
    const int r = tid >> 4, c4 = (tid & 15) * 4;
#pragma unroll
    for (int ps = 0; ps < 2; ++ps) { const int k = r + 32 * ps; v[ps] = (f32x4){0.f, 0.f, 0.f, 0.f};
        if (d.src) { v[ps] = *(const f32x4*)(d.src + (size_t)(d.k0 + k) * d.ldsrc + d.c0 + c4); if (d.ks) v[ps] = v[ps] * d.ks[d.k0 + k]; } }
}
__device__ __forceinline__ void cvt_store(LAS float* tile, const CvtDesc& d, int tid, const f32x4 (&v)[2]) {
    { const int r = tid >> 4, c4 = (tid & 15) * 4;
#pragma unroll
      for (int ps = 0; ps < 2; ++ps) { const int k = r + 32 * ps; tile[k * 65 + c4 + 0] = v[ps][0]; tile[k * 65 + c4 + 1] = v[ps][1]; tile[k * 65 + c4 + 2] = v[ps][2]; tile[k * 65 + c4 + 3] = v[ps][3]; } }
    __syncthreads();
    { const int n = tid >> 3, k8 = (tid & 7) * 8; float x[8];
#pragma unroll
      for (int i = 0; i < 8; ++i) x[i] = tile[(k8 + i) * 65 + n];
      if (d.q8max) {
          const float mx = fmaxf(__uint_as_float(d.q8max[n]), 1e-30f), inv = 127.0f / mx;
          int q[8];
#pragma unroll
          for (int i = 0; i < 8; ++i) q[i] = (int)rintf(x[i] * inv) & 0xff;
          u32x2 w; w.x = (unsigned)q[0] | ((unsigned)q[1] << 8) | ((unsigned)q[2] << 16) | ((unsigned)q[3] << 24); w.y = (unsigned)q[4] | ((unsigned)q[5] << 8) | ((unsigned)q[6] << 16) | ((unsigned)q[7] << 24);
          *(u32x2*)((signed char*)d.dst + (size_t)(d.n0 + n) * d.lddst + d.k0 + k8) = w;
          if (d.k0 == 0 && k8 == 0) d.q8scale[n] = mx * (1.0f / 127.0f);
      } else {
          u32x4 w; w.x = cvt_pk_bf16(x[0], x[1]); w.y = cvt_pk_bf16(x[2], x[3]); w.z = cvt_pk_bf16(x[4], x[5]); w.w = cvt_pk_bf16(x[6], x[7]);
          *(u32x4*)(d.dst + (size_t)(d.n0 + n) * d.lddst + d.k0 + k8) = w; } }
    __syncthreads();
}
constexpr int CV_N0 = 2 * 176 * 32, CV_N1 = 2 * 32 * 88, CV_N2 = 224 * 32, CV_N3 = 12 * 8, CV_N4 = 16 * 4, CV_N5 = 4 * 32 * 8, CV_N6 = 32 * 32, CV_N7 = 1024;
constexpr int CV_BLOCKS = CV_N0 + CV_N1 + CV_N2 + CV_N3 + CV_N4 + CV_N5 + CV_N6;
__device__ __forceinline__ CvtDesc cvt_desc(CKP& p, int l, int b) {
    unsigned char* ws = p.ws; CvtDesc d; d.ks = nullptr; d.q8max = nullptr; d.q8scale = nullptr;
    if (b < CV_N0) { const int f = b / (176 * 32), rem = b % (176 * 32), nb = rem / 32, kb = rem % 32, t = nb >> 2, q = nb & 3;
        d.src = (q < 2 ? p.in[I_WG] : p.in[I_WU]) + (size_t)(l * 2 + f) * DM * DFF; d.ldsrc = DFF; d.c0 = 128 * t + (q & 1) * 64; d.k0 = kb * 64; d.dst = (bf16_t*)(ws + WS_WGU + (size_t)f * 11264 * 2048); d.lddst = 2048; d.n0 = nb * 64;
        d.q8max = (const unsigned*)(ws + WS_CMAX) + (size_t)((l * 2 + f) * 2 + (q < 2 ? 0 : 1)) * DFF + d.c0; d.q8scale = (float*)(ws + WS_WSC) + (size_t)f * 11264 + d.n0; return d; }
    b -= CV_N0;
    if (b < CV_N1) { const int f = b / (32 * 88), rem = b % (32 * 88), nb = rem / 88, kb = rem % 88;
        d.src = p.in[I_WDN] + (size_t)(l * 2 + f) * DFF * DM; d.ldsrc = DM; d.c0 = nb * 64; d.k0 = kb * 64; d.dst = (bf16_t*)(ws + WS_WD) + (size_t)f * 2048 * 5632; d.lddst = 5632; d.n0 = nb * 64; return d; }
    b -= CV_N1;
    if (b < CV_N2) { const int nb = b / 32, kb = b % 32, j0 = nb * 64; int sc;
        if (j0 < 512) sc = j0; else if (j0 < 5632) sc = 832 + (j0 - 512); else if (j0 < 5888) sc = 512 + (j0 - 5632); else if (j0 < 5952) sc = 768 + (j0 - 5888); else if (j0 < 6144) sc = -1; else sc = 5952 + (j0 - 6144);
        d.src = sc < 0 ? nullptr : p.in[I_WIN] + (size_t)l * DM * DIN; d.ldsrc = DIN; d.c0 = sc < 0 ? 0 : sc; d.k0 = kb * 64; d.dst = (bf16_t*)(ws + WS_WIN); d.lddst = 2048; d.n0 = j0;
        d.q8max = (const unsigned*)(ws + WS_CMAX2) + (size_t)l * 14336 + (sc < 0 ? DIN : sc);
        d.q8scale = j0 < 6144 ? (float*)(ws + WS_WPS) + j0 : (float*)(ws + WS_WGS) + (j0 - 6144);
        return d; }
    b -= CV_N2;
    if (b < CV_N3) { const int nb = b / 8, kb = b % 8;
        d.src = p.in[I_WUQ] + (size_t)l * 512 * 768; d.ldsrc = 768; d.c0 = nb * 64; d.k0 = kb * 64; d.ks = p.in[I_QNORM] + l * 512; d.dst = (bf16_t*)(ws + WS_WUQ); d.lddst = 512; d.n0 = nb * 64; return d; }
    b -= CV_N3;
    if (b < CV_N4) { const int nb = b / 4, kb = b % 4;
        d.src = p.in[I_WUKV] + (size_t)l * 256 * 1024; d.ldsrc = 1024; d.c0 = nb * 64; d.k0 = kb * 64; d.ks = p.in[I_KVNORM] + l * 256; d.dst = (bf16_t*)(ws + WS_WUKV); d.lddst = 256; d.n0 = nb * 64; return d; }
    b -= CV_N4;
    if (b < CV_N5) { const int n = b / 256, rem = b % 256, nb = rem / 8, kb = rem % 8;
        d.src = p.in[I_WBR] + (size_t)(l * 4 + n) * 512 * DM; d.ldsrc = DM; d.c0 = nb * 64; d.k0 = kb * 64; d.dst = (bf16_t*)(ws + WS_WBR) + (size_t)n * 2048 * 512; d.lddst = 512; d.n0 = nb * 64; return d; }
    b -= CV_N5;
    { const int nb = b / 32, kb = b % 32;
        d.src = p.in[I_WOUT] + (size_t)l * DM * DM; d.ldsrc = DM; d.c0 = nb * 64; d.k0 = kb * 64; d.dst = (bf16_t*)(ws + WS_WOUT); d.lddst = 2048; d.n0 = nb * 64; return d; }
}
__device__ __forceinline__ void job_convert(CKP& p, LAS unsigned char* lds, int l) {
    LAS float* tile = (LAS float*)lds;
    const int tid = otid();
    {
        int u = obid();
        if (u < CV_BLOCKS) {
            f32x4 vc[2]; { const CvtDesc d0 = cvt_desc(p, l, u); cvt_load(d0, tid, vc); }
            for (;;) {
                const int un = u + gridDim.x; const bool more = un < CV_BLOCKS;
                f32x4 vn[2] = {vc[0], vc[1]};
                if (more) { const CvtDesc dn = cvt_desc(p, l, un); cvt_load(dn, tid, vn); }
                { const CvtDesc dc = cvt_desc(p, l, u); cvt_store(tile, dc, tid, vc); }
                if (!more) break;
                vc[0] = vn[0]; vc[1] = vn[1]; u = un;
            }
        }
    }
    for (int b = obid(); b < CV_N7; b += gridDim.x) {
        bf16_t* dst = (bf16_t*)(p.ws + WS_WRG);
#pragma unroll
        for (int e = 0; e < 2; ++e) { const int idx = b * 1024 + e * 512 + tid, o = idx >> 9, k = idx & 511;
            const int t8 = o >> 8, d = t8 >> 2, blk = t8 & 3, g = (o >> 7) & 1, i = o & 127, kin = k - blk * 128;
            float v = 0.f; if (kin >= 0 && kin < 128) v = (g ? p.in[I_RGWI] : p.in[I_RGWR])[((size_t)((l * 2 + d) * 4 + blk) * 128 + kin) * 128 + i];
            dst[idx] = f2bf(v); }
    }
}

struct RNArgs {
    const float* xs_lat; const float* xs_ctx; float* xd_lat; float* xd_ctx;
    const bf16_t* y; float wres;
    const float* modl_res; int jres; const float* postg;
    bool do_norm; const float* modl_norm; int jn; const float* preg; bf16_t* h; int nrows; signed char* h8; float* hsc;
};
__device__ __forceinline__ void job_resnorm(const RNArgs& a, LAS unsigned char* lds) {
    const int tid_ = otid(); const int lane = tid_ & 63, gw = obid() * 8 + (tid_ >> 6), nw = gridDim.x * 8;
    LAS float* PA = (LAS float*)lds; LAS float* PB = PA + 3 * DM; LAS float* PC = PB + 3 * DM;
    for (int i = tid_; i < 3 * DM; i += NTHR) { const int g = i / DM, c = i % DM;
        if (a.y) PA[i] = a.modl_res[(size_t)g * (NMOD * DM) + (3 * a.jres + 2) * DM + c] * a.postg[c];
        if (a.do_norm) { const float* sh = a.modl_norm + (size_t)g * (NMOD * DM) + (3 * a.jn) * DM; PB[i] = a.preg[c] * (sh[DM + c] + 1.0f); PC[i] = sh[c]; } }
    __syncthreads();
    f32x4 xq[8]; u32x2 yq[8];
#define RN_LOAD(R, X, Y) do { const int r_ = (R); const float* xs_ = r_ < MLAT ? a.xs_lat + (size_t)r_ * DM : a.xs_ctx + (size_t)(r_ - MLAT) * DM; \
        _Pragma("unroll") for (int i = 0; i < 8; ++i) X[i] = *(const f32x4*)(xs_ + i * 256 + lane * 4); \
        if (a.y) { _Pragma("unroll") for (int i = 0; i < 8; ++i) Y[i] = *(const u32x2*)(a.y + (size_t)r_ * DM + i * 256 + lane * 4); } } while (0)
    if (gw < a.nrows) RN_LOAD(gw, xq, yq);
    for (int r = gw; r < a.nrows; r += nw) {
        const int g = r < SEQ ? 0 : (r < MLAT ? 1 : 2); const bool lat = r < MLAT;
        f32x4 x[8]; u32x2 yr[8];
#pragma unroll
        for (int i = 0; i < 8; ++i) { x[i] = xq[i]; yr[i] = yq[i]; }
        RN_LOAD(r + nw < a.nrows ? r + nw : r, xq, yq);
        if (a.y) {
            f32x4 yv[8]; float ss = 0.f;
#pragma unroll
            for (int i = 0; i < 8; ++i) { const u32x2 w = yr[i]; yv[i] = (f32x4){bflo(w.x), bfhi(w.x), bflo(w.y), bfhi(w.y)}; ss += yv[i][0] * yv[i][0] + yv[i][1] * yv[i][1] + yv[i][2] * yv[i][2] + yv[i][3] * yv[i][3]; }
            ss = wave_sum(ss, lane);
            const float rr = a.wres * rsqrtf(ss * (1.0f / DM) + EPS);
            float* xd = lat ? a.xd_lat + (size_t)r * DM : a.xd_ctx + (size_t)(r - MLAT) * DM;
#pragma unroll
            for (int i = 0; i < 8; ++i) { const int c = i * 256 + lane * 4; const f32x4 gp = *(const LAS f32x4*)(PA + g * DM + c);
                x[i] = x[i] + gp * (yv[i] * rr); *(f32x4*)(xd + c) = x[i]; }
        }
        if (a.do_norm) {
            float ss = 0.f;
#pragma unroll
            for (int i = 0; i < 8; ++i) ss += x[i][0] * x[i][0] + x[i][1] * x[i][1] + x[i][2] * x[i][2] + x[i][3] * x[i][3];
            ss = wave_sum(ss, lane);
            const float rr = rsqrtf(ss * (1.0f / DM) + EPS);
            float mx = 0.f;
#pragma unroll
            for (int i = 0; i < 8; ++i) { const int c = i * 256 + lane * 4; const f32x4 ps = *(const LAS f32x4*)(PB + g * DM + c), hv = *(const LAS f32x4*)(PC + g * DM + c);
                x[i] = (x[i] * rr) * ps + hv; mx = fmaxf(mx, fmaxf(fmaxf(fabsf(x[i][0]), fabsf(x[i][1])), fmaxf(fabsf(x[i][2]), fabsf(x[i][3]))));
                if (a.h) { u32x2 w; w.x = cvt_pk_bf16(x[i][0], x[i][1]); w.y = cvt_pk_bf16(x[i][2], x[i][3]); *(u32x2*)(a.h + (size_t)r * DM + c) = w; } }
            if (a.h8) {
#pragma unroll
                for (int o = 32; o >= 1; o >>= 1) mx = fmaxf(mx, shx(mx, o, lane));
                mx = fmaxf(mx, 1e-30f); const float inv = 127.0f / mx;
                if (lane == 0) a.hsc[r] = mx * (1.0f / 127.0f);
#pragma unroll
                for (int i = 0; i < 8; ++i) { const unsigned q0 = (unsigned)((int)rintf(x[i][0] * inv) & 0xff), q1 = (unsigned)((int)rintf(x[i][1] * inv) & 0xff), q2 = (unsigned)((int)rintf(x[i][2] * inv) & 0xff), q3 = (unsigned)((int)rintf(x[i][3] * inv) & 0xff);
                    *(unsigned*)(a.h8 + (size_t)r * DM + i * 256 + lane * 4) = q0 | (q1 << 8) | (q2 << 16) | (q3 << 24); }
            }
        }
    }
    __syncthreads();
#undef RN_LOAD
}

__device__ __forceinline__ void job_stats_conv(CKP& p, int l) {
    const bf16_t* ubuf = (const bf16_t*)(p.ws + WS_R1); float* rsq = (float*)(p.ws + WS_RSQ); float* rsk = rsq + MALL; bf16_t* xcv = (bf16_t*)(p.ws + WS_XCV);
    const int tid_ = otid(); const int lane = tid_ & 63, gw = obid() * 8 + (tid_ >> 6), nw = gridDim.x * 8;
    float cw[4][8], cb[8];
#pragma unroll
    for (int j = 0; j < 4; ++j)
#pragma unroll
        for (int i = 0; i < 8; ++i) cw[j][i] = p.in[I_CONVW][(l * 4 + j) * 512 + lane * 8 + i];
#pragma unroll
    for (int i = 0; i < 8; ++i) cb[i] = p.in[I_CONVB][l * 512 + lane * 8 + i];
    for (int r = gw; r < MALL; r += nw) {
        const bf16_t* ur = ubuf + (size_t)r * NU;
        {
            const u32x4 w = *(const u32x4*)(ur + U_AQ + lane * 8); float ss = 0.f;
            { const float v[8] = {bflo(w.x), bfhi(w.x), bflo(w.y), bfhi(w.y), bflo(w.z), bfhi(w.z), bflo(w.w), bfhi(w.w)};
#pragma unroll
              for (int i = 0; i < 8; ++i) ss += v[i] * v[i]; }
            ss = wave_sum(ss, lane);
            float s2 = 0.f;
            if (lane < 32) { const u32x4 w2 = *(const u32x4*)(ur + U_AKV + lane * 8); const float v[8] = {bflo(w2.x), bfhi(w2.x), bflo(w2.y), bfhi(w2.y), bflo(w2.z), bfhi(w2.z), bflo(w2.w), bfhi(w2.w)};
#pragma unroll
              for (int i = 0; i < 8; ++i) s2 += v[i] * v[i]; }
            s2 = wave_sum(s2, lane);
            if (lane == 0) { rsq[r] = rsqrtf(ss * (1.0f / 512.0f) + EPS); rsk[r] = rsqrtf(s2 * (1.0f / 256.0f) + EPS); }
        }
        {
            const bool lat = r < MLAT; const int s = lat ? (r & (SEQ - 1)) : ((r - MLAT) & (CTXL - 1)), len = lat ? SEQ : CTXL;
            float acc[8];
#pragma unroll
            for (int i = 0; i < 8; ++i) acc[i] = cb[i];
#pragma unroll
            for (int j = 0; j < 4; ++j) { const int sj = s + j - 2;
                if (sj >= 0 && sj < len) { const u32x4 w = *(const u32x4*)(ur + (ptrdiff_t)(j - 2) * NU + U_BX + lane * 8);
                    const float v[8] = {bflo(w.x), bfhi(w.x), bflo(w.y), bfhi(w.y), bflo(w.z), bfhi(w.z), bflo(w.w), bfhi(w.w)};
#pragma unroll
                    for (int i = 0; i < 8; ++i) acc[i] += cw[j][i] * v[i]; } }
            u32x4 o; o.x = cvt_pk_bf16(acc[0], acc[1]); o.y = cvt_pk_bf16(acc[2], acc[3]); o.z = cvt_pk_bf16(acc[4], acc[5]); o.w = cvt_pk_bf16(acc[6], acc[7]);
            *(u32x4*)(xcv + (size_t)r * 512 + lane * 8) = o;
        }
    }
}

__device__ __forceinline__ void job_rg_scan1(CKP& p) {
    const bf16_t* la = (const bf16_t*)(p.ws + WS_LA); const bf16_t* bb = (const bf16_t*)(p.ws + WS_BB); f32x2* rgs = (f32x2*)(p.ws + WS_RGS);
    const int w = otid();
    for (int u = obid(); u < NRT * 2; u += gridDim.x) {
        const int pm = u >> 1, d = u & 1;
        const bf16_t* lp = la + (size_t)pm * 256 * 1024 + d * 512 + w; const bf16_t* bp = bb + (size_t)pm * 256 * 1024 + d * 512 + w;
        float H = 0.f, sl = 0.f;
#pragma unroll 1
        for (int i0 = 0; i0 < 256; i0 += 32) { bf16_t lr[32], br[32];
#pragma unroll
            for (int q = 0; q < 32; ++q) { const int t = d ? 255 - (i0 + q) : i0 + q; lr[q] = lp[(size_t)t * 1024]; br[q] = bp[(size_t)t * 1024]; }
            asm volatile("" ::: "memory");
#pragma unroll
            for (int q = 0; q < 32; ++q) { const float lv = bf2f(lr[q]); H = __expf(lv) * H + bf2f(br[q]); sl += lv; } }
        rgs[(size_t)u * 512 + w] = (f32x2){__expf(sl), H};
    }
}
__device__ __forceinline__ void job_rg_out(CKP& p, int ntiles) {
    const bf16_t* la = (const bf16_t*)(p.ws + WS_LA); const bf16_t* bb = (const bf16_t*)(p.ws + WS_BB); const f32x2* rgs = (const f32x2*)(p.ws + WS_RGS);
    bf16_t* hf = (bf16_t*)(p.ws + WS_XCV); const bf16_t* ubuf = (const bf16_t*)(p.ws + WS_R1); bf16_t* yb = (bf16_t*)(p.ws + WS_YBR) + (size_t)1 * MALL * 512;
    const int w = otid();
    for (int u = obid(); u < ntiles; u += gridDim.x) {
        const int pm = (int)gridDim.x > ntiles ? u : u;
        const bool isctx = pm >= 128; const int b = isctx ? pm - 128 : (pm >> 6);
        float h = 0.f;
        if (!isctx) { h = rgs[(size_t)((128 + b) * 2 + 0) * 512 + w][1];
#pragma unroll 1
            for (int q0 = b * 64; q0 < pm; q0 += 16) { f32x2 sv[16];
#pragma unroll
                for (int k = 0; k < 16; ++k) { const int q = q0 + k < pm ? q0 + k : pm - 1; sv[k] = rgs[(size_t)(q * 2 + 0) * 512 + w]; }
                asm volatile("" ::: "memory");
#pragma unroll
                for (int k = 0; k < 16; ++k) if (q0 + k < pm) h = sv[k][0] * h + sv[k][1]; } }
        const size_t r0 = (size_t)pm * 256;
#pragma unroll 1
        for (int t0 = 0; t0 < 256; t0 += 64) { bf16_t lr[64], br[64];
#pragma unroll
            for (int k = 0; k < 64; ++k) { lr[k] = la[(r0 + t0 + k) * 1024 + w]; br[k] = bb[(r0 + t0 + k) * 1024 + w]; }
            asm volatile("" ::: "memory");
#pragma unroll
            for (int k = 0; k < 64; ++k) { h = __expf(bf2f(lr[k])) * h + bf2f(br[k]); hf[(r0 + t0 + k) * 512 + w] = f2bf(h); } }
        float hb = 0.f;
        if (!isctx) { hb = rgs[(size_t)((128 + b) * 2 + 1) * 512 + w][1];
#pragma unroll 1
            for (int q0 = b * 64 + 63; q0 > pm; q0 -= 16) { f32x2 sv[16];
#pragma unroll
                for (int k = 0; k < 16; ++k) { const int q = q0 - k > pm ? q0 - k : pm + 1; sv[k] = rgs[(size_t)(q * 2 + 1) * 512 + w]; }
                asm volatile("" ::: "memory");
#pragma unroll
                for (int k = 0; k < 16; ++k) if (q0 - k > pm) hb = sv[k][0] * hb + sv[k][1]; } }
#pragma unroll 1
        for (int i0 = 0; i0 < 256; i0 += 32) { bf16_t lr[32], br[32], gr[32], fr[32];
#pragma unroll
            for (int k = 0; k < 32; ++k) { const size_t t = r0 + 255 - i0 - k; lr[k] = la[t * 1024 + 512 + w]; br[k] = bb[t * 1024 + 512 + w]; gr[k] = ubuf[t * NU + U_BG + w]; fr[k] = hf[t * 512 + w]; }
#pragma unroll
            for (int k = 0; k < 32; ++k) { const size_t t = r0 + 255 - i0 - k; hb = __expf(bf2f(lr[k])) * hb + bf2f(br[k]); yb[t * 512 + w] = f2bf((bf2f(fr[k]) + hb) * gelu_tanh(bf2f(gr[k]))); } }
    }
}

namespace at {
constexpr float THR2 = 8.f * 1.4426950408889634f;
__device__ __forceinline__ int crow(int r, int hi) { return (r & 3) + 8 * (r >> 2) + 4 * hi; }
__device__ __forceinline__ unsigned cvtpk(float lo, float hi) { return cvt_pk_bf16(lo, hi); }
__device__ __forceinline__ int v_rd_base(int lane) { return ((lane & 3) << 3) | (((lane >> 2) & 3) << 6) | (((lane >> 4) & 1) << 5) | (((lane >> 5) & 1) << 8); }
constexpr int v_rd_off(int d0, int ks, int half) { return d0 * 512 + ks * 4096 + half * 2048; }
template <int OFF> __device__ __forceinline__ s16x4 tr_read(unsigned vb) { s16x4 r; asm volatile("ds_read_b64_tr_b16 %0, %1 offset:%2" : "=&v"(r) : "v"(vb), "i"(OFF) : "memory"); return r; }
template <int D0> __device__ __forceinline__ void pv_one(f32x16& od, unsigned vb, bf16x8 pa0, bf16x8 pa1, bf16x8 pa2, bf16x8 pa3) {
    const s16x4 l0 = tr_read<v_rd_off(D0, 0, 0)>(vb), h0 = tr_read<v_rd_off(D0, 0, 1)>(vb), l1 = tr_read<v_rd_off(D0, 1, 0)>(vb), h1 = tr_read<v_rd_off(D0, 1, 1)>(vb);
    const s16x4 l2 = tr_read<v_rd_off(D0, 2, 0)>(vb), h2 = tr_read<v_rd_off(D0, 2, 1)>(vb), l3 = tr_read<v_rd_off(D0, 3, 0)>(vb), h3 = tr_read<v_rd_off(D0, 3, 1)>(vb);
    asm volatile("s_waitcnt lgkmcnt(0)" ::: "memory"); __builtin_amdgcn_sched_barrier(0);
#define AT_PK(L, H) (bf16x8){L[0], L[1], L[2], L[3], H[0], H[1], H[2], H[3]}
    od = __builtin_amdgcn_mfma_f32_32x32x16_bf16(pa0, AT_PK(l0, h0), od, 0, 0, 0);
    od = __builtin_amdgcn_mfma_f32_32x32x16_bf16(pa1, AT_PK(l1, h1), od, 0, 0, 0);
    od = __builtin_amdgcn_mfma_f32_32x32x16_bf16(pa2, AT_PK(l2, h2), od, 0, 0, 0);
    od = __builtin_amdgcn_mfma_f32_32x32x16_bf16(pa3, AT_PK(l3, h3), od, 0, 0, 0);
#undef AT_PK
}
struct VFrag { s16x4 l[4], h[4]; };
template <int D0> __device__ __forceinline__ void rd_v(VFrag& f, const LAS unsigned char* vbp) {
#pragma unroll
    for (int ks = 0; ks < 4; ++ks) {
        f.l[ks] = __builtin_amdgcn_ds_read_tr16_b64_v4i16((LAS s16x4*)(vbp + v_rd_off(D0, ks, 0)));
        f.h[ks] = __builtin_amdgcn_ds_read_tr16_b64_v4i16((LAS s16x4*)(vbp + v_rd_off(D0, ks, 1))); }
}
__device__ __forceinline__ void mm_pv(f32x16& od, const VFrag& f, bf16x8 pa0, bf16x8 pa1, bf16x8 pa2, bf16x8 pa3) {
#define AT_PK(L, H) (bf16x8){L[0], L[1], L[2], L[3], H[0], H[1], H[2], H[3]}
    od = __builtin_amdgcn_mfma_f32_32x32x16_bf16(pa0, AT_PK(f.l[0], f.h[0]), od, 0, 0, 0);
    od = __builtin_amdgcn_mfma_f32_32x32x16_bf16(pa1, AT_PK(f.l[1], f.h[1]), od, 0, 0, 0);
    od = __builtin_amdgcn_mfma_f32_32x32x16_bf16(pa2, AT_PK(f.l[2], f.h[2]), od, 0, 0, 0);
    od = __builtin_amdgcn_mfma_f32_32x32x16_bf16(pa3, AT_PK(f.l[3], f.h[3]), od, 0, 0, 0);
#undef AT_PK
}
__device__ __forceinline__ f32x16 mfma_srcc(bf16x8 a, bf16x8 b, const f32x16& c) { f32x16 d; asm("v_mfma_f32_32x32x16_bf16 %0, %1, %2, %3" : "=&v"(d) : "v"(a), "v"(b), "v"(c)); return d; }
struct KeyMap { int ctx_row0, lat_row0, nctx, nt; __device__ __forceinline__ int row(int j) const { return j < nctx ? ctx_row0 + 64 * j : lat_row0 + 64 * (j - nctx); } };

template <int DQK>
__device__ __forceinline__ void attn_body(LAS unsigned char* lds, const bf16_t* Qg, int ldq, int q0, const bf16_t* Kg, int ldk, const bf16_t* Vg, int ldv, const KeyMap km,
                                          f32x16 (&o)[4], float& l_out) {
    constexpr int RB = DQK * 2, CPR = RB / 16, NKI = 64 * RB / 8192, KBYTES = 64 * RB, VOFF = 3 * KBYTES, SCR = VOFF + 4 * 16384, ND0 = DQK / 16;
    static_assert(SCR + 2048 <= LDS_MISC, "attention LDS");
    const int tid = otid(), wid = __builtin_amdgcn_readfirstlane(tid >> 6), lane = tid & 63, r32 = lane & 31, hi = lane >> 5, half = wid >> 2;
    LAS float* wsl = (LAS float*)(lds + SCR) + wid * 64; LAS float* al_l = wsl;
    unsigned koff[NKI], voff[2];
#pragma unroll
    for (int i = 0; i < NKI; ++i) { const int q = i * 512 + wid * 64 + lane, row = q / CPR, cp = q % CPR, ch = cp ^ ((row >> 1) & 7); koff[i] = (unsigned)row * (unsigned)(ldk * 2) + (unsigned)ch * 16u; }
#pragma unroll
    for (int i = 0; i < 2; ++i) { const int q = i * 512 + wid * 64 + lane, sub = q >> 5, wi = q & 31, k = (sub >> 2) * 8 + (wi >> 2), c = (sub & 3) * 32 + (wi & 3) * 8;
        voff[i] = (unsigned)k * (unsigned)(ldv * 2) + (unsigned)c * 2u; }
    const int NT = km.nt;
#define AT_ISSUE(j, sk, sv) do { const int _j = (j) < NT ? (j) : NT - 1; const int _kr = km.row(_j); const char* _kb = (const char*)Kg + (size_t)_kr * ldk * 2; const char* _vb = (const char*)Vg + (size_t)_kr * ldv * 2; \
        _Pragma("unroll") for (int _i = 0; _i < NKI; ++_i) __builtin_amdgcn_global_load_lds((const unsigned*)(_kb + koff[_i]), (LAS unsigned*)(lds + (sk) * KBYTES + _i * 8192 + wid * 1024), 16, 0, 0); \
        _Pragma("unroll") for (int _i = 0; _i < 2; ++_i) __builtin_amdgcn_global_load_lds((const unsigned*)(_vb + voff[_i]), (LAS unsigned*)(lds + VOFF + (sv) * 16384 + _i * 8192 + wid * 1024), 16, 0, 0); } while (0)
    bf16x8 qr[ND0];
    { const bf16_t* Qw = Qg + (size_t)(q0 + wid * 32 + r32) * ldq + hi * 8;
#pragma unroll
      for (int d0 = 0; d0 < ND0; ++d0) qr[d0] = *(const bf16x8*)(Qw + d0 * 16); }
    float m_reg = 0.f, l_reg = 0.f;
    f32x16 cm;
#pragma unroll
    for (int r = 0; r < 16; ++r) cm[r] = 0.f;
#pragma unroll
    for (int d = 0; d < 4; ++d)
#pragma unroll
        for (int r = 0; r < 16; ++r) o[d][r] = 0.f;
    const unsigned ksw = (unsigned)((r32 >> 1) & 7), kb0 = (unsigned)r32 * RB, vrb = (unsigned)v_rd_base(lane);
    bf16x8 pa0, pa1, pa2, pa3;
#define AT_PV(sv) do { const unsigned vb = (unsigned)(uintptr_t)(lds + VOFF + (sv) * 16384) + vrb; \
        pv_one<0>(o[0], vb, pa0, pa1, pa2, pa3); pv_one<1>(o[1], vb, pa0, pa1, pa2, pa3); pv_one<2>(o[2], vb, pa0, pa1, pa2, pa3); pv_one<3>(o[3], vb, pa0, pa1, pa2, pa3); } while (0)
    AT_ISSUE(0, 0, 0); AT_ISSUE(1, 1, 1);
    if constexpr (NKI == 3) asm volatile("s_waitcnt vmcnt(5)" ::: "memory"); else asm volatile("s_waitcnt vmcnt(3)" ::: "memory");
    if (half) { __builtin_amdgcn_s_barrier(); }
    int sk = 0, sv = 0;
    for (int j = 0; j < NT; ++j) {
        __builtin_amdgcn_s_barrier(); asm volatile("" ::: "memory");
        __builtin_amdgcn_s_setprio(1);
#define AT_SB __builtin_amdgcn_sched_barrier(0)
#define AT_RK(d0, KF) do { const unsigned cb = (((unsigned)(2 * (d0) + hi)) ^ ksw) << 4; KF[0] = *(const LAS bf16x8*)(Ks + cb); KF[1] = *(const LAS bf16x8*)(Ks + 32 * RB + cb); } while (0)
        const LAS unsigned char* Ks = lds + sk * KBYTES + kb0;
        bf16x8 kf[2][2];
        if (j > 0) {
            const LAS unsigned char* vbp = lds + VOFF + ((sv + 3) & 3) * 16384 + vrb;
            VFrag fa, fb;
            rd_v<0>(fa, vbp); rd_v<1>(fb, vbp); AT_SB;
            mm_pv(o[0], fa, pa0, pa1, pa2, pa3); AT_SB;
            rd_v<2>(fa, vbp); AT_SB;
            mm_pv(o[1], fb, pa0, pa1, pa2, pa3); AT_SB;
            rd_v<3>(fb, vbp); AT_SB;
            mm_pv(o[2], fa, pa0, pa1, pa2, pa3); AT_SB;
            AT_RK(0, kf[0]); AT_SB;
            mm_pv(o[3], fb, pa0, pa1, pa2, pa3); AT_SB;
        } else { AT_RK(0, kf[0]); AT_SB; }
        f32x16 p0, p1;
        AT_RK(1, kf[1]); AT_SB;
        p0 = mfma_srcc(kf[0][0], qr[0], cm); p1 = mfma_srcc(kf[0][1], qr[0], cm); AT_SB;
#pragma unroll
        for (int d0 = 1; d0 < ND0; ++d0) {
            if (d0 + 1 < ND0) { AT_RK(d0 + 1, kf[(d0 + 1) & 1]); AT_SB; }
            p0 = __builtin_amdgcn_mfma_f32_32x32x16_bf16(kf[d0 & 1][0], qr[d0], p0, 0, 0, 0);
            p1 = __builtin_amdgcn_mfma_f32_32x32x16_bf16(kf[d0 & 1][1], qr[d0], p1, 0, 0, 0); AT_SB;
        }
#undef AT_RK
#undef AT_SB
        asm volatile("s_waitcnt vmcnt(0)" ::: "memory");
        __builtin_amdgcn_s_setprio(0);
        __builtin_amdgcn_s_barrier(); asm volatile("" ::: "memory");
        { const int sk2 = sk == 0 ? 2 : sk - 1; AT_ISSUE(j + 2, sk2, (sv + 2) & 3); }
        float pmax = p0[0];
#pragma unroll
        for (int r = 1; r < 16; ++r) pmax = fmaxf(pmax, p0[r]);
#pragma unroll
        for (int r = 0; r < 16; ++r) pmax = fmaxf(pmax, p1[r]);
        { auto rr = __builtin_amdgcn_permlane32_swap(__float_as_uint(pmax), __float_as_uint(pmax), false, false); pmax = fmaxf(__uint_as_float(rr[0]), __uint_as_float(rr[1])); }
        float alpha = 1.f;
        if (__builtin_expect(j == 0 || !__all(pmax <= THR2), 0)) {
            const float delta = j == 0 ? pmax : fmaxf(pmax, 0.f);
            if (j != 0) alpha = __builtin_amdgcn_exp2f(-delta);
            m_reg += delta;
#pragma unroll
            for (int r = 0; r < 16; ++r) { p0[r] -= delta; p1[r] -= delta; cm[r] = -m_reg; }
        }
#pragma unroll
        for (int r = 0; r < 16; ++r) { p0[r] = __builtin_amdgcn_exp2f(p0[r]); p1[r] = __builtin_amdgcn_exp2f(p1[r]); }
        float ps = 0.f;
#pragma unroll
        for (int r = 0; r < 16; ++r) ps += p0[r] + p1[r];
        l_reg = l_reg * alpha + ps;
#define AT_PK4(P, BASE, OUT) do { u32x4 w = {cvtpk(P[BASE + 0], P[BASE + 1]), cvtpk(P[BASE + 2], P[BASE + 3]), cvtpk(P[BASE + 4], P[BASE + 5]), cvtpk(P[BASE + 6], P[BASE + 7])}; OUT = *reinterpret_cast<bf16x8*>(&w); } while (0)
        AT_PK4(p0, 0, pa0); AT_PK4(p0, 8, pa1); AT_PK4(p1, 0, pa2); AT_PK4(p1, 8, pa3);
#undef AT_PK4
        if (__any(alpha < 1.f)) {
            if (hi == 0) al_l[r32] = alpha;
            asm volatile("s_waitcnt lgkmcnt(0)" ::: "memory");
            float av[16];
#pragma unroll
            for (int r = 0; r < 16; ++r) av[r] = al_l[crow(r, hi)];
#pragma unroll
            for (int d = 0; d < 4; ++d)
#pragma unroll
                for (int r = 0; r < 16; ++r) o[d][r] *= av[r];
        }
        sk = sk == 2 ? 0 : sk + 1; sv = (sv + 1) & 3;
    }
    __builtin_amdgcn_s_barrier(); asm volatile("" ::: "memory");
    AT_PV((sv + 3) & 3);
    if (!half) __builtin_amdgcn_s_barrier();
    asm volatile("s_waitcnt vmcnt(0)" ::: "memory");
    __builtin_amdgcn_s_barrier();
    asm volatile("" ::: "memory");
    { auto rr = __builtin_amdgcn_permlane32_swap(__float_as_uint(l_reg), __float_as_uint(l_reg), false, false); l_out = __uint_as_float(rr[0]) + __uint_as_float(rr[1]); }
#undef AT_ISSUE
#undef AT_PV
}
__device__ __forceinline__ void row_inv_l(LAS unsigned char* lds_scratch, float l_reg, float (&rli)[16]) {
    const int tid = otid(), wid = tid >> 6, lane = tid & 63, r32 = lane & 31, hi = lane >> 5;
    LAS float* li_l = (LAS float*)lds_scratch + wid * 64 + 32;
    if (hi == 0) li_l[r32] = l_reg;
    asm volatile("s_waitcnt lgkmcnt(0)" ::: "memory");
#pragma unroll
    for (int r = 0; r < 16; ++r) rli[r] = __builtin_amdgcn_rcpf(li_l[crow(r, hi)]);
}
}

__device__ __forceinline__ void attn_unit_mla(CKP& p, LAS unsigned char* lds, int q0, int h, const at::KeyMap km) {
    const bf16_t* qm = (const bf16_t*)(p.ws + WS_QM); const bf16_t* kmb = (const bf16_t*)(p.ws + WS_KM); const bf16_t* vmb = (const bf16_t*)(p.ws + WS_VM); bf16_t* ya = (bf16_t*)(p.ws + WS_YBR);
    f32x16 o[4]; float l;
    at::attn_body<192>(lds, qm + h * 192, 768, q0, kmb + h * 192, 768, vmb + h * 128, 512, km, o, l);
    float rli[16]; at::row_inv_l(lds + 3 * 64 * 384 + 4 * 16384, l, rli);
    const int tid_ = otid(); const int wid = tid_ >> 6, lane = tid_ & 63, r32 = lane & 31, hi = lane >> 5;
    bf16_t* yw = ya + (size_t)(q0 + wid * 32) * 512 + h * 128 + r32;
#pragma unroll
    for (int r = 0; r < 16; ++r) { const int orow = at::crow(r, hi);
#pragma unroll
        for (int d0 = 0; d0 < 4; ++d0) yw[(size_t)orow * 512 + d0 * 32] = f2bf(o[d0][r] * rli[r]); }
}
__device__ __forceinline__ void attn_unit_diff(CKP& p, LAS unsigned char* lds, int l_idx, int q0, int h, const at::KeyMap km) {
    const bf16_t* ubuf = (const bf16_t*)(p.ws + WS_R1); bf16_t* yc = (bf16_t*)(p.ws + WS_YBR) + (size_t)2 * MALL * 512;
    const float lam = ((const float*)(p.ws + WS_SCAL))[l_idx]; const float lam_init = 0.8f - 0.6f * expf(-0.3f * (float)l_idx);
    f32x16 o[4]; float l; float rli[16];
    at::attn_body<64>(lds, ubuf + U_CQ + (2 * h) * 64, NU, q0, ubuf + U_CK + (2 * h) * 64, NU, ubuf + U_CV + h * 128, NU, km, o, l);
    at::row_inv_l(lds + 3 * 64 * 128 + 4 * 16384, l, rli);
    const int tid_ = otid(); const int wid = tid_ >> 6, lane = tid_ & 63, r32 = lane & 31, hi = lane >> 5;
    bf16_t* yw = yc + (size_t)(q0 + wid * 32) * 512 + h * 128 + r32;
#pragma unroll
    for (int r = 0; r < 16; ++r) { const int orow = at::crow(r, hi);
#pragma unroll
        for (int d0 = 0; d0 < 4; ++d0) yw[(size_t)orow * 512 + d0 * 32] = f2bf(o[d0][r] * rli[r]); }
    at::attn_body<64>(lds, ubuf + U_CQ + (2 * h + 1) * 64, NU, q0, ubuf + U_CK + (2 * h + 1) * 64, NU, ubuf + U_CV + h * 128, NU, km, o, l);
    at::row_inv_l(lds + 3 * 64 * 128 + 4 * 16384, l, rli);
    { const int t2 = otid(); yw = yc + (size_t)(q0 + (t2 >> 6) * 32) * 512 + h * 128 + (t2 & 31); }
    float ss[16];
#pragma unroll
    for (int r = 0; r < 16; ++r) { const int orow = at::crow(r, hi); float s = 0.f;
#pragma unroll
        for (int d = 0; d < 4; ++d) { const float v = bf2f(yw[(size_t)orow * 512 + d * 32]) - lam * (o[d][r] * rli[r]); o[d][r] = v; s += v * v; }
        ss[r] = s; }
#pragma unroll
    for (int r = 0; r < 16; ++r) {
#pragma unroll
        for (int x = 16; x >= 1; x >>= 1) ss[r] += shx(ss[r], x, lane); }
    const float* sub = p.in[I_SUBLN] + l_idx * 128; float sg[4];
#pragma unroll
    for (int d = 0; d < 4; ++d) sg[d] = sub[d * 32 + r32] * (1.0f - lam_init);
#pragma unroll
    for (int r = 0; r < 16; ++r) { const int orow = at::crow(r, hi); const float rn = rsqrtf(ss[r] * (1.0f / 128.0f) + EPS);
#pragma unroll
        for (int d0 = 0; d0 < 4; ++d0) yw[(size_t)orow * 512 + d0 * 32] = f2bf(o[d0][r] * rn * sg[d0]); }
}

__device__ __forceinline__ void lds_barrier() { asm volatile("s_waitcnt lgkmcnt(0)" ::: "memory"); __builtin_amdgcn_s_barrier(); asm volatile("" ::: "memory"); }
namespace hg {
__device__ __forceinline__ bf16x8 gather8(const LAS bf16_t* p, int stride) { bf16x8 r;
#pragma unroll
    for (int i = 0; i < 8; ++i) r[i] = (short)p[i * stride];
    return r; }
__device__ __forceinline__ void gates16(const bf16_t* zp  , float lbk, int dd, float (&gi)[16], float (&kf)[16], float& tot) {
    float g[16];
#pragma unroll
    for (int i = 0; i < 16; ++i) { const float z = bf2f(zp[(size_t)i * NU]); const float sg = sigmoidf_(z); g[i] = flog(lbk + (1.0f - lbk) * sg); kf[i] = (1.0f - lbk) * frcp(1.0f + __expf(z)); }
    float run = 0.f;
    if (dd == 0) {
#pragma unroll
        for (int i = 0; i < 16; ++i) { run += g[i]; gi[i] = run; }
    } else {
#pragma unroll
        for (int i = 15; i >= 0; --i) { run += g[i]; gi[i] = run; }
    }
    tot = run;
}
__device__ __forceinline__ void gates16r(const bf16_t (&zr)[16], float lbk, int dd, float (&gi)[16], float (&kf)[16], float& tot) {
    float g[16];
#pragma unroll
    for (int i = 0; i < 16; ++i) { const float z = bf2f(zr[i]); const float sg = sigmoidf_(z); g[i] = flog(lbk + (1.0f - lbk) * sg); kf[i] = (1.0f - lbk) * frcp(1.0f + __expf(z)); }
    float run = 0.f;
    if (dd == 0) {
#pragma unroll
        for (int i = 0; i < 16; ++i) { run += g[i]; gi[i] = run; }
    } else {
#pragma unroll
        for (int i = 15; i >= 0; --i) { run += g[i]; gi[i] = run; }
    }
    tot = run;
}
__device__ __forceinline__ void pack16_store(LAS bf16_t* dst, const float (&v)[16]) {
    u32x4 a, b; a.x = cvt_pk_bf16(v[0], v[1]); a.y = cvt_pk_bf16(v[2], v[3]); a.z = cvt_pk_bf16(v[4], v[5]); a.w = cvt_pk_bf16(v[6], v[7]);
    b.x = cvt_pk_bf16(v[8], v[9]); b.y = cvt_pk_bf16(v[10], v[11]); b.z = cvt_pk_bf16(v[12], v[13]); b.w = cvt_pk_bf16(v[14], v[15]);
    *(LAS u32x4*)dst = a; *(LAS u32x4*)(dst + 8) = b;
}
__device__ __forceinline__ void stage_vT(LAS bf16_t* VsT, const bf16_t* vp  , int v, int part) {
    unsigned short h[16];
#pragma unroll
    for (int i = 0; i < 16; ++i) h[i] = vp[(size_t)i * NU];
    u32x4 a, b; a.x = h[0] | ((unsigned)h[1] << 16); a.y = h[2] | ((unsigned)h[3] << 16); a.z = h[4] | ((unsigned)h[5] << 16); a.w = h[6] | ((unsigned)h[7] << 16);
    b.x = h[8] | ((unsigned)h[9] << 16); b.y = h[10] | ((unsigned)h[11] << 16); b.z = h[12] | ((unsigned)h[13] << 16); b.w = h[14] | ((unsigned)h[15] << 16);
    *(LAS u32x4*)(VsT + v * 72 + part * 16) = a; *(LAS u32x4*)(VsT + v * 72 + part * 16 + 8) = b;
}
__device__ __forceinline__ void pass1_unit(CKP& p, LAS unsigned char* lds, const float* lb, int cid, int hh) {
    const bf16_t* ubuf = (const bf16_t*)(p.ws + WS_R1); bf16_t* HS = (bf16_t*)(p.ws + WS_YBUF); float* HD = (float*)(p.ws + WS_HD);
    LAS bf16_t* VsT = (LAS bf16_t*)lds; LAS bf16_t* KtT = (LAS bf16_t*)(lds + 18432); LAS float* ptot = (LAS float*)(lds + 36864);
    const int tid = otid(), wid = tid >> 6, lane = tid & 63, row0 = cid * 64;
    const int k = tid & 127, part = tid >> 7; const float lbk = lb[hh * 128 + k];
    bf16_t zf[16], zb[16];
    { const bf16_t* zp = ubuf + (size_t)(row0 + part * 16) * NU + hh * 128 + k;
#pragma unroll
      for (int i = 0; i < 16; ++i) { zf[i] = zp[(size_t)i * NU + U_DFF]; zb[i] = zp[(size_t)i * NU + U_DFB]; } }
    stage_vT(VsT, ubuf + (size_t)(row0 + part * 16) * NU + U_DI + hh * 128 + k, k, part);
#pragma unroll 1
    for (int dd = 0; dd < 2; ++dd) {
        float gi[16], kf[16], tot;
        { bf16_t zr[16];
#pragma unroll
          for (int i = 0; i < 16; ++i) zr[i] = dd ? zb[i] : zf[i];
          gates16r(zr, lbk, dd, gi, kf, tot); }
        ptot[part * 128 + k] = tot;
        lds_barrier();
        float off = 0.f, gt = 0.f;
#pragma unroll
        for (int q = 0; q < 4; ++q) { const float v = ptot[q * 128 + k]; gt += v; if (dd == 0 ? (q < part) : (q > part)) off += v; }
#pragma unroll
        for (int i = 0; i < 16; ++i) kf[i] = kf[i] * __expf(gt - (off + gi[i]));
        pack16_store(KtT + k * 72 + part * 16, kf);
        if (part == 0) HD[(size_t)((cid * 4 + hh) * 2 + dd) * 128 + k] = __expf(gt);
        lds_barrier();
        {
            const int l15 = lane & 15, kg = lane >> 4;
            bf16x8 vf[2];
#pragma unroll
            for (int ks = 0; ks < 2; ++ks) vf[ks] = *(const LAS bf16x8*)(VsT + (wid * 16 + l15) * 72 + ks * 32 + kg * 8);
            bf16_t* dst = HS + ((size_t)((cid * 4 + hh) * 2 + dd) * 128 + wid * 16 + l15) * 128;
#pragma unroll
            for (int kb = 0; kb < 8; ++kb) {
                f32x4 c = {0.f, 0.f, 0.f, 0.f};
#pragma unroll
                for (int ks = 0; ks < 2; ++ks) { const bf16x8 kfr = *(const LAS bf16x8*)(KtT + (kb * 16 + l15) * 72 + ks * 32 + kg * 8); c = __builtin_amdgcn_mfma_f32_16x16x32_bf16(kfr, vf[ks], c, 0, 0, 0); }
                u32x2 w; w.x = cvt_pk_bf16(c[0], c[1]); w.y = cvt_pk_bf16(c[2], c[3]);
                *(u32x2*)(dst + kb * 16 + kg * 4) = w;
            }
        }
        lds_barrier();
    }
}
__device__ __forceinline__ void carry_unit(CKP& p, int u) {
    bf16_t* HS = (bf16_t*)(p.ws + WS_YBUF); const float* HD = (const float*)(p.ws + WS_HD);
    const int combo = u >> 4, sub = u & 15, b = combo >> 3, hh = (combo >> 1) & 3, dd = combo & 1;
    const int tid_ = otid(); const int v = sub * 8 + (tid_ >> 6), k = 2 * (tid_ & 63);
    float s0 = 0.f, s1 = 0.f;
#pragma unroll 1
    for (int s0i = 0; s0i < 260; s0i += 20) {
        unsigned uw[20]; f32x2 d2[20];
#pragma unroll
        for (int q = 0; q < 20; ++q) { const int st = s0i + q;
            const int cid = dd == 0 ? (st < 4 ? 512 + b * 4 + st : b * 256 + (st - 4)) : (st < 4 ? 512 + b * 4 + (3 - st) : b * 256 + (259 - st));
            const size_t base = (size_t)((cid * 4 + hh) * 2 + dd) * 128;
            uw[q] = *(const unsigned*)(HS + (base + v) * 128 + k); d2[q] = *(const f32x2*)(HD + base + k); }
#pragma unroll
        for (int q = 0; q < 20; ++q) { const int st = s0i + q;
            const int cid = dd == 0 ? (st < 4 ? 512 + b * 4 + st : b * 256 + (st - 4)) : (st < 4 ? 512 + b * 4 + (3 - st) : b * 256 + (259 - st));
            const size_t base = (size_t)((cid * 4 + hh) * 2 + dd) * 128;
            *(unsigned*)(HS + (base + v) * 128 + k) = cvt_pk_bf16(s0, s1);
            s0 = d2[q][0] * s0 + bflo(uw[q]); s1 = d2[q][1] * s1 + bfhi(uw[q]); }
    }
}
constexpr int O_QS = 0, O_KF = 17408, O_VS = 34816, O_GS = 53248, O_ST = 87040, O_AS = 121856, O_R = 140288, O_PT = 142336, O_RS = 144384;
static_assert(O_RS + 512 <= LDS_MISC, "HGRN LDS");
__device__ __forceinline__ void out_unit(CKP& p, LAS unsigned char* lds, const float* lb, const float* gnorm, int cid, int hh) {
    const bf16_t* ubuf = (const bf16_t*)(p.ws + WS_R1); const bf16_t* HS = (const bf16_t*)(p.ws + WS_YBUF); bf16_t* yd = (bf16_t*)(p.ws + WS_YBR) + (size_t)3 * MALL * 512;
    LAS bf16_t* qs = (LAS bf16_t*)(lds + O_QS); LAS bf16_t* kfs = (LAS bf16_t*)(lds + O_KF); LAS bf16_t* Vs = (LAS bf16_t*)(lds + O_VS); LAS float* Gs = (LAS float*)(lds + O_GS);
    LAS bf16_t* St = (LAS bf16_t*)(lds + O_ST); LAS float* Rr = (LAS float*)(lds + O_R); LAS float* ptot = (LAS float*)(lds + O_PT); LAS float* rss = (LAS float*)(lds + O_RS);
    const int tid = otid(), wid = tid >> 6, lane = tid & 63, row0 = cid * 64, l15 = lane & 15, kg = lane >> 4;
    LAS bf16_t* Asc = (LAS bf16_t*)(lds + O_AS) + wid * (16 * 72);
    const int k = tid & 127, part = tid >> 7; const float lbk = lb[hh * 128 + k];
    bf16_t zf[16], zb[16]; u32x4 sin0[4], sin1[4];
    { const bf16_t* zp = ubuf + (size_t)(row0 + part * 16) * NU + hh * 128 + k;
#pragma unroll
      for (int i = 0; i < 16; ++i) { zf[i] = zp[(size_t)i * NU + U_DFF]; zb[i] = zp[(size_t)i * NU + U_DFB]; }
      const int v_ = tid >> 2, seg_ = tid & 3; const bf16_t* src = HS + ((size_t)((cid * 4 + hh) * 2) * 128 + v_) * 128 + seg_ * 32;
#pragma unroll
      for (int i = 0; i < 4; ++i) { sin0[i] = *(const u32x4*)(src + i * 8); sin1[i] = *(const u32x4*)(src + (size_t)128 * 128 + i * 8); } }
    stage_vT(Vs, ubuf + (size_t)(row0 + part * 16) * NU + U_DI + hh * 128 + k, k, part);
#pragma unroll
    for (int i = 0; i < 16; ++i) { const int t = part * 16 + i; qs[t * 136 + k] = f2bf(siluf_(bf2f(ubuf[(size_t)(row0 + t) * NU + U_DQ + hh * 128 + k]))); }
    const int bi = wid >> 1, vh = wid & 1;
    f32x4 o[4];
#pragma unroll
    for (int nb = 0; nb < 4; ++nb) o[nb] = (f32x4){0.f, 0.f, 0.f, 0.f};
#pragma unroll 1
    for (int dd = 0; dd < 2; ++dd) {
        {
            float gi[16], kf[16], tot;
            { bf16_t zr[16];
#pragma unroll
              for (int i = 0; i < 16; ++i) zr[i] = dd ? zb[i] : zf[i];
              gates16r(zr, lbk, dd, gi, kf, tot); }
            ptot[part * 128 + k] = tot;
            lds_barrier();
            float off = 0.f;
#pragma unroll
            for (int q = 0; q < 4; ++q) { const float v = ptot[q * 128 + k]; if (dd == 0 ? (q < part) : (q > part)) off += v; }
#pragma unroll
            for (int i = 0; i < 16; ++i) { const int t = part * 16 + i; Gs[t * 132 + k] = off + gi[i]; kfs[t * 136 + k] = f2bf(kf[i]); }
            Rr[part * 128 + k] = off;
        }
        {
            const int v = tid >> 2, seg = tid & 3;
#pragma unroll
            for (int i = 0; i < 4; ++i) *(LAS u32x4*)(St + v * 136 + seg * 32 + i * 8) = dd ? sin1[i] : sin0[i];
        }
        lds_barrier();
        const int ti = bi * 16 + l15;
        u32x4 awq[4];
#pragma unroll
        for (int ks = 0; ks < 4; ++ks) { const int kc = ks * 32 + kg * 8;
            const u32x4 qw = *(const LAS u32x4*)(qs + ti * 136 + kc);
            const f32x4 g0 = *(const LAS f32x4*)(Gs + ti * 132 + kc), g1 = *(const LAS f32x4*)(Gs + ti * 132 + kc + 4), r0 = *(const LAS f32x4*)(Rr + bi * 128 + kc), r1 = *(const LAS f32x4*)(Rr + bi * 128 + kc + 4);
            const float qv[8] = {bflo(qw.x), bfhi(qw.x), bflo(qw.y), bfhi(qw.y), bflo(qw.z), bfhi(qw.z), bflo(qw.w), bfhi(qw.w)}; float qa[8];
#pragma unroll
            for (int e = 0; e < 4; ++e) { qa[e] = qv[e] * __expf(g0[e] - r0[e]); qa[4 + e] = qv[4 + e] * __expf(g1[e] - r1[e]); }
            awq[ks].x = cvt_pk_bf16(qa[0], qa[1]); awq[ks].y = cvt_pk_bf16(qa[2], qa[3]); awq[ks].z = cvt_pk_bf16(qa[4], qa[5]); awq[ks].w = cvt_pk_bf16(qa[6], qa[7]); }
#pragma unroll 1
        for (int j = 0; j < 4; ++j) {
            const bool use = dd == 0 ? (j <= bi) : (j >= bi);
            f32x4 c = {0.f, 0.f, 0.f, 0.f};
            if (use) {
                const int sj = j * 16 + l15;
#pragma unroll
                for (int ks = 0; ks < 4; ++ks) {
                    const int kc = ks * 32 + kg * 8;
                    const u32x4 kw = *(const LAS u32x4*)(kfs + sj * 136 + kc);
                    const f32x4 h0 = *(const LAS f32x4*)(Gs + sj * 132 + kc), h1 = *(const LAS f32x4*)(Gs + sj * 132 + kc + 4);
                    const f32x4 r0 = *(const LAS f32x4*)(Rr + bi * 128 + kc), r1 = *(const LAS f32x4*)(Rr + bi * 128 + kc + 4);
                    const float kv[8] = {bflo(kw.x), bfhi(kw.x), bflo(kw.y), bfhi(kw.y), bflo(kw.z), bfhi(kw.z), bflo(kw.w), bfhi(kw.w)};
                    float ka[8];
#pragma unroll
                    for (int e = 0; e < 4; ++e) { ka[e] = kv[e] * __expf(r0[e] - h0[e]); ka[4 + e] = kv[4 + e] * __expf(r1[e] - h1[e]); }
                    u32x4 aw = awq[ks], bw;
                    bw.x = cvt_pk_bf16(ka[0], ka[1]); bw.y = cvt_pk_bf16(ka[2], ka[3]); bw.z = cvt_pk_bf16(ka[4], ka[5]); bw.w = cvt_pk_bf16(ka[6], ka[7]);
                    c = __builtin_amdgcn_mfma_f32_16x16x32_bf16(*reinterpret_cast<bf16x8*>(&aw), *reinterpret_cast<bf16x8*>(&bw), c, 0, 0, 0);
                }
                if (j == bi) {
#pragma unroll
                    for (int e = 0; e < 4; ++e) { const int tl = 4 * kg + e; const bool keep = dd == 0 ? (l15 <= tl) : (l15 >= tl); c[e] = keep ? c[e] : 0.f; }
                }
            }
#pragma unroll
            for (int e = 0; e < 4; ++e) Asc[(4 * kg + e) * 72 + j * 16 + l15] = f2bf(c[e]);
        }
        bf16x8 af[2], qf[4];
#pragma unroll
        for (int ks = 0; ks < 2; ++ks) af[ks] = *(const LAS bf16x8*)(Asc + l15 * 72 + ks * 32 + kg * 8);
#pragma unroll
        for (int ks = 0; ks < 4; ++ks) { const int kc = ks * 32 + kg * 8;
            const u32x4 qw = *(const LAS u32x4*)(qs + ti * 136 + kc); const f32x4 g0 = *(const LAS f32x4*)(Gs + ti * 132 + kc), g1 = *(const LAS f32x4*)(Gs + ti * 132 + kc + 4);
            u32x4 aw; aw.x = cvt_pk_bf16(bflo(qw.x) * __expf(g0[0]), bfhi(qw.x) * __expf(g0[1])); aw.y = cvt_pk_bf16(bflo(qw.y) * __expf(g0[2]), bfhi(qw.y) * __expf(g0[3]));
            aw.z = cvt_pk_bf16(bflo(qw.z) * __expf(g1[0]), bfhi(qw.z) * __expf(g1[1])); aw.w = cvt_pk_bf16(bflo(qw.w) * __expf(g1[2]), bfhi(qw.w) * __expf(g1[3]));
            qf[ks] = *reinterpret_cast<bf16x8*>(&aw); }
#pragma unroll
        for (int nb = 0; nb < 4; ++nb) { const int vcol = vh * 64 + nb * 16 + l15;
#pragma unroll
            for (int ks = 0; ks < 2; ++ks) { const bf16x8 vf = *(const LAS bf16x8*)(Vs + vcol * 72 + ks * 32 + kg * 8); o[nb] = __builtin_amdgcn_mfma_f32_16x16x32_bf16(af[ks], vf, o[nb], 0, 0, 0); }
#pragma unroll
            for (int ks = 0; ks < 4; ++ks) { const bf16x8 sf = *(const LAS bf16x8*)(St + vcol * 136 + ks * 32 + kg * 8); o[nb] = __builtin_amdgcn_mfma_f32_16x16x32_bf16(qf[ks], sf, o[nb], 0, 0, 0); }
        }
        lds_barrier();
    }
    bf16_t ogr[4][4]; float gn[4];
#pragma unroll
    for (int e = 0; e < 4; ++e)
#pragma unroll
        for (int nb = 0; nb < 4; ++nb) ogr[e][nb] = ubuf[(size_t)(row0 + bi * 16 + 4 * kg + e) * NU + U_DG + hh * 128 + vh * 64 + nb * 16 + l15];
#pragma unroll
    for (int nb = 0; nb < 4; ++nb) gn[nb] = gnorm[vh * 64 + nb * 16 + l15];
    float ss[4];
#pragma unroll
    for (int e = 0; e < 4; ++e) { float s = 0.f;
#pragma unroll
        for (int nb = 0; nb < 4; ++nb) s += o[nb][e] * o[nb][e];
#pragma unroll
        for (int x = 8; x >= 1; x >>= 1) s += shx(s, x, lane);
        ss[e] = s; }
    if (l15 == 0) {
#pragma unroll
        for (int e = 0; e < 4; ++e) rss[vh * 64 + bi * 16 + 4 * kg + e] = ss[e]; }
    lds_barrier();
#pragma unroll
    for (int e = 0; e < 4; ++e) { const int tl = bi * 16 + 4 * kg + e; const float tot = rss[tl] + rss[64 + tl]; const float rn = rsqrtf(tot * (1.0f / 128.0f) + EPS);
        const size_t row = (size_t)(row0 + tl);
#pragma unroll
        for (int nb = 0; nb < 4; ++nb) { const int v = vh * 64 + nb * 16 + l15; const float og = bf2f(ogr[e][nb]);
            yd[row * 512 + hh * 128 + v] = f2bf(o[nb][e] * rn * gn[nb] * siluf_(og)); } }
    lds_barrier();
}
}

constexpr int PH_PER_LAYER = 14, N_PHASES = 1 + PH_PER_LAYER * NL + 1;
#ifndef MK_LAUNCHES
#define MK_LAUNCHES 1
#endif

__global__ void __launch_bounds__(NTHR, 2) fwd_kernel(KP karg) {
    extern __shared__ __attribute__((aligned(16))) unsigned char lds_raw[];
    LAS unsigned char* lds0 = (LAS unsigned char*)lds_raw;
    const int tid = otid(), G = gridDim.x, c = obid();
    volatile LAS unsigned* bst = (volatile LAS unsigned*)(lds0 + LDS_MISC);
    if (tid < 4) bst[tid] = 0u;
    __syncthreads();
    const int lo = karg.ph_lo, hi = karg.ph_hi;
    const bool fused = (MK_LAUNCHES == 1) || (hi - lo) > 1;
    XcdBarrier bar; bar.bar = (unsigned*)(karg.ws + WS_CTL); bar.x = 0; bar.st = bst;
    if (fused) bar = xcd_barrier_post((unsigned*)(karg.ws + WS_CTL), bst);
#ifndef ONLY_PH
#define ONLY_PH (-1)
#endif
#ifndef SUBMASK
#define SUBMASK 0xff
#endif
#define SUB(b) ((SUBMASK >> (b)) & 1)
#define EN(x) (ONLY_PH < 0 || ONLY_PH == (x))
#ifndef REPX
#define REPX (-1)
#define REPN 1
#endif
#define REPEAT(x) _Pragma("unroll 1") for (int rep_ = 0; rep_ < (REPX == (x) ? REPN : 1); ++rep_)
#define IN(k) ((MK_LAUNCHES == 1) || (lo <= (k) && (k) < hi))
#define INL(x) (EN(x) && IN(pb + (x)))
#define SEAM(k) do { if (IN((k) + 1)) xcd_barrier(bar); } while (0)

#define PH_LOCALS CKP& p = kp_here(); const int c = obid(); unsigned char* ws = p.ws; LAS unsigned char* lds = lds_here(lds_raw); \
    float* mod = (float*)(ws + WS_MOD); const float* rope = (const float*)(ws + WS_ROPE); const float* scal = (const float*)(ws + WS_SCAL); \
    bf16_t* hbuf = (bf16_t*)(ws + WS_HBUF); bf16_t* act = (bf16_t*)(ws + WS_R1); bf16_t* ubuf = (bf16_t*)(ws + WS_R1); bf16_t* mrg = (bf16_t*)(ws + WS_R1); bf16_t* ybuf = (bf16_t*)(ws + WS_YBUF); \
    float* xc = (float*)(ws + WS_XC); const float* modl = mod + (size_t)l * 3 * NMOD * DM; \
    (void)rope; (void)scal; (void)hbuf; (void)act; (void)ubuf; (void)mrg; (void)ybuf; (void)xc; (void)modl;

    if (EN(100) && IN(0)) { CKP& p = kp_here(); LAS unsigned char* lds = lds_here(lds_raw); job_tables(p); job_colmax(p); job_mod(p, lds); SEAM(0); }

#pragma unroll 1
    for (int l = 0; l < NL; ++l) {
        const int pb = 1 + PH_PER_LAYER * l; const bool need_ctx = l < NL - 1; const int nrt = need_ctx ? NRT : 128;
        if (INL(0)) { PH_LOCALS
            RNArgs a{};
            if (l == 0) { a.xs_lat = p.in[I_X]; a.xs_ctx = p.in[I_CTX]; a.xd_lat = p.out; a.xd_ctx = xc; a.y = nullptr; }
            else { a.xs_lat = p.out; a.xs_ctx = xc; a.xd_lat = p.out; a.xd_ctx = xc; a.y = ybuf; a.wres = 0.5f; a.modl_res = mod + (size_t)(l - 1) * 3 * NMOD * DM; a.jres = 2; a.postg = p.in[I_POST] + ((l - 1) * 3 + 2) * DM; }
            a.do_norm = true; a.modl_norm = modl; a.jn = 0; a.preg = p.in[I_PRE] + (l * 3 + 0) * DM; a.h = nullptr; a.h8 = (signed char*)hbuf; a.nrows = MALL; a.hsc = (float*)(ws + WS_HSC);
            job_resnorm(a, lds);
            job_convert(p, lds, l);
            SEAM(pb + 0);
        }
        if (INL(1)) { PH_LOCALS
            SchedPlain S; S.T.init(NRT, 44, G, c); S.A = (const char*)hbuf; S.B = (const char*)(ws + WS_WGU); S.lda2 = DM; S.ldb2 = DM; S.nt = DM / 128;
            REPEAT(1) { EpiGateUpI8 E{act, (const float*)(ws + WS_HSC), (const float*)(ws + WS_WSC)}; gm::gemm_stream<false>(lds, S, E); } SEAM(pb + 1);
        }
        if (INL(2)) { PH_LOCALS
            const bool spl = G == 256 && MK_LAUNCHES == 1; float* ypart = (float*)(ws + WS_R1 + (size_t)MALL * DFF * 2);
            SchedSplitK S; S.T.init(spl ? 128 : NRT, 8, G, c); S.A = (const char*)act; S.B = (const char*)(ws + WS_WD); S.lda2 = DFF * 2; S.ldb2 = DFF * 2; S.nt = DFF / 64; S.xe = (spl && c < 64) ? c : -1;
            REPEAT(2) { EpiStoreK E{ybuf, ypart}; gm::gemm_stream<false>(lds, S, E); } SEAM(pb + 2);
            if (spl) { job_splitk_reduce(ypart, ybuf); xcd_barrier(bar); }
        }
        if (INL(3)) { PH_LOCALS
            RNArgs a{};
            if (l == 0) { a.xs_lat = p.in[I_X]; a.xs_ctx = p.in[I_CTX]; } else { a.xs_lat = p.out; a.xs_ctx = xc; }
            a.xd_lat = p.out; a.xd_ctx = xc; a.y = ybuf; a.wres = 0.5f; a.modl_res = modl; a.jres = 0; a.postg = p.in[I_POST] + (l * 3 + 0) * DM;
            a.do_norm = true; a.modl_norm = modl; a.jn = 1; a.preg = p.in[I_PRE] + (l * 3 + 1) * DM; a.h = nullptr; a.h8 = (signed char*)(ws + WS_H8); a.hsc = (float*)(ws + WS_HSC2); a.nrows = MALL;
            job_resnorm(a, lds); SEAM(pb + 3);
        }
        if (INL(4)) { PH_LOCALS
            SchedPlain S; S.T.init(NRT, 24, G, c); S.A = (const char*)(ws + WS_H8); S.B = (const char*)(ws + WS_WIN); S.lda2 = DM; S.ldb2 = DM; S.nt = DM / 128;
            REPEAT(4) { EpiProj E{ubuf, (bf16_t*)(ws + WS_KM), rope, (const float*)(ws + WS_HSC2), (const float*)(ws + WS_WPS)}; gm::gemm_stream<false>(lds, S, E); } SEAM(pb + 4);
        }
        if (INL(5)) { PH_LOCALS job_stats_conv(p, l); SEAM(pb + 5); }
        if (INL(6)) { PH_LOCALS
            if (SUB(0)) { SchedPlain S; S.T.init(NRT, 3, G, c); S.A = (const char*)(ubuf + U_AQ); S.B = (const char*)(ws + WS_WUQ); S.lda2 = NU * 2; S.ldb2 = 512 * 2; S.nt = 8;
              EpiQup E{(bf16_t*)(ws + WS_QM), (const float*)(ws + WS_RSQ), rope}; gm::gemm_stream<false>(lds, S, E); }
            if (SUB(1)) { SchedPlain S; S.T.init(NRT, 4, G, G == 256 ? (c + 120) & 255 : c); S.A = (const char*)(ubuf + U_AKV); S.B = (const char*)(ws + WS_WUKV); S.lda2 = NU * 2; S.ldb2 = 256 * 2; S.nt = 4;
              EpiKVup E{(bf16_t*)(ws + WS_KM), (bf16_t*)(ws + WS_VM), (const float*)(ws + WS_RSQ) + MALL}; gm::gemm_stream<false>(lds, S, E); }
            if (SUB(2)) { SchedPlain S; S.T.init(NRT, 8, G, G == 256 ? (c + 112) & 255 : c); S.A = (const char*)(ws + WS_XCV); S.B = (const char*)(ws + WS_WRG); S.lda2 = 512 * 2; S.ldb2 = 512 * 2; S.nt = 8;
              EpiRG E{(const bf16_t*)(ws + WS_XCV), (bf16_t*)(ws + WS_LA), (bf16_t*)(ws + WS_BB), p.in[I_RGBR] + l * 1024, p.in[I_RGBI] + l * 1024, scal + 2048 + l * 1024}; gm::gemm_stream<false>(lds, S, E); }
            if (SUB(3)) for (int u = (G == 256 ? (c + 96) & 255 : c); u < 520 * 4; u += G) hg::pass1_unit(p, lds, scal + 256 + l * 512, u >> 2, u & 3);
            SEAM(pb + 6);
        }
        if (INL(7)) { PH_LOCALS job_rg_scan1(p); for (int u = c; u < 256; u += G) hg::carry_unit(p, u); SEAM(pb + 7); }
        if (INL(8)) { PH_LOCALS {
            REPEAT(81) if (SUB(0)) job_rg_out(p, nrt);
            REPEAT(82) if (SUB(1)) { const int ncu = need_ctx ? 520 * 4 : 512 * 4;
                if (G > nrt + 16) {
                    if (c < nrt) { for (int i = 0; i < 7; ++i) { const int u = c + i * nrt; hg::out_unit(p, lds, scal + 256 + l * 512, p.in[I_HNORM] + l * 128, u >> 2, u & 3); } }
                    else for (int u = 7 * nrt + (c - nrt); u < ncu; u += G - nrt) hg::out_unit(p, lds, scal + 256 + l * 512, p.in[I_HNORM] + l * 128, u >> 2, u & 3);
                } else for (int u = c; u < ncu; u += G) hg::out_unit(p, lds, scal + 256 + l * 512, p.in[I_HNORM] + l * 128, u >> 2, u & 3); }
            if (SUB(4) && need_ctx) for (int t = (G == 256 ? (c + 16) & 255 : c); t < 16; t += G) { const int bh = t & 7, b = bh >> 2, h = bh & 3; at::KeyMap km{MLAT + b * CTXL, 0, 4, 4};
                if (t < 8) attn_unit_mla(p, lds, MLAT + b * CTXL, h, km); else attn_unit_diff(p, lds, l, MLAT + b * CTXL, h, km); }
            REPEAT(83) if (SUB(2)) for (int t = c; t < 512; t += G) { const int bh = t & 7, qb = t >> 3, b = bh >> 2, h = bh & 3; at::KeyMap km{MLAT + b * CTXL, b * SEQ, 4, 260}; attn_unit_mla(p, lds, b * SEQ + qb * 256, h, km); }
            REPEAT(84) if (SUB(3)) for (int t = c; t < 512; t += G) { const int bh = t & 7, qb = t >> 3, b = bh >> 2, h = bh & 3; at::KeyMap km{MLAT + b * CTXL, b * SEQ, 4, 260}; attn_unit_diff(p, lds, l, b * SEQ + qb * 256, h, km); }
            }
            SEAM(pb + 8);
        }
        if (INL(9)) { PH_LOCALS
            const bool bal = need_ctx && G == 256 && MK_LAUNCHES == 1;
            bf16_t* part = mrg + (size_t)2 * MALL * DM; bf16_t* gx = part + (size_t)4 * MCTX * DM;
            EpiMergeG EG{mrg + (size_t)MALL * DM, p.in[I_MB] + l * 4 * DM, (const float*)(ws + WS_HSC2), (const float*)(ws + WS_WGS), bal, gx};
            EpiMergeY EY{mrg, mrg + (size_t)MALL * DM, bal, gx, part};
            REPEAT(9) {
#pragma unroll 1
            for (int n = 0; n < 4; ++n) { const int xe = (bal && c >= 16 * n && c < 16 * n + 16) ? c - 16 * n : -1, nrm = bal ? 128 : nrt;
                { SchedMergeG S; S.T.init(nrm, 8, G, c); S.h8 = (const char*)(ws + WS_H8); S.wg = (const char*)(ws + WS_WIN) + (size_t)NU * DM; S.n = n; S.xe = xe; gm::gemm_stream<false>(lds, S, EG); }
                { SchedMergeY S; S.T.init(nrm, 8, G, c); S.ybr = (const char*)(ws + WS_YBR); S.wbr = (const char*)(ws + WS_WBR); S.n = n; S.xe = xe; gm::gemm_stream<false>(lds, S, EY); }
            } }
            SEAM(pb + 9);
            if (bal) {
                const int tid = otid();
                for (int idx = c * 512 + tid; idx < MCTX * 256; idx += G * 512) { const int row = idx >> 8, q = idx & 255; float sm[8] = {0.f, 0.f, 0.f, 0.f, 0.f, 0.f, 0.f, 0.f};
#pragma unroll
                    for (int n = 0; n < 4; ++n) { const u32x4 w = *(const u32x4*)(part + ((size_t)n * MCTX + row) * DM + q * 8);
                        sm[0] += bflo(w.x); sm[1] += bfhi(w.x); sm[2] += bflo(w.y); sm[3] += bfhi(w.y); sm[4] += bflo(w.z); sm[5] += bfhi(w.z); sm[6] += bflo(w.w); sm[7] += bfhi(w.w); }
                    u32x4 o; o.x = cvt_pk_bf16(sm[0], sm[1]); o.y = cvt_pk_bf16(sm[2], sm[3]); o.z = cvt_pk_bf16(sm[4], sm[5]); o.w = cvt_pk_bf16(sm[6], sm[7]);
                    *(u32x4*)(mrg + (size_t)(MLAT + row) * DM + q * 8) = o; }
                xcd_barrier(bar);
            }
        }
        if (INL(10)) { PH_LOCALS
            const bool spl = need_ctx && G == 256 && MK_LAUNCHES == 1; float* ypart = (float*)(ws + WS_R1 + (size_t)MALL * DFF * 2);
            SchedSplitK S; S.T.init(spl ? 128 : nrt, 8, G, c); S.A = (const char*)mrg; S.B = (const char*)(ws + WS_WOUT); S.lda2 = DM * 2; S.ldb2 = DM * 2; S.nt = DM / 64; S.xe = (spl && c < 64) ? c : -1;
            EpiStoreK E{ybuf, ypart}; gm::gemm_stream<false>(lds, S, E); SEAM(pb + 10);
            if (spl) { job_splitk_reduce(ypart, ybuf); xcd_barrier(bar); }
        }
        if (INL(11)) { PH_LOCALS
            RNArgs a{}; a.xs_lat = p.out; a.xs_ctx = xc; a.xd_lat = p.out; a.xd_ctx = xc; a.y = ybuf; a.wres = 1.0f; a.modl_res = modl; a.jres = 1; a.postg = p.in[I_POST] + (l * 3 + 1) * DM;
            a.do_norm = true; a.modl_norm = modl; a.jn = 2; a.preg = p.in[I_PRE] + (l * 3 + 2) * DM; a.h = nullptr; a.h8 = (signed char*)hbuf; a.nrows = nrt * 256; a.hsc = (float*)(ws + WS_HSC);
            job_resnorm(a, lds); SEAM(pb + 11);
        }
        if (INL(12)) { PH_LOCALS
            SchedPlain S; S.T.init(nrt, 44, G, c); S.A = (const char*)hbuf; S.B = (const char*)(ws + WS_WGU) + (size_t)11264 * 2048; S.lda2 = DM; S.ldb2 = DM; S.nt = DM / 128;
            EpiGateUpI8 E{act, (const float*)(ws + WS_HSC), (const float*)(ws + WS_WSC) + 11264}; gm::gemm_stream<false>(lds, S, E); SEAM(pb + 12);
        }
        if (INL(13)) { PH_LOCALS
            const bool spl = need_ctx && G == 256 && MK_LAUNCHES == 1; float* ypart = (float*)(ws + WS_R1 + (size_t)MALL * DFF * 2);
            SchedSplitK S; S.T.init(spl ? 128 : nrt, 8, G, c); S.A = (const char*)act; S.B = (const char*)(ws + WS_WD) + (size_t)2048 * 5632 * 2; S.lda2 = DFF * 2; S.ldb2 = DFF * 2; S.nt = DFF / 64; S.xe = (spl && c < 64) ? c : -1;
            EpiStoreK E{ybuf, ypart}; gm::gemm_stream<false>(lds, S, E); SEAM(pb + 13);
            if (spl) { job_splitk_reduce(ypart, ybuf); xcd_barrier(bar); }
        }
    }
    if (EN(101) && IN(N_PHASES - 1)) {
        const int l = NL - 1; PH_LOCALS
        RNArgs a{}; a.xs_lat = p.out; a.xs_ctx = xc; a.xd_lat = p.out; a.xd_ctx = xc; a.y = ybuf; a.wres = 0.5f; a.modl_res = mod + (size_t)l * 3 * NMOD * DM; a.jres = 2; a.postg = p.in[I_POST] + (l * 3 + 2) * DM;
        a.do_norm = false; a.modl_norm = a.modl_res; a.jn = 0; a.preg = nullptr; a.h = nullptr; a.nrows = MLAT;
        job_resnorm(a, lds);
    }
#undef PH_LOCALS
#undef IN
#undef INL
#undef EN
#undef SEAM
}


#ifdef DBG_K
__global__ void dbg_dump(float* out, const unsigned char* ws, size_t off, size_t nelem, int is_bf16) {
    const size_t N = (size_t)MLAT * DM;
    for (size_t i = (size_t)obid() * blockDim.x + threadIdx.x; i < N; i += (size_t)gridDim.x * blockDim.x) {
        float s = 0.f;
        for (size_t j = i; j < nelem; j += N) s += is_bf16 ? bf2f(((const bf16_t*)(ws + off))[j]) : ((const float*)(ws + off))[j];
        out[i] = (s - s == 0.f) ? s : 12345.0f;
    }
}
#endif

extern "C" void kernel_launch(void* const* d_in, const int* in_sizes, int n_in, void* d_out, int out_size, void* d_ws, size_t ws_size, hipStream_t stream) {
    static int grid = 0;
    if (grid == 0) {
        if (n_in != 30 || out_size != MLAT * DM || ws_size < WS_END) { fprintf(stderr, "kernel_launch: unexpected shapes: n_in %d out %d ws %zu (need %zu)\n", n_in, out_size, ws_size, (size_t)WS_END); grid = -1; return; }
        int dev = 0, cus = 0;
        if (hipGetDevice(&dev) != hipSuccess || hipDeviceGetAttribute(&cus, hipDeviceAttributeMultiprocessorCount, dev) != hipSuccess) { grid = -1; return; }
        if (hipFuncSetAttribute((const void*)fwd_kernel, hipFuncAttributeMaxDynamicSharedMemorySize, LDS_BYTES) != hipSuccess) { fprintf(stderr, "kernel_launch: hipFuncSetAttribute failed\n"); grid = -1; return; }
        int per_cu = 0; (void)hipOccupancyMaxActiveBlocksPerMultiprocessor(&per_cu, (const void*)fwd_kernel, NTHR, LDS_BYTES); (void)hipGetLastError();
        grid = cus;
    }
    if (grid < 0) return;
    (void)hipMemsetAsync((char*)d_ws + WS_CTL, 0, WS_ZERO_BYTES, stream);
    KP p{};
    for (int i = 0; i < 30; ++i) p.in[i] = (const float*)d_in[i];
    p.out = (float*)d_out; p.ws = (unsigned char*)d_ws;
#ifdef DBG_K
    for (int k = 0; k < DBG_K; ++k) { p.ph_lo = k; p.ph_hi = k + 1; hipLaunchKernelGGL(fwd_kernel, dim3(grid), dim3(NTHR), LDS_BYTES, stream, p); }
    hipLaunchKernelGGL(dbg_dump, dim3(2048), dim3(256), 0, stream, (float*)d_out, (const unsigned char*)d_ws, (size_t)(DBG_OFF), (size_t)(DBG_N), (int)(DBG_BF));
#elif MK_LAUNCHES == 1
    p.ph_lo = 0; p.ph_hi = N_PHASES;
    hipLaunchKernelGGL(fwd_kernel, dim3(grid), dim3(NTHR), LDS_BYTES, stream, p);
#else
    for (int k = 0; k < N_PHASES; ++k) { p.ph_lo = k; p.ph_hi = k + 1; hipLaunchKernelGGL(fwd_kernel, dim3(grid), dim3(NTHR), LDS_BYTES, stream, p); }
#endif
}
```

```cpp
#include <hip/hip_runtime.h>
#include <stdint.h>
#include <stdio.h>

#define LAS __attribute__((address_space(3)))
typedef unsigned short bf16_t;
typedef short bf16x8 __attribute__((ext_vector_type(8)));
typedef short s16x4 __attribute__((ext_vector_type(4)));
typedef float f32x2 __attribute__((ext_vector_type(2)));
typedef float f32x4 __attribute__((ext_vector_type(4)));
typedef float f32x16 __attribute__((ext_vector_type(16)));
typedef unsigned u32x2 __attribute__((ext_vector_type(2)));
typedef unsigned u32x4 __attribute__((ext_vector_type(4)));
typedef int i32x4 __attribute__((ext_vector_type(4)));

constexpr int DM = 2048, NB = 2, SEQ = 16384, NL = 2, CTXL = 256, DFF = 5632, NMOD = 9;
constexpr int MLAT = NB * SEQ, MCTX = NB * CTXL, MALL = MLAT + MCTX;
constexpr int NRT = MALL / 256;
constexpr int DIN = 14144, NU = 6144;
constexpr float EPS = 1e-6f;
constexpr int U_AQ = 0, U_BX = 512, U_BG = 1024, U_CQ = 1536, U_CK = 2048, U_CV = 2560, U_DQ = 3072, U_DFF = 3584, U_DFB = 4096, U_DI = 4608, U_DG = 5120, U_AKV = 5632, U_AKR = 5888;

constexpr size_t al256(size_t x) { return (x + 255) / 256 * 256; }
constexpr size_t WS_CTL = 0;
constexpr size_t WS_CMAX = 16384;
constexpr size_t WS_CMAX2 = WS_CMAX + (size_t)NL * 2 * 2 * 5632 * 4;
constexpr size_t WS_ZERO_BYTES = 524288;
static_assert(WS_CMAX2 + (size_t)NL * 14336 * 4 <= WS_ZERO_BYTES, "column maxima inside the zeroed region");
constexpr size_t WS_MOD = 524288;
constexpr size_t WS_ROPE = WS_MOD + al256((size_t)NL * 3 * NMOD * DM * 4);
constexpr size_t WS_SCAL = WS_ROPE + 32768;
constexpr size_t WS_RSQ = WS_SCAL + 32768;
constexpr size_t WS_RGS = WS_RSQ + al256((size_t)MALL * 8);
constexpr size_t WS_HD = WS_RGS + al256((size_t)NRT * 2 * 512 * 8);
constexpr size_t WS_XC = WS_HD + al256((size_t)520 * 4 * 2 * 128 * 4);
constexpr size_t WS_WGU = WS_XC + (size_t)MCTX * DM * 4;
constexpr size_t WS_WD = WS_WGU + (size_t)2 * 11264 * 2048 * 2;
constexpr size_t WS_WIN = WS_WD + (size_t)2 * 2048 * 5632 * 2;
constexpr size_t WS_WUQ = WS_WIN + (size_t)14336 * 2048 * 2;
constexpr size_t WS_WUKV = WS_WUQ + (size_t)768 * 512 * 2;
constexpr size_t WS_WRG = WS_WUKV + (size_t)1024 * 256 * 2;
constexpr size_t WS_WBR = WS_WRG + (size_t)2048 * 512 * 2;
constexpr size_t WS_WOUT = WS_WBR + (size_t)4 * 2048 * 512 * 2;
constexpr size_t WS_HBUF = WS_WOUT + (size_t)2048 * 2048 * 2;
constexpr size_t WS_R1 = WS_HBUF + (size_t)MALL * DM * 2;
constexpr size_t WS_YBUF = WS_R1 + (size_t)MALL * NU * 2;
constexpr size_t WS_QM = WS_YBUF + (size_t)MALL * DM * 2;
constexpr size_t WS_KM = WS_QM + (size_t)MALL * 768 * 2;
constexpr size_t WS_VM = WS_KM + (size_t)MALL * 768 * 2;
constexpr size_t WS_YBR = WS_VM + (size_t)MALL * 512 * 2;
constexpr size_t WS_XCV = WS_YBR + (size_t)4 * MALL * 512 * 2;
constexpr size_t WS_LA = WS_XCV + (size_t)MALL * 512 * 2;
constexpr size_t WS_BB = WS_LA + (size_t)MALL * 1024 * 2;
constexpr size_t WS_WSC = WS_BB + (size_t)MALL * 1024 * 2;
constexpr size_t WS_HSC = WS_WSC + al256((size_t)2 * 11264 * 4);
constexpr size_t WS_HSC2 = WS_HSC + al256((size_t)MALL * 4);
constexpr size_t WS_WGS = WS_HSC2 + al256((size_t)MALL * 4);
constexpr size_t WS_WPS = WS_WGS + 32768;
constexpr size_t WS_H8 = WS_WPS + 32768;
constexpr size_t WS_END = WS_H8 + (size_t)MALL * DM;

constexpr int NTHR = 512;
constexpr int LDS_BYTES = 147456;
constexpr int LDS_MISC = 147456 - 64;

typedef __bf16 bf16x2n __attribute__((ext_vector_type(2)));
__device__ __forceinline__ unsigned cvt_pk_bf16(float lo, float hi) { const f32x2 v = {lo, hi}; const bf16x2n b = __builtin_convertvector(v, bf16x2n); return __builtin_bit_cast(unsigned, b); }
__device__ __forceinline__ bf16_t f2bf(float x) { return (bf16_t)(cvt_pk_bf16(x, 0.f) & 0xffffu); }
__device__ __forceinline__ float bf2f(bf16_t b) { return __uint_as_float(((unsigned)b) << 16); }
__device__ __forceinline__ float bflo(unsigned w) { return __uint_as_float(w << 16); }
__device__ __forceinline__ float bfhi(unsigned w) { return __uint_as_float(w & 0xffff0000u); }
__device__ __forceinline__ float frcp(float x) { return __builtin_amdgcn_rcpf(x); }
__device__ __forceinline__ float flog(float x) { return __builtin_amdgcn_logf(x) * 0.6931471805599453f; }
__device__ __forceinline__ float sigmoidf_(float x) { return frcp(1.0f + __expf(-x)); }
__device__ __forceinline__ float siluf_(float x) { return x * sigmoidf_(x); }
__device__ __forceinline__ float gelu_tanh(float x) { const float u = 0.7978845608028654f * (x + 0.044715f * x * x * x); const float t = 1.0f - 2.0f * frcp(1.0f + __expf(2.0f * u)); return 0.5f * x * (1.0f + t); }
__device__ __forceinline__ float shx(float v, int mask, int lane) { return __int_as_float(__builtin_amdgcn_ds_bpermute((lane ^ mask) << 2, __float_as_int(v))); }
__device__ __forceinline__ float wave_sum(float v, int lane) {
#pragma unroll
    for (int o = 32; o >= 1; o >>= 1) v += shx(v, o, lane);
    return v;
}
__device__ __forceinline__ int obid() { int b = blockIdx.x; asm volatile("" : "+s"(b)); return b; }
__device__ __forceinline__ int otid() { int t = threadIdx.x; asm volatile("" : "+v"(t)); return t; }
#define WAIT_VM0() asm volatile("s_waitcnt vmcnt(0)" ::: "memory")
#define WAIT_LGKM0() asm volatile("s_waitcnt lgkmcnt(0)" ::: "memory")

#define XB_TMO      128
#define XB_XCNT(j)  (256  + 64 * (j))
#define XB_XSUB(j)  (1280 + 64 * (j))
#define XB_XGEN(j)  (2304 + 64 * (j))
#define XB_TOP      3328
#define XB_TOPGEN   3392
#define XCD_BAR_WORDS 3456
#define XB_SPIN_CAP (1u << 22)
__device__ __forceinline__ unsigned xb_ld(unsigned* p)              { return __hip_atomic_load(p, __ATOMIC_RELAXED, __HIP_MEMORY_SCOPE_AGENT); }
__device__ __forceinline__ unsigned xb_add(unsigned* p, unsigned v) { return __hip_atomic_fetch_add(p, v, __ATOMIC_RELAXED, __HIP_MEMORY_SCOPE_AGENT); }
__device__ __forceinline__ unsigned xb_xcc_id() { return (unsigned)__builtin_amdgcn_s_getreg((3 << 11) | 20) & 0xFu; }
#define XB_SPIN(cond, bar) do { unsigned _sp = 0; while (cond) { __builtin_amdgcn_s_sleep(1); \
    if ((++_sp & 255u) == 0u) { if (xb_ld(&(bar)[XB_TMO])) break; if (_sp > XB_SPIN_CAP) { atomicAdd(&(bar)[XB_TMO], 1u); break; } } } } while (0)
struct XcdBarrier { unsigned* bar; unsigned x; volatile LAS unsigned* st; };
__device__ __forceinline__ XcdBarrier xcd_barrier_post(unsigned* bar, volatile LAS unsigned* st) {
    XcdBarrier b; b.bar = bar; b.x = xb_xcc_id(); b.st = st;
    if (threadIdx.x == 0) (void)xb_add(&bar[XB_XCNT(b.x)], 1u);
    return b;
}
__device__ __forceinline__ void xcd_barrier_complete(unsigned* bar, unsigned x, unsigned& nloc, unsigned& nx) {
    const unsigned G = gridDim.x * gridDim.y * gridDim.z;
    unsigned sum, cnt, mine, sp = 0u;
    for (;;) {
        sum = 0u; cnt = 0u; mine = 0u;
#pragma unroll 1
        for (unsigned j = 0; j < 16; ++j) { const unsigned c = xb_ld(&bar[XB_XCNT(j)]); sum += c; cnt += (c > 0u) ? 1u : 0u; mine = (j == x) ? c : mine; }
        if (sum == G) break;
        __builtin_amdgcn_s_sleep(1);
        if ((++sp & 255u) == 0u) { if (xb_ld(&bar[XB_TMO])) break; if (sp > XB_SPIN_CAP) { atomicAdd(&bar[XB_TMO], 1u); break; } }
    }
    nloc = mine > 0u ? mine : 1u; nx = cnt > 0u ? cnt : 1u;
}
__device__ __forceinline__ void xcd_barrier(const XcdBarrier& b) {
    asm volatile("s_waitcnt vmcnt(0)" ::: "memory");
    __syncthreads();
    if (threadIdx.x == 0) {
        unsigned* bar = b.bar; unsigned bx = b.x;
        asm volatile("" : "+s"(bar), "+s"(bx));
        __builtin_amdgcn_s_waitcnt(0);
        unsigned nloc = b.st[0], nx = b.st[1];
        if (nloc == 0u) { xcd_barrier_complete(bar, bx, nloc, nx); b.st[0] = nloc; b.st[1] = nx; }
        const unsigned old = xb_add(&bar[XB_XSUB(bx)], 1u);
        const unsigned gen = old / nloc;
        if (old + 1u == (gen + 1u) * nloc) {
            __builtin_amdgcn_fence(__ATOMIC_RELEASE, "agent");
            asm volatile("s_waitcnt vmcnt(0)" ::: "memory");
            const unsigned og = xb_add(&bar[XB_TOP], 1u);
            const unsigned tg = og / nx;
            if (og + 1u == (tg + 1u) * nx) xb_add(&bar[XB_TOPGEN], 1u);
            else XB_SPIN(xb_ld(&bar[XB_TOPGEN]) == tg, bar);
            __builtin_amdgcn_fence(__ATOMIC_ACQUIRE, "agent");
            xb_add(&bar[XB_XGEN(bx)], 1u);
            asm volatile("s_waitcnt vmcnt(0)" ::: "memory");
        } else {
            XB_SPIN(xb_ld(&bar[XB_XGEN(bx)]) == gen, bar);
            __builtin_amdgcn_fence(__ATOMIC_ACQUIRE, "agent");
            asm volatile("s_waitcnt vmcnt(0)" ::: "memory");
        }
    }
    __syncthreads();
}

constexpr float MLA_QC = 0.07216878364870322f * 1.4426950408889634f, DIFF_QC = 0.125f * 1.4426950408889634f;
namespace gm {
constexpr int BM = 256, BK = 64, HALF = 128, HTB = HALF * BK * 2, STAGE_BYTES = 8 * HTB;
__device__ __forceinline__ int lds_byte(int r, int c) { const int st = (r >> 4) * 2 + (c >> 5), rr = r & 15, cc = c & 31, ob = rr * 64 + cc * 2; return st * 1024 + (ob ^ (((ob >> 9) & 1) << 5)); }
__device__ __forceinline__ void stage_rc(int b, int& R, int& C) { const int st = b / 1024, sb = b % 1024, swz = sb ^ (((sb >> 9) & 1) << 5); R = (st >> 1) * 16 + swz / 64; C = (st & 1) * 32 + (swz % 64) / 2; }
__device__ __forceinline__ int perm32(int rho) { const int n = rho >> 4, i = rho & 15; return 8 * (i >> 2) + 4 * n + (i & 3); }

struct Unit { const char* A; const char* B; unsigned lda2, ldb2; int nt; int pm, pn, tag; };

struct TileOrder {
    int nM, nN, nwg, G, c;
    __device__ __forceinline__ void init(int nM_, int nN_, int G_, int c_) { nM = nM_; nN = nN_; nwg = nM * nN; G = G_; c = c_; }
    __device__ __forceinline__ bool tile(int i, int& pm, int& pn) const {
        const long L = (long)i * G + c; if (L >= nwg) return false;
        int wgid = (int)L; { const int q = nwg / 8, r = nwg % 8, xcd = wgid % 8, off = wgid / 8; wgid = (xcd < r ? xcd * (q + 1) : r * (q + 1) + (xcd - r) * q) + off; }
        const int nig = 8 * nN, gid = wgid / nig, fm = gid * 8, gsz = (nM - fm) < 8 ? (nM - fm) : 8;
        pm = fm + ((wgid % nig) % gsz); pn = (wgid % nig) / gsz; return true;
    }
};

typedef i32x4 AccI[2][2][4][2];
__device__ __forceinline__ void zero_acc(AccI& acc) {
#pragma unroll
    for (int a = 0; a < 2; ++a)
#pragma unroll
        for (int b = 0; b < 2; ++b)
#pragma unroll
            for (int m = 0; m < 4; ++m)
#pragma unroll
                for (int n = 0; n < 2; ++n) acc[a][b][m][n] = (i32x4){0, 0, 0, 0};
}
template <class E> struct is_mixed { static constexpr bool v = false; };
typedef f32x4 Acc[2][2][4][2];
__device__ __forceinline__ void zero_acc(Acc& acc) {
#pragma unroll
    for (int a = 0; a < 2; ++a)
#pragma unroll
        for (int b = 0; b < 2; ++b)
#pragma unroll
            for (int m = 0; m < 4; ++m)
#pragma unroll
                for (int n = 0; n < 2; ++n) acc[a][b][m][n] = (f32x4){0.f, 0.f, 0.f, 0.f};
}

template <bool HALFN, class Sched, class Epi>
__device__ __forceinline__ void gemm_stream(LAS unsigned char* lds, const Sched& S, Epi& E) {
    const int tid = otid(), wid = __builtin_amdgcn_readfirstlane(tid >> 6), lane = tid & 63, wr = wid >> 2, wc = wid & 3, fr = lane & 15, fq = lane >> 4;
    int R0, C0; stage_rc(tid * 16, R0, C0);
    const int Rb0 = Epi::PERM ? ((R0 & ~31) + perm32(R0 & 31)) : R0;
    const unsigned ldsw = (unsigned)wid * 1024u;
    const int aoff = lds_byte(wr * 64 + fr, fq * 8), boff = lds_byte(wc * 32 + fr, fq * 8);
#define GM_SA(b, h) (((b) * 2 + (h)) * HTB)
#define GM_SB(b, h) ((4 + (b) * 2 + (h)) * HTB)
#define GM_STAGE(bufoff, gbase, voff, ld2) do { _Pragma("unroll") for (int _i = 0; _i < 2; ++_i) \
        __builtin_amdgcn_global_load_lds((const unsigned*)((const char*)(gbase) + (size_t)_i * 64 * (ld2) + (voff)), (LAS unsigned*)(lds + (bufoff) + ldsw + _i * 8192), 16, 0, 0); } while (0)
#define GM_LDA(dst, b, h) do { _Pragma("unroll") for (int m = 0; m < 4; ++m) _Pragma("unroll") for (int k = 0; k < 2; ++k) dst[m][k] = *(const LAS bf16x8*)(lds + GM_SA(b, h) + aoff + m * 2048 + k * 1024); } while (0)
#define GM_LDB(dst, b, h) do { _Pragma("unroll") for (int n = 0; n < 2; ++n) _Pragma("unroll") for (int k = 0; k < 2; ++k) dst[n][k] = *(const LAS bf16x8*)(lds + GM_SB(b, h) + boff + n * 2048 + k * 1024); } while (0)
#define GM_MMA_I8(ai, bj, At, Bt) do { _Pragma("unroll") for (int m = 0; m < 4; ++m) _Pragma("unroll") for (int n = 0; n < 2; ++n) _Pragma("unroll") for (int k = 0; k < 2; ++k) \
        acc[ai][bj][m][n] = __builtin_bit_cast(typename Epi::AccT_elem, __builtin_amdgcn_mfma_i32_16x16x64_i8(__builtin_bit_cast(i32x4, Bt[n][k]), __builtin_bit_cast(i32x4, At[m][k]), __builtin_bit_cast(i32x4, acc[ai][bj][m][n]), 0, 0, 0)); } while (0)
#define GM_MMA_BF(ai, bj, At, Bt) do { _Pragma("unroll") for (int m = 0; m < 4; ++m) _Pragma("unroll") for (int n = 0; n < 2; ++n) _Pragma("unroll") for (int k = 0; k < 2; ++k) \
        acc[ai][bj][m][n] = __builtin_bit_cast(typename Epi::AccT_elem, __builtin_amdgcn_mfma_f32_16x16x32_bf16(Bt[n][k], At[m][k], __builtin_bit_cast(f32x4, acc[ai][bj][m][n]), 0, 0, 0)); } while (0)
#define GM_MMA(ai, bj, At, Bt) do { __builtin_amdgcn_s_setprio(1); \
        if constexpr (is_mixed<Epi>::v) { if (cur_i8) GM_MMA_I8(ai, bj, At, Bt); else GM_MMA_BF(ai, bj, At, Bt); } \
        else if constexpr (Epi::I8) GM_MMA_I8(ai, bj, At, Bt); else GM_MMA_BF(ai, bj, At, Bt); \
        __builtin_amdgcn_s_setprio(0); } while (0)
#define GM_WAIT_V(n) asm volatile("s_waitcnt vmcnt(" #n ")" ::: "memory")
#define GM_WAIT_L(n) asm volatile("s_waitcnt lgkmcnt(" #n ")" ::: "memory")
#define GM_BAR __builtin_amdgcn_s_barrier()
#define GM_SCHED __builtin_amdgcn_sched_barrier(0)
    Unit cur, nxt; int ui = 0;
    if (!S.next(0, cur)) return;
    typename Epi::AccT acc;
    bf16x8 At[4][2], B0[2][2], B1[2][2];
    unsigned voffA = (unsigned)R0 * cur.lda2 + (unsigned)C0 * 2u, voffB = (unsigned)Rb0 * cur.ldb2 + (unsigned)C0 * 2u;
    const char* cA = cur.A; const char* cB = cur.B;
    {
        const size_t hA = (size_t)HALF * cur.lda2, hB = (size_t)HALF * cur.ldb2;
        GM_STAGE(GM_SB(0, 0), cB, voffB, cur.ldb2); GM_STAGE(GM_SA(0, 0), cA, voffA, cur.lda2);
        if constexpr (!HALFN) GM_STAGE(GM_SB(0, 1), cB + hB, voffB, cur.ldb2);
        GM_STAGE(GM_SA(0, 1), cA + hA, voffA, cur.lda2);
        if (wr == 1) GM_BAR;
        if constexpr (HALFN) GM_WAIT_V(2); else GM_WAIT_V(4);
        GM_BAR;
        GM_STAGE(GM_SB(1, 0), cB + 128, voffB, cur.ldb2); GM_STAGE(GM_SA(1, 0), cA + 128, voffA, cur.lda2);
        if constexpr (!HALFN) GM_STAGE(GM_SB(1, 1), cB + hB + 128, voffB, cur.ldb2);
        if constexpr (HALFN) GM_WAIT_V(4); else GM_WAIT_V(6);
        GM_BAR;
    }
#define GM_UNIT(BJ) { \
        if constexpr (HALFN) { _Pragma("unroll") for (int _a = 0; _a < 2; ++_a) _Pragma("unroll") for (int _m = 0; _m < 4; ++_m) _Pragma("unroll") for (int _n = 0; _n < 2; ++_n) acc[_a][0][_m][_n] = (f32x4){0.f, 0.f, 0.f, 0.f}; } \
        else zero_acc(acc); \
        const bool cur_i8 = (cur.tag & 1) == 0; (void)cur_i8; \
        const bool has_next = S.next(ui + 1, nxt); \
        const char* nA = has_next ? nxt.A : cA; const char* nB = has_next ? nxt.B : cB; \
        const unsigned nlda2 = has_next ? nxt.lda2 : cur.lda2, nldb2 = has_next ? nxt.ldb2 : cur.ldb2; \
        const unsigned nvoffA = (unsigned)R0 * nlda2 + (unsigned)C0 * 2u, nvoffB = (unsigned)Rb0 * nldb2 + (unsigned)C0 * 2u; \
        const size_t hA = (size_t)HALF * cur.lda2, hB = (size_t)HALF * cur.ldb2, nhA = (size_t)HALF * nlda2, nhB = (size_t)HALF * nldb2; \
        const int nt = cur.nt; \
        for (int t = 0; t < nt; t += 2) { \
            const bool last = (t == nt - 2); \
            const char* a1 = cA + (size_t)(t + 1) * 128; \
            const char* a2 = last ? nA : cA + (size_t)(t + 2) * 128; const char* b2 = last ? nB : cB + (size_t)(t + 2) * 128; \
            const char* a3 = a2 + 128; const char* b3 = b2 + 128; \
            const unsigned vA2 = last ? nvoffA : voffA, vB2 = last ? nvoffB : voffB; \
            const unsigned lA2 = last ? nlda2 : cur.lda2, lB2 = last ? nldb2 : cur.ldb2; \
            const size_t hA2 = last ? nhA : hA, hB2 = last ? nhB : hB; \
              \
            GM_LDB(B0, 0, 0); GM_SCHED; GM_LDA(At, 0, 0); GM_STAGE(GM_SA(1, 1), a1 + hA, voffA, cur.lda2); \
            GM_WAIT_L(8); GM_BAR; GM_WAIT_L(0); GM_MMA(0, 0, At, B0); GM_BAR; GM_SCHED; \
              \
            if constexpr (!HALFN) GM_LDB(B1, 0, 1); \
            GM_STAGE(GM_SB(0, 0), b2, vB2, lB2); \
            GM_BAR; GM_WAIT_L(0); if constexpr (!HALFN) GM_MMA(0, 1, At, B1); GM_BAR; \
              \
            GM_LDA(At, 0, 1); GM_STAGE(GM_SA(0, 0), a2, vA2, lA2); \
            GM_BAR; GM_WAIT_L(0); GM_MMA(1, 0, At, B0); GM_BAR; GM_SCHED; \
              \
            if constexpr (!HALFN) { GM_STAGE(GM_SB(0, 1), b2 + hB2, vB2, lB2); GM_WAIT_V(6); } else { GM_WAIT_V(4); } \
            GM_BAR; if constexpr (!HALFN) GM_MMA(1, 1, At, B1); GM_BAR; \
              \
            GM_LDB(B0, 1, 0); GM_SCHED; GM_LDA(At, 1, 0); GM_STAGE(GM_SA(0, 1), a2 + hA2, vA2, lA2); \
            GM_WAIT_L(8); GM_BAR; GM_WAIT_L(0); GM_MMA(0, 0, At, B0); GM_BAR; GM_SCHED; \
              \
            if constexpr (!HALFN) GM_LDB(B1, 1, 1); \
            GM_STAGE(GM_SB(1, 0), b3, vB2, lB2); \
            GM_BAR; GM_WAIT_L(0); if constexpr (!HALFN) GM_MMA(0, 1, At, B1); GM_BAR; \
              \
            GM_LDA(At, 1, 1); GM_STAGE(GM_SA(1, 0), a3, vA2, lA2); \
            GM_BAR; GM_WAIT_L(0); GM_MMA(1, 0, At, B0); GM_BAR; GM_SCHED; \
              \
            if constexpr (!HALFN) { GM_STAGE(GM_SB(1, 1), b3 + hB2, vB2, lB2); GM_WAIT_V(6); } else { GM_WAIT_V(4); } \
            GM_BAR; if constexpr (!HALFN) GM_MMA(1, 1, At, B1); GM_BAR; \
        } \
        { const int tz_ = otid(); const int wz_ = __builtin_amdgcn_readfirstlane(tz_ >> 6), lz_ = tz_ & 63; E.template post<BJ>(acc, cur, wz_ >> 2, wz_ & 3, lz_ & 15, lz_ >> 4); } \
        if (!has_next) break; \
        cur = nxt; cA = nA; cB = nB; voffA = nvoffA; voffB = nvoffB; ++ui; \
    }
    for (;;) {
        GM_UNIT(0)
    }
    GM_WAIT_V(0);
    if (wr == 0) GM_BAR;
    GM_BAR;
#undef GM_UNIT
#undef GM_SA
#undef GM_SB
#undef GM_STAGE
#undef GM_LDA
#undef GM_LDB
#undef GM_MMA
#undef GM_MMA_I8
#undef GM_MMA_BF
#undef GM_WAIT_V
#undef GM_WAIT_L
#undef GM_BAR
#undef GM_SCHED
}
}

struct SchedPlain {
    gm::TileOrder T; const char* A; const char* B; unsigned lda2, ldb2; int nt;
    __device__ __forceinline__ bool next(int i, gm::Unit& u) const {
        int pm, pn; if (!T.tile(i, pm, pn)) return false;
        u.A = A + (size_t)pm * 256 * lda2; u.B = B + (size_t)pn * 256 * ldb2; u.lda2 = lda2; u.ldb2 = ldb2; u.nt = nt; u.pm = pm; u.pn = pn; u.tag = 0; return true;
    }
};
struct SchedSplitK {
    gm::TileOrder T; const char* A; const char* B; unsigned lda2, ldb2; int nt, xe;
    __device__ __forceinline__ bool next(int i, gm::Unit& u) const {
        int pm, pn; u.lda2 = lda2; u.ldb2 = ldb2;
        if (T.tile(i, pm, pn)) { u.A = A + (size_t)pm * 256 * lda2; u.B = B + (size_t)pn * 256 * ldb2; u.nt = nt; u.pm = pm; u.pn = pn; u.tag = 0; return true; }
        if (xe < 0 || i != 4) return false;
        const int e = xe >> 2, sl = xe & 3, ks = nt >> 2; pm = 128 + (e & 1); pn = e >> 1;
        u.A = A + (size_t)pm * 256 * lda2 + (size_t)sl * ks * 128; u.B = B + (size_t)pn * 256 * ldb2 + (size_t)sl * ks * 128; u.nt = ks; u.pm = pm; u.pn = pn; u.tag = 1 + sl; return true;
    }
};
struct SchedMergeG {
    gm::TileOrder T; const char* h8; const char* wg; int n, xe;
    __device__ __forceinline__ bool next(int i, gm::Unit& u) const {
        int pm, pn; if (!T.tile(i, pm, pn)) { if (xe < 0 || i != 4) return false; pm = 128 + (xe & 1); pn = xe >> 1; }
        u.A = h8 + (size_t)pm * 256 * 2048; u.lda2 = 2048; u.nt = 16; u.B = wg + ((size_t)n * 2048 + (size_t)pn * 256) * 2048; u.ldb2 = 2048; u.pm = pm; u.pn = pn; u.tag = n; return true;
    }
};
struct SchedMergeY {
    gm::TileOrder T; const char* ybr; const char* wbr; int n, xe;
    __device__ __forceinline__ bool next(int i, gm::Unit& u) const {
        int pm, pn; if (!T.tile(i, pm, pn)) { if (xe < 0 || i != 4) return false; pm = 128 + (xe & 1); pn = xe >> 1; }
        u.A = ybr + (size_t)n * MALL * 1024 + (size_t)pm * 256 * 1024; u.lda2 = 1024; u.nt = 8; u.B = wbr + ((size_t)n * 2048 + (size_t)pn * 256) * 1024; u.ldb2 = 1024; u.pm = pm; u.pn = pn; u.tag = n; return true;
    }
};

struct EpiGateUp {
    static constexpr bool PERM = true, I8 = false; typedef gm::Acc AccT; typedef f32x4 AccT_elem; bf16_t* act;
    template <int BJ> __device__ __forceinline__ void post(gm::Acc& acc, const gm::Unit& u, int wr, int wc, int fr, int fq) {
        const int row0 = u.pm * 256 + wr * 64 + fr, col0 = u.pn * 128 + wc * 32 + 8 * fq;
#pragma unroll
        for (int ai = 0; ai < 2; ++ai)
#pragma unroll
            for (int m = 0; m < 4; ++m) {
                float v[8];
#pragma unroll
                for (int n = 0; n < 2; ++n)
#pragma unroll
                    for (int j = 0; j < 4; ++j) v[n * 4 + j] = siluf_(acc[ai][0][m][n][j]) * acc[ai][1][m][n][j];
                u32x4 w; w.x = cvt_pk_bf16(v[0], v[1]); w.y = cvt_pk_bf16(v[2], v[3]); w.z = cvt_pk_bf16(v[4], v[5]); w.w = cvt_pk_bf16(v[6], v[7]);
                *(u32x4*)(act + (size_t)(row0 + ai * 128 + m * 16) * DFF + col0) = w;
            }
    }
};
struct EpiGateUpI8 {
    static constexpr bool PERM = true, I8 = true; typedef gm::AccI AccT; typedef i32x4 AccT_elem; bf16_t* act; const float* hsc; const float* wsc;
    template <int BJ> __device__ __forceinline__ void post(gm::AccI& acc, const gm::Unit& u, int wr, int wc, int fr, int fq) {
        const int row0 = u.pm * 256 + wr * 64 + fr, col0 = u.pn * 128 + wc * 32 + 8 * fq, wrow = u.pn * 256 + wc * 32 + 8 * fq;
        float sg[8], su[8];
#pragma unroll
        for (int j = 0; j < 8; ++j) { sg[j] = wsc[wrow + j]; su[j] = wsc[wrow + 128 + j]; }
        float hsv[8];
#pragma unroll
        for (int i = 0; i < 8; ++i) hsv[i] = hsc[row0 + (i >> 2) * 128 + (i & 3) * 16];
#pragma unroll
        for (int ai = 0; ai < 2; ++ai)
#pragma unroll
            for (int m = 0; m < 4; ++m) {
                const int row = row0 + ai * 128 + m * 16; const float hs = hsv[ai * 4 + m];
                float v[8];
#pragma unroll
                for (int n = 0; n < 2; ++n)
#pragma unroll
                    for (int j = 0; j < 4; ++j) { const float g = (float)acc[ai][0][m][n][j] * (hs * sg[n * 4 + j]), up = (float)acc[ai][1][m][n][j] * (hs * su[n * 4 + j]); v[n * 4 + j] = siluf_(g) * up; }
                u32x4 w; w.x = cvt_pk_bf16(v[0], v[1]); w.y = cvt_pk_bf16(v[2], v[3]); w.z = cvt_pk_bf16(v[4], v[5]); w.w = cvt_pk_bf16(v[6], v[7]);
                *(u32x4*)(act + (size_t)row * DFF + col0) = w;
            }
    }
};
struct EpiStore {
    static constexpr bool PERM = true, I8 = false; typedef gm::Acc AccT; typedef f32x4 AccT_elem; bf16_t* O; int ldc;
    template <int BJ> __device__ __forceinline__ void post(gm::Acc& acc, const gm::Unit& u, int wr, int wc, int fr, int fq) {
        const int row0 = u.pm * 256 + wr * 64 + fr, col0 = u.pn * 256 + wc * 32 + 8 * fq;
#pragma unroll
        for (int ai = 0; ai < 2; ++ai)
#pragma unroll
            for (int m = 0; m < 4; ++m)
#pragma unroll
                for (int bj = 0; bj < 2; ++bj) {
                    const f32x4 a = acc[ai][bj][m][0], b = acc[ai][bj][m][1];
                    u32x4 w; w.x = cvt_pk_bf16(a[0], a[1]); w.y = cvt_pk_bf16(a[2], a[3]); w.z = cvt_pk_bf16(b[0], b[1]); w.w = cvt_pk_bf16(b[2], b[3]);
                    *(u32x4*)(O + (size_t)(row0 + ai * 128 + m * 16) * ldc + col0 + bj * 128) = w;
                }
    }
};
struct EpiStoreK {
    static constexpr bool PERM = true, I8 = false; typedef gm::Acc AccT; typedef f32x4 AccT_elem; bf16_t* O; float* yp;
    template <int BJ> __device__ __forceinline__ void post(gm::Acc& acc, const gm::Unit& u, int wr, int wc, int fr, int fq) {
        const int row0 = u.pm * 256 + wr * 64 + fr, col0 = u.pn * 256 + wc * 32 + 8 * fq;
        if (u.tag == 0) {
#pragma unroll
            for (int ai = 0; ai < 2; ++ai)
#pragma unroll
                for (int m = 0; m < 4; ++m)
#pragma unroll
                    for (int bj = 0; bj < 2; ++bj) {
                        const f32x4 a = acc[ai][bj][m][0], b = acc[ai][bj][m][1];
                        u32x4 w; w.x = cvt_pk_bf16(a[0], a[1]); w.y = cvt_pk_bf16(a[2], a[3]); w.z = cvt_pk_bf16(b[0], b[1]); w.w = cvt_pk_bf16(b[2], b[3]);
                        *(u32x4*)(O + (size_t)(row0 + ai * 128 + m * 16) * DM + col0 + bj * 128) = w;
                    }
        } else {
            float* base = yp + (size_t)(u.tag - 1) * MCTX * DM;
#pragma unroll
            for (int ai = 0; ai < 2; ++ai)
#pragma unroll
                for (int m = 0; m < 4; ++m)
#pragma unroll
                    for (int bj = 0; bj < 2; ++bj) { float* o = base + (size_t)(row0 - MLAT + ai * 128 + m * 16) * DM + col0 + bj * 128;
                        *(f32x4*)o = acc[ai][bj][m][0]; *(f32x4*)(o + 4) = acc[ai][bj][m][1]; }
        }
    }
};
__device__ __forceinline__ void job_splitk_reduce(const float* yp, bf16_t* y) {
    const int c = obid(), tid = otid(), G = gridDim.x;
    for (int idx = c * 512 + tid; idx < MCTX * 256; idx += G * 512) { const int row = idx >> 8, q = idx & 255; f32x4 a = {0.f, 0.f, 0.f, 0.f}, b = a;
#pragma unroll
        for (int sl = 0; sl < 4; ++sl) { const float* s = yp + ((size_t)sl * MCTX + row) * DM + q * 8; a += *(const f32x4*)s; b += *(const f32x4*)(s + 4); }
        u32x4 o; o.x = cvt_pk_bf16(a[0], a[1]); o.y = cvt_pk_bf16(a[2], a[3]); o.z = cvt_pk_bf16(b[0], b[1]); o.w = cvt_pk_bf16(b[2], b[3]);
        *(u32x4*)(y + (size_t)(MLAT + row) * DM + q * 8) = o; }
}
__device__ __forceinline__ void rope4(f32x4& x0, f32x4& x1, const float* rope, int pos, int fq) {
    const f32x4 t0 = *(const f32x4*)(rope + pos * 32 + 8 * fq), t1 = *(const f32x4*)(rope + pos * 32 + 8 * fq + 4);
    const float c[4] = {t0[0], t0[2], t1[0], t1[2]}, s[4] = {t0[1], t0[3], t1[1], t1[3]};
#pragma unroll
    for (int j = 0; j < 4; ++j) { const float a = x0[j], b = x1[j]; x0[j] = a * c[j] - b * s[j]; x1[j] = a * s[j] + b * c[j]; }
}
__device__ __forceinline__ void rope4v(f32x4& x0, f32x4& x1, const f32x4 t0, const f32x4 t1) {
    const float c[4] = {t0[0], t0[2], t1[0], t1[2]}, s[4] = {t0[1], t0[3], t1[1], t1[3]};
#pragma unroll
    for (int j = 0; j < 4; ++j) { const float a = x0[j], b = x1[j]; x0[j] = a * c[j] - b * s[j]; x1[j] = a * s[j] + b * c[j]; }
}
struct EpiProj {
    static constexpr bool PERM = false, I8 = true; typedef gm::AccI AccT; typedef i32x4 AccT_elem; bf16_t* ubuf; bf16_t* km; const float* rope; const float* hsc; const float* wps;
    template <int BJ> __device__ __forceinline__ void post(gm::AccI& acc, const gm::Unit& u, int wr, int wc, int fr, int fq) {
        const int pn = u.pn; const bool lat = u.pm < 128, ropet = (pn >= 6 && pn <= 9), akr = (pn == 23);
        const int row0 = u.pm * 256 + wr * 64 + fr;
        f32x4 wsv[2][2];
#pragma unroll
        for (int bj = 0; bj < 2; ++bj)
#pragma unroll
            for (int n = 0; n < 2; ++n) wsv[bj][n] = *(const f32x4*)(wps + pn * 256 + bj * 128 + wc * 32 + 16 * n + 4 * fq);
        float hsv[8];
#pragma unroll
        for (int i = 0; i < 8; ++i) hsv[i] = hsc[row0 + (i >> 2) * 128 + (i & 3) * 16];
        const bool dor = lat && (ropet || (akr && wc < 2));
#pragma unroll
        for (int ai = 0; ai < 2; ++ai) {
            f32x4 rt[4][2];
            if (dor) {
#pragma unroll
                for (int m = 0; m < 4; ++m) { const int s = (row0 + ai * 128 + m * 16) & (SEQ - 1), pos = (wc & 1) ? (s & 63) : (s >> 6);
                    rt[m][0] = *(const f32x4*)(rope + pos * 32 + 8 * fq); rt[m][1] = *(const f32x4*)(rope + pos * 32 + 8 * fq + 4); }
            }
#pragma unroll
            for (int m = 0; m < 4; ++m) {
                const int row = row0 + ai * 128 + m * 16; const float hs = hsv[ai * 4 + m] * ((pn == 6 || pn == 7) ? DIFF_QC : 1.0f);
#pragma unroll
                for (int bj = 0; bj < 2; ++bj) {
                    f32x4 x0, x1;
#pragma unroll
                    for (int j = 0; j < 4; ++j) { x0[j] = (float)acc[ai][bj][m][0][j] * (hs * wsv[bj][0][j]); x1[j] = (float)acc[ai][bj][m][1][j] * (hs * wsv[bj][1][j]); }
                    const bool akr_blk = akr && bj == 0 && wc < 2;
                    if (lat && (ropet || akr_blk)) rope4v(x0, x1, rt[m][0], rt[m][1]);
                    u32x2 w0, w1; w0.x = cvt_pk_bf16(x0[0], x0[1]); w0.y = cvt_pk_bf16(x0[2], x0[3]); w1.x = cvt_pk_bf16(x1[0], x1[1]); w1.y = cvt_pk_bf16(x1[2], x1[3]);
                    if (!akr) { bf16_t* o = ubuf + (size_t)row * NU + pn * 256 + bj * 128 + wc * 32 + 4 * fq; *(u32x2*)o = w0; *(u32x2*)(o + 16) = w1; }
                    else if (akr_blk) {
#pragma unroll
                        for (int h = 0; h < 4; ++h) { bf16_t* o = km + (size_t)row * 768 + h * 192 + 128 + wc * 32 + 4 * fq; *(u32x2*)o = w0; *(u32x2*)(o + 16) = w1; }
                    }
                }
            }
        }
    }
};
struct EpiQup {
    static constexpr bool PERM = false, I8 = false; typedef gm::Acc AccT; typedef f32x4 AccT_elem; bf16_t* qm; const float* rsq; const float* rope;
    template <int BJ> __device__ __forceinline__ void post(gm::Acc& acc, const gm::Unit& u, int wr, int wc, int fr, int fq) {
        const bool lat = u.pm < 128; const int row0 = u.pm * 256 + wr * 64 + fr;
        float rsv[8];
#pragma unroll
        for (int i = 0; i < 8; ++i) rsv[i] = rsq[row0 + (i >> 2) * 128 + (i & 3) * 16];
#pragma unroll
        for (int ai = 0; ai < 2; ++ai)
#pragma unroll
            for (int m = 0; m < 4; ++m) {
                const int row = row0 + ai * 128 + m * 16, s = row & (SEQ - 1); const float rs = rsv[ai * 4 + m] * MLA_QC;
#pragma unroll
                for (int bj = 0; bj < 2; ++bj) {
                    const int b32 = 8 * u.pn + 4 * bj + wc, m6 = b32 % 6;
                    f32x4 x0 = acc[ai][bj][m][0] * rs, x1 = acc[ai][bj][m][1] * rs;
                    if (lat && m6 >= 4) rope4(x0, x1, rope, (m6 == 5) ? (s & 63) : (s >> 6), fq);
                    u32x2 w0, w1; w0.x = cvt_pk_bf16(x0[0], x0[1]); w0.y = cvt_pk_bf16(x0[2], x0[3]); w1.x = cvt_pk_bf16(x1[0], x1[1]); w1.y = cvt_pk_bf16(x1[2], x1[3]);
                    bf16_t* o = qm + (size_t)row * 768 + b32 * 32 + 4 * fq; *(u32x2*)o = w0; *(u32x2*)(o + 16) = w1;
                }
            }
    }
};
struct EpiKVup {
    static constexpr bool PERM = true, I8 = false; typedef gm::Acc AccT; typedef f32x4 AccT_elem; bf16_t* km; bf16_t* vm; const float* rsk;
    template <int BJ> __device__ __forceinline__ void post(gm::Acc& acc, const gm::Unit& u, int wr, int wc, int fr, int fq) {
        const int row0 = u.pm * 256 + wr * 64 + fr, h = u.pn, c0 = wc * 32 + 8 * fq;
        float rsv[8];
#pragma unroll
        for (int i = 0; i < 8; ++i) rsv[i] = rsk[row0 + (i >> 2) * 128 + (i & 3) * 16];
#pragma unroll
        for (int ai = 0; ai < 2; ++ai)
#pragma unroll
            for (int m = 0; m < 4; ++m) {
                const int row = row0 + ai * 128 + m * 16; const float rs = rsv[ai * 4 + m];
#pragma unroll
                for (int bj = 0; bj < 2; ++bj) {
                    const f32x4 a = acc[ai][bj][m][0] * rs, b = acc[ai][bj][m][1] * rs;
                    u32x4 w; w.x = cvt_pk_bf16(a[0], a[1]); w.y = cvt_pk_bf16(a[2], a[3]); w.z = cvt_pk_bf16(b[0], b[1]); w.w = cvt_pk_bf16(b[2], b[3]);
                    if (bj == 0) *(u32x4*)(km + (size_t)row * 768 + h * 192 + c0) = w; else *(u32x4*)(vm + (size_t)row * 512 + h * 128 + c0) = w;
                }
            }
    }
};
struct EpiRG {
    static constexpr bool PERM = true, I8 = false; typedef gm::Acc AccT; typedef f32x4 AccT_elem; const bf16_t* xcv; bf16_t* la; bf16_t* bb; const float* b_r; const float* b_i; const float* sp;
    template <int BJ> __device__ __forceinline__ void post(gm::Acc& acc, const gm::Unit& u, int wr, int wc, int fr, int fq) {
        const int d = u.pn >> 2, w0 = (u.pn & 3) * 128 + wc * 32 + 8 * fq, row0 = u.pm * 256 + wr * 64 + fr;
        float br[8], bi[8], sv[8];
#pragma unroll
        for (int j = 0; j < 8; ++j) { br[j] = b_r[d * 512 + w0 + j]; bi[j] = b_i[d * 512 + w0 + j]; sv[j] = sp[d * 512 + w0 + j]; }
        u32x4 xwv[8];
#pragma unroll
        for (int i = 0; i < 8; ++i) xwv[i] = *(const u32x4*)(xcv + (size_t)(row0 + (i >> 2) * 128 + (i & 3) * 16) * 512 + w0);
#pragma unroll
        for (int ai = 0; ai < 2; ++ai)
#pragma unroll
            for (int m = 0; m < 4; ++m) {
                const int row = row0 + ai * 128 + m * 16;
                const u32x4 xw = xwv[ai * 4 + m];
                const float xv[8] = {bflo(xw.x), bfhi(xw.x), bflo(xw.y), bfhi(xw.y), bflo(xw.z), bfhi(xw.z), bflo(xw.w), bfhi(xw.w)};
                float lo[8], bo[8];
#pragma unroll
                for (int n = 0; n < 2; ++n)
#pragma unroll
                    for (int j = 0; j < 4; ++j) {
                        const int k = n * 4 + j;
                        const float r = sigmoidf_(acc[ai][0][m][n][j] + br[k]), ig = sigmoidf_(acc[ai][1][m][n][j] + bi[k]);
                        const float l_a = -8.0f * r * sv[k], x2 = 2.0f * l_a;
                        const float om = (x2 > -0.3f) ? (-x2 * (1.0f + x2 * (0.5f + x2 * (0.16666667f + x2 * (0.041666668f + x2 * 0.0083333338f))))) : (1.0f - __expf(x2));
                        lo[k] = l_a; bo[k] = __builtin_amdgcn_sqrtf(om) * ig * xv[k];
                    }
                u32x4 wl, wb;
                wl.x = cvt_pk_bf16(lo[0], lo[1]); wl.y = cvt_pk_bf16(lo[2], lo[3]); wl.z = cvt_pk_bf16(lo[4], lo[5]); wl.w = cvt_pk_bf16(lo[6], lo[7]);
                wb.x = cvt_pk_bf16(bo[0], bo[1]); wb.y = cvt_pk_bf16(bo[2], bo[3]); wb.z = cvt_pk_bf16(bo[4], bo[5]); wb.w = cvt_pk_bf16(bo[6], bo[7]);
                *(u32x4*)(la + (size_t)row * 1024 + d * 512 + w0) = wl; *(u32x4*)(bb + (size_t)row * 1024 + d * 512 + w0) = wb;
            }
    }
};
struct EpiMergeG {
    static constexpr bool PERM = true, I8 = true; typedef gm::AccI AccT; typedef i32x4 AccT_elem; bf16_t* gtmp; const float* mb; const float* hsc; const float* wgs; bool bal; bf16_t* gx;
    template <int BJ> __device__ __forceinline__ void post(gm::AccI& acc, const gm::Unit& u, int wr, int wc, int fr, int fq) {
        const int col0 = u.pn * 256 + wc * 32 + 8 * fq, row0 = u.pm * 256 + wr * 64 + fr, nbr = u.tag;
        const bool ex = bal && u.pm >= 128; bf16_t* go = ex ? gx : gtmp; const int orow0 = ex ? nbr * 512 + row0 - MLAT : row0;
        f32x4 bv[2][2], sv[2][2];
#pragma unroll
        for (int bj = 0; bj < 2; ++bj)
#pragma unroll
            for (int n = 0; n < 2; ++n) { bv[bj][n] = *(const f32x4*)(mb + nbr * DM + col0 + bj * 128 + 4 * n); sv[bj][n] = *(const f32x4*)(wgs + nbr * DM + col0 + bj * 128 + 4 * n); }
        float hsv[8];
#pragma unroll
        for (int i = 0; i < 8; ++i) hsv[i] = hsc[row0 + (i >> 2) * 128 + (i & 3) * 16];
#pragma unroll
        for (int ai = 0; ai < 2; ++ai)
#pragma unroll
            for (int m = 0; m < 4; ++m) { const float hs = hsv[ai * 4 + m];
#pragma unroll
                for (int bj = 0; bj < 2; ++bj) { float g[8];
#pragma unroll
                    for (int n = 0; n < 2; ++n)
#pragma unroll
                        for (int j = 0; j < 4; ++j) g[n * 4 + j] = sigmoidf_((float)acc[ai][bj][m][n][j] * (hs * sv[bj][n][j]) + bv[bj][n][j]);
                    u32x4 w; w.x = cvt_pk_bf16(g[0], g[1]); w.y = cvt_pk_bf16(g[2], g[3]); w.z = cvt_pk_bf16(g[4], g[5]); w.w = cvt_pk_bf16(g[6], g[7]);
                    *(u32x4*)(go + (size_t)(orow0 + ai * 128 + m * 16) * DM + col0 + bj * 128) = w; } }
    }
};
struct EpiMergeY {
    static constexpr bool PERM = true, I8 = false; typedef gm::Acc AccT; typedef f32x4 AccT_elem; bf16_t* mrg; const bf16_t* gtmp; bool bal; const bf16_t* gx; bf16_t* part;
    template <int BJ> __device__ __forceinline__ void post(gm::Acc& acc, const gm::Unit& u, int wr, int wc, int fr, int fq) {
        const int col0 = u.pn * 256 + wc * 32 + 8 * fq, row0 = u.pm * 256 + wr * 64 + fr, nbr = u.tag;
        const bool ex = bal && u.pm >= 128; const bf16_t* gi = ex ? gx : gtmp; bf16_t* mo = ex ? part : mrg; const int orow0 = ex ? nbr * 512 + row0 - MLAT : row0;
        const bool rd = nbr > 0 && !ex;
#pragma unroll
        for (int ai = 0; ai < 2; ++ai) {
            u32x4 gwv[4][2], mwv[4][2];
#pragma unroll
            for (int m = 0; m < 4; ++m)
#pragma unroll
                for (int bj = 0; bj < 2; ++bj) { const size_t off = (size_t)(orow0 + ai * 128 + m * 16) * DM + col0 + bj * 128;
                    gwv[m][bj] = *(const u32x4*)(gi + off); mwv[m][bj] = (u32x4){0u, 0u, 0u, 0u}; if (rd) mwv[m][bj] = *(const u32x4*)(mo + off); }
#pragma unroll
            for (int m = 0; m < 4; ++m)
#pragma unroll
                for (int bj = 0; bj < 2; ++bj) {
                    const size_t off = (size_t)(orow0 + ai * 128 + m * 16) * DM + col0 + bj * 128;
                    const u32x4 gw = gwv[m][bj], mw = mwv[m][bj];
                    const float g[8] = {bflo(gw.x), bfhi(gw.x), bflo(gw.y), bfhi(gw.y), bflo(gw.z), bfhi(gw.z), bflo(gw.w), bfhi(gw.w)};
                    float mm[8] = {bflo(mw.x), bfhi(mw.x), bflo(mw.y), bfhi(mw.y), bflo(mw.z), bfhi(mw.z), bflo(mw.w), bfhi(mw.w)};
#pragma unroll
                    for (int n = 0; n < 2; ++n)
#pragma unroll
                        for (int j = 0; j < 4; ++j) mm[n * 4 + j] += g[n * 4 + j] * acc[ai][bj][m][n][j];
                    u32x4 w; w.x = cvt_pk_bf16(mm[0], mm[1]); w.y = cvt_pk_bf16(mm[2], mm[3]); w.z = cvt_pk_bf16(mm[4], mm[5]); w.w = cvt_pk_bf16(mm[6], mm[7]);
                    *(u32x4*)(mo + off) = w;
                }
        }
    }
};


struct KP { const float* in[30]; float* out; unsigned char* ws; int ph_lo, ph_hi; };
typedef const __attribute__((address_space(4))) KP CKP;
__device__ __forceinline__ LAS unsigned char* lds_here(unsigned char* raw) { unsigned a = (unsigned)(uintptr_t)(LAS unsigned char*)raw; asm volatile("" : "+s"(a)); return (LAS unsigned char*)(uintptr_t)a; }
__device__ __forceinline__ CKP& kp_here() { CKP* q = (CKP*)__builtin_amdgcn_kernarg_segment_ptr(); asm volatile("" : "+s"(q)); return *q; }
enum { I_X = 0, I_C, I_CTX, I_CCTX, I_ADAW, I_ADAB, I_PRE, I_POST, I_WG, I_WU, I_WDN, I_WIN, I_QNORM, I_WUQ, I_KVNORM, I_WUKV, I_CONVW, I_CONVB, I_RGWR, I_RGBR, I_RGWI, I_RGBI, I_RGLAM,
       I_DLAM, I_SUBLN, I_HLB, I_HNORM, I_MB, I_WBR, I_WOUT };

__device__ __forceinline__ void job_mod(CKP& p, LAS unsigned char* lds) {
    LAS float* sl = (LAS float*)lds;
    LAS float* red = (LAS float*)(lds + 24576);
    const int tid = otid(), lane = tid & 63, wave = tid >> 6;
    for (int i = tid; i < 3 * DM; i += NTHR) { const int g = i / DM, k = i % DM; const float c = g < 2 ? p.in[I_C][g * DM + k] : p.in[I_CCTX][k]; sl[i] = siluf_(c); }
    __syncthreads();
    float* mod = (float*)(p.ws + WS_MOD);
    for (int u = obid(); u < NL * 288; u += gridDim.x) {
        const int l = u / 288, col = (u % 288) * 64 + lane;
        const float* w = p.in[I_ADAW] + (size_t)l * DM * (NMOD * DM) + col;
        float a0 = 0.f, a1 = 0.f, a2 = 0.f;
        const int k0 = wave * 256;
#pragma unroll 1
        for (int k1 = k0; k1 < k0 + 256; k1 += 32) { float wv[32];
#pragma unroll
            for (int q = 0; q < 32; ++q) wv[q] = w[(size_t)(k1 + q) * (NMOD * DM)];
            asm volatile("" ::: "memory");
#pragma unroll
            for (int q = 0; q < 32; ++q) { const int k = k1 + q; a0 += sl[k] * wv[q]; a1 += sl[DM + k] * wv[q]; a2 += sl[2 * DM + k] * wv[q]; } }
        red[(wave * 3 + 0) * 64 + lane] = a0; red[(wave * 3 + 1) * 64 + lane] = a1; red[(wave * 3 + 2) * 64 + lane] = a2;
        __syncthreads();
        if (tid < 192) { const int g = tid >> 6; float s = 0.f;
#pragma unroll
            for (int w8 = 0; w8 < 8; ++w8) s += red[(w8 * 3 + g) * 64 + lane];
            mod[(size_t)(l * 3 + g) * (NMOD * DM) + col] = s + p.in[I_ADAB][l * (NMOD * DM) + col]; }
        __syncthreads();
    }
}
__device__ __forceinline__ void job_tables(CKP& p) {
    const int tid = otid();
    if (obid() == 0) {
        float* rope = (float*)(p.ws + WS_ROPE);
        for (int i = tid; i < 4096; i += NTHR) { const int pos = i >> 4, f = i & 15; const float inv = powf(10000.0f, -(float)f / 16.0f); const float ang = (float)pos * inv; float s, c; sincosf(ang, &s, &c); rope[2 * i] = c; rope[2 * i + 1] = s; }
    }
    if (obid() == 1 % gridDim.x) {
        float* sc = (float*)(p.ws + WS_SCAL);
        if (tid < NL) { const float* lv = p.in[I_DLAM] + tid * 256; float s01 = 0.f, s23 = 0.f; for (int i = 0; i < 64; ++i) { s01 += lv[i] * lv[64 + i]; s23 += lv[128 + i] * lv[192 + i]; }
            sc[tid] = expf(s01) - expf(s23) + (0.8f - 0.6f * expf(-0.3f * (float)tid)); }
        for (int k = tid; k < 512; k += NTHR) {
            float mx = -1e30f; for (int l = 0; l < NL; ++l) mx = fmaxf(mx, p.in[I_HLB][l * 512 + k]);
            float den = 0.f; for (int l = 0; l < NL; ++l) den += expf(p.in[I_HLB][l * 512 + k] - mx);
            float cum = 0.f; for (int l = 0; l < NL; ++l) { if (l > 0) cum += expf(p.in[I_HLB][l * 512 + k] - mx) / den; sc[256 + l * 512 + k] = cum; }
        }
        for (int i = tid; i < NL * 1024; i += NTHR) { const float x = -p.in[I_RGLAM][i]; sc[2048 + i] = fmaxf(x, 0.f) + log1pf(expf(-fabsf(x))); }
    }
}

__device__ __forceinline__ void job_colmax(CKP& p) {
    unsigned* cmax = (unsigned*)(p.ws + WS_CMAX);
    const int tid = otid(), c4 = (tid & 63) * 4, wv = tid >> 6;
    for (int u = obid(); u < NL * 2 * 2 * 22 * 4; u += gridDim.x) {
        const int kc = u & 3, cb = (u >> 2) % 22, mat = u / (4 * 22), which = mat & 1, lf = mat >> 1;
        const float* w = (which ? p.in[I_WU] : p.in[I_WG]) + (size_t)lf * DM * DFF + (size_t)(kc * 512 + wv * 64) * DFF + cb * 256 + c4;
        u32x4 mx = {0u, 0u, 0u, 0u};
#pragma unroll 1
        for (int k0 = 0; k0 < 64; k0 += 16) { u32x4 v[16];
#pragma unroll
            for (int k = 0; k < 16; ++k) v[k] = *(const u32x4*)(w + (size_t)(k0 + k) * DFF);
            asm volatile("" ::: "memory");
#pragma unroll
            for (int k = 0; k < 16; ++k) { mx.x = max(mx.x, v[k].x & 0x7fffffffu); mx.y = max(mx.y, v[k].y & 0x7fffffffu); mx.z = max(mx.z, v[k].z & 0x7fffffffu); mx.w = max(mx.w, v[k].w & 0x7fffffffu); } }
        unsigned* dst = cmax + (size_t)(lf * 2 + which) * DFF + cb * 256 + c4;
        atomicMax(dst, mx.x); atomicMax(dst + 1, mx.y); atomicMax(dst + 2, mx.z); atomicMax(dst + 3, mx.w);
    }
    unsigned* cmax2 = (unsigned*)(p.ws + WS_CMAX2);
    for (int u = obid(); u < NL * 56 * 4; u += gridDim.x) {
        const int kc = u & 3, cb = (u >> 2) % 56, l = u / (4 * 56), cc = cb * 256 + c4;
        if (cc < DIN) {
            const float* w = p.in[I_WIN] + (size_t)l * DM * DIN + (size_t)(kc * 512 + wv * 64) * DIN + cc;
            u32x4 mx = {0u, 0u, 0u, 0u};
#pragma unroll 1
            for (int k0 = 0; k0 < 64; k0 += 16) { u32x4 v[16];
#pragma unroll
                for (int k = 0; k < 16; ++k) v[k] = *(const u32x4*)(w + (size_t)(k0 + k) * DIN);
                asm volatile("" ::: "memory");
#pragma unroll
                for (int k = 0; k < 16; ++k) { mx.x = max(mx.x, v[k].x & 0x7fffffffu); mx.y = max(mx.y, v[k].y & 0x7fffffffu); mx.z = max(mx.z, v[k].z & 0x7fffffffu); mx.w = max(mx.w, v[k].w & 0x7fffffffu); } }
            unsigned* dst = cmax2 + (size_t)l * 14336 + cc;
            atomicMax(dst, mx.x); atomicMax(dst + 1, mx.y); atomicMax(dst + 2, mx.z); atomicMax(dst + 3, mx.w);
        }
    }
}
struct CvtDesc { const float* src; const float* ks; bf16_t* dst; int ldsrc, c0, k0, lddst, n0; const unsigned* q8max; float* q8scale; };
__device__ __forceinline__ void cvt_load(const CvtDesc& d, int tid, f32x4 (&v)[2]) {
    const int r = tid >> 4, c4 = (tid & 15) * 4;
#pragma unroll
    for (int ps = 0; ps < 2; ++ps) { const int k = r + 32 * ps; v[ps] = (f32x4){0.f, 0.f, 0.f, 0.f};
        if (d.src) { v[ps] = *(const f32x4*)(d.src + (size_t)(d.k0 + k) * d.ldsrc + d.c0 + c4); if (d.ks) v[ps] = v[ps] * d.ks[d.k0 + k]; } }
}
__device__ __forceinline__ void cvt_store(LAS float* tile, const CvtDesc& d, int tid, const f32x4 (&v)[2]) {
    { const int r = tid >> 4, c4 = (tid & 15) * 4;
#pragma unroll
      for (int ps = 0; ps < 2; ++ps) { const int k = r + 32 * ps; tile[k * 65 + c4 + 0] = v[ps][0]; tile[k * 65 + c4 + 1] = v[ps][1]; tile[k * 65 + c4 + 2] = v[ps][2]; tile[k * 65 + c4 + 3] = v[ps][3]; } }
    __syncthreads();
    { const int n = tid >> 3, k8 = (tid & 7) * 8; float x[8];
#pragma unroll
      for (int i = 0; i < 8; ++i) x[i] = tile[(k8 + i) * 65 + n];
      if (d.q8max) {
          const float mx = fmaxf(__uint_as_float(d.q8max[n]), 1e-30f), inv = 127.0f / mx;
          int q[8];
#pragma unroll
          for (int i = 0; i < 8; ++i) q[i] = (int)rintf(x[i] * inv) & 0xff;
          u32x2 w; w.x = (unsigned)q[0] | ((unsigned)q[1] << 8) | ((unsigned)q[2] << 16) | ((unsigned)q[3] << 24); w.y = (unsigned)q[4] | ((unsigned)q[5] << 8) | ((unsigned)q[6] << 16) | ((unsigned)q[7] << 24);
          *(u32x2*)((signed char*)d.dst + (size_t)(d.n0 + n) * d.lddst + d.k0 + k8) = w;
          if (d.k0 == 0 && k8 == 0) d.q8scale[n] = mx * (1.0f / 127.0f);
      } else {
          u32x4 w; w.x = cvt_pk_bf16(x[0], x[1]); w.y = cvt_pk_bf16(x[2], x[3]); w.z = cvt_pk_bf16(x[4], x[5]); w.w = cvt_pk_bf16(x[6], x[7]);
          *(u32x4*)(d.dst + (size_t)(d.n0 + n) * d.lddst + d.k0 + k8) = w; } }
    __syncthreads();
}
constexpr int CV_N0 = 2 * 176 * 32, CV_N1 = 2 * 32 * 88, CV_N2 = 224 * 32, CV_N3 = 12 * 8, CV_N4 = 16 * 4, CV_N5 = 4 * 32 * 8, CV_N6 = 32 * 32, CV_N7 = 1024;
constexpr int CV_BLOCKS = CV_N0 + CV_N1 + CV_N2 + CV_N3 + CV_N4 + CV_N5 + CV_N6;
__device__ __forceinline__ CvtDesc cvt_desc(CKP& p, int l, int b) {
    unsigned char* ws = p.ws; CvtDesc d; d.ks = nullptr; d.q8max = nullptr; d.q8scale = nullptr;
    if (b < CV_N0) { const int f = b / (176 * 32), rem = b % (176 * 32), nb = rem / 32, kb = rem % 32, t = nb >> 2, q = nb & 3;
        d.src = (q < 2 ? p.in[I_WG] : p.in[I_WU]) + (size_t)(l * 2 + f) * DM * DFF; d.ldsrc = DFF; d.c0 = 128 * t + (q & 1) * 64; d.k0 = kb * 64; d.dst = (bf16_t*)(ws + WS_WGU + (size_t)f * 11264 * 2048); d.lddst = 2048; d.n0 = nb * 64;
        d.q8max = (const unsigned*)(ws + WS_CMAX) + (size_t)((l * 2 + f) * 2 + (q < 2 ? 0 : 1)) * DFF + d.c0; d.q8scale = (float*)(ws + WS_WSC) + (size_t)f * 11264 + d.n0; return d; }
    b -= CV_N0;
    if (b < CV_N1) { const int f = b / (32 * 88), rem = b % (32 * 88), nb = rem / 88, kb = rem % 88;
        d.src = p.in[I_WDN] + (size_t)(l * 2 + f) * DFF * DM; d.ldsrc = DM; d.c0 = nb * 64; d.k0 = kb * 64; d.dst = (bf16_t*)(ws + WS_WD) + (size_t)f * 2048 * 5632; d.lddst = 5632; d.n0 = nb * 64; return d; }
    b -= CV_N1;
    if (b < CV_N2) { const int nb = b / 32, kb = b % 32, j0 = nb * 64; int sc;
        if (j0 < 512) sc = j0; else if (j0 < 5632) sc = 832 + (j0 - 512); else if (j0 < 5888) sc = 512 + (j0 - 5632); else if (j0 < 5952) sc = 768 + (j0 - 5888); else if (j0 < 6144) sc = -1; else sc = 5952 + (j0 - 6144);
        d.src = sc < 0 ? nullptr : p.in[I_WIN] + (size_t)l * DM * DIN; d.ldsrc = DIN; d.c0 = sc < 0 ? 0 : sc; d.k0 = kb * 64; d.dst = (bf16_t*)(ws + WS_WIN); d.lddst = 2048; d.n0 = j0;
        d.q8max = (const unsigned*)(ws + WS_CMAX2) + (size_t)l * 14336 + (sc < 0 ? DIN : sc);
        d.q8scale = j0 < 6144 ? (float*)(ws + WS_WPS) + j0 : (float*)(ws + WS_WGS) + (j0 - 6144);
        return d; }
    b -= CV_N2;
    if (b < CV_N3) { const int nb = b / 8, kb = b % 8;
        d.src = p.in[I_WUQ] + (size_t)l * 512 * 768; d.ldsrc = 768; d.c0 = nb * 64; d.k0 = kb * 64; d.ks = p.in[I_QNORM] + l * 512; d.dst = (bf16_t*)(ws + WS_WUQ); d.lddst = 512; d.n0 = nb * 64; return d; }
    b -= CV_N3;
    if (b < CV_N4) { const int nb = b / 4, kb = b % 4;
        d.src = p.in[I_WUKV] + (size_t)l * 256 * 1024; d.ldsrc = 1024; d.c0 = nb * 64; d.k0 = kb * 64; d.ks = p.in[I_KVNORM] + l * 256; d.dst = (bf16_t*)(ws + WS_WUKV); d.lddst = 256; d.n0 = nb * 64; return d; }
    b -= CV_N4;
    if (b < CV_N5) { const int n = b / 256, rem = b % 256, nb = rem / 8, kb = rem % 8;
        d.src = p.in[I_WBR] + (size_t)(l * 4 + n) * 512 * DM; d.ldsrc = DM; d.c0 = nb * 64; d.k0 = kb * 64; d.dst = (bf16_t*)(ws + WS_WBR) + (size_t)n * 2048 * 512; d.lddst = 512; d.n0 = nb * 64; return d; }
    b -= CV_N5;
    { const int nb = b / 32, kb = b % 32;
        d.src = p.in[I_WOUT] + (size_t)l * DM * DM; d.ldsrc = DM; d.c0 = nb * 64; d.k0 = kb * 64; d.dst = (bf16_t*)(ws + WS_WOUT); d.lddst = 2048; d.n0 = nb * 64; return d; }
}
__device__ __forceinline__ void job_convert(CKP& p, LAS unsigned char* lds, int l) {
    LAS float* tile = (LAS float*)lds;
    const int tid = otid();
    {
        int u = obid();
        if (u < CV_BLOCKS) {
            f32x4 vc[2]; { const CvtDesc d0 = cvt_desc(p, l, u); cvt_load(d0, tid, vc); }
            for (;;) {
                const int un = u + gridDim.x; const bool more = un < CV_BLOCKS;
                f32x4 vn[2] = {vc[0], vc[1]};
                if (more) { const CvtDesc dn = cvt_desc(p, l, un); cvt_load(dn, tid, vn); }
                { const CvtDesc dc = cvt_desc(p, l, u); cvt_store(tile, dc, tid, vc); }
                if (!more) break;
                vc[0] = vn[0]; vc[1] = vn[1]; u = un;
            }
        }
    }
    for (int b = obid(); b < CV_N7; b += gridDim.x) {
        bf16_t* dst = (bf16_t*)(p.ws + WS_WRG);
#pragma unroll
        for (int e = 0; e < 2; ++e) { const int idx = b * 1024 + e * 512 + tid, o = idx >> 9, k = idx & 511;
            const int t8 = o >> 8, d = t8 >> 2, blk = t8 & 3, g = (o >> 7) & 1, i = o & 127, kin = k - blk * 128;
            float v = 0.f; if (kin >= 0 && kin < 128) v = (g ? p.in[I_RGWI] : p.in[I_RGWR])[((size_t)((l * 2 + d) * 4 + blk) * 128 + kin) * 128 + i];
            dst[idx] = f2bf(v); }
    }
}

struct RNArgs {
    const float* xs_lat; const float* xs_ctx; float* xd_lat; float* xd_ctx;
    const bf16_t* y; float wres;
    const float* modl_res; int jres; const float* postg;
    bool do_norm; const float* modl_norm; int jn; const float* preg; bf16_t* h; int nrows; signed char* h8; float* hsc;
};
__device__ __forceinline__ void job_resnorm(const RNArgs& a, LAS unsigned char* lds) {
    const int tid_ = otid(); const int lane = tid_ & 63, gw = obid() * 8 + (tid_ >> 6), nw = gridDim.x * 8;
    LAS float* PA = (LAS float*)lds; LAS float* PB = PA + 3 * DM; LAS float* PC = PB + 3 * DM;
    for (int i = tid_; i < 3 * DM; i += NTHR) { const int g = i / DM, c = i % DM;
        if (a.y) PA[i] = a.modl_res[(size_t)g * (NMOD * DM) + (3 * a.jres + 2) * DM + c] * a.postg[c];
        if (a.do_norm) { const float* sh = a.modl_norm + (size_t)g * (NMOD * DM) + (3 * a.jn) * DM; PB[i] = a.preg[c] * (sh[DM + c] + 1.0f); PC[i] = sh[c]; } }
    __syncthreads();
    f32x4 xq[8]; u32x2 yq[8];
#define RN_LOAD(R, X, Y) do { const int r_ = (R); const float* xs_ = r_ < MLAT ? a.xs_lat + (size_t)r_ * DM : a.xs_ctx + (size_t)(r_ - MLAT) * DM; \
        _Pragma("unroll") for (int i = 0; i < 8; ++i) X[i] = *(const f32x4*)(xs_ + i * 256 + lane * 4); \
        if (a.y) { _Pragma("unroll") for (int i = 0; i < 8; ++i) Y[i] = *(const u32x2*)(a.y + (size_t)r_ * DM + i * 256 + lane * 4); } } while (0)
    if (gw < a.nrows) RN_LOAD(gw, xq, yq);
    for (int r = gw; r < a.nrows; r += nw) {
        const int g = r < SEQ ? 0 : (r < MLAT ? 1 : 2); const bool lat = r < MLAT;
        f32x4 x[8]; u32x2 yr[8];
#pragma unroll
        for (int i = 0; i < 8; ++i) { x[i] = xq[i]; yr[i] = yq[i]; }
        RN_LOAD(r + nw < a.nrows ? r + nw : r, xq, yq);
        if (a.y) {
            f32x4 yv[8]; float ss = 0.f;
#pragma unroll
            for (int i = 0; i < 8; ++i) { const u32x2 w = yr[i]; yv[i] = (f32x4){bflo(w.x), bfhi(w.x), bflo(w.y), bfhi(w.y)}; ss += yv[i][0] * yv[i][0] + yv[i][1] * yv[i][1] + yv[i][2] * yv[i][2] + yv[i][3] * yv[i][3]; }
            ss = wave_sum(ss, lane);
            const float rr = a.wres * rsqrtf(ss * (1.0f / DM) + EPS);
            float* xd = lat ? a.xd_lat + (size_t)r * DM : a.xd_ctx + (size_t)(r - MLAT) * DM;
#pragma unroll
            for (int i = 0; i < 8; ++i) { const int c = i * 256 + lane * 4; const f32x4 gp = *(const LAS f32x4*)(PA + g * DM + c);
                x[i] = x[i] + gp * (yv[i] * rr); *(f32x4*)(xd + c) = x[i]; }
        }
        if (a.do_norm) {
            float ss = 0.f;
#pragma unroll
            for (int i = 0; i < 8; ++i) ss += x[i][0] * x[i][0] + x[i][1] * x[i][1] + x[i][2] * x[i][2] + x[i][3] * x[i][3];
            ss = wave_sum(ss, lane);
            const float rr = rsqrtf(ss * (1.0f / DM) + EPS);
            float mx = 0.f;
#pragma unroll
            for (int i = 0; i < 8; ++i) { const int c = i * 256 + lane * 4; const f32x4 ps = *(const LAS f32x4*)(PB + g * DM + c), hv = *(const LAS f32x4*)(PC + g * DM + c);
                x[i] = (x[i] * rr) * ps + hv; mx = fmaxf(mx, fmaxf(fmaxf(fabsf(x[i][0]), fabsf(x[i][1])), fmaxf(fabsf(x[i][2]), fabsf(x[i][3]))));
                if (a.h) { u32x2 w; w.x = cvt_pk_bf16(x[i][0], x[i][1]); w.y = cvt_pk_bf16(x[i][2], x[i][3]); *(u32x2*)(a.h + (size_t)r * DM + c) = w; } }
            if (a.h8) {
#pragma unroll
                for (int o = 32; o >= 1; o >>= 1) mx = fmaxf(mx, shx(mx, o, lane));
                mx = fmaxf(mx, 1e-30f); const float inv = 127.0f / mx;
                if (lane == 0) a.hsc[r] = mx * (1.0f / 127.0f);
#pragma unroll
                for (int i = 0; i < 8; ++i) { const unsigned q0 = (unsigned)((int)rintf(x[i][0] * inv) & 0xff), q1 = (unsigned)((int)rintf(x[i][1] * inv) & 0xff), q2 = (unsigned)((int)rintf(x[i][2] * inv) & 0xff), q3 = (unsigned)((int)rintf(x[i][3] * inv) & 0xff);
                    *(unsigned*)(a.h8 + (size_t)r * DM + i * 256 + lane * 4) = q0 | (q1 << 8) | (q2 << 16) | (q3 << 24); }
            }
        }
    }
    __syncthreads();
#undef RN_LOAD
}

__device__ __forceinline__ void job_stats_conv(CKP& p, int l) {
    const bf16_t* ubuf = (const bf16_t*)(p.ws + WS_R1); float* rsq = (float*)(p.ws + WS_RSQ); float* rsk = rsq + MALL; bf16_t* xcv = (bf16_t*)(p.ws + WS_XCV);
    const int tid_ = otid(); const int lane = tid_ & 63, gw = obid() * 8 + (tid_ >> 6), nw = gridDim.x * 8;
    float cw[4][8], cb[8];
#pragma unroll
    for (int j = 0; j < 4; ++j)
#pragma unroll
        for (int i = 0; i < 8; ++i) cw[j][i] = p.in[I_CONVW][(l * 4 + j) * 512 + lane * 8 + i];
#pragma unroll
    for (int i = 0; i < 8; ++i) cb[i] = p.in[I_CONVB][l * 512 + lane * 8 + i];
    for (int r = gw; r < MALL; r += nw) {
        const bf16_t* ur = ubuf + (size_t)r * NU;
        const bool lat = r < MLAT; const int s = lat ? (r & (SEQ - 1)) : ((r - MLAT) & (CTXL - 1)), len = lat ? SEQ : CTXL;
        const u32x4 w = *(const u32x4*)(ur + U_AQ + lane * 8); const u32x4 w2 = *(const u32x4*)(ur + U_AKV + (lane & 31) * 8);
        u32x4 wt[4]; float okf[4];
#pragma unroll
        for (int j = 0; j < 4; ++j) { const int sj = s + j - 2; const bool ok = sj >= 0 && sj < len; okf[j] = ok ? 1.0f : 0.0f;
            wt[j] = *(const u32x4*)(ur + (ptrdiff_t)(ok ? j - 2 : 0) * NU + U_BX + lane * 8); }
        asm volatile("" ::: "memory");
        {
            float ss = 0.f;
            { const float v[8] = {bflo(w.x), bfhi(w.x), bflo(w.y), bfhi(w.y), bflo(w.z), bfhi(w.z), bflo(w.w), bfhi(w.w)};
#pragma unroll
              for (int i = 0; i < 8; ++i) ss += v[i] * v[i]; }
            ss = wave_sum(ss, lane);
            float s2 = 0.f;
            { const float v[8] = {bflo(w2.x), bfhi(w2.x), bflo(w2.y), bfhi(w2.y), bflo(w2.z), bfhi(w2.z), bflo(w2.w), bfhi(w2.w)};
#pragma unroll
              for (int i = 0; i < 8; ++i) s2 += v[i] * v[i]; }
            s2 = lane < 32 ? s2 : 0.f;
            s2 = wave_sum(s2, lane);
            if (lane == 0) { rsq[r] = rsqrtf(ss * (1.0f / 512.0f) + EPS); rsk[r] = rsqrtf(s2 * (1.0f / 256.0f) + EPS); }
        }
        {
            float acc[8];
#pragma unroll
            for (int i = 0; i < 8; ++i) acc[i] = cb[i];
#pragma unroll
            for (int j = 0; j < 4; ++j) { const u32x4 wj = wt[j];
                const float v[8] = {bflo(wj.x), bfhi(wj.x), bflo(wj.y), bfhi(wj.y), bflo(wj.z), bfhi(wj.z), bflo(wj.w), bfhi(wj.w)};
#pragma unroll
                for (int i = 0; i < 8; ++i) acc[i] += (cw[j][i] * okf[j]) * v[i]; }
            u32x4 o; o.x = cvt_pk_bf16(acc[0], acc[1]); o.y = cvt_pk_bf16(acc[2], acc[3]); o.z = cvt_pk_bf16(acc[4], acc[5]); o.w = cvt_pk_bf16(acc[6], acc[7]);
            *(u32x4*)(xcv + (size_t)r * 512 + lane * 8) = o;
        }
    }
}

__device__ __forceinline__ void job_rg_scan1(CKP& p) {
    const bf16_t* la = (const bf16_t*)(p.ws + WS_LA); const bf16_t* bb = (const bf16_t*)(p.ws + WS_BB); f32x2* rgs = (f32x2*)(p.ws + WS_RGS);
    const int w = otid();
    for (int u = obid(); u < NRT * 2; u += gridDim.x) {
        const int pm = u >> 1, d = u & 1;
        const bf16_t* lp = la + (size_t)pm * 256 * 1024 + d * 512 + w; const bf16_t* bp = bb + (size_t)pm * 256 * 1024 + d * 512 + w;
        float H = 0.f, sl = 0.f;
#pragma unroll 1
        for (int i0 = 0; i0 < 256; i0 += 32) { bf16_t lr[32], br[32];
#pragma unroll
            for (int q = 0; q < 32; ++q) { const int t = d ? 255 - (i0 + q) : i0 + q; lr[q] = lp[(size_t)t * 1024]; br[q] = bp[(size_t)t * 1024]; }
            asm volatile("" ::: "memory");
#pragma unroll
            for (int q = 0; q < 32; ++q) { const float lv = bf2f(lr[q]); H = __expf(lv) * H + bf2f(br[q]); sl += lv; } }
        rgs[(size_t)u * 512 + w] = (f32x2){__expf(sl), H};
    }
}
__device__ __forceinline__ void job_rg_out(CKP& p, int ntiles) {
    const bf16_t* la = (const bf16_t*)(p.ws + WS_LA); const bf16_t* bb = (const bf16_t*)(p.ws + WS_BB); const f32x2* rgs = (const f32x2*)(p.ws + WS_RGS);
    bf16_t* hf = (bf16_t*)(p.ws + WS_XCV); const bf16_t* ubuf = (const bf16_t*)(p.ws + WS_R1); bf16_t* yb = (bf16_t*)(p.ws + WS_YBR) + (size_t)1 * MALL * 512;
    const int w = otid();
    for (int u = obid(); u < ntiles; u += gridDim.x) {
        const int pm = (int)gridDim.x > ntiles ? u : u;
        const bool isctx = pm >= 128; const int b = isctx ? pm - 128 : (pm >> 6);
        float h = 0.f;
        if (!isctx) { h = rgs[(size_t)((128 + b) * 2 + 0) * 512 + w][1];
#pragma unroll 1
            for (int q0 = b * 64; q0 < pm; q0 += 16) { f32x2 sv[16];
#pragma unroll
                for (int k = 0; k < 16; ++k) { const int q = q0 + k < pm ? q0 + k : pm - 1; sv[k] = rgs[(size_t)(q * 2 + 0) * 512 + w]; }
                asm volatile("" ::: "memory");
#pragma unroll
                for (int k = 0; k < 16; ++k) if (q0 + k < pm) h = sv[k][0] * h + sv[k][1]; } }
        const size_t r0 = (size_t)pm * 256;
#pragma unroll 1
        for (int t0 = 0; t0 < 256; t0 += 64) { bf16_t lr[64], br[64];
#pragma unroll
            for (int k = 0; k < 64; ++k) { lr[k] = la[(r0 + t0 + k) * 1024 + w]; br[k] = bb[(r0 + t0 + k) * 1024 + w]; }
            asm volatile("" ::: "memory");
#pragma unroll
            for (int k = 0; k < 64; ++k) { h = __expf(bf2f(lr[k])) * h + bf2f(br[k]); hf[(r0 + t0 + k) * 512 + w] = f2bf(h); } }
        float hb = 0.f;
        if (!isctx) { hb = rgs[(size_t)((128 + b) * 2 + 1) * 512 + w][1];
#pragma unroll 1
            for (int q0 = b * 64 + 63; q0 > pm; q0 -= 16) { f32x2 sv[16];
#pragma unroll
                for (int k = 0; k < 16; ++k) { const int q = q0 - k > pm ? q0 - k : pm + 1; sv[k] = rgs[(size_t)(q * 2 + 1) * 512 + w]; }
                asm volatile("" ::: "memory");
#pragma unroll
                for (int k = 0; k < 16; ++k) if (q0 - k > pm) hb = sv[k][0] * hb + sv[k][1]; } }
#pragma unroll 1
        for (int i0 = 0; i0 < 256; i0 += 32) { bf16_t lr[32], br[32], gr[32], fr[32];
#pragma unroll
            for (int k = 0; k < 32; ++k) { const size_t t = r0 + 255 - i0 - k; lr[k] = la[t * 1024 + 512 + w]; br[k] = bb[t * 1024 + 512 + w]; gr[k] = ubuf[t * NU + U_BG + w]; fr[k] = hf[t * 512 + w]; }
#pragma unroll
            for (int k = 0; k < 32; ++k) { const size_t t = r0 + 255 - i0 - k; hb = __expf(bf2f(lr[k])) * hb + bf2f(br[k]); yb[t * 512 + w] = f2bf((bf2f(fr[k]) + hb) * gelu_tanh(bf2f(gr[k]))); } }
    }
}

namespace at {
constexpr float THR2 = 8.f * 1.4426950408889634f;
__device__ __forceinline__ int crow(int r, int hi) { return (r & 3) + 8 * (r >> 2) + 4 * hi; }
__device__ __forceinline__ unsigned cvtpk(float lo, float hi) { return cvt_pk_bf16(lo, hi); }
__device__ __forceinline__ int v_rd_base(int lane) { return ((lane & 3) << 3) | (((lane >> 2) & 3) << 6) | (((lane >> 4) & 1) << 5) | (((lane >> 5) & 1) << 8); }
constexpr int v_rd_off(int d0, int ks, int half) { return d0 * 512 + ks * 4096 + half * 2048; }
template <int OFF> __device__ __forceinline__ s16x4 tr_read(unsigned vb) { s16x4 r; asm volatile("ds_read_b64_tr_b16 %0, %1 offset:%2" : "=&v"(r) : "v"(vb), "i"(OFF) : "memory"); return r; }
template <int D0> __device__ __forceinline__ void pv_one(f32x16& od, unsigned vb, bf16x8 pa0, bf16x8 pa1, bf16x8 pa2, bf16x8 pa3) {
    const s16x4 l0 = tr_read<v_rd_off(D0, 0, 0)>(vb), h0 = tr_read<v_rd_off(D0, 0, 1)>(vb), l1 = tr_read<v_rd_off(D0, 1, 0)>(vb), h1 = tr_read<v_rd_off(D0, 1, 1)>(vb);
    const s16x4 l2 = tr_read<v_rd_off(D0, 2, 0)>(vb), h2 = tr_read<v_rd_off(D0, 2, 1)>(vb), l3 = tr_read<v_rd_off(D0, 3, 0)>(vb), h3 = tr_read<v_rd_off(D0, 3, 1)>(vb);
    asm volatile("s_waitcnt lgkmcnt(0)" ::: "memory"); __builtin_amdgcn_sched_barrier(0);
#define AT_PK(L, H) (bf16x8){L[0], L[1], L[2], L[3], H[0], H[1], H[2], H[3]}
    od = __builtin_amdgcn_mfma_f32_32x32x16_bf16(pa0, AT_PK(l0, h0), od, 0, 0, 0);
    od = __builtin_amdgcn_mfma_f32_32x32x16_bf16(pa1, AT_PK(l1, h1), od, 0, 0, 0);
    od = __builtin_amdgcn_mfma_f32_32x32x16_bf16(pa2, AT_PK(l2, h2), od, 0, 0, 0);
    od = __builtin_amdgcn_mfma_f32_32x32x16_bf16(pa3, AT_PK(l3, h3), od, 0, 0, 0);
#undef AT_PK
}
struct VFrag { s16x4 l[4], h[4]; };
template <int D0> __device__ __forceinline__ void rd_v(VFrag& f, const LAS unsigned char* vbp) {
#pragma unroll
    for (int ks = 0; ks < 4; ++ks) {
        f.l[ks] = __builtin_amdgcn_ds_read_tr16_b64_v4i16((LAS s16x4*)(vbp + v_rd_off(D0, ks, 0)));
        f.h[ks] = __builtin_amdgcn_ds_read_tr16_b64_v4i16((LAS s16x4*)(vbp + v_rd_off(D0, ks, 1))); }
}
__device__ __forceinline__ void mm_pv(f32x16& od, const VFrag& f, bf16x8 pa0, bf16x8 pa1, bf16x8 pa2, bf16x8 pa3) {
#define AT_PK(L, H) (bf16x8){L[0], L[1], L[2], L[3], H[0], H[1], H[2], H[3]}
    od = __builtin_amdgcn_mfma_f32_32x32x16_bf16(pa0, AT_PK(f.l[0], f.h[0]), od, 0, 0, 0);
    od = __builtin_amdgcn_mfma_f32_32x32x16_bf16(pa1, AT_PK(f.l[1], f.h[1]), od, 0, 0, 0);
    od = __builtin_amdgcn_mfma_f32_32x32x16_bf16(pa2, AT_PK(f.l[2], f.h[2]), od, 0, 0, 0);
    od = __builtin_amdgcn_mfma_f32_32x32x16_bf16(pa3, AT_PK(f.l[3], f.h[3]), od, 0, 0, 0);
#undef AT_PK
}
__device__ __forceinline__ f32x16 mfma_srcc(bf16x8 a, bf16x8 b, const f32x16& c) { f32x16 d; asm("v_mfma_f32_32x32x16_bf16 %0, %1, %2, %3" : "=&v"(d) : "v"(a), "v"(b), "v"(c)); return d; }
struct KeyMap { int ctx_row0, lat_row0, nctx, nt; __device__ __forceinline__ int row(int j) const { return j < nctx ? ctx_row0 + 64 * j : lat_row0 + 64 * (j - nctx); } };

template <int DQK>
__device__ __forceinline__ void attn_body(LAS unsigned char* lds, const bf16_t* Qg, int ldq, int q0, const bf16_t* Kg, int ldk, const bf16_t* Vg, int ldv, const KeyMap km,
                                          f32x16 (&o)[4], float& l_out) {
    constexpr int RB = DQK * 2, CPR = RB / 16, NKI = 64 * RB / 8192, KBYTES = 64 * RB, VOFF = 3 * KBYTES, SCR = VOFF + 4 * 16384, ND0 = DQK / 16;
    static_assert(SCR + 2048 <= LDS_MISC, "attention LDS");
    const int tid = otid(), wid = __builtin_amdgcn_readfirstlane(tid >> 6), lane = tid & 63, r32 = lane & 31, hi = lane >> 5, half = wid >> 2;
    LAS float* wsl = (LAS float*)(lds + SCR) + wid * 64; LAS float* al_l = wsl;
    unsigned koff[NKI], voff[2];
#pragma unroll
    for (int i = 0; i < NKI; ++i) { const int q = i * 512 + wid * 64 + lane, row = q / CPR, cp = q % CPR, ch = cp ^ ((row >> 1) & 7); koff[i] = (unsigned)row * (unsigned)(ldk * 2) + (unsigned)ch * 16u; }
#pragma unroll
    for (int i = 0; i < 2; ++i) { const int q = i * 512 + wid * 64 + lane, sub = q >> 5, wi = q & 31, k = (sub >> 2) * 8 + (wi >> 2), c = (sub & 3) * 32 + (wi & 3) * 8;
        voff[i] = (unsigned)k * (unsigned)(ldv * 2) + (unsigned)c * 2u; }
    const int NT = km.nt;
#define AT_ISSUE(j, sk, sv) do { const int _j = (j) < NT ? (j) : NT - 1; const int _kr = km.row(_j); const char* _kb = (const char*)Kg + (size_t)_kr * ldk * 2; const char* _vb = (const char*)Vg + (size_t)_kr * ldv * 2; \
        _Pragma("unroll") for (int _i = 0; _i < NKI; ++_i) __builtin_amdgcn_global_load_lds((const unsigned*)(_kb + koff[_i]), (LAS unsigned*)(lds + (sk) * KBYTES + _i * 8192 + wid * 1024), 16, 0, 0); \
        _Pragma("unroll") for (int _i = 0; _i < 2; ++_i) __builtin_amdgcn_global_load_lds((const unsigned*)(_vb + voff[_i]), (LAS unsigned*)(lds + VOFF + (sv) * 16384 + _i * 8192 + wid * 1024), 16, 0, 0); } while (0)
    bf16x8 qr[ND0];
    { const bf16_t* Qw = Qg + (size_t)(q0 + wid * 32 + r32) * ldq + hi * 8;
#pragma unroll
      for (int d0 = 0; d0 < ND0; ++d0) qr[d0] = *(const bf16x8*)(Qw + d0 * 16); }
    float m_reg = 0.f, l_reg = 0.f;
    f32x16 cm;
#pragma unroll
    for (int r = 0; r < 16; ++r) cm[r] = 0.f;
#pragma unroll
    for (int d = 0; d < 4; ++d)
#pragma unroll
        for (int r = 0; r < 16; ++r) o[d][r] = 0.f;
    const unsigned ksw = (unsigned)((r32 >> 1) & 7), kb0 = (unsigned)r32 * RB, vrb = (unsigned)v_rd_base(lane);
    bf16x8 pa0, pa1, pa2, pa3;
#define AT_PV(sv) do { const unsigned vb = (unsigned)(uintptr_t)(lds + VOFF + (sv) * 16384) + vrb; \
        pv_one<0>(o[0], vb, pa0, pa1, pa2, pa3); pv_one<1>(o[1], vb, pa0, pa1, pa2, pa3); pv_one<2>(o[2], vb, pa0, pa1, pa2, pa3); pv_one<3>(o[3], vb, pa0, pa1, pa2, pa3); } while (0)
    AT_ISSUE(0, 0, 0); AT_ISSUE(1, 1, 1);
    if constexpr (NKI == 3) asm volatile("s_waitcnt vmcnt(5)" ::: "memory"); else asm volatile("s_waitcnt vmcnt(3)" ::: "memory");
    if (half) { __builtin_amdgcn_s_barrier(); }
    int sk = 0, sv = 0;
    for (int j = 0; j < NT; ++j) {
        __builtin_amdgcn_s_barrier(); asm volatile("" ::: "memory");
        __builtin_amdgcn_s_setprio(1);
#define AT_SB __builtin_amdgcn_sched_barrier(0)
#define AT_RK(d0, KF) do { const unsigned cb = (((unsigned)(2 * (d0) + hi)) ^ ksw) << 4; KF[0] = *(const LAS bf16x8*)(Ks + cb); KF[1] = *(const LAS bf16x8*)(Ks + 32 * RB + cb); } while (0)
        const LAS unsigned char* Ks = lds + sk * KBYTES + kb0;
        bf16x8 kf[2][2];
        if (j > 0) {
            const LAS unsigned char* vbp = lds + VOFF + ((sv + 3) & 3) * 16384 + vrb;
            VFrag fa, fb;
            rd_v<0>(fa, vbp); rd_v<1>(fb, vbp); AT_SB;
            mm_pv(o[0], fa, pa0, pa1, pa2, pa3); AT_SB;
            rd_v<2>(fa, vbp); AT_SB;
            mm_pv(o[1], fb, pa0, pa1, pa2, pa3); AT_SB;
            rd_v<3>(fb, vbp); AT_SB;
            mm_pv(o[2], fa, pa0, pa1, pa2, pa3); AT_SB;
            AT_RK(0, kf[0]); AT_SB;
            mm_pv(o[3], fb, pa0, pa1, pa2, pa3); AT_SB;
        } else { AT_RK(0, kf[0]); AT_SB; }
        f32x16 p0, p1;
        AT_RK(1, kf[1]); AT_SB;
        p0 = mfma_srcc(kf[0][0], qr[0], cm); p1 = mfma_srcc(kf[0][1], qr[0], cm); AT_SB;
#pragma unroll
        for (int d0 = 1; d0 < ND0; ++d0) {
            if (d0 + 1 < ND0) { AT_RK(d0 + 1, kf[(d0 + 1) & 1]); AT_SB; }
            p0 = __builtin_amdgcn_mfma_f32_32x32x16_bf16(kf[d0 & 1][0], qr[d0], p0, 0, 0, 0);
            p1 = __builtin_amdgcn_mfma_f32_32x32x16_bf16(kf[d0 & 1][1], qr[d0], p1, 0, 0, 0); AT_SB;
        }
#undef AT_RK
#undef AT_SB
        asm volatile("s_waitcnt vmcnt(0)" ::: "memory");
        __builtin_amdgcn_s_setprio(0);
        __builtin_amdgcn_s_barrier(); asm volatile("" ::: "memory");
        { const int sk2 = sk == 0 ? 2 : sk - 1; AT_ISSUE(j + 2, sk2, (sv + 2) & 3); }
        float pmax = p0[0];
#pragma unroll
        for (int r = 1; r < 16; ++r) pmax = fmaxf(pmax, p0[r]);
#pragma unroll
        for (int r = 0; r < 16; ++r) pmax = fmaxf(pmax, p1[r]);
        { auto rr = __builtin_amdgcn_permlane32_swap(__float_as_uint(pmax), __float_as_uint(pmax), false, false); pmax = fmaxf(__uint_as_float(rr[0]), __uint_as_float(rr[1])); }
        float alpha = 1.f;
        if (__builtin_expect(j == 0 || !__all(pmax <= THR2), 0)) {
            const float delta = j == 0 ? pmax : fmaxf(pmax, 0.f);
            if (j != 0) alpha = __builtin_amdgcn_exp2f(-delta);
            m_reg += delta;
#pragma unroll
            for (int r = 0; r < 16; ++r) { p0[r] -= delta; p1[r] -= delta; cm[r] = -m_reg; }
        }
#pragma unroll
        for (int r = 0; r < 16; ++r) { p0[r] = __builtin_amdgcn_exp2f(p0[r]); p1[r] = __builtin_amdgcn_exp2f(p1[r]); }
        float ps = 0.f;
#pragma unroll
        for (int r = 0; r < 16; ++r) ps += p0[r] + p1[r];
        l_reg = l_reg * alpha + ps;
#define AT_PK4(P, BASE, OUT) do { u32x4 w = {cvtpk(P[BASE + 0], P[BASE + 1]), cvtpk(P[BASE + 2], P[BASE + 3]), cvtpk(P[BASE + 4], P[BASE + 5]), cvtpk(P[BASE + 6], P[BASE + 7])}; OUT = *reinterpret_cast<bf16x8*>(&w); } while (0)
        AT_PK4(p0, 0, pa0); AT_PK4(p0, 8, pa1); AT_PK4(p1, 0, pa2); AT_PK4(p1, 8, pa3);
#undef AT_PK4
        if (__any(alpha < 1.f)) {
            if (hi == 0) al_l[r32] = alpha;
            asm volatile("s_waitcnt lgkmcnt(0)" ::: "memory");
            float av[16];
#pragma unroll
            for (int r = 0; r < 16; ++r) av[r] = al_l[crow(r, hi)];
#pragma unroll
            for (int d = 0; d < 4; ++d)
#pragma unroll
                for (int r = 0; r < 16; ++r) o[d][r] *= av[r];
        }
        sk = sk == 2 ? 0 : sk + 1; sv = (sv + 1) & 3;
    }
    __builtin_amdgcn_s_barrier(); asm volatile("" ::: "memory");
    AT_PV((sv + 3) & 3);
    if (!half) __builtin_amdgcn_s_barrier();
    asm volatile("s_waitcnt vmcnt(0)" ::: "memory");
    __builtin_amdgcn_s_barrier();
    asm volatile("" ::: "memory");
    { auto rr = __builtin_amdgcn_permlane32_swap(__float_as_uint(l_reg), __float_as_uint(l_reg), false, false); l_out = __uint_as_float(rr[0]) + __uint_as_float(rr[1]); }
#undef AT_ISSUE
#undef AT_PV
}
__device__ __forceinline__ void row_inv_l(LAS unsigned char* lds_scratch, float l_reg, float (&rli)[16]) {
    const int tid = otid(), wid = tid >> 6, lane = tid & 63, r32 = lane & 31, hi = lane >> 5;
    LAS float* li_l = (LAS float*)lds_scratch + wid * 64 + 32;
    if (hi == 0) li_l[r32] = l_reg;
    asm volatile("s_waitcnt lgkmcnt(0)" ::: "memory");
#pragma unroll
    for (int r = 0; r < 16; ++r) rli[r] = __builtin_amdgcn_rcpf(li_l[crow(r, hi)]);
}
}

__device__ __forceinline__ void attn_unit_mla(CKP& p, LAS unsigned char* lds, int q0, int h, const at::KeyMap km) {
    const bf16_t* qm = (const bf16_t*)(p.ws + WS_QM); const bf16_t* kmb = (const bf16_t*)(p.ws + WS_KM); const bf16_t* vmb = (const bf16_t*)(p.ws + WS_VM); bf16_t* ya = (bf16_t*)(p.ws + WS_YBR);
    f32x16 o[4]; float l;
    at::attn_body<192>(lds, qm + h * 192, 768, q0, kmb + h * 192, 768, vmb + h * 128, 512, km, o, l);
    float rli[16]; at::row_inv_l(lds + 3 * 64 * 384 + 4 * 16384, l, rli);
    const int tid_ = otid(); const int wid = tid_ >> 6, lane = tid_ & 63, r32 = lane & 31, hi = lane >> 5;
    bf16_t* yw = ya + (size_t)(q0 + wid * 32) * 512 + h * 128 + r32;
#pragma unroll
    for (int r = 0; r < 16; ++r) { const int orow = at::crow(r, hi);
#pragma unroll
        for (int d0 = 0; d0 < 4; ++d0) yw[(size_t)orow * 512 + d0 * 32] = f2bf(o[d0][r] * rli[r]); }
}
__device__ __forceinline__ void attn_unit_diff(CKP& p, LAS unsigned char* lds, int l_idx, int q0, int h, const at::KeyMap km) {
    const bf16_t* ubuf = (const bf16_t*)(p.ws + WS_R1); bf16_t* yc = (bf16_t*)(p.ws + WS_YBR) + (size_t)2 * MALL * 512;
    const float lam = ((const float*)(p.ws + WS_SCAL))[l_idx]; const float lam_init = 0.8f - 0.6f * expf(-0.3f * (float)l_idx);
    f32x16 o[4]; float l; float rli[16];
    at::attn_body<64>(lds, ubuf + U_CQ + (2 * h) * 64, NU, q0, ubuf + U_CK + (2 * h) * 64, NU, ubuf + U_CV + h * 128, NU, km, o, l);
    at::row_inv_l(lds + 3 * 64 * 128 + 4 * 16384, l, rli);
    const int tid_ = otid(); const int wid = tid_ >> 6, lane = tid_ & 63, r32 = lane & 31, hi = lane >> 5;
    bf16_t* yw = yc + (size_t)(q0 + wid * 32) * 512 + h * 128 + r32;
#pragma unroll
    for (int r = 0; r < 16; ++r) { const int orow = at::crow(r, hi);
#pragma unroll
        for (int d0 = 0; d0 < 4; ++d0) yw[(size_t)orow * 512 + d0 * 32] = f2bf(o[d0][r] * rli[r]); }
    at::attn_body<64>(lds, ubuf + U_CQ + (2 * h + 1) * 64, NU, q0, ubuf + U_CK + (2 * h + 1) * 64, NU, ubuf + U_CV + h * 128, NU, km, o, l);
    at::row_inv_l(lds + 3 * 64 * 128 + 4 * 16384, l, rli);
    { const int t2 = otid(); yw = yc + (size_t)(q0 + (t2 >> 6) * 32) * 512 + h * 128 + (t2 & 31); }
    float ss[16];
#pragma unroll
    for (int r = 0; r < 16; ++r) { const int orow = at::crow(r, hi); float s = 0.f;
#pragma unroll
        for (int d = 0; d < 4; ++d) { const float v = bf2f(yw[(size_t)orow * 512 + d * 32]) - lam * (o[d][r] * rli[r]); o[d][r] = v; s += v * v; }
        ss[r] = s; }
#pragma unroll
    for (int r = 0; r < 16; ++r) {
#pragma unroll
        for (int x = 16; x >= 1; x >>= 1) ss[r] += shx(ss[r], x, lane); }
    const float* sub = p.in[I_SUBLN] + l_idx * 128; float sg[4];
#pragma unroll
    for (int d = 0; d < 4; ++d) sg[d] = sub[d * 32 + r32] * (1.0f - lam_init);
#pragma unroll
    for (int r = 0; r < 16; ++r) { const int orow = at::crow(r, hi); const float rn = rsqrtf(ss[r] * (1.0f / 128.0f) + EPS);
#pragma unroll
        for (int d0 = 0; d0 < 4; ++d0) yw[(size_t)orow * 512 + d0 * 32] = f2bf(o[d0][r] * rn * sg[d0]); }
}

__device__ __forceinline__ void lds_barrier() { asm volatile("s_waitcnt lgkmcnt(0)" ::: "memory"); __builtin_amdgcn_s_barrier(); asm volatile("" ::: "memory"); }
namespace hg {
__device__ __forceinline__ bf16x8 gather8(const LAS bf16_t* p, int stride) { bf16x8 r;
#pragma unroll
    for (int i = 0; i < 8; ++i) r[i] = (short)p[i * stride];
    return r; }
__device__ __forceinline__ void gates16(const bf16_t* zp  , float lbk, int dd, float (&gi)[16], float (&kf)[16], float& tot) {
    float g[16];
#pragma unroll
    for (int i = 0; i < 16; ++i) { const float z = bf2f(zp[(size_t)i * NU]); const float sg = sigmoidf_(z); g[i] = flog(lbk + (1.0f - lbk) * sg); kf[i] = (1.0f - lbk) * frcp(1.0f + __expf(z)); }
    float run = 0.f;
    if (dd == 0) {
#pragma unroll
        for (int i = 0; i < 16; ++i) { run += g[i]; gi[i] = run; }
    } else {
#pragma unroll
        for (int i = 15; i >= 0; --i) { run += g[i]; gi[i] = run; }
    }
    tot = run;
}
__device__ __forceinline__ void gates16r(const bf16_t (&zr)[16], float lbk, int dd, float (&gi)[16], float (&kf)[16], float& tot) {
    float g[16];
#pragma unroll
    for (int i = 0; i < 16; ++i) { const float z = bf2f(zr[i]); const float sg = sigmoidf_(z); g[i] = flog(lbk + (1.0f - lbk) * sg); kf[i] = (1.0f - lbk) * frcp(1.0f + __expf(z)); }
    float run = 0.f;
    if (dd == 0) {
#pragma unroll
        for (int i = 0; i < 16; ++i) { run += g[i]; gi[i] = run; }
    } else {
#pragma unroll
        for (int i = 15; i >= 0; --i) { run += g[i]; gi[i] = run; }
    }
    tot = run;
}
__device__ __forceinline__ void pack16_store(LAS bf16_t* dst, const float (&v)[16]) {
    u32x4 a, b; a.x = cvt_pk_bf16(v[0], v[1]); a.y = cvt_pk_bf16(v[2], v[3]); a.z = cvt_pk_bf16(v[4], v[5]); a.w = cvt_pk_bf16(v[6], v[7]);
    b.x = cvt_pk_bf16(v[8], v[9]); b.y = cvt_pk_bf16(v[10], v[11]); b.z = cvt_pk_bf16(v[12], v[13]); b.w = cvt_pk_bf16(v[14], v[15]);
    *(LAS u32x4*)dst = a; *(LAS u32x4*)(dst + 8) = b;
}
__device__ __forceinline__ void stage_vT(LAS bf16_t* VsT, const bf16_t* vp  , int v, int part) {
    unsigned short h[16];
#pragma unroll
    for (int i = 0; i < 16; ++i) h[i] = vp[(size_t)i * NU];
    u32x4 a, b; a.x = h[0] | ((unsigned)h[1] << 16); a.y = h[2] | ((unsigned)h[3] << 16); a.z = h[4] | ((unsigned)h[5] << 16); a.w = h[6] | ((unsigned)h[7] << 16);
    b.x = h[8] | ((unsigned)h[9] << 16); b.y = h[10] | ((unsigned)h[11] << 16); b.z = h[12] | ((unsigned)h[13] << 16); b.w = h[14] | ((unsigned)h[15] << 16);
    *(LAS u32x4*)(VsT + v * 72 + part * 16) = a; *(LAS u32x4*)(VsT + v * 72 + part * 16 + 8) = b;
}
__device__ __forceinline__ void pass1_unit(CKP& p, LAS unsigned char* lds, const float* lb, int cid, int hh) {
    const bf16_t* ubuf = (const bf16_t*)(p.ws + WS_R1); bf16_t* HS = (bf16_t*)(p.ws + WS_YBUF); float* HD = (float*)(p.ws + WS_HD);
    LAS bf16_t* VsT = (LAS bf16_t*)lds; LAS bf16_t* KtT = (LAS bf16_t*)(lds + 18432); LAS float* ptot = (LAS float*)(lds + 36864);
    const int tid = otid(), wid = tid >> 6, lane = tid & 63, row0 = cid * 64;
    const int k = tid & 127, part = tid >> 7; const float lbk = lb[hh * 128 + k];
    bf16_t zf[16], zb[16];
    { const bf16_t* zp = ubuf + (size_t)(row0 + part * 16) * NU + hh * 128 + k;
#pragma unroll
      for (int i = 0; i < 16; ++i) { zf[i] = zp[(size_t)i * NU + U_DFF]; zb[i] = zp[(size_t)i * NU + U_DFB]; } }
    stage_vT(VsT, ubuf + (size_t)(row0 + part * 16) * NU + U_DI + hh * 128 + k, k, part);
#pragma unroll 1
    for (int dd = 0; dd < 2; ++dd) {
        float gi[16], kf[16], tot;
        { bf16_t zr[16];
#pragma unroll
          for (int i = 0; i < 16; ++i) zr[i] = dd ? zb[i] : zf[i];
          gates16r(zr, lbk, dd, gi, kf, tot); }
        ptot[part * 128 + k] = tot;
        lds_barrier();
        float off = 0.f, gt = 0.f;
#pragma unroll
        for (int q = 0; q < 4; ++q) { const float v = ptot[q * 128 + k]; gt += v; if (dd == 0 ? (q < part) : (q > part)) off += v; }
#pragma unroll
        for (int i = 0; i < 16; ++i) kf[i] = kf[i] * __expf(gt - (off + gi[i]));
        pack16_store(KtT + k * 72 + part * 16, kf);
        if (part == 0) HD[(size_t)((cid * 4 + hh) * 2 + dd) * 128 + k] = __expf(gt);
        lds_barrier();
        {
            const int l15 = lane & 15, kg = lane >> 4;
            bf16x8 vf[2];
#pragma unroll
            for (int ks = 0; ks < 2; ++ks) vf[ks] = *(const LAS bf16x8*)(VsT + (wid * 16 + l15) * 72 + ks * 32 + kg * 8);
            bf16_t* dst = HS + ((size_t)((cid * 4 + hh) * 2 + dd) * 128 + wid * 16 + l15) * 128;
            bf16x8 kfr[8][2];
#pragma unroll
            for (int kb = 0; kb < 8; ++kb)
#pragma unroll
                for (int ks = 0; ks < 2; ++ks) kfr[kb][ks] = *(const LAS bf16x8*)(KtT + (kb * 16 + l15) * 72 + ks * 32 + kg * 8);
            asm volatile("" ::: "memory");
#pragma unroll
            for (int kb = 0; kb < 8; ++kb) {
                f32x4 c = {0.f, 0.f, 0.f, 0.f};
#pragma unroll
                for (int ks = 0; ks < 2; ++ks) c = __builtin_amdgcn_mfma_f32_16x16x32_bf16(kfr[kb][ks], vf[ks], c, 0, 0, 0);
                u32x2 w; w.x = cvt_pk_bf16(c[0], c[1]); w.y = cvt_pk_bf16(c[2], c[3]);
                *(u32x2*)(dst + kb * 16 + kg * 4) = w;
            }
        }
        lds_barrier();
    }
}
__device__ __forceinline__ void carry_unit(CKP& p, int u) {
    bf16_t* HS = (bf16_t*)(p.ws + WS_YBUF); const float* HD = (const float*)(p.ws + WS_HD);
    const int combo = u >> 4, sub = u & 15, b = combo >> 3, hh = (combo >> 1) & 3, dd = combo & 1;
    const int tid_ = otid(); const int v = sub * 8 + (tid_ >> 6), k = 2 * (tid_ & 63);
    float s0 = 0.f, s1 = 0.f;
#pragma unroll 1
    for (int s0i = 0; s0i < 260; s0i += 52) {
        unsigned uw[52]; f32x2 d2[52];
#pragma unroll
        for (int q = 0; q < 52; ++q) { const int st = s0i + q;
            const int cid = dd == 0 ? (st < 4 ? 512 + b * 4 + st : b * 256 + (st - 4)) : (st < 4 ? 512 + b * 4 + (3 - st) : b * 256 + (259 - st));
            const size_t base = (size_t)((cid * 4 + hh) * 2 + dd) * 128;
            uw[q] = *(const unsigned*)(HS + (base + v) * 128 + k); d2[q] = *(const f32x2*)(HD + base + k); }
#pragma unroll
        for (int q = 0; q < 52; ++q) { const int st = s0i + q;
            const int cid = dd == 0 ? (st < 4 ? 512 + b * 4 + st : b * 256 + (st - 4)) : (st < 4 ? 512 + b * 4 + (3 - st) : b * 256 + (259 - st));
            const size_t base = (size_t)((cid * 4 + hh) * 2 + dd) * 128;
            *(unsigned*)(HS + (base + v) * 128 + k) = cvt_pk_bf16(s0, s1);
            s0 = d2[q][0] * s0 + bflo(uw[q]); s1 = d2[q][1] * s1 + bfhi(uw[q]); }
    }
}
constexpr int O_QS = 0, O_KF = 17408, O_VS = 34816, O_GS = 53248, O_ST = 87040, O_AS = 121856, O_R = 140288, O_PT = 142336, O_RS = 144384;
static_assert(O_RS + 512 <= LDS_MISC, "HGRN LDS");
__device__ __forceinline__ void out_unit(CKP& p, LAS unsigned char* lds, const float* lb, const float* gnorm, int cid, int hh) {
    const bf16_t* ubuf = (const bf16_t*)(p.ws + WS_R1); const bf16_t* HS = (const bf16_t*)(p.ws + WS_YBUF); bf16_t* yd = (bf16_t*)(p.ws + WS_YBR) + (size_t)3 * MALL * 512;
    LAS bf16_t* qs = (LAS bf16_t*)(lds + O_QS); LAS bf16_t* kfs = (LAS bf16_t*)(lds + O_KF); LAS bf16_t* Vs = (LAS bf16_t*)(lds + O_VS); LAS float* Gs = (LAS float*)(lds + O_GS);
    LAS bf16_t* St = (LAS bf16_t*)(lds + O_ST); LAS float* Rr = (LAS float*)(lds + O_R); LAS float* ptot = (LAS float*)(lds + O_PT); LAS float* rss = (LAS float*)(lds + O_RS);
    const int tid = otid(), wid = tid >> 6, lane = tid & 63, row0 = cid * 64, l15 = lane & 15, kg = lane >> 4;
    LAS bf16_t* Asc = (LAS bf16_t*)(lds + O_AS) + wid * (16 * 72);
    const int k = tid & 127, part = tid >> 7; const float lbk = lb[hh * 128 + k];
    bf16_t zf[16], zb[16]; u32x4 sin0[4], sin1[4];
    { const bf16_t* zp = ubuf + (size_t)(row0 + part * 16) * NU + hh * 128 + k;
#pragma unroll
      for (int i = 0; i < 16; ++i) { zf[i] = zp[(size_t)i * NU + U_DFF]; zb[i] = zp[(size_t)i * NU + U_DFB]; }
      const int v_ = tid >> 2, seg_ = tid & 3; const bf16_t* src = HS + ((size_t)((cid * 4 + hh) * 2) * 128 + v_) * 128 + seg_ * 32;
#pragma unroll
      for (int i = 0; i < 4; ++i) { sin0[i] = *(const u32x4*)(src + i * 8); sin1[i] = *(const u32x4*)(src + (size_t)128 * 128 + i * 8); } }
    stage_vT(Vs, ubuf + (size_t)(row0 + part * 16) * NU + U_DI + hh * 128 + k, k, part);
#pragma unroll
    for (int i = 0; i < 16; ++i) { const int t = part * 16 + i; qs[t * 136 + k] = f2bf(siluf_(bf2f(ubuf[(size_t)(row0 + t) * NU + U_DQ + hh * 128 + k]))); }
    const int bi = wid >> 1, vh = wid & 1;
    f32x4 o[4];
#pragma unroll
    for (int nb = 0; nb < 4; ++nb) o[nb] = (f32x4){0.f, 0.f, 0.f, 0.f};
#pragma unroll 1
    for (int dd = 0; dd < 2; ++dd) {
        {
            float gi[16], kf[16], tot;
            { bf16_t zr[16];
#pragma unroll
              for (int i = 0; i < 16; ++i) zr[i] = dd ? zb[i] : zf[i];
              gates16r(zr, lbk, dd, gi, kf, tot); }
            ptot[part * 128 + k] = tot;
            lds_barrier();
            float off = 0.f;
#pragma unroll
            for (int q = 0; q < 4; ++q) { const float v = ptot[q * 128 + k]; if (dd == 0 ? (q < part) : (q > part)) off += v; }
#pragma unroll
            for (int i = 0; i < 16; ++i) { const int t = part * 16 + i; Gs[t * 132 + k] = off + gi[i]; kfs[t * 136 + k] = f2bf(kf[i]); }
            Rr[part * 128 + k] = off;
        }
        {
            const int v = tid >> 2, seg = tid & 3;
#pragma unroll
            for (int i = 0; i < 4; ++i) *(LAS u32x4*)(St + v * 136 + seg * 32 + i * 8) = dd ? sin1[i] : sin0[i];
        }
        lds_barrier();
        const int ti = bi * 16 + l15;
        u32x4 awq[4];
#pragma unroll
        for (int ks = 0; ks < 4; ++ks) { const int kc = ks * 32 + kg * 8;
            const u32x4 qw = *(const LAS u32x4*)(qs + ti * 136 + kc);
            const f32x4 g0 = *(const LAS f32x4*)(Gs + ti * 132 + kc), g1 = *(const LAS f32x4*)(Gs + ti * 132 + kc + 4), r0 = *(const LAS f32x4*)(Rr + bi * 128 + kc), r1 = *(const LAS f32x4*)(Rr + bi * 128 + kc + 4);
            const float qv[8] = {bflo(qw.x), bfhi(qw.x), bflo(qw.y), bfhi(qw.y), bflo(qw.z), bfhi(qw.z), bflo(qw.w), bfhi(qw.w)}; float qa[8];
#pragma unroll
            for (int e = 0; e < 4; ++e) { qa[e] = qv[e] * __expf(g0[e] - r0[e]); qa[4 + e] = qv[4 + e] * __expf(g1[e] - r1[e]); }
            awq[ks].x = cvt_pk_bf16(qa[0], qa[1]); awq[ks].y = cvt_pk_bf16(qa[2], qa[3]); awq[ks].z = cvt_pk_bf16(qa[4], qa[5]); awq[ks].w = cvt_pk_bf16(qa[6], qa[7]); }
#pragma unroll 1
        for (int j = 0; j < 4; ++j) {
            const bool use = dd == 0 ? (j <= bi) : (j >= bi);
            f32x4 c = {0.f, 0.f, 0.f, 0.f};
            if (use) {
                const int sj = j * 16 + l15;
#pragma unroll
                for (int ks = 0; ks < 4; ++ks) {
                    const int kc = ks * 32 + kg * 8;
                    const u32x4 kw = *(const LAS u32x4*)(kfs + sj * 136 + kc);
                    const f32x4 h0 = *(const LAS f32x4*)(Gs + sj * 132 + kc), h1 = *(const LAS f32x4*)(Gs + sj * 132 + kc + 4);
                    const f32x4 r0 = *(const LAS f32x4*)(Rr + bi * 128 + kc), r1 = *(const LAS f32x4*)(Rr + bi * 128 + kc + 4);
                    const float kv[8] = {bflo(kw.x), bfhi(kw.x), bflo(kw.y), bfhi(kw.y), bflo(kw.z), bfhi(kw.z), bflo(kw.w), bfhi(kw.w)};
                    float ka[8];
#pragma unroll
                    for (int e = 0; e < 4; ++e) { ka[e] = kv[e] * __expf(r0[e] - h0[e]); ka[4 + e] = kv[4 + e] * __expf(r1[e] - h1[e]); }
                    u32x4 aw = awq[ks], bw;
                    bw.x = cvt_pk_bf16(ka[0], ka[1]); bw.y = cvt_pk_bf16(ka[2], ka[3]); bw.z = cvt_pk_bf16(ka[4], ka[5]); bw.w = cvt_pk_bf16(ka[6], ka[7]);
                    c = __builtin_amdgcn_mfma_f32_16x16x32_bf16(*reinterpret_cast<bf16x8*>(&aw), *reinterpret_cast<bf16x8*>(&bw), c, 0, 0, 0);
                }
                if (j == bi) {
#pragma unroll
                    for (int e = 0; e < 4; ++e) { const int tl = 4 * kg + e; const bool keep = dd == 0 ? (l15 <= tl) : (l15 >= tl); c[e] = keep ? c[e] : 0.f; }
                }
            }
#pragma unroll
            for (int e = 0; e < 4; ++e) Asc[(4 * kg + e) * 72 + j * 16 + l15] = f2bf(c[e]);
        }
        bf16x8 af[2], qf[4];
#pragma unroll
        for (int ks = 0; ks < 2; ++ks) af[ks] = *(const LAS bf16x8*)(Asc + l15 * 72 + ks * 32 + kg * 8);
#pragma unroll
        for (int ks = 0; ks < 4; ++ks) { const int kc = ks * 32 + kg * 8;
            const u32x4 qw = *(const LAS u32x4*)(qs + ti * 136 + kc); const f32x4 g0 = *(const LAS f32x4*)(Gs + ti * 132 + kc), g1 = *(const LAS f32x4*)(Gs + ti * 132 + kc + 4);
            u32x4 aw; aw.x = cvt_pk_bf16(bflo(qw.x) * __expf(g0[0]), bfhi(qw.x) * __expf(g0[1])); aw.y = cvt_pk_bf16(bflo(qw.y) * __expf(g0[2]), bfhi(qw.y) * __expf(g0[3]));
            aw.z = cvt_pk_bf16(bflo(qw.z) * __expf(g1[0]), bfhi(qw.z) * __expf(g1[1])); aw.w = cvt_pk_bf16(bflo(qw.w) * __expf(g1[2]), bfhi(qw.w) * __expf(g1[3]));
            qf[ks] = *reinterpret_cast<bf16x8*>(&aw); }
#pragma unroll
        for (int nb = 0; nb < 4; ++nb) { const int vcol = vh * 64 + nb * 16 + l15;
            bf16x8 vf[2], sf[4];
#pragma unroll
            for (int ks = 0; ks < 2; ++ks) vf[ks] = *(const LAS bf16x8*)(Vs + vcol * 72 + ks * 32 + kg * 8);
#pragma unroll
            for (int ks = 0; ks < 4; ++ks) sf[ks] = *(const LAS bf16x8*)(St + vcol * 136 + ks * 32 + kg * 8);
            asm volatile("" ::: "memory");
#pragma unroll
            for (int ks = 0; ks < 2; ++ks) o[nb] = __builtin_amdgcn_mfma_f32_16x16x32_bf16(af[ks], vf[ks], o[nb], 0, 0, 0);
#pragma unroll
            for (int ks = 0; ks < 4; ++ks) o[nb] = __builtin_amdgcn_mfma_f32_16x16x32_bf16(qf[ks], sf[ks], o[nb], 0, 0, 0);
        }
        lds_barrier();
    }
    bf16_t ogr[4][4]; float gn[4];
#pragma unroll
    for (int e = 0; e < 4; ++e)
#pragma unroll
        for (int nb = 0; nb < 4; ++nb) ogr[e][nb] = ubuf[(size_t)(row0 + bi * 16 + 4 * kg + e) * NU + U_DG + hh * 128 + vh * 64 + nb * 16 + l15];
#pragma unroll
    for (int nb = 0; nb < 4; ++nb) gn[nb] = gnorm[vh * 64 + nb * 16 + l15];
    float ss[4];
#pragma unroll
    for (int e = 0; e < 4; ++e) { float s = 0.f;
#pragma unroll
        for (int nb = 0; nb < 4; ++nb) s += o[nb][e] * o[nb][e];
#pragma unroll
        for (int x = 8; x >= 1; x >>= 1) s += shx(s, x, lane);
        ss[e] = s; }
    if (l15 == 0) {
#pragma unroll
        for (int e = 0; e < 4; ++e) rss[vh * 64 + bi * 16 + 4 * kg + e] = ss[e]; }
    lds_barrier();
#pragma unroll
    for (int e = 0; e < 4; ++e) { const int tl = bi * 16 + 4 * kg + e; const float tot = rss[tl] + rss[64 + tl]; const float rn = rsqrtf(tot * (1.0f / 128.0f) + EPS);
        const size_t row = (size_t)(row0 + tl);
#pragma unroll
        for (int nb = 0; nb < 4; ++nb) { const int v = vh * 64 + nb * 16 + l15; const float og = bf2f(ogr[e][nb]);
            yd[row * 512 + hh * 128 + v] = f2bf(o[nb][e] * rn * gn[nb] * siluf_(og)); } }
    lds_barrier();
}
}

constexpr int PH_PER_LAYER = 14, N_PHASES = 1 + PH_PER_LAYER * NL + 1;
#ifndef MK_LAUNCHES
#define MK_LAUNCHES 1
#endif

__global__ void __launch_bounds__(NTHR, 2) fwd_kernel(KP karg) {
    extern __shared__ __attribute__((aligned(16))) unsigned char lds_raw[];
    LAS unsigned char* lds0 = (LAS unsigned char*)lds_raw;
    const int tid = otid(), G = gridDim.x, c = obid();
    volatile LAS unsigned* bst = (volatile LAS unsigned*)(lds0 + LDS_MISC);
    if (tid < 4) bst[tid] = 0u;
    __syncthreads();
    const int lo = karg.ph_lo, hi = karg.ph_hi;
    const bool fused = (MK_LAUNCHES == 1) || (hi - lo) > 1;
    XcdBarrier bar; bar.bar = (unsigned*)(karg.ws + WS_CTL); bar.x = 0; bar.st = bst;
    if (fused) bar = xcd_barrier_post((unsigned*)(karg.ws + WS_CTL), bst);
#ifndef ONLY_PH
#define ONLY_PH (-1)
#endif
#ifndef SUBMASK
#define SUBMASK 0xff
#endif
#define SUB(b) ((SUBMASK >> (b)) & 1)
#define EN(x) (ONLY_PH < 0 || ONLY_PH == (x))
#ifndef REPX
#define REPX (-1)
#define REPN 1
#endif
#define REPEAT(x) _Pragma("unroll 1") for (int rep_ = 0; rep_ < (REPX == (x) ? REPN : 1); ++rep_)
#define IN(k) ((MK_LAUNCHES == 1) || (lo <= (k) && (k) < hi))
#define INL(x) (EN(x) && IN(pb + (x)))
#define SEAM(k) do { if (IN((k) + 1)) xcd_barrier(bar); } while (0)

#define PH_LOCALS CKP& p = kp_here(); const int c = obid(); unsigned char* ws = p.ws; LAS unsigned char* lds = lds_here(lds_raw); \
    float* mod = (float*)(ws + WS_MOD); const float* rope = (const float*)(ws + WS_ROPE); const float* scal = (const float*)(ws + WS_SCAL); \
    bf16_t* hbuf = (bf16_t*)(ws + WS_HBUF); bf16_t* act = (bf16_t*)(ws + WS_R1); bf16_t* ubuf = (bf16_t*)(ws + WS_R1); bf16_t* mrg = (bf16_t*)(ws + WS_R1); bf16_t* ybuf = (bf16_t*)(ws + WS_YBUF); \
    float* xc = (float*)(ws + WS_XC); const float* modl = mod + (size_t)l * 3 * NMOD * DM; \
    (void)rope; (void)scal; (void)hbuf; (void)act; (void)ubuf; (void)mrg; (void)ybuf; (void)xc; (void)modl;

    if (EN(100) && IN(0)) { CKP& p = kp_here(); LAS unsigned char* lds = lds_here(lds_raw); job_tables(p); job_colmax(p); job_mod(p, lds); SEAM(0); }

#pragma unroll 1
    for (int l = 0; l < NL; ++l) {
        const int pb = 1 + PH_PER_LAYER * l; const bool need_ctx = l < NL - 1; const int nrt = need_ctx ? NRT : 128;
        if (INL(0)) { PH_LOCALS
            RNArgs a{};
            if (l == 0) { a.xs_lat = p.in[I_X]; a.xs_ctx = p.in[I_CTX]; a.xd_lat = p.out; a.xd_ctx = xc; a.y = nullptr; }
            else { a.xs_lat = p.out; a.xs_ctx = xc; a.xd_lat = p.out; a.xd_ctx = xc; a.y = ybuf; a.wres = 0.5f; a.modl_res = mod + (size_t)(l - 1) * 3 * NMOD * DM; a.jres = 2; a.postg = p.in[I_POST] + ((l - 1) * 3 + 2) * DM; }
            a.do_norm = true; a.modl_norm = modl; a.jn = 0; a.preg = p.in[I_PRE] + (l * 3 + 0) * DM; a.h = nullptr; a.h8 = (signed char*)hbuf; a.nrows = MALL; a.hsc = (float*)(ws + WS_HSC);
            job_resnorm(a, lds);
            job_convert(p, lds, l);
            SEAM(pb + 0);
        }
        if (INL(1)) { PH_LOCALS
            SchedPlain S; S.T.init(NRT, 44, G, c); S.A = (const char*)hbuf; S.B = (const char*)(ws + WS_WGU); S.lda2 = DM; S.ldb2 = DM; S.nt = DM / 128;
            REPEAT(1) { EpiGateUpI8 E{act, (const float*)(ws + WS_HSC), (const float*)(ws + WS_WSC)}; gm::gemm_stream<false>(lds, S, E); } SEAM(pb + 1);
        }
        if (INL(2)) { PH_LOCALS
            const bool spl = G == 256 && MK_LAUNCHES == 1; float* ypart = (float*)(ws + WS_R1 + (size_t)MALL * DFF * 2);
            SchedSplitK S; S.T.init(spl ? 128 : NRT, 8, G, c); S.A = (const char*)act; S.B = (const char*)(ws + WS_WD); S.lda2 = DFF * 2; S.ldb2 = DFF * 2; S.nt = DFF / 64; S.xe = (spl && c < 64) ? c : -1;
            REPEAT(2) { EpiStoreK E{ybuf, ypart}; gm::gemm_stream<false>(lds, S, E); } SEAM(pb + 2);
            if (spl) { job_splitk_reduce(ypart, ybuf); xcd_barrier(bar); }
        }
        if (INL(3)) { PH_LOCALS
            RNArgs a{};
            if (l == 0) { a.xs_lat = p.in[I_X]; a.xs_ctx = p.in[I_CTX]; } else { a.xs_lat = p.out; a.xs_ctx = xc; }
            a.xd_lat = p.out; a.xd_ctx = xc; a.y = ybuf; a.wres = 0.5f; a.modl_res = modl; a.jres = 0; a.postg = p.in[I_POST] + (l * 3 + 0) * DM;
            a.do_norm = true; a.modl_norm = modl; a.jn = 1; a.preg = p.in[I_PRE] + (l * 3 + 1) * DM; a.h = nullptr; a.h8 = (signed char*)(ws + WS_H8); a.hsc = (float*)(ws + WS_HSC2); a.nrows = MALL;
            job_resnorm(a, lds); SEAM(pb + 3);
        }
        if (INL(4)) { PH_LOCALS
            SchedPlain S; S.T.init(NRT, 24, G, c); S.A = (const char*)(ws + WS_H8); S.B = (const char*)(ws + WS_WIN); S.lda2 = DM; S.ldb2 = DM; S.nt = DM / 128;
            REPEAT(4) { EpiProj E{ubuf, (bf16_t*)(ws + WS_KM), rope, (const float*)(ws + WS_HSC2), (const float*)(ws + WS_WPS)}; gm::gemm_stream<false>(lds, S, E); } SEAM(pb + 4);
        }
        if (INL(5)) { PH_LOCALS job_stats_conv(p, l); SEAM(pb + 5); }
        if (INL(6)) { PH_LOCALS
            if (SUB(0)) { SchedPlain S; S.T.init(NRT, 3, G, c); S.A = (const char*)(ubuf + U_AQ); S.B = (const char*)(ws + WS_WUQ); S.lda2 = NU * 2; S.ldb2 = 512 * 2; S.nt = 8;
              EpiQup E{(bf16_t*)(ws + WS_QM), (const float*)(ws + WS_RSQ), rope}; gm::gemm_stream<false>(lds, S, E); }
            if (SUB(1)) { SchedPlain S; S.T.init(NRT, 4, G, G == 256 ? (c + 120) & 255 : c); S.A = (const char*)(ubuf + U_AKV); S.B = (const char*)(ws + WS_WUKV); S.lda2 = NU * 2; S.ldb2 = 256 * 2; S.nt = 4;
              EpiKVup E{(bf16_t*)(ws + WS_KM), (bf16_t*)(ws + WS_VM), (const float*)(ws + WS_RSQ) + MALL}; gm::gemm_stream<false>(lds, S, E); }
            if (SUB(2)) { SchedPlain S; S.T.init(NRT, 8, G, G == 256 ? (c + 112) & 255 : c); S.A = (const char*)(ws + WS_XCV); S.B = (const char*)(ws + WS_WRG); S.lda2 = 512 * 2; S.ldb2 = 512 * 2; S.nt = 8;
              EpiRG E{(const bf16_t*)(ws + WS_XCV), (bf16_t*)(ws + WS_LA), (bf16_t*)(ws + WS_BB), p.in[I_RGBR] + l * 1024, p.in[I_RGBI] + l * 1024, scal + 2048 + l * 1024}; gm::gemm_stream<false>(lds, S, E); }
            if (SUB(3)) for (int u = (G == 256 ? (c + 96) & 255 : c); u < 520 * 4; u += G) hg::pass1_unit(p, lds, scal + 256 + l * 512, u >> 2, u & 3);
            SEAM(pb + 6);
        }
        if (INL(7)) { PH_LOCALS job_rg_scan1(p); for (int u = c; u < 256; u += G) hg::carry_unit(p, u); SEAM(pb + 7); }
        if (INL(8)) { PH_LOCALS {
            REPEAT(81) if (SUB(0)) job_rg_out(p, nrt);
            REPEAT(82) if (SUB(1)) { const int ncu = need_ctx ? 520 * 4 : 512 * 4;
                if (G > nrt + 16) {
                    if (c < nrt) { for (int i = 0; i < 7; ++i) { const int u = c + i * nrt; hg::out_unit(p, lds, scal + 256 + l * 512, p.in[I_HNORM] + l * 128, u >> 2, u & 3); } }
                    else for (int u = 7 * nrt + (c - nrt); u < ncu; u += G - nrt) hg::out_unit(p, lds, scal + 256 + l * 512, p.in[I_HNORM] + l * 128, u >> 2, u & 3);
                } else for (int u = c; u < ncu; u += G) hg::out_unit(p, lds, scal + 256 + l * 512, p.in[I_HNORM] + l * 128, u >> 2, u & 3); }
            if (SUB(4) && need_ctx) for (int t = (G == 256 ? (c + 16) & 255 : c); t < 16; t += G) { const int bh = t & 7, b = bh >> 2, h = bh & 3; at::KeyMap km{MLAT + b * CTXL, 0, 4, 4};
                if (t < 8) attn_unit_mla(p, lds, MLAT + b * CTXL, h, km); else attn_unit_diff(p, lds, l, MLAT + b * CTXL, h, km); }
            REPEAT(83) if (SUB(2)) for (int t = c; t < 512; t += G) { const int bh = t & 7, qb = t >> 3, b = bh >> 2, h = bh & 3; at::KeyMap km{MLAT + b * CTXL, b * SEQ, 4, 260}; attn_unit_mla(p, lds, b * SEQ + qb * 256, h, km); }
            REPEAT(84) if (SUB(3)) for (int t = c; t < 512; t += G) { const int bh = t & 7, qb = t >> 3, b = bh >> 2, h = bh & 3; at::KeyMap km{MLAT + b * CTXL, b * SEQ, 4, 260}; attn_unit_diff(p, lds, l, b * SEQ + qb * 256, h, km); }
            }
            SEAM(pb + 8);
        }
        if (INL(9)) { PH_LOCALS
            const bool bal = need_ctx && G == 256 && MK_LAUNCHES == 1;
            bf16_t* part = mrg + (size_t)2 * MALL * DM; bf16_t* gx = part + (size_t)4 * MCTX * DM;
            EpiMergeG EG{mrg + (size_t)MALL * DM, p.in[I_MB] + l * 4 * DM, (const float*)(ws + WS_HSC2), (const float*)(ws + WS_WGS), bal, gx};
            EpiMergeY EY{mrg, mrg + (size_t)MALL * DM, bal, gx, part};
            REPEAT(9) {
#pragma unroll 1
            for (int n = 0; n < 4; ++n) { const int xe = (bal && c >= 16 * n && c < 16 * n + 16) ? c - 16 * n : -1, nrm = bal ? 128 : nrt;
                { SchedMergeG S; S.T.init(nrm, 8, G, c); S.h8 = (const char*)(ws + WS_H8); S.wg = (const char*)(ws + WS_WIN) + (size_t)NU * DM; S.n = n; S.xe = xe; gm::gemm_stream<false>(lds, S, EG); }
                { SchedMergeY S; S.T.init(nrm, 8, G, c); S.ybr = (const char*)(ws + WS_YBR); S.wbr = (const char*)(ws + WS_WBR); S.n = n; S.xe = xe; gm::gemm_stream<false>(lds, S, EY); }
            } }
            SEAM(pb + 9);
            if (bal) {
                const int tid = otid();
                for (int idx = c * 512 + tid; idx < MCTX * 256; idx += G * 512) { const int row = idx >> 8, q = idx & 255; float sm[8] = {0.f, 0.f, 0.f, 0.f, 0.f, 0.f, 0.f, 0.f};
#pragma unroll
                    for (int n = 0; n < 4; ++n) { const u32x4 w = *(const u32x4*)(part + ((size_t)n * MCTX + row) * DM + q * 8);
                        sm[0] += bflo(w.x); sm[1] += bfhi(w.x); sm[2] += bflo(w.y); sm[3] += bfhi(w.y); sm[4] += bflo(w.z); sm[5] += bfhi(w.z); sm[6] += bflo(w.w); sm[7] += bfhi(w.w); }
                    u32x4 o; o.x = cvt_pk_bf16(sm[0], sm[1]); o.y = cvt_pk_bf16(sm[2], sm[3]); o.z = cvt_pk_bf16(sm[4], sm[5]); o.w = cvt_pk_bf16(sm[6], sm[7]);
                    *(u32x4*)(mrg + (size_t)(MLAT + row) * DM + q * 8) = o; }
                xcd_barrier(bar);
            }
        }
        if (INL(10)) { PH_LOCALS
            const bool spl = need_ctx && G == 256 && MK_LAUNCHES == 1; float* ypart = (float*)(ws + WS_R1 + (size_t)MALL * DFF * 2);
            SchedSplitK S; S.T.init(spl ? 128 : nrt, 8, G, c); S.A = (const char*)mrg; S.B = (const char*)(ws + WS_WOUT); S.lda2 = DM * 2; S.ldb2 = DM * 2; S.nt = DM / 64; S.xe = (spl && c < 64) ? c : -1;
            EpiStoreK E{ybuf, ypart}; gm::gemm_stream<false>(lds, S, E); SEAM(pb + 10);
            if (spl) { job_splitk_reduce(ypart, ybuf); xcd_barrier(bar); }
        }
        if (INL(11)) { PH_LOCALS
            RNArgs a{}; a.xs_lat = p.out; a.xs_ctx = xc; a.xd_lat = p.out; a.xd_ctx = xc; a.y = ybuf; a.wres = 1.0f; a.modl_res = modl; a.jres = 1; a.postg = p.in[I_POST] + (l * 3 + 1) * DM;
            a.do_norm = true; a.modl_norm = modl; a.jn = 2; a.preg = p.in[I_PRE] + (l * 3 + 2) * DM; a.h = nullptr; a.h8 = (signed char*)hbuf; a.nrows = nrt * 256; a.hsc = (float*)(ws + WS_HSC);
            job_resnorm(a, lds); SEAM(pb + 11);
        }
        if (INL(12)) { PH_LOCALS
            SchedPlain S; S.T.init(nrt, 44, G, c); S.A = (const char*)hbuf; S.B = (const char*)(ws + WS_WGU) + (size_t)11264 * 2048; S.lda2 = DM; S.ldb2 = DM; S.nt = DM / 128;
            EpiGateUpI8 E{act, (const float*)(ws + WS_HSC), (const float*)(ws + WS_WSC) + 11264}; gm::gemm_stream<false>(lds, S, E); SEAM(pb + 12);
        }
        if (INL(13)) { PH_LOCALS
            const bool spl = need_ctx && G == 256 && MK_LAUNCHES == 1; float* ypart = (float*)(ws + WS_R1 + (size_t)MALL * DFF * 2);
            SchedSplitK S; S.T.init(spl ? 128 : nrt, 8, G, c); S.A = (const char*)act; S.B = (const char*)(ws + WS_WD) + (size_t)2048 * 5632 * 2; S.lda2 = DFF * 2; S.ldb2 = DFF * 2; S.nt = DFF / 64; S.xe = (spl && c < 64) ? c : -1;
            EpiStoreK E{ybuf, ypart}; gm::gemm_stream<false>(lds, S, E); SEAM(pb + 13);
            if (spl) { job_splitk_reduce(ypart, ybuf); xcd_barrier(bar); }
        }
    }
    if (EN(101) && IN(N_PHASES - 1)) {
        const int l = NL - 1; PH_LOCALS
        RNArgs a{}; a.xs_lat = p.out; a.xs_ctx = xc; a.xd_lat = p.out; a.xd_ctx = xc; a.y = ybuf; a.wres = 0.5f; a.modl_res = mod + (size_t)l * 3 * NMOD * DM; a.jres = 2; a.postg = p.in[I_POST] + (l * 3 + 2) * DM;
        a.do_norm = false; a.modl_norm = a.modl_res; a.jn = 0; a.preg = nullptr; a.h = nullptr; a.nrows = MLAT;
        job_resnorm(a, lds);
    }
#undef PH_LOCALS
#undef IN
#undef INL
#undef EN
#undef SEAM
}


#ifdef DBG_K
__global__ void dbg_dump(float* out, const unsigned char* ws, size_t off, size_t nelem, int is_bf16) {
    const size_t N = (size_t)MLAT * DM;
    for (size_t i = (size_t)obid() * blockDim.x + threadIdx.x; i < N; i += (size_t)gridDim.x * blockDim.x) {
        float s = 0.f;
        for (size_t j = i; j < nelem; j += N) s += is_bf16 ? bf2f(((const bf16_t*)(ws + off))[j]) : ((const float*)(ws + off))[j];
        out[i] = (s - s == 0.f) ? s : 12345.0f;
    }
}
#endif

extern "C" void kernel_launch(void* const* d_in, const int* in_sizes, int n_in, void* d_out, int out_size, void* d_ws, size_t ws_size, hipStream_t stream) {
    static int grid = 0;
    if (grid == 0) {
        if (n_in != 30 || out_size != MLAT * DM || ws_size < WS_END) { fprintf(stderr, "kernel_launch: unexpected shapes: n_in %d out %d ws %zu (need %zu)\n", n_in, out_size, ws_size, (size_t)WS_END); grid = -1; return; }
        int dev = 0, cus = 0;
        if (hipGetDevice(&dev) != hipSuccess || hipDeviceGetAttribute(&cus, hipDeviceAttributeMultiprocessorCount, dev) != hipSuccess) { grid = -1; return; }
        if (hipFuncSetAttribute((const void*)fwd_kernel, hipFuncAttributeMaxDynamicSharedMemorySize, LDS_BYTES) != hipSuccess) { fprintf(stderr, "kernel_launch: hipFuncSetAttribute failed\n"); grid = -1; return; }
        int per_cu = 0; (void)hipOccupancyMaxActiveBlocksPerMultiprocessor(&per_cu, (const void*)fwd_kernel, NTHR, LDS_BYTES); (void)hipGetLastError();
        grid = cus;
    }
    if (grid < 0) return;
    (void)hipMemsetAsync((char*)d_ws + WS_CTL, 0, WS_ZERO_BYTES, stream);
    KP p{};
    for (int i = 0; i < 30; ++i) p.in[i] = (const float*)d_in[i];
    p.out = (float*)d_out; p.ws = (unsigned char*)d_ws;
#ifdef DBG_K
    for (int k = 0; k < DBG_K; ++k) { p.ph_lo = k; p.ph_hi = k + 1; hipLaunchKernelGGL(fwd_kernel, dim3(grid), dim3(NTHR), LDS_BYTES, stream, p); }
    hipLaunchKernelGGL(dbg_dump, dim3(2048), dim3(256), 0, stream, (float*)d_out, (const unsigned char*)d_ws, (size_t)(DBG_OFF), (size_t)(DBG_N), (int)(DBG_BF));
#elif MK_LAUNCHES == 1
    p.ph_lo = 0; p.ph_hi = N_PHASES;
    hipLaunchKernelGGL(fwd_kernel, dim3(grid), dim3(NTHR), LDS_BYTES, stream, p);
#else
    for (int k = 0; k < N_PHASES; ++k) { p.ph_lo = k; p.ph_hi = k + 1; hipLaunchKernelGGL(fwd_kernel, dim3(grid), dim3(NTHR), LDS_BYTES, stream, p); }
#endif
}
```

```cpp
#include <hip/hip_runtime.h>
#include <stdint.h>
#include <stdio.h>

#define LAS __attribute__((address_space(3)))
typedef unsigned short bf16_t;
typedef short bf16x8 __attribute__((ext_vector_type(8)));
typedef short s16x4 __attribute__((ext_vector_type(4)));
typedef float f32x2 __attribute__((ext_vector_type(2)));
typedef float f32x4 __attribute__((ext_vector_type(4)));
typedef float f32x16 __attribute__((ext_vector_type(16)));
typedef unsigned u32x2 __attribute__((ext_vector_type(2)));
typedef unsigned u32x4 __attribute__((ext_vector_type(4)));
typedef int i32x4 __attribute__((ext_vector_type(4)));

constexpr int DM = 2048, NB = 2, SEQ = 16384, NL = 2, CTXL = 256, DFF = 5632, NMOD = 9;
constexpr int MLAT = NB * SEQ, MCTX = NB * CTXL, MALL = MLAT + MCTX;
constexpr int NRT = MALL / 256;
constexpr int DIN = 14144, NU = 6144;
constexpr float EPS = 1e-6f;
constexpr int U_AQ = 0, U_BX = 512, U_BG = 1024, U_CQ = 1536, U_CK = 2048, U_CV = 2560, U_DQ = 3072, U_DFF = 3584, U_DFB = 4096, U_DI = 4608, U_DG = 5120, U_AKV = 5632, U_AKR = 5888;

constexpr size_t al256(size_t x) { return (x + 255) / 256 * 256; }
constexpr size_t WS_CTL = 0;
constexpr size_t WS_CMAX = 16384;
constexpr size_t WS_CMAX2 = WS_CMAX + (size_t)NL * 2 * 2 * 5632 * 4;
constexpr size_t WS_ZERO_BYTES = 524288;
static_assert(WS_CMAX2 + (size_t)NL * 14336 * 4 <= WS_ZERO_BYTES, "column maxima inside the zeroed region");
constexpr size_t WS_MOD = 524288;
constexpr size_t WS_ROPE = WS_MOD + al256((size_t)NL * 3 * NMOD * DM * 4);
constexpr size_t WS_SCAL = WS_ROPE + 32768;
constexpr size_t WS_RSQ = WS_SCAL + 32768;
constexpr size_t WS_RGS = WS_RSQ + al256((size_t)MALL * 8);
constexpr size_t WS_HD = WS_RGS + al256((size_t)NRT * 2 * 512 * 8);
constexpr size_t WS_XC = WS_HD + al256((size_t)520 * 4 * 2 * 128 * 4);
constexpr size_t WS_WGU = WS_XC + (size_t)MCTX * DM * 4;
constexpr size_t WS_WD = WS_WGU + (size_t)2 * 11264 * 2048 * 2;
constexpr size_t WS_WIN = WS_WD + (size_t)2 * 2048 * 5632 * 2;
constexpr size_t WS_WUQ = WS_WIN + (size_t)14336 * 2048 * 2;
constexpr size_t WS_WUKV = WS_WUQ + (size_t)768 * 512 * 2;
constexpr size_t WS_WRG = WS_WUKV + (size_t)1024 * 256 * 2;
constexpr size_t WS_WBR = WS_WRG + (size_t)2048 * 512 * 2;
constexpr size_t WS_WOUT = WS_WBR + (size_t)4 * 2048 * 512 * 2;
constexpr size_t WS_HBUF = WS_WOUT + (size_t)2048 * 2048 * 2;
constexpr size_t WS_R1 = WS_HBUF + (size_t)MALL * DM * 2;
constexpr size_t WS_YBUF = WS_R1 + (size_t)MALL * NU * 2;
constexpr size_t WS_QM = WS_YBUF + (size_t)MALL * DM * 2;
constexpr size_t WS_KM = WS_QM + (size_t)MALL * 768 * 2;
constexpr size_t WS_VM = WS_KM + (size_t)MALL * 768 * 2;
constexpr size_t WS_YBR = WS_VM + (size_t)MALL * 512 * 2;
constexpr size_t WS_XCV = WS_YBR + (size_t)4 * MALL * 512 * 2;
constexpr size_t WS_LA = WS_XCV + (size_t)MALL * 512 * 2;
constexpr size_t WS_BB = WS_LA + (size_t)MALL * 1024 * 2;
constexpr size_t WS_WSC = WS_BB + (size_t)MALL * 1024 * 2;
constexpr size_t WS_HSC = WS_WSC + al256((size_t)2 * 11264 * 4);
constexpr size_t WS_HSC2 = WS_HSC + al256((size_t)MALL * 4);
constexpr size_t WS_WGS = WS_HSC2 + al256((size_t)MALL * 4);
constexpr size_t WS_WPS = WS_WGS + 32768;
constexpr size_t WS_H8 = WS_WPS + 32768;
constexpr size_t WS_END = WS_H8 + (size_t)MALL * DM;

constexpr int NTHR = 512;
constexpr int LDS_BYTES = 147456;
constexpr int LDS_MISC = 147456 - 64;

typedef __bf16 bf16x2n __attribute__((ext_vector_type(2)));
__device__ __forceinline__ unsigned cvt_pk_bf16(float lo, float hi) { const f32x2 v = {lo, hi}; const bf16x2n b = __builtin_convertvector(v, bf16x2n); return __builtin_bit_cast(unsigned, b); }
__device__ __forceinline__ bf16_t f2bf(float x) { return (bf16_t)(cvt_pk_bf16(x, 0.f) & 0xffffu); }
__device__ __forceinline__ float bf2f(bf16_t b) { return __uint_as_float(((unsigned)b) << 16); }
__device__ __forceinline__ float bflo(unsigned w) { return __uint_as_float(w << 16); }
__device__ __forceinline__ float bfhi(unsigned w) { return __uint_as_float(w & 0xffff0000u); }
__device__ __forceinline__ float frcp(float x) { return __builtin_amdgcn_rcpf(x); }
__device__ __forceinline__ float flog(float x) { return __builtin_amdgcn_logf(x) * 0.6931471805599453f; }
__device__ __forceinline__ float sigmoidf_(float x) { return frcp(1.0f + __expf(-x)); }
__device__ __forceinline__ float siluf_(float x) { return x * sigmoidf_(x); }
__device__ __forceinline__ float gelu_tanh(float x) { const float u = 0.7978845608028654f * (x + 0.044715f * x * x * x); const float t = 1.0f - 2.0f * frcp(1.0f + __expf(2.0f * u)); return 0.5f * x * (1.0f + t); }
__device__ __forceinline__ float shx(float v, int mask, int lane) { return __int_as_float(__builtin_amdgcn_ds_bpermute((lane ^ mask) << 2, __float_as_int(v))); }
__device__ __forceinline__ float wave_sum(float v, int lane) {
#pragma unroll
    for (int o = 32; o >= 1; o >>= 1) v += shx(v, o, lane);
    return v;
}
__device__ __forceinline__ int obid() { int b = blockIdx.x; asm volatile("" : "+s"(b)); return b; }
__device__ __forceinline__ int otid() { int t = threadIdx.x; asm volatile("" : "+v"(t)); return t; }
#define WAIT_VM0() asm volatile("s_waitcnt vmcnt(0)" ::: "memory")
#define WAIT_LGKM0() asm volatile("s_waitcnt lgkmcnt(0)" ::: "memory")

#define XB_TMO      128
#define XB_XCNT(j)  (256  + 64 * (j))
#define XB_XSUB(j)  (1280 + 64 * (j))
#define XB_XGEN(j)  (2304 + 64 * (j))
#define XB_TOP      3328
#define XB_TOPGEN   3392
#define XCD_BAR_WORDS 3456
#define XB_SPIN_CAP (1u << 22)
__device__ __forceinline__ unsigned xb_ld(unsigned* p)              { return __hip_atomic_load(p, __ATOMIC_RELAXED, __HIP_MEMORY_SCOPE_AGENT); }
__device__ __forceinline__ unsigned xb_add(unsigned* p, unsigned v) { return __hip_atomic_fetch_add(p, v, __ATOMIC_RELAXED, __HIP_MEMORY_SCOPE_AGENT); }
__device__ __forceinline__ unsigned xb_xcc_id() { return (unsigned)__builtin_amdgcn_s_getreg((3 << 11) | 20) & 0xFu; }
#define XB_SPIN(cond, bar) do { unsigned _sp = 0; while (cond) { __builtin_amdgcn_s_sleep(1); \
    if ((++_sp & 255u) == 0u) { if (xb_ld(&(bar)[XB_TMO])) break; if (_sp > XB_SPIN_CAP) { atomicAdd(&(bar)[XB_TMO], 1u); break; } } } } while (0)
struct XcdBarrier { unsigned* bar; unsigned x; volatile LAS unsigned* st; };
__device__ __forceinline__ XcdBarrier xcd_barrier_post(unsigned* bar, volatile LAS unsigned* st) {
    XcdBarrier b; b.bar = bar; b.x = xb_xcc_id(); b.st = st;
    if (threadIdx.x == 0) (void)xb_add(&bar[XB_XCNT(b.x)], 1u);
    return b;
}
__device__ __forceinline__ void xcd_barrier_complete(unsigned* bar, unsigned x, unsigned& nloc, unsigned& nx) {
    const unsigned G = gridDim.x * gridDim.y * gridDim.z;
    unsigned sum, cnt, mine, sp = 0u;
    for (;;) {
        sum = 0u; cnt = 0u; mine = 0u;
#pragma unroll 1
        for (unsigned j = 0; j < 16; ++j) { const unsigned c = xb_ld(&bar[XB_XCNT(j)]); sum += c; cnt += (c > 0u) ? 1u : 0u; mine = (j == x) ? c : mine; }
        if (sum == G) break;
        __builtin_amdgcn_s_sleep(1);
        if ((++sp & 255u) == 0u) { if (xb_ld(&bar[XB_TMO])) break; if (sp > XB_SPIN_CAP) { atomicAdd(&bar[XB_TMO], 1u); break; } }
    }
    nloc = mine > 0u ? mine : 1u; nx = cnt > 0u ? cnt : 1u;
}
__device__ __forceinline__ void xcd_barrier(const XcdBarrier& b) {
    asm volatile("s_waitcnt vmcnt(0)" ::: "memory");
    __syncthreads();
    if (threadIdx.x == 0) {
        unsigned* bar = b.bar; unsigned bx = b.x;
        asm volatile("" : "+s"(bar), "+s"(bx));
        __builtin_amdgcn_s_waitcnt(0);
        unsigned nloc = b.st[0], nx = b.st[1];
        if (nloc == 0u) { xcd_barrier_complete(bar, bx, nloc, nx); b.st[0] = nloc; b.st[1] = nx; }
        const unsigned old = xb_add(&bar[XB_XSUB(bx)], 1u);
        const unsigned gen = old / nloc;
        if (old + 1u == (gen + 1u) * nloc) {
            __builtin_amdgcn_fence(__ATOMIC_RELEASE, "agent");
            asm volatile("s_waitcnt vmcnt(0)" ::: "memory");
            const unsigned og = xb_add(&bar[XB_TOP], 1u);
            const unsigned tg = og / nx;
            if (og + 1u == (tg + 1u) * nx) xb_add(&bar[XB_TOPGEN], 1u);
            else XB_SPIN(xb_ld(&bar[XB_TOPGEN]) == tg, bar);
            __builtin_amdgcn_fence(__ATOMIC_ACQUIRE, "agent");
            xb_add(&bar[XB_XGEN(bx)], 1u);
            asm volatile("s_waitcnt vmcnt(0)" ::: "memory");
        } else {
            XB_SPIN(xb_ld(&bar[XB_XGEN(bx)]) == gen, bar);
            __builtin_amdgcn_fence(__ATOMIC_ACQUIRE, "agent");
            asm volatile("s_waitcnt vmcnt(0)" ::: "memory");
        }
    }
    __syncthreads();
}

constexpr float MLA_QC = 0.07216878364870322f * 1.4426950408889634f, DIFF_QC = 0.125f * 1.4426950408889634f;
namespace gm {
constexpr int BM = 256, BK = 64, HALF = 128, HTB = HALF * BK * 2, STAGE_BYTES = 8 * HTB;
__device__ __forceinline__ int lds_byte(int r, int c) { const int st = (r >> 4) * 2 + (c >> 5), rr = r & 15, cc = c & 31, ob = rr * 64 + cc * 2; return st * 1024 + (ob ^ (((ob >> 9) & 1) << 5)); }
__device__ __forceinline__ void stage_rc(int b, int& R, int& C) { const int st = b / 1024, sb = b % 1024, swz = sb ^ (((sb >> 9) & 1) << 5); R = (st >> 1) * 16 + swz / 64; C = (st & 1) * 32 + (swz % 64) / 2; }
__device__ __forceinline__ int perm32(int rho) { const int n = rho >> 4, i = rho & 15; return 8 * (i >> 2) + 4 * n + (i & 3); }

struct Unit { const char* A; const char* B; unsigned lda2, ldb2; int nt; int pm, pn, tag; };

struct TileOrder {
    int nM, nN, nwg, G, c, wgm;
    __device__ __forceinline__ void init(int nM_, int nN_, int G_, int c_, int wgm_ = 8) { nM = nM_; nN = nN_; nwg = nM * nN; G = G_; c = c_; wgm = wgm_; }
    __device__ __forceinline__ bool tile(int i, int& pm, int& pn) const {
        const long L = (long)i * G + c; if (L >= nwg) return false;
        int wgid = (int)L; { const int q = nwg / 8, r = nwg % 8, xcd = wgid % 8, off = wgid / 8; wgid = (xcd < r ? xcd * (q + 1) : r * (q + 1) + (xcd - r) * q) + off; }
        const int nig = wgm * nN, gid = wgid / nig, fm = gid * wgm, gsz = (nM - fm) < wgm ? (nM - fm) : wgm;
        pm = fm + ((wgid % nig) % gsz); pn = (wgid % nig) / gsz; return true;
    }
};

typedef i32x4 AccI[2][2][4][2];
__device__ __forceinline__ void zero_acc(AccI& acc) {
#pragma unroll
    for (int a = 0; a < 2; ++a)
#pragma unroll
        for (int b = 0; b < 2; ++b)
#pragma unroll
            for (int m = 0; m < 4; ++m)
#pragma unroll
                for (int n = 0; n < 2; ++n) acc[a][b][m][n] = (i32x4){0, 0, 0, 0};
}
template <class E> struct is_mixed { static constexpr bool v = false; };
typedef f32x4 Acc[2][2][4][2];
__device__ __forceinline__ void zero_acc(Acc& acc) {
#pragma unroll
    for (int a = 0; a < 2; ++a)
#pragma unroll
        for (int b = 0; b < 2; ++b)
#pragma unroll
            for (int m = 0; m < 4; ++m)
#pragma unroll
                for (int n = 0; n < 2; ++n) acc[a][b][m][n] = (f32x4){0.f, 0.f, 0.f, 0.f};
}

template <bool HALFN, class Sched, class Epi>
__device__ __forceinline__ void gemm_stream(LAS unsigned char* lds, const Sched& S, Epi& E) {
    const int tid = otid(), wid = __builtin_amdgcn_readfirstlane(tid >> 6), lane = tid & 63, wr = wid >> 2, wc = wid & 3, fr = lane & 15, fq = lane >> 4;
    int R0, C0; stage_rc(tid * 16, R0, C0);
    const int Rb0 = Epi::PERM ? ((R0 & ~31) + perm32(R0 & 31)) : R0;
    const unsigned ldsw = (unsigned)wid * 1024u;
    const int aoff = lds_byte(wr * 64 + fr, fq * 8), boff = lds_byte(wc * 32 + fr, fq * 8);
#define GM_SA(b, h) (((b) * 2 + (h)) * HTB)
#define GM_SB(b, h) ((4 + (b) * 2 + (h)) * HTB)
#define GM_STAGE(bufoff, gbase, voff, ld2) do { _Pragma("unroll") for (int _i = 0; _i < 2; ++_i) \
        __builtin_amdgcn_global_load_lds((const unsigned*)((const char*)(gbase) + (size_t)_i * 64 * (ld2) + (voff)), (LAS unsigned*)(lds + (bufoff) + ldsw + _i * 8192), 16, 0, 0); } while (0)
#define GM_LDA(dst, b, h) do { _Pragma("unroll") for (int m = 0; m < 4; ++m) _Pragma("unroll") for (int k = 0; k < 2; ++k) dst[m][k] = *(const LAS bf16x8*)(lds + GM_SA(b, h) + aoff + m * 2048 + k * 1024); } while (0)
#define GM_LDB(dst, b, h) do { _Pragma("unroll") for (int n = 0; n < 2; ++n) _Pragma("unroll") for (int k = 0; k < 2; ++k) dst[n][k] = *(const LAS bf16x8*)(lds + GM_SB(b, h) + boff + n * 2048 + k * 1024); } while (0)
#define GM_MMA_I8(ai, bj, At, Bt) do { _Pragma("unroll") for (int m = 0; m < 4; ++m) _Pragma("unroll") for (int n = 0; n < 2; ++n) _Pragma("unroll") for (int k = 0; k < 2; ++k) \
        acc[ai][bj][m][n] = __builtin_bit_cast(typename Epi::AccT_elem, __builtin_amdgcn_mfma_i32_16x16x64_i8(__builtin_bit_cast(i32x4, Bt[n][k]), __builtin_bit_cast(i32x4, At[m][k]), __builtin_bit_cast(i32x4, acc[ai][bj][m][n]), 0, 0, 0)); } while (0)
#define GM_MMA_BF(ai, bj, At, Bt) do { _Pragma("unroll") for (int m = 0; m < 4; ++m) _Pragma("unroll") for (int n = 0; n < 2; ++n) _Pragma("unroll") for (int k = 0; k < 2; ++k) \
        acc[ai][bj][m][n] = __builtin_bit_cast(typename Epi::AccT_elem, __builtin_amdgcn_mfma_f32_16x16x32_bf16(Bt[n][k], At[m][k], __builtin_bit_cast(f32x4, acc[ai][bj][m][n]), 0, 0, 0)); } while (0)
#define GM_MMA(ai, bj, At, Bt) do { __builtin_amdgcn_s_setprio(1); \
        if constexpr (is_mixed<Epi>::v) { if (cur_i8) GM_MMA_I8(ai, bj, At, Bt); else GM_MMA_BF(ai, bj, At, Bt); } \
        else if constexpr (Epi::I8) GM_MMA_I8(ai, bj, At, Bt); else GM_MMA_BF(ai, bj, At, Bt); \
        __builtin_amdgcn_s_setprio(0); } while (0)
#define GM_WAIT_V(n) asm volatile("s_waitcnt vmcnt(" #n ")" ::: "memory")
#define GM_WAIT_L(n) asm volatile("s_waitcnt lgkmcnt(" #n ")" ::: "memory")
#define GM_BAR __builtin_amdgcn_s_barrier()
#define GM_SCHED __builtin_amdgcn_sched_barrier(0)
    Unit cur, nxt; int ui = 0;
    if (!S.next(0, cur)) return;
    typename Epi::AccT acc;
    bf16x8 At[4][2], B0[2][2], B1[2][2];
    unsigned voffA = (unsigned)R0 * cur.lda2 + (unsigned)C0 * 2u, voffB = (unsigned)Rb0 * cur.ldb2 + (unsigned)C0 * 2u;
    const char* cA = cur.A; const char* cB = cur.B;
    {
        const size_t hA = (size_t)HALF * cur.lda2, hB = (size_t)HALF * cur.ldb2;
        GM_STAGE(GM_SB(0, 0), cB, voffB, cur.ldb2); GM_STAGE(GM_SA(0, 0), cA, voffA, cur.lda2);
        if constexpr (!HALFN) GM_STAGE(GM_SB(0, 1), cB + hB, voffB, cur.ldb2);
        GM_STAGE(GM_SA(0, 1), cA + hA, voffA, cur.lda2);
        if (wr == 1) GM_BAR;
        if constexpr (HALFN) GM_WAIT_V(2); else GM_WAIT_V(4);
        GM_BAR;
        GM_STAGE(GM_SB(1, 0), cB + 128, voffB, cur.ldb2); GM_STAGE(GM_SA(1, 0), cA + 128, voffA, cur.lda2);
        if constexpr (!HALFN) GM_STAGE(GM_SB(1, 1), cB + hB + 128, voffB, cur.ldb2);
        if constexpr (HALFN) GM_WAIT_V(4); else GM_WAIT_V(6);
        GM_BAR;
    }
#define GM_UNIT(BJ) { \
        if constexpr (HALFN) { _Pragma("unroll") for (int _a = 0; _a < 2; ++_a) _Pragma("unroll") for (int _m = 0; _m < 4; ++_m) _Pragma("unroll") for (int _n = 0; _n < 2; ++_n) acc[_a][0][_m][_n] = (f32x4){0.f, 0.f, 0.f, 0.f}; } \
        else zero_acc(acc); \
        const bool cur_i8 = (cur.tag & 1) == 0; (void)cur_i8; \
        const bool has_next = S.next(ui + 1, nxt); \
        const char* nA = has_next ? nxt.A : cA; const char* nB = has_next ? nxt.B : cB; \
        const unsigned nlda2 = has_next ? nxt.lda2 : cur.lda2, nldb2 = has_next ? nxt.ldb2 : cur.ldb2; \
        const unsigned nvoffA = (unsigned)R0 * nlda2 + (unsigned)C0 * 2u, nvoffB = (unsigned)Rb0 * nldb2 + (unsigned)C0 * 2u; \
        const size_t hA = (size_t)HALF * cur.lda2, hB = (size_t)HALF * cur.ldb2, nhA = (size_t)HALF * nlda2, nhB = (size_t)HALF * nldb2; \
        const int nt = cur.nt; \
        for (int t = 0; t < nt; t += 2) { \
            const bool last = (t == nt - 2); \
            const char* a1 = cA + (size_t)(t + 1) * 128; \
            const char* a2 = last ? nA : cA + (size_t)(t + 2) * 128; const char* b2 = last ? nB : cB + (size_t)(t + 2) * 128; \
            const char* a3 = a2 + 128; const char* b3 = b2 + 128; \
            const unsigned vA2 = last ? nvoffA : voffA, vB2 = last ? nvoffB : voffB; \
            const unsigned lA2 = last ? nlda2 : cur.lda2, lB2 = last ? nldb2 : cur.ldb2; \
            const size_t hA2 = last ? nhA : hA, hB2 = last ? nhB : hB; \
              \
            GM_LDB(B0, 0, 0); GM_SCHED; GM_LDA(At, 0, 0); GM_STAGE(GM_SA(1, 1), a1 + hA, voffA, cur.lda2); \
            GM_WAIT_L(8); GM_BAR; GM_WAIT_L(0); GM_MMA(0, 0, At, B0); GM_BAR; GM_SCHED; \
              \
            if constexpr (!HALFN) GM_LDB(B1, 0, 1); \
            GM_STAGE(GM_SB(0, 0), b2, vB2, lB2); \
            GM_BAR; GM_WAIT_L(0); if constexpr (!HALFN) GM_MMA(0, 1, At, B1); GM_BAR; \
              \
            GM_LDA(At, 0, 1); GM_STAGE(GM_SA(0, 0), a2, vA2, lA2); \
            GM_BAR; GM_WAIT_L(0); GM_MMA(1, 0, At, B0); GM_BAR; GM_SCHED; \
              \
            if constexpr (!HALFN) { GM_STAGE(GM_SB(0, 1), b2 + hB2, vB2, lB2); GM_WAIT_V(6); } else { GM_WAIT_V(4); } \
            GM_BAR; if constexpr (!HALFN) GM_MMA(1, 1, At, B1); GM_BAR; \
              \
            GM_LDB(B0, 1, 0); GM_SCHED; GM_LDA(At, 1, 0); GM_STAGE(GM_SA(0, 1), a2 + hA2, vA2, lA2); \
            GM_WAIT_L(8); GM_BAR; GM_WAIT_L(0); GM_MMA(0, 0, At, B0); GM_BAR; GM_SCHED; \
              \
            if constexpr (!HALFN) GM_LDB(B1, 1, 1); \
            GM_STAGE(GM_SB(1, 0), b3, vB2, lB2); \
            GM_BAR; GM_WAIT_L(0); if constexpr (!HALFN) GM_MMA(0, 1, At, B1); GM_BAR; \
              \
            GM_LDA(At, 1, 1); GM_STAGE(GM_SA(1, 0), a3, vA2, lA2); \
            GM_BAR; GM_WAIT_L(0); GM_MMA(1, 0, At, B0); GM_BAR; GM_SCHED; \
              \
            if constexpr (!HALFN) { GM_STAGE(GM_SB(1, 1), b3 + hB2, vB2, lB2); GM_WAIT_V(6); } else { GM_WAIT_V(4); } \
            GM_BAR; if constexpr (!HALFN) GM_MMA(1, 1, At, B1); GM_BAR; \
        } \
        { const int tz_ = otid(); const int wz_ = __builtin_amdgcn_readfirstlane(tz_ >> 6), lz_ = tz_ & 63; E.template post<BJ>(acc, cur, wz_ >> 2, wz_ & 3, lz_ & 15, lz_ >> 4); } \
        if (!has_next) break; \
        cur = nxt; cA = nA; cB = nB; voffA = nvoffA; voffB = nvoffB; ++ui; \
    }
    for (;;) {
        GM_UNIT(0)
    }
    GM_WAIT_V(0);
    if (wr == 0) GM_BAR;
    GM_BAR;
#undef GM_UNIT
#undef GM_SA
#undef GM_SB
#undef GM_STAGE
#undef GM_LDA
#undef GM_LDB
#undef GM_MMA
#undef GM_MMA_I8
#undef GM_MMA_BF
#undef GM_WAIT_V
#undef GM_WAIT_L
#undef GM_BAR
#undef GM_SCHED
}
}

struct SchedPlain {
    gm::TileOrder T; const char* A; const char* B; unsigned lda2, ldb2; int nt;
    __device__ __forceinline__ bool next(int i, gm::Unit& u) const {
        int pm, pn; if (!T.tile(i, pm, pn)) return false;
        u.A = A + (size_t)pm * 256 * lda2; u.B = B + (size_t)pn * 256 * ldb2; u.lda2 = lda2; u.ldb2 = ldb2; u.nt = nt; u.pm = pm; u.pn = pn; u.tag = 0; return true;
    }
};
struct SchedSplitK {
    gm::TileOrder T; const char* A; const char* B; unsigned lda2, ldb2; int nt, xe;
    __device__ __forceinline__ bool next(int i, gm::Unit& u) const {
        int pm, pn; u.lda2 = lda2; u.ldb2 = ldb2;
        if (T.tile(i, pm, pn)) { u.A = A + (size_t)pm * 256 * lda2; u.B = B + (size_t)pn * 256 * ldb2; u.nt = nt; u.pm = pm; u.pn = pn; u.tag = 0; return true; }
        if (xe < 0 || i != 4) return false;
        const int e = xe >> 2, sl = xe & 3, ks = nt >> 2; pm = 128 + (e & 1); pn = e >> 1;
        u.A = A + (size_t)pm * 256 * lda2 + (size_t)sl * ks * 128; u.B = B + (size_t)pn * 256 * ldb2 + (size_t)sl * ks * 128; u.nt = ks; u.pm = pm; u.pn = pn; u.tag = 1 + sl; return true;
    }
};
struct SchedMergeG {
    gm::TileOrder T; const char* h8; const char* wg; int n, xe;
    __device__ __forceinline__ bool next(int i, gm::Unit& u) const {
        int pm, pn; if (!T.tile(i, pm, pn)) { if (xe < 0 || i != 4) return false; pm = 128 + (xe & 1); pn = xe >> 1; }
        u.A = h8 + (size_t)pm * 256 * 2048; u.lda2 = 2048; u.nt = 16; u.B = wg + ((size_t)n * 2048 + (size_t)pn * 256) * 2048; u.ldb2 = 2048; u.pm = pm; u.pn = pn; u.tag = n; return true;
    }
};
struct SchedMergeY {
    gm::TileOrder T; const char* ybr; const char* wbr; int n, xe;
    __device__ __forceinline__ bool next(int i, gm::Unit& u) const {
        int pm, pn; if (!T.tile(i, pm, pn)) { if (xe < 0 || i != 4) return false; pm = 128 + (xe & 1); pn = xe >> 1; }
        u.A = ybr + (size_t)n * MALL * 1024 + (size_t)pm * 256 * 1024; u.lda2 = 1024; u.nt = 8; u.B = wbr + ((size_t)n * 2048 + (size_t)pn * 256) * 1024; u.ldb2 = 1024; u.pm = pm; u.pn = pn; u.tag = n; return true;
    }
};

struct EpiGateUp {
    static constexpr bool PERM = true, I8 = false; typedef gm::Acc AccT; typedef f32x4 AccT_elem; bf16_t* act;
    template <int BJ> __device__ __forceinline__ void post(gm::Acc& acc, const gm::Unit& u, int wr, int wc, int fr, int fq) {
        const int row0 = u.pm * 256 + wr * 64 + fr, col0 = u.pn * 128 + wc * 32 + 8 * fq;
#pragma unroll
        for (int ai = 0; ai < 2; ++ai)
#pragma unroll
            for (int m = 0; m < 4; ++m) {
                float v[8];
#pragma unroll
                for (int n = 0; n < 2; ++n)
#pragma unroll
                    for (int j = 0; j < 4; ++j) v[n * 4 + j] = siluf_(acc[ai][0][m][n][j]) * acc[ai][1][m][n][j];
                u32x4 w; w.x = cvt_pk_bf16(v[0], v[1]); w.y = cvt_pk_bf16(v[2], v[3]); w.z = cvt_pk_bf16(v[4], v[5]); w.w = cvt_pk_bf16(v[6], v[7]);
                *(u32x4*)(act + (size_t)(row0 + ai * 128 + m * 16) * DFF + col0) = w;
            }
    }
};
struct EpiGateUpI8 {
    static constexpr bool PERM = true, I8 = true; typedef gm::AccI AccT; typedef i32x4 AccT_elem; bf16_t* act; const float* hsc; const float* wsc;
    template <int BJ> __device__ __forceinline__ void post(gm::AccI& acc, const gm::Unit& u, int wr, int wc, int fr, int fq) {
        const int row0 = u.pm * 256 + wr * 64 + fr, col0 = u.pn * 128 + wc * 32 + 8 * fq, wrow = u.pn * 256 + wc * 32 + 8 * fq;
        float sg[8], su[8];
#pragma unroll
        for (int j = 0; j < 8; ++j) { sg[j] = wsc[wrow + j]; su[j] = wsc[wrow + 128 + j]; }
        float hsv[8];
#pragma unroll
        for (int i = 0; i < 8; ++i) hsv[i] = hsc[row0 + (i >> 2) * 128 + (i & 3) * 16];
#pragma unroll
        for (int ai = 0; ai < 2; ++ai)
#pragma unroll
            for (int m = 0; m < 4; ++m) {
                const int row = row0 + ai * 128 + m * 16; const float hs = hsv[ai * 4 + m];
                float v[8];
#pragma unroll
                for (int n = 0; n < 2; ++n)
#pragma unroll
                    for (int j = 0; j < 4; ++j) { const float g = (float)acc[ai][0][m][n][j] * (hs * sg[n * 4 + j]), up = (float)acc[ai][1][m][n][j] * (hs * su[n * 4 + j]); v[n * 4 + j] = siluf_(g) * up; }
                u32x4 w; w.x = cvt_pk_bf16(v[0], v[1]); w.y = cvt_pk_bf16(v[2], v[3]); w.z = cvt_pk_bf16(v[4], v[5]); w.w = cvt_pk_bf16(v[6], v[7]);
                *(u32x4*)(act + (size_t)row * DFF + col0) = w;
            }
    }
};
struct EpiStore {
    static constexpr bool PERM = true, I8 = false; typedef gm::Acc AccT; typedef f32x4 AccT_elem; bf16_t* O; int ldc;
    template <int BJ> __device__ __forceinline__ void post(gm::Acc& acc, const gm::Unit& u, int wr, int wc, int fr, int fq) {
        const int row0 = u.pm * 256 + wr * 64 + fr, col0 = u.pn * 256 + wc * 32 + 8 * fq;
#pragma unroll
        for (int ai = 0; ai < 2; ++ai)
#pragma unroll
            for (int m = 0; m < 4; ++m)
#pragma unroll
                for (int bj = 0; bj < 2; ++bj) {
                    const f32x4 a = acc[ai][bj][m][0], b = acc[ai][bj][m][1];
                    u32x4 w; w.x = cvt_pk_bf16(a[0], a[1]); w.y = cvt_pk_bf16(a[2], a[3]); w.z = cvt_pk_bf16(b[0], b[1]); w.w = cvt_pk_bf16(b[2], b[3]);
                    *(u32x4*)(O + (size_t)(row0 + ai * 128 + m * 16) * ldc + col0 + bj * 128) = w;
                }
    }
};
struct EpiStoreK {
    static constexpr bool PERM = true, I8 = false; typedef gm::Acc AccT; typedef f32x4 AccT_elem; bf16_t* O; float* yp;
    template <int BJ> __device__ __forceinline__ void post(gm::Acc& acc, const gm::Unit& u, int wr, int wc, int fr, int fq) {
        const int row0 = u.pm * 256 + wr * 64 + fr, col0 = u.pn * 256 + wc * 32 + 8 * fq;
        if (u.tag == 0) {
#pragma unroll
            for (int ai = 0; ai < 2; ++ai)
#pragma unroll
                for (int m = 0; m < 4; ++m)
#pragma unroll
                    for (int bj = 0; bj < 2; ++bj) {
                        const f32x4 a = acc[ai][bj][m][0], b = acc[ai][bj][m][1];
                        u32x4 w; w.x = cvt_pk_bf16(a[0], a[1]); w.y = cvt_pk_bf16(a[2], a[3]); w.z = cvt_pk_bf16(b[0], b[1]); w.w = cvt_pk_bf16(b[2], b[3]);
                        *(u32x4*)(O + (size_t)(row0 + ai * 128 + m * 16) * DM + col0 + bj * 128) = w;
                    }
        } else {
            float* base = yp + (size_t)(u.tag - 1) * MCTX * DM;
#pragma unroll
            for (int ai = 0; ai < 2; ++ai)
#pragma unroll
                for (int m = 0; m < 4; ++m)
#pragma unroll
                    for (int bj = 0; bj < 2; ++bj) { float* o = base + (size_t)(row0 - MLAT + ai * 128 + m * 16) * DM + col0 + bj * 128;
                        *(f32x4*)o = acc[ai][bj][m][0]; *(f32x4*)(o + 4) = acc[ai][bj][m][1]; }
        }
    }
};
__device__ __forceinline__ void job_splitk_reduce(const float* yp, bf16_t* y) {
    const int c = obid(), tid = otid(), G = gridDim.x;
    for (int idx = c * 512 + tid; idx < MCTX * 256; idx += G * 512) { const int row = idx >> 8, q = idx & 255; f32x4 a = {0.f, 0.f, 0.f, 0.f}, b = a;
#pragma unroll
        for (int sl = 0; sl < 4; ++sl) { const float* s = yp + ((size_t)sl * MCTX + row) * DM + q * 8; a += *(const f32x4*)s; b += *(const f32x4*)(s + 4); }
        u32x4 o; o.x = cvt_pk_bf16(a[0], a[1]); o.y = cvt_pk_bf16(a[2], a[3]); o.z = cvt_pk_bf16(b[0], b[1]); o.w = cvt_pk_bf16(b[2], b[3]);
        *(u32x4*)(y + (size_t)(MLAT + row) * DM + q * 8) = o; }
}
__device__ __forceinline__ void rope4(f32x4& x0, f32x4& x1, const float* rope, int pos, int fq) {
    const f32x4 t0 = *(const f32x4*)(rope + pos * 32 + 8 * fq), t1 = *(const f32x4*)(rope + pos * 32 + 8 * fq + 4);
    const float c[4] = {t0[0], t0[2], t1[0], t1[2]}, s[4] = {t0[1], t0[3], t1[1], t1[3]};
#pragma unroll
    for (int j = 0; j < 4; ++j) { const float a = x0[j], b = x1[j]; x0[j] = a * c[j] - b * s[j]; x1[j] = a * s[j] + b * c[j]; }
}
__device__ __forceinline__ void rope4v(f32x4& x0, f32x4& x1, const f32x4 t0, const f32x4 t1) {
    const float c[4] = {t0[0], t0[2], t1[0], t1[2]}, s[4] = {t0[1], t0[3], t1[1], t1[3]};
#pragma unroll
    for (int j = 0; j < 4; ++j) { const float a = x0[j], b = x1[j]; x0[j] = a * c[j] - b * s[j]; x1[j] = a * s[j] + b * c[j]; }
}
struct EpiProj {
    static constexpr bool PERM = false, I8 = true; typedef gm::AccI AccT; typedef i32x4 AccT_elem; bf16_t* ubuf; bf16_t* km; const float* rope; const float* hsc; const float* wps;
    template <int BJ> __device__ __forceinline__ void post(gm::AccI& acc, const gm::Unit& u, int wr, int wc, int fr, int fq) {
        const int pn = u.pn; const bool lat = u.pm < 128, ropet = (pn >= 6 && pn <= 9), akr = (pn == 23);
        const int row0 = u.pm * 256 + wr * 64 + fr;
        f32x4 wsv[2][2];
#pragma unroll
        for (int bj = 0; bj < 2; ++bj)
#pragma unroll
            for (int n = 0; n < 2; ++n) wsv[bj][n] = *(const f32x4*)(wps + pn * 256 + bj * 128 + wc * 32 + 16 * n + 4 * fq);
        float hsv[8];
#pragma unroll
        for (int i = 0; i < 8; ++i) hsv[i] = hsc[row0 + (i >> 2) * 128 + (i & 3) * 16];
        const bool dor = lat && (ropet || (akr && wc < 2));
#pragma unroll
        for (int ai = 0; ai < 2; ++ai) {
            f32x4 rt[4][2];
            if (dor) {
#pragma unroll
                for (int m = 0; m < 4; ++m) { const int s = (row0 + ai * 128 + m * 16) & (SEQ - 1), pos = (wc & 1) ? (s & 63) : (s >> 6);
                    rt[m][0] = *(const f32x4*)(rope + pos * 32 + 8 * fq); rt[m][1] = *(const f32x4*)(rope + pos * 32 + 8 * fq + 4); }
            }
#pragma unroll
            for (int m = 0; m < 4; ++m) {
                const int row = row0 + ai * 128 + m * 16; const float hs = hsv[ai * 4 + m] * ((pn == 6 || pn == 7) ? DIFF_QC : 1.0f);
#pragma unroll
                for (int bj = 0; bj < 2; ++bj) {
                    f32x4 x0, x1;
#pragma unroll
                    for (int j = 0; j < 4; ++j) { x0[j] = (float)acc[ai][bj][m][0][j] * (hs * wsv[bj][0][j]); x1[j] = (float)acc[ai][bj][m][1][j] * (hs * wsv[bj][1][j]); }
                    const bool akr_blk = akr && bj == 0 && wc < 2;
                    if (lat && (ropet || akr_blk)) rope4v(x0, x1, rt[m][0], rt[m][1]);
                    u32x2 w0, w1; w0.x = cvt_pk_bf16(x0[0], x0[1]); w0.y = cvt_pk_bf16(x0[2], x0[3]); w1.x = cvt_pk_bf16(x1[0], x1[1]); w1.y = cvt_pk_bf16(x1[2], x1[3]);
                    if (!akr) { bf16_t* o = ubuf + (size_t)row * NU + pn * 256 + bj * 128 + wc * 32 + 4 * fq; *(u32x2*)o = w0; *(u32x2*)(o + 16) = w1; }
                    else if (akr_blk) {
#pragma unroll
                        for (int h = 0; h < 4; ++h) { bf16_t* o = km + (size_t)row * 768 + h * 192 + 128 + wc * 32 + 4 * fq; *(u32x2*)o = w0; *(u32x2*)(o + 16) = w1; }
                    }
                }
            }
        }
    }
};
struct EpiQup {
    static constexpr bool PERM = false, I8 = false; typedef gm::Acc AccT; typedef f32x4 AccT_elem; bf16_t* qm; const float* rsq; const float* rope;
    template <int BJ> __device__ __forceinline__ void post(gm::Acc& acc, const gm::Unit& u, int wr, int wc, int fr, int fq) {
        const bool lat = u.pm < 128; const int row0 = u.pm * 256 + wr * 64 + fr;
        float rsv[8];
#pragma unroll
        for (int i = 0; i < 8; ++i) rsv[i] = rsq[row0 + (i >> 2) * 128 + (i & 3) * 16];
#pragma unroll
        for (int ai = 0; ai < 2; ++ai)
#pragma unroll
            for (int m = 0; m < 4; ++m) {
                const int row = row0 + ai * 128 + m * 16, s = row & (SEQ - 1); const float rs = rsv[ai * 4 + m] * MLA_QC;
#pragma unroll
                for (int bj = 0; bj < 2; ++bj) {
                    const int b32 = 8 * u.pn + 4 * bj + wc, m6 = b32 % 6;
                    f32x4 x0 = acc[ai][bj][m][0] * rs, x1 = acc[ai][bj][m][1] * rs;
                    if (lat && m6 >= 4) rope4(x0, x1, rope, (m6 == 5) ? (s & 63) : (s >> 6), fq);
                    u32x2 w0, w1; w0.x = cvt_pk_bf16(x0[0], x0[1]); w0.y = cvt_pk_bf16(x0[2], x0[3]); w1.x = cvt_pk_bf16(x1[0], x1[1]); w1.y = cvt_pk_bf16(x1[2], x1[3]);
                    bf16_t* o = qm + (size_t)row * 768 + b32 * 32 + 4 * fq; *(u32x2*)o = w0; *(u32x2*)(o + 16) = w1;
                }
            }
    }
};
struct EpiKVup {
    static constexpr bool PERM = true, I8 = false; typedef gm::Acc AccT; typedef f32x4 AccT_elem; bf16_t* km; bf16_t* vm; const float* rsk;
    template <int BJ> __device__ __forceinline__ void post(gm::Acc& acc, const gm::Unit& u, int wr, int wc, int fr, int fq) {
        const int row0 = u.pm * 256 + wr * 64 + fr, h = u.pn, c0 = wc * 32 + 8 * fq;
        float rsv[8];
#pragma unroll
        for (int i = 0; i < 8; ++i) rsv[i] = rsk[row0 + (i >> 2) * 128 + (i & 3) * 16];
#pragma unroll
        for (int ai = 0; ai < 2; ++ai)
#pragma unroll
            for (int m = 0; m < 4; ++m) {
                const int row = row0 + ai * 128 + m * 16; const float rs = rsv[ai * 4 + m];
#pragma unroll
                for (int bj = 0; bj < 2; ++bj) {
                    const f32x4 a = acc[ai][bj][m][0] * rs, b = acc[ai][bj][m][1] * rs;
                    u32x4 w; w.x = cvt_pk_bf16(a[0], a[1]); w.y = cvt_pk_bf16(a[2], a[3]); w.z = cvt_pk_bf16(b[0], b[1]); w.w = cvt_pk_bf16(b[2], b[3]);
                    if (bj == 0) *(u32x4*)(km + (size_t)row * 768 + h * 192 + c0) = w; else *(u32x4*)(vm + (size_t)row * 512 + h * 128 + c0) = w;
                }
            }
    }
};
struct EpiRG {
    static constexpr bool PERM = true, I8 = false; typedef gm::Acc AccT; typedef f32x4 AccT_elem; const bf16_t* xcv; bf16_t* la; bf16_t* bb; const float* b_r; const float* b_i; const float* sp;
    template <int BJ> __device__ __forceinline__ void post(gm::Acc& acc, const gm::Unit& u, int wr, int wc, int fr, int fq) {
        const int d = u.pn >> 2, w0 = (u.pn & 3) * 128 + wc * 32 + 8 * fq, row0 = u.pm * 256 + wr * 64 + fr;
        float br[8], bi[8], sv[8];
#pragma unroll
        for (int j = 0; j < 8; ++j) { br[j] = b_r[d * 512 + w0 + j]; bi[j] = b_i[d * 512 + w0 + j]; sv[j] = sp[d * 512 + w0 + j]; }
        u32x4 xwv[8];
#pragma unroll
        for (int i = 0; i < 8; ++i) xwv[i] = *(const u32x4*)(xcv + (size_t)(row0 + (i >> 2) * 128 + (i & 3) * 16) * 512 + w0);
#pragma unroll
        for (int ai = 0; ai < 2; ++ai)
#pragma unroll
            for (int m = 0; m < 4; ++m) {
                const int row = row0 + ai * 128 + m * 16;
                const u32x4 xw = xwv[ai * 4 + m];
                const float xv[8] = {bflo(xw.x), bfhi(xw.x), bflo(xw.y), bfhi(xw.y), bflo(xw.z), bfhi(xw.z), bflo(xw.w), bfhi(xw.w)};
                float lo[8], bo[8];
#pragma unroll
                for (int n = 0; n < 2; ++n)
#pragma unroll
                    for (int j = 0; j < 4; ++j) {
                        const int k = n * 4 + j;
                        const float r = sigmoidf_(acc[ai][0][m][n][j] + br[k]), ig = sigmoidf_(acc[ai][1][m][n][j] + bi[k]);
                        const float l_a = -8.0f * r * sv[k], x2 = 2.0f * l_a;
                        const float om = (x2 > -0.3f) ? (-x2 * (1.0f + x2 * (0.5f + x2 * (0.16666667f + x2 * (0.041666668f + x2 * 0.0083333338f))))) : (1.0f - __expf(x2));
                        lo[k] = l_a; bo[k] = __builtin_amdgcn_sqrtf(om) * ig * xv[k];
                    }
                u32x4 wl, wb;
                wl.x = cvt_pk_bf16(lo[0], lo[1]); wl.y = cvt_pk_bf16(lo[2], lo[3]); wl.z = cvt_pk_bf16(lo[4], lo[5]); wl.w = cvt_pk_bf16(lo[6], lo[7]);
                wb.x = cvt_pk_bf16(bo[0], bo[1]); wb.y = cvt_pk_bf16(bo[2], bo[3]); wb.z = cvt_pk_bf16(bo[4], bo[5]); wb.w = cvt_pk_bf16(bo[6], bo[7]);
                *(u32x4*)(la + (size_t)row * 1024 + d * 512 + w0) = wl; *(u32x4*)(bb + (size_t)row * 1024 + d * 512 + w0) = wb;
            }
    }
};
struct EpiMergeG {
    static constexpr bool PERM = true, I8 = true; typedef gm::AccI AccT; typedef i32x4 AccT_elem; bf16_t* gtmp; const float* mb; const float* hsc; const float* wgs; bool bal; bf16_t* gx;
    template <int BJ> __device__ __forceinline__ void post(gm::AccI& acc, const gm::Unit& u, int wr, int wc, int fr, int fq) {
        const int col0 = u.pn * 256 + wc * 32 + 8 * fq, row0 = u.pm * 256 + wr * 64 + fr, nbr = u.tag;
        const bool ex = bal && u.pm >= 128; bf16_t* go = ex ? gx : gtmp; const int orow0 = ex ? nbr * 512 + row0 - MLAT : row0;
        f32x4 bv[2][2], sv[2][2];
#pragma unroll
        for (int bj = 0; bj < 2; ++bj)
#pragma unroll
            for (int n = 0; n < 2; ++n) { bv[bj][n] = *(const f32x4*)(mb + nbr * DM + col0 + bj * 128 + 4 * n); sv[bj][n] = *(const f32x4*)(wgs + nbr * DM + col0 + bj * 128 + 4 * n); }
        float hsv[8];
#pragma unroll
        for (int i = 0; i < 8; ++i) hsv[i] = hsc[row0 + (i >> 2) * 128 + (i & 3) * 16];
#pragma unroll
        for (int ai = 0; ai < 2; ++ai)
#pragma unroll
            for (int m = 0; m < 4; ++m) { const float hs = hsv[ai * 4 + m];
#pragma unroll
                for (int bj = 0; bj < 2; ++bj) { float g[8];
#pragma unroll
                    for (int n = 0; n < 2; ++n)
#pragma unroll
                        for (int j = 0; j < 4; ++j) g[n * 4 + j] = sigmoidf_((float)acc[ai][bj][m][n][j] * (hs * sv[bj][n][j]) + bv[bj][n][j]);
                    u32x4 w; w.x = cvt_pk_bf16(g[0], g[1]); w.y = cvt_pk_bf16(g[2], g[3]); w.z = cvt_pk_bf16(g[4], g[5]); w.w = cvt_pk_bf16(g[6], g[7]);
                    *(u32x4*)(go + (size_t)(orow0 + ai * 128 + m * 16) * DM + col0 + bj * 128) = w; } }
    }
};
struct EpiMergeY {
    static constexpr bool PERM = true, I8 = false; typedef gm::Acc AccT; typedef f32x4 AccT_elem; bf16_t* mrg; const bf16_t* gtmp; bool bal; const bf16_t* gx; bf16_t* part;
    template <int BJ> __device__ __forceinline__ void post(gm::Acc& acc, const gm::Unit& u, int wr, int wc, int fr, int fq) {
        const int col0 = u.pn * 256 + wc * 32 + 8 * fq, row0 = u.pm * 256 + wr * 64 + fr, nbr = u.tag;
        const bool ex = bal && u.pm >= 128; const bf16_t* gi = ex ? gx : gtmp; bf16_t* mo = ex ? part : mrg; const int orow0 = ex ? nbr * 512 + row0 - MLAT : row0;
        const bool rd = nbr > 0 && !ex;
#pragma unroll
        for (int ai = 0; ai < 2; ++ai) {
            u32x4 gwv[4][2], mwv[4][2];
#pragma unroll
            for (int m = 0; m < 4; ++m)
#pragma unroll
                for (int bj = 0; bj < 2; ++bj) { const size_t off = (size_t)(orow0 + ai * 128 + m * 16) * DM + col0 + bj * 128;
                    gwv[m][bj] = *(const u32x4*)(gi + off); mwv[m][bj] = (u32x4){0u, 0u, 0u, 0u}; if (rd) mwv[m][bj] = *(const u32x4*)(mo + off); }
#pragma unroll
            for (int m = 0; m < 4; ++m)
#pragma unroll
                for (int bj = 0; bj < 2; ++bj) {
                    const size_t off = (size_t)(orow0 + ai * 128 + m * 16) * DM + col0 + bj * 128;
                    const u32x4 gw = gwv[m][bj], mw = mwv[m][bj];
                    const float g[8] = {bflo(gw.x), bfhi(gw.x), bflo(gw.y), bfhi(gw.y), bflo(gw.z), bfhi(gw.z), bflo(gw.w), bfhi(gw.w)};
                    float mm[8] = {bflo(mw.x), bfhi(mw.x), bflo(mw.y), bfhi(mw.y), bflo(mw.z), bfhi(mw.z), bflo(mw.w), bfhi(mw.w)};
#pragma unroll
                    for (int n = 0; n < 2; ++n)
#pragma unroll
                        for (int j = 0; j < 4; ++j) mm[n * 4 + j] += g[n * 4 + j] * acc[ai][bj][m][n][j];
                    u32x4 w; w.x = cvt_pk_bf16(mm[0], mm[1]); w.y = cvt_pk_bf16(mm[2], mm[3]); w.z = cvt_pk_bf16(mm[4], mm[5]); w.w = cvt_pk_bf16(mm[6], mm[7]);
                    *(u32x4*)(mo + off) = w;
                }
        }
    }
};


struct KP { const float* in[30]; float* out; unsigned char* ws; int ph_lo, ph_hi; };
typedef const __attribute__((address_space(4))) KP CKP;
__device__ __forceinline__ LAS unsigned char* lds_here(unsigned char* raw) { unsigned a = (unsigned)(uintptr_t)(LAS unsigned char*)raw; asm volatile("" : "+s"(a)); return (LAS unsigned char*)(uintptr_t)a; }
__device__ __forceinline__ CKP& kp_here() { CKP* q = (CKP*)__builtin_amdgcn_kernarg_segment_ptr(); asm volatile("" : "+s"(q)); return *q; }
enum { I_X = 0, I_C, I_CTX, I_CCTX, I_ADAW, I_ADAB, I_PRE, I_POST, I_WG, I_WU, I_WDN, I_WIN, I_QNORM, I_WUQ, I_KVNORM, I_WUKV, I_CONVW, I_CONVB, I_RGWR, I_RGBR, I_RGWI, I_RGBI, I_RGLAM,
       I_DLAM, I_SUBLN, I_HLB, I_HNORM, I_MB, I_WBR, I_WOUT };

__device__ __forceinline__ void job_mod(CKP& p, LAS unsigned char* lds) {
    LAS float* sl = (LAS float*)lds;
    LAS float* red = (LAS float*)(lds + 24576);
    const int tid = otid(), lane = tid & 63, wave = tid >> 6;
    for (int i = tid; i < 3 * DM; i += NTHR) { const int g = i / DM, k = i % DM; const float c = g < 2 ? p.in[I_C][g * DM + k] : p.in[I_CCTX][k]; sl[i] = siluf_(c); }
    __syncthreads();
    float* mod = (float*)(p.ws + WS_MOD);
    for (int u = obid(); u < NL * 288; u += gridDim.x) {
        const int l = u / 288, col = (u % 288) * 64 + lane;
        const float* w = p.in[I_ADAW] + (size_t)l * DM * (NMOD * DM) + col;
        float a0 = 0.f, a1 = 0.f, a2 = 0.f;
        const int k0 = wave * 256;
#pragma unroll 1
        for (int k1 = k0; k1 < k0 + 256; k1 += 32) { float wv[32];
#pragma unroll
            for (int q = 0; q < 32; ++q) wv[q] = w[(size_t)(k1 + q) * (NMOD * DM)];
            asm volatile("" ::: "memory");
#pragma unroll
            for (int q = 0; q < 32; ++q) { const int k = k1 + q; a0 += sl[k] * wv[q]; a1 += sl[DM + k] * wv[q]; a2 += sl[2 * DM + k] * wv[q]; } }
        red[(wave * 3 + 0) * 64 + lane] = a0; red[(wave * 3 + 1) * 64 + lane] = a1; red[(wave * 3 + 2) * 64 + lane] = a2;
        __syncthreads();
        if (tid < 192) { const int g = tid >> 6; float s = 0.f;
#pragma unroll
            for (int w8 = 0; w8 < 8; ++w8) s += red[(w8 * 3 + g) * 64 + lane];
            mod[(size_t)(l * 3 + g) * (NMOD * DM) + col] = s + p.in[I_ADAB][l * (NMOD * DM) + col]; }
        __syncthreads();
    }
}
__device__ __forceinline__ void job_tables(CKP& p) {
    const int tid = otid();
    if (obid() == 0) {
        float* rope = (float*)(p.ws + WS_ROPE);
        for (int i = tid; i < 4096; i += NTHR) { const int pos = i >> 4, f = i & 15; const float inv = powf(10000.0f, -(float)f / 16.0f); const float ang = (float)pos * inv; float s, c; sincosf(ang, &s, &c); rope[2 * i] = c; rope[2 * i + 1] = s; }
    }
    if (obid() == 1 % gridDim.x) {
        float* sc = (float*)(p.ws + WS_SCAL);
        if (tid < NL) { const float* lv = p.in[I_DLAM] + tid * 256; float s01 = 0.f, s23 = 0.f; for (int i = 0; i < 64; ++i) { s01 += lv[i] * lv[64 + i]; s23 += lv[128 + i] * lv[192 + i]; }
            sc[tid] = expf(s01) - expf(s23) + (0.8f - 0.6f * expf(-0.3f * (float)tid)); }
        for (int k = tid; k < 512; k += NTHR) {
            float mx = -1e30f; for (int l = 0; l < NL; ++l) mx = fmaxf(mx, p.in[I_HLB][l * 512 + k]);
            float den = 0.f; for (int l = 0; l < NL; ++l) den += expf(p.in[I_HLB][l * 512 + k] - mx);
            float cum = 0.f; for (int l = 0; l < NL; ++l) { if (l > 0) cum += expf(p.in[I_HLB][l * 512 + k] - mx) / den; sc[256 + l * 512 + k] = cum; }
        }
        for (int i = tid; i < NL * 1024; i += NTHR) { const float x = -p.in[I_RGLAM][i]; sc[2048 + i] = fmaxf(x, 0.f) + log1pf(expf(-fabsf(x))); }
    }
}

__device__ __forceinline__ void job_colmax(CKP& p) {
    unsigned* cmax = (unsigned*)(p.ws + WS_CMAX);
    const int tid = otid(), c4 = (tid & 63) * 4, wv = tid >> 6;
    for (int u = obid(); u < NL * 2 * 2 * 22 * 4; u += gridDim.x) {
        const int kc = u & 3, cb = (u >> 2) % 22, mat = u / (4 * 22), which = mat & 1, lf = mat >> 1;
        const float* w = (which ? p.in[I_WU] : p.in[I_WG]) + (size_t)lf * DM * DFF + (size_t)(kc * 512 + wv * 64) * DFF + cb * 256 + c4;
        u32x4 mx = {0u, 0u, 0u, 0u};
#pragma unroll 1
        for (int k0 = 0; k0 < 64; k0 += 16) { u32x4 v[16];
#pragma unroll
            for (int k = 0; k < 16; ++k) v[k] = *(const u32x4*)(w + (size_t)(k0 + k) * DFF);
            asm volatile("" ::: "memory");
#pragma unroll
            for (int k = 0; k < 16; ++k) { mx.x = max(mx.x, v[k].x & 0x7fffffffu); mx.y = max(mx.y, v[k].y & 0x7fffffffu); mx.z = max(mx.z, v[k].z & 0x7fffffffu); mx.w = max(mx.w, v[k].w & 0x7fffffffu); } }
        unsigned* dst = cmax + (size_t)(lf * 2 + which) * DFF + cb * 256 + c4;
        atomicMax(dst, mx.x); atomicMax(dst + 1, mx.y); atomicMax(dst + 2, mx.z); atomicMax(dst + 3, mx.w);
    }
    unsigned* cmax2 = (unsigned*)(p.ws + WS_CMAX2);
    for (int u = obid(); u < NL * 56 * 4; u += gridDim.x) {
        const int kc = u & 3, cb = (u >> 2) % 56, l = u / (4 * 56), cc = cb * 256 + c4;
        if (cc < DIN) {
            const float* w = p.in[I_WIN] + (size_t)l * DM * DIN + (size_t)(kc * 512 + wv * 64) * DIN + cc;
            u32x4 mx = {0u, 0u, 0u, 0u};
#pragma unroll 1
            for (int k0 = 0; k0 < 64; k0 += 16) { u32x4 v[16];
#pragma unroll
                for (int k = 0; k < 16; ++k) v[k] = *(const u32x4*)(w + (size_t)(k0 + k) * DIN);
                asm volatile("" ::: "memory");
#pragma unroll
                for (int k = 0; k < 16; ++k) { mx.x = max(mx.x, v[k].x & 0x7fffffffu); mx.y = max(mx.y, v[k].y & 0x7fffffffu); mx.z = max(mx.z, v[k].z & 0x7fffffffu); mx.w = max(mx.w, v[k].w & 0x7fffffffu); } }
            unsigned* dst = cmax2 + (size_t)l * 14336 + cc;
            atomicMax(dst, mx.x); atomicMax(dst + 1, mx.y); atomicMax(dst + 2, mx.z); atomicMax(dst + 3, mx.w);
        }
    }
}
struct CvtDesc { const float* src; const float* ks; bf16_t* dst; int ldsrc, c0, k0, lddst, n0; const unsigned* q8max; float* q8scale; };
__device__ __forceinline__ void cvt_load(const CvtDesc& d, int tid, f32x4 (&v)[2]) {
    const int r = tid >> 4, c4 = (tid & 15) * 4;
#pragma unroll
    for (int ps = 0; ps < 2; ++ps) { const int k = r + 32 * ps; v[ps] = (f32x4){0.f, 0.f, 0.f, 0.f};
        if (d.src) { v[ps] = *(const f32x4*)(d.src + (size_t)(d.k0 + k) * d.ldsrc + d.c0 + c4); if (d.ks) v[ps] = v[ps] * d.ks[d.k0 + k]; } }
}
__device__ __forceinline__ void cvt_store(LAS float* tile, const CvtDesc& d, int tid, const f32x4 (&v)[2]) {
    { const int r = tid >> 4, c4 = (tid & 15) * 4;
#pragma unroll
      for (int ps = 0; ps < 2; ++ps) { const int k = r + 32 * ps; tile[k * 65 + c4 + 0] = v[ps][0]; tile[k * 65 + c4 + 1] = v[ps][1]; tile[k * 65 + c4 + 2] = v[ps][2]; tile[k * 65 + c4 + 3] = v[ps][3]; } }
    __syncthreads();
    { const int n = tid >> 3, k8 = (tid & 7) * 8; float x[8];
#pragma unroll
      for (int i = 0; i < 8; ++i) x[i] = tile[(k8 + i) * 65 + n];
      if (d.q8max) {
          const float mx = fmaxf(__uint_as_float(d.q8max[n]), 1e-30f), inv = 127.0f / mx;
          int q[8];
#pragma unroll
          for (int i = 0; i < 8; ++i) q[i] = (int)rintf(x[i] * inv) & 0xff;
          u32x2 w; w.x = (unsigned)q[0] | ((unsigned)q[1] << 8) | ((unsigned)q[2] << 16) | ((unsigned)q[3] << 24); w.y = (unsigned)q[4] | ((unsigned)q[5] << 8) | ((unsigned)q[6] << 16) | ((unsigned)q[7] << 24);
          *(u32x2*)((signed char*)d.dst + (size_t)(d.n0 + n) * d.lddst + d.k0 + k8) = w;
          if (d.k0 == 0 && k8 == 0) d.q8scale[n] = mx * (1.0f / 127.0f);
      } else {
          u32x4 w; w.x = cvt_pk_bf16(x[0], x[1]); w.y = cvt_pk_bf16(x[2], x[3]); w.z = cvt_pk_bf16(x[4], x[5]); w.w = cvt_pk_bf16(x[6], x[7]);
          *(u32x4*)(d.dst + (size_t)(d.n0 + n) * d.lddst + d.k0 + k8) = w; } }
    __syncthreads();
}
constexpr int CV_N0 = 2 * 176 * 32, CV_N1 = 2 * 32 * 88, CV_N2 = 224 * 32, CV_N3 = 12 * 8, CV_N4 = 16 * 4, CV_N5 = 4 * 32 * 8, CV_N6 = 32 * 32, CV_N7 = 1024;
constexpr int CV_BLOCKS = CV_N0 + CV_N1 + CV_N2 + CV_N3 + CV_N4 + CV_N5 + CV_N6;
__device__ __forceinline__ CvtDesc cvt_desc(CKP& p, int l, int b) {
    unsigned char* ws = p.ws; CvtDesc d; d.ks = nullptr; d.q8max = nullptr; d.q8scale = nullptr;
    if (b < CV_N0) { const int f = b / (176 * 32), rem = b % (176 * 32), nb = rem / 32, kb = rem % 32, t = nb >> 2, q = nb & 3;
        d.src = (q < 2 ? p.in[I_WG] : p.in[I_WU]) + (size_t)(l * 2 + f) * DM * DFF; d.ldsrc = DFF; d.c0 = 128 * t + (q & 1) * 64; d.k0 = kb * 64; d.dst = (bf16_t*)(ws + WS_WGU + (size_t)f * 11264 * 2048); d.lddst = 2048; d.n0 = nb * 64;
        d.q8max = (const unsigned*)(ws + WS_CMAX) + (size_t)((l * 2 + f) * 2 + (q < 2 ? 0 : 1)) * DFF + d.c0; d.q8scale = (float*)(ws + WS_WSC) + (size_t)f * 11264 + d.n0; return d; }
    b -= CV_N0;
    if (b < CV_N1) { const int f = b / (32 * 88), rem = b % (32 * 88), nb = rem / 88, kb = rem % 88;
        d.src = p.in[I_WDN] + (size_t)(l * 2 + f) * DFF * DM; d.ldsrc = DM; d.c0 = nb * 64; d.k0 = kb * 64; d.dst = (bf16_t*)(ws + WS_WD) + (size_t)f * 2048 * 5632; d.lddst = 5632; d.n0 = nb * 64; return d; }
    b -= CV_N1;
    if (b < CV_N2) { const int nb = b / 32, kb = b % 32, j0 = nb * 64; int sc;
        if (j0 < 512) sc = j0; else if (j0 < 5632) sc = 832 + (j0 - 512); else if (j0 < 5888) sc = 512 + (j0 - 5632); else if (j0 < 5952) sc = 768 + (j0 - 5888); else if (j0 < 6144) sc = -1; else sc = 5952 + (j0 - 6144);
        d.src = sc < 0 ? nullptr : p.in[I_WIN] + (size_t)l * DM * DIN; d.ldsrc = DIN; d.c0 = sc < 0 ? 0 : sc; d.k0 = kb * 64; d.dst = (bf16_t*)(ws + WS_WIN); d.lddst = 2048; d.n0 = j0;
        d.q8max = (const unsigned*)(ws + WS_CMAX2) + (size_t)l * 14336 + (sc < 0 ? DIN : sc);
        d.q8scale = j0 < 6144 ? (float*)(ws + WS_WPS) + j0 : (float*)(ws + WS_WGS) + (j0 - 6144);
        return d; }
    b -= CV_N2;
    if (b < CV_N3) { const int nb = b / 8, kb = b % 8;
        d.src = p.in[I_WUQ] + (size_t)l * 512 * 768; d.ldsrc = 768; d.c0 = nb * 64; d.k0 = kb * 64; d.ks = p.in[I_QNORM] + l * 512; d.dst = (bf16_t*)(ws + WS_WUQ); d.lddst = 512; d.n0 = nb * 64; return d; }
    b -= CV_N3;
    if (b < CV_N4) { const int nb = b / 4, kb = b % 4;
        d.src = p.in[I_WUKV] + (size_t)l * 256 * 1024; d.ldsrc = 1024; d.c0 = nb * 64; d.k0 = kb * 64; d.ks = p.in[I_KVNORM] + l * 256; d.dst = (bf16_t*)(ws + WS_WUKV); d.lddst = 256; d.n0 = nb * 64; return d; }
    b -= CV_N4;
    if (b < CV_N5) { const int n = b / 256, rem = b % 256, nb = rem / 8, kb = rem % 8;
        d.src = p.in[I_WBR] + (size_t)(l * 4 + n) * 512 * DM; d.ldsrc = DM; d.c0 = nb * 64; d.k0 = kb * 64; d.dst = (bf16_t*)(ws + WS_WBR) + (size_t)n * 2048 * 512; d.lddst = 512; d.n0 = nb * 64; return d; }
    b -= CV_N5;
    { const int nb = b / 32, kb = b % 32;
        d.src = p.in[I_WOUT] + (size_t)l * DM * DM; d.ldsrc = DM; d.c0 = nb * 64; d.k0 = kb * 64; d.dst = (bf16_t*)(ws + WS_WOUT); d.lddst = 2048; d.n0 = nb * 64; return d; }
}
__device__ __forceinline__ void job_convert(CKP& p, LAS unsigned char* lds, int l) {
    LAS float* tile = (LAS float*)lds;
    const int tid = otid();
    {
        int u = obid();
        if (u < CV_BLOCKS) {
            f32x4 vc[2]; { const CvtDesc d0 = cvt_desc(p, l, u); cvt_load(d0, tid, vc); }
            for (;;) {
                const int un = u + gridDim.x; const bool more = un < CV_BLOCKS;
                f32x4 vn[2] = {vc[0], vc[1]};
                if (more) { const CvtDesc dn = cvt_desc(p, l, un); cvt_load(dn, tid, vn); }
                { const CvtDesc dc = cvt_desc(p, l, u); cvt_store(tile, dc, tid, vc); }
                if (!more) break;
                vc[0] = vn[0]; vc[1] = vn[1]; u = un;
            }
        }
    }
    for (int b = obid(); b < CV_N7; b += gridDim.x) {
        bf16_t* dst = (bf16_t*)(p.ws + WS_WRG);
#pragma unroll
        for (int e = 0; e < 2; ++e) { const int idx = b * 1024 + e * 512 + tid, o = idx >> 9, k = idx & 511;
            const int t8 = o >> 8, d = t8 >> 2, blk = t8 & 3, g = (o >> 7) & 1, i = o & 127, kin = k - blk * 128;
            float v = 0.f; if (kin >= 0 && kin < 128) v = (g ? p.in[I_RGWI] : p.in[I_RGWR])[((size_t)((l * 2 + d) * 4 + blk) * 128 + kin) * 128 + i];
            dst[idx] = f2bf(v); }
    }
}

struct RNArgs {
    const float* xs_lat; const float* xs_ctx; float* xd_lat; float* xd_ctx;
    const bf16_t* y; float wres;
    const float* modl_res; int jres; const float* postg;
    bool do_norm; const float* modl_norm; int jn; const float* preg; bf16_t* h; int nrows; signed char* h8; float* hsc;
};
__device__ __forceinline__ void job_resnorm(const RNArgs& a, LAS unsigned char* lds) {
    const int tid_ = otid(); const int lane = tid_ & 63, gw = obid() * 8 + (tid_ >> 6), nw = gridDim.x * 8;
    LAS float* PA = (LAS float*)lds; LAS float* PB = PA + 3 * DM; LAS float* PC = PB + 3 * DM;
    for (int i = tid_; i < 3 * DM; i += NTHR) { const int g = i / DM, c = i % DM;
        if (a.y) PA[i] = a.modl_res[(size_t)g * (NMOD * DM) + (3 * a.jres + 2) * DM + c] * a.postg[c];
        if (a.do_norm) { const float* sh = a.modl_norm + (size_t)g * (NMOD * DM) + (3 * a.jn) * DM; PB[i] = a.preg[c] * (sh[DM + c] + 1.0f); PC[i] = sh[c]; } }
    __syncthreads();
    f32x4 xq[8]; u32x2 yq[8];
#define RN_LOAD(R, X, Y) do { const int r_ = (R); const float* xs_ = r_ < MLAT ? a.xs_lat + (size_t)r_ * DM : a.xs_ctx + (size_t)(r_ - MLAT) * DM; \
        _Pragma("unroll") for (int i = 0; i < 8; ++i) X[i] = *(const f32x4*)(xs_ + i * 256 + lane * 4); \
        if (a.y) { _Pragma("unroll") for (int i = 0; i < 8; ++i) Y[i] = *(const u32x2*)(a.y + (size_t)r_ * DM + i * 256 + lane * 4); } } while (0)
    if (gw < a.nrows) RN_LOAD(gw, xq, yq);
    for (int r = gw; r < a.nrows; r += nw) {
        const int g = r < SEQ ? 0 : (r < MLAT ? 1 : 2); const bool lat = r < MLAT;
        f32x4 x[8]; u32x2 yr[8];
#pragma unroll
        for (int i = 0; i < 8; ++i) { x[i] = xq[i]; yr[i] = yq[i]; }
        RN_LOAD(r + nw < a.nrows ? r + nw : r, xq, yq);
        if (a.y) {
            f32x4 yv[8]; float ss = 0.f;
#pragma unroll
            for (int i = 0; i < 8; ++i) { const u32x2 w = yr[i]; yv[i] = (f32x4){bflo(w.x), bfhi(w.x), bflo(w.y), bfhi(w.y)}; ss += yv[i][0] * yv[i][0] + yv[i][1] * yv[i][1] + yv[i][2] * yv[i][2] + yv[i][3] * yv[i][3]; }
            ss = wave_sum(ss, lane);
            const float rr = a.wres * rsqrtf(ss * (1.0f / DM) + EPS);
            float* xd = lat ? a.xd_lat + (size_t)r * DM : a.xd_ctx + (size_t)(r - MLAT) * DM;
#pragma unroll
            for (int i = 0; i < 8; ++i) { const int c = i * 256 + lane * 4; const f32x4 gp = *(const LAS f32x4*)(PA + g * DM + c);
                x[i] = x[i] + gp * (yv[i] * rr); *(f32x4*)(xd + c) = x[i]; }
        }
        if (a.do_norm) {
            float ss = 0.f;
#pragma unroll
            for (int i = 0; i < 8; ++i) ss += x[i][0] * x[i][0] + x[i][1] * x[i][1] + x[i][2] * x[i][2] + x[i][3] * x[i][3];
            ss = wave_sum(ss, lane);
            const float rr = rsqrtf(ss * (1.0f / DM) + EPS);
            float mx = 0.f;
#pragma unroll
            for (int i = 0; i < 8; ++i) { const int c = i * 256 + lane * 4; const f32x4 ps = *(const LAS f32x4*)(PB + g * DM + c), hv = *(const LAS f32x4*)(PC + g * DM + c);
                x[i] = (x[i] * rr) * ps + hv; mx = fmaxf(mx, fmaxf(fmaxf(fabsf(x[i][0]), fabsf(x[i][1])), fmaxf(fabsf(x[i][2]), fabsf(x[i][3]))));
                if (a.h) { u32x2 w; w.x = cvt_pk_bf16(x[i][0], x[i][1]); w.y = cvt_pk_bf16(x[i][2], x[i][3]); *(u32x2*)(a.h + (size_t)r * DM + c) = w; } }
            if (a.h8) {
#pragma unroll
                for (int o = 32; o >= 1; o >>= 1) mx = fmaxf(mx, shx(mx, o, lane));
                mx = fmaxf(mx, 1e-30f); const float inv = 127.0f / mx;
                if (lane == 0) a.hsc[r] = mx * (1.0f / 127.0f);
#pragma unroll
                for (int i = 0; i < 8; ++i) { const unsigned q0 = (unsigned)((int)rintf(x[i][0] * inv) & 0xff), q1 = (unsigned)((int)rintf(x[i][1] * inv) & 0xff), q2 = (unsigned)((int)rintf(x[i][2] * inv) & 0xff), q3 = (unsigned)((int)rintf(x[i][3] * inv) & 0xff);
                    *(unsigned*)(a.h8 + (size_t)r * DM + i * 256 + lane * 4) = q0 | (q1 << 8) | (q2 << 16) | (q3 << 24); }
            }
        }
    }
    __syncthreads();
#undef RN_LOAD
}

__device__ __forceinline__ void job_stats_conv(CKP& p, int l) {
    const bf16_t* ubuf = (const bf16_t*)(p.ws + WS_R1); float* rsq = (float*)(p.ws + WS_RSQ); float* rsk = rsq + MALL; bf16_t* xcv = (bf16_t*)(p.ws + WS_XCV);
    const int tid_ = otid(); const int lane = tid_ & 63, gw = obid() * 8 + (tid_ >> 6), nw = gridDim.x * 8;
    float cw[4][8], cb[8];
#pragma unroll
    for (int j = 0; j < 4; ++j)
#pragma unroll
        for (int i = 0; i < 8; ++i) cw[j][i] = p.in[I_CONVW][(l * 4 + j) * 512 + lane * 8 + i];
#pragma unroll
    for (int i = 0; i < 8; ++i) cb[i] = p.in[I_CONVB][l * 512 + lane * 8 + i];
    for (int r = gw; r < MALL; r += nw) {
        const bf16_t* ur = ubuf + (size_t)r * NU;
        const bool lat = r < MLAT; const int s = lat ? (r & (SEQ - 1)) : ((r - MLAT) & (CTXL - 1)), len = lat ? SEQ : CTXL;
        const u32x4 w = *(const u32x4*)(ur + U_AQ + lane * 8); const u32x4 w2 = *(const u32x4*)(ur + U_AKV + (lane & 31) * 8);
        u32x4 wt[4]; float okf[4];
#pragma unroll
        for (int j = 0; j < 4; ++j) { const int sj = s + j - 2; const bool ok = sj >= 0 && sj < len; okf[j] = ok ? 1.0f : 0.0f;
            wt[j] = *(const u32x4*)(ur + (ptrdiff_t)(ok ? j - 2 : 0) * NU + U_BX + lane * 8); }
        asm volatile("" ::: "memory");
        {
            float ss = 0.f;
            { const float v[8] = {bflo(w.x), bfhi(w.x), bflo(w.y), bfhi(w.y), bflo(w.z), bfhi(w.z), bflo(w.w), bfhi(w.w)};
#pragma unroll
              for (int i = 0; i < 8; ++i) ss += v[i] * v[i]; }
            ss = wave_sum(ss, lane);
            float s2 = 0.f;
            { const float v[8] = {bflo(w2.x), bfhi(w2.x), bflo(w2.y), bfhi(w2.y), bflo(w2.z), bfhi(w2.z), bflo(w2.w), bfhi(w2.w)};
#pragma unroll
              for (int i = 0; i < 8; ++i) s2 += v[i] * v[i]; }
            s2 = lane < 32 ? s2 : 0.f;
            s2 = wave_sum(s2, lane);
            if (lane == 0) { rsq[r] = rsqrtf(ss * (1.0f / 512.0f) + EPS); rsk[r] = rsqrtf(s2 * (1.0f / 256.0f) + EPS); }
        }
        {
            float acc[8];
#pragma unroll
            for (int i = 0; i < 8; ++i) acc[i] = cb[i];
#pragma unroll
            for (int j = 0; j < 4; ++j) { const u32x4 wj = wt[j];
                const float v[8] = {bflo(wj.x), bfhi(wj.x), bflo(wj.y), bfhi(wj.y), bflo(wj.z), bfhi(wj.z), bflo(wj.w), bfhi(wj.w)};
#pragma unroll
                for (int i = 0; i < 8; ++i) acc[i] += (cw[j][i] * okf[j]) * v[i]; }
            u32x4 o; o.x = cvt_pk_bf16(acc[0], acc[1]); o.y = cvt_pk_bf16(acc[2], acc[3]); o.z = cvt_pk_bf16(acc[4], acc[5]); o.w = cvt_pk_bf16(acc[6], acc[7]);
            *(u32x4*)(xcv + (size_t)r * 512 + lane * 8) = o;
        }
    }
}

__device__ __forceinline__ void job_rg_scan1(CKP& p) {
    const bf16_t* la = (const bf16_t*)(p.ws + WS_LA); const bf16_t* bb = (const bf16_t*)(p.ws + WS_BB); f32x2* rgs = (f32x2*)(p.ws + WS_RGS);
    const int w = otid();
    for (int u = obid(); u < NRT * 2; u += gridDim.x) {
        const int pm = u >> 1, d = u & 1;
        const bf16_t* lp = la + (size_t)pm * 256 * 1024 + d * 512 + w; const bf16_t* bp = bb + (size_t)pm * 256 * 1024 + d * 512 + w;
        float H = 0.f, sl = 0.f;
#pragma unroll 1
        for (int i0 = 0; i0 < 256; i0 += 32) { bf16_t lr[32], br[32];
#pragma unroll
            for (int q = 0; q < 32; ++q) { const int t = d ? 255 - (i0 + q) : i0 + q; lr[q] = lp[(size_t)t * 1024]; br[q] = bp[(size_t)t * 1024]; }
            asm volatile("" ::: "memory");
#pragma unroll
            for (int q = 0; q < 32; ++q) { const float lv = bf2f(lr[q]); H = __expf(lv) * H + bf2f(br[q]); sl += lv; } }
        rgs[(size_t)u * 512 + w] = (f32x2){__expf(sl), H};
    }
}
__device__ __forceinline__ void job_rg_out(CKP& p, int ntiles) {
    const bf16_t* la = (const bf16_t*)(p.ws + WS_LA); const bf16_t* bb = (const bf16_t*)(p.ws + WS_BB); const f32x2* rgs = (const f32x2*)(p.ws + WS_RGS);
    bf16_t* hf = (bf16_t*)(p.ws + WS_XCV); const bf16_t* ubuf = (const bf16_t*)(p.ws + WS_R1); bf16_t* yb = (bf16_t*)(p.ws + WS_YBR) + (size_t)1 * MALL * 512;
    const int w = otid();
    for (int u = obid(); u < ntiles; u += gridDim.x) {
        const int pm = (int)gridDim.x > ntiles ? u : u;
        const bool isctx = pm >= 128; const int b = isctx ? pm - 128 : (pm >> 6);
        float h = 0.f;
        if (!isctx) { h = rgs[(size_t)((128 + b) * 2 + 0) * 512 + w][1];
#pragma unroll 1
            for (int q0 = b * 64; q0 < pm; q0 += 16) { f32x2 sv[16];
#pragma unroll
                for (int k = 0; k < 16; ++k) { const int q = q0 + k < pm ? q0 + k : pm - 1; sv[k] = rgs[(size_t)(q * 2 + 0) * 512 + w]; }
                asm volatile("" ::: "memory");
#pragma unroll
                for (int k = 0; k < 16; ++k) if (q0 + k < pm) h = sv[k][0] * h + sv[k][1]; } }
        const size_t r0 = (size_t)pm * 256;
#pragma unroll 1
        for (int t0 = 0; t0 < 256; t0 += 64) { bf16_t lr[64], br[64];
#pragma unroll
            for (int k = 0; k < 64; ++k) { lr[k] = la[(r0 + t0 + k) * 1024 + w]; br[k] = bb[(r0 + t0 + k) * 1024 + w]; }
            asm volatile("" ::: "memory");
#pragma unroll
            for (int k = 0; k < 64; ++k) { h = __expf(bf2f(lr[k])) * h + bf2f(br[k]); hf[(r0 + t0 + k) * 512 + w] = f2bf(h); } }
        float hb = 0.f;
        if (!isctx) { hb = rgs[(size_t)((128 + b) * 2 + 1) * 512 + w][1];
#pragma unroll 1
            for (int q0 = b * 64 + 63; q0 > pm; q0 -= 16) { f32x2 sv[16];
#pragma unroll
                for (int k = 0; k < 16; ++k) { const int q = q0 - k > pm ? q0 - k : pm + 1; sv[k] = rgs[(size_t)(q * 2 + 1) * 512 + w]; }
                asm volatile("" ::: "memory");
#pragma unroll
                for (int k = 0; k < 16; ++k) if (q0 - k > pm) hb = sv[k][0] * hb + sv[k][1]; } }
#pragma unroll 1
        for (int i0 = 0; i0 < 256; i0 += 32) { bf16_t lr[32], br[32], gr[32], fr[32];
#pragma unroll
            for (int k = 0; k < 32; ++k) { const size_t t = r0 + 255 - i0 - k; lr[k] = la[t * 1024 + 512 + w]; br[k] = bb[t * 1024 + 512 + w]; gr[k] = ubuf[t * NU + U_BG + w]; fr[k] = hf[t * 512 + w]; }
#pragma unroll
            for (int k = 0; k < 32; ++k) { const size_t t = r0 + 255 - i0 - k; hb = __expf(bf2f(lr[k])) * hb + bf2f(br[k]); yb[t * 512 + w] = f2bf((bf2f(fr[k]) + hb) * gelu_tanh(bf2f(gr[k]))); } }
    }
}

namespace at {
constexpr float THR2 = 8.f * 1.4426950408889634f;
__device__ __forceinline__ int crow(int r, int hi) { return (r & 3) + 8 * (r >> 2) + 4 * hi; }
__device__ __forceinline__ unsigned cvtpk(float lo, float hi) { return cvt_pk_bf16(lo, hi); }
__device__ __forceinline__ int v_rd_base(int lane) { return ((lane & 3) << 3) | (((lane >> 2) & 3) << 6) | (((lane >> 4) & 1) << 5) | (((lane >> 5) & 1) << 8); }
constexpr int v_rd_off(int d0, int ks, int half) { return d0 * 512 + ks * 4096 + half * 2048; }
template <int OFF> __device__ __forceinline__ s16x4 tr_read(unsigned vb) { s16x4 r; asm volatile("ds_read_b64_tr_b16 %0, %1 offset:%2" : "=&v"(r) : "v"(vb), "i"(OFF) : "memory"); return r; }
template <int D0> __device__ __forceinline__ void pv_one(f32x16& od, unsigned vb, bf16x8 pa0, bf16x8 pa1, bf16x8 pa2, bf16x8 pa3) {
    const s16x4 l0 = tr_read<v_rd_off(D0, 0, 0)>(vb), h0 = tr_read<v_rd_off(D0, 0, 1)>(vb), l1 = tr_read<v_rd_off(D0, 1, 0)>(vb), h1 = tr_read<v_rd_off(D0, 1, 1)>(vb);
    const s16x4 l2 = tr_read<v_rd_off(D0, 2, 0)>(vb), h2 = tr_read<v_rd_off(D0, 2, 1)>(vb), l3 = tr_read<v_rd_off(D0, 3, 0)>(vb), h3 = tr_read<v_rd_off(D0, 3, 1)>(vb);
    asm volatile("s_waitcnt lgkmcnt(0)" ::: "memory"); __builtin_amdgcn_sched_barrier(0);
#define AT_PK(L, H) (bf16x8){L[0], L[1], L[2], L[3], H[0], H[1], H[2], H[3]}
    od = __builtin_amdgcn_mfma_f32_32x32x16_bf16(pa0, AT_PK(l0, h0), od, 0, 0, 0);
    od = __builtin_amdgcn_mfma_f32_32x32x16_bf16(pa1, AT_PK(l1, h1), od, 0, 0, 0);
    od = __builtin_amdgcn_mfma_f32_32x32x16_bf16(pa2, AT_PK(l2, h2), od, 0, 0, 0);
    od = __builtin_amdgcn_mfma_f32_32x32x16_bf16(pa3, AT_PK(l3, h3), od, 0, 0, 0);
#undef AT_PK
}
struct VFrag { s16x4 l[4], h[4]; };
template <int D0> __device__ __forceinline__ void rd_v(VFrag& f, const LAS unsigned char* vbp) {
#pragma unroll
    for (int ks = 0; ks < 4; ++ks) {
        f.l[ks] = __builtin_amdgcn_ds_read_tr16_b64_v4i16((LAS s16x4*)(vbp + v_rd_off(D0, ks, 0)));
        f.h[ks] = __builtin_amdgcn_ds_read_tr16_b64_v4i16((LAS s16x4*)(vbp + v_rd_off(D0, ks, 1))); }
}
__device__ __forceinline__ void mm_pv(f32x16& od, const VFrag& f, bf16x8 pa0, bf16x8 pa1, bf16x8 pa2, bf16x8 pa3) {
#define AT_PK(L, H) (bf16x8){L[0], L[1], L[2], L[3], H[0], H[1], H[2], H[3]}
    od = __builtin_amdgcn_mfma_f32_32x32x16_bf16(pa0, AT_PK(f.l[0], f.h[0]), od, 0, 0, 0);
    od = __builtin_amdgcn_mfma_f32_32x32x16_bf16(pa1, AT_PK(f.l[1], f.h[1]), od, 0, 0, 0);
    od = __builtin_amdgcn_mfma_f32_32x32x16_bf16(pa2, AT_PK(f.l[2], f.h[2]), od, 0, 0, 0);
    od = __builtin_amdgcn_mfma_f32_32x32x16_bf16(pa3, AT_PK(f.l[3], f.h[3]), od, 0, 0, 0);
#undef AT_PK
}
__device__ __forceinline__ f32x16 mfma_srcc(bf16x8 a, bf16x8 b, const f32x16& c) { f32x16 d; asm("v_mfma_f32_32x32x16_bf16 %0, %1, %2, %3" : "=&v"(d) : "v"(a), "v"(b), "v"(c)); return d; }
struct KeyMap { int ctx_row0, lat_row0, nctx, nt; __device__ __forceinline__ int row(int j) const { return j < nctx ? ctx_row0 + 64 * j : lat_row0 + 64 * (j - nctx); } };

template <int DQK>
__device__ __forceinline__ void attn_body(LAS unsigned char* lds, const bf16_t* Qg, int ldq, int q0, const bf16_t* Kg, int ldk, const bf16_t* Vg, int ldv, const KeyMap km,
                                          f32x16 (&o)[4], float& l_out) {
    constexpr int RB = DQK * 2, CPR = RB / 16, NKI = 64 * RB / 8192, KBYTES = 64 * RB, VOFF = 3 * KBYTES, SCR = VOFF + 4 * 16384, ND0 = DQK / 16;
    static_assert(SCR + 2048 <= LDS_MISC, "attention LDS");
    const int tid = otid(), wid = __builtin_amdgcn_readfirstlane(tid >> 6), lane = tid & 63, r32 = lane & 31, hi = lane >> 5, half = wid >> 2;
    LAS float* wsl = (LAS float*)(lds + SCR) + wid * 64; LAS float* al_l = wsl;
    unsigned koff[NKI], voff[2];
#pragma unroll
    for (int i = 0; i < NKI; ++i) { const int q = i * 512 + wid * 64 + lane, row = q / CPR, cp = q % CPR, ch = cp ^ ((row >> 1) & 7); koff[i] = (unsigned)row * (unsigned)(ldk * 2) + (unsigned)ch * 16u; }
#pragma unroll
    for (int i = 0; i < 2; ++i) { const int q = i * 512 + wid * 64 + lane, sub = q >> 5, wi = q & 31, k = (sub >> 2) * 8 + (wi >> 2), c = (sub & 3) * 32 + (wi & 3) * 8;
        voff[i] = (unsigned)k * (unsigned)(ldv * 2) + (unsigned)c * 2u; }
    const int NT = km.nt;
#define AT_ISSUE(j, sk, sv) do { const int _j = (j) < NT ? (j) : NT - 1; const int _kr = km.row(_j); const char* _kb = (const char*)Kg + (size_t)_kr * ldk * 2; const char* _vb = (const char*)Vg + (size_t)_kr * ldv * 2; \
        _Pragma("unroll") for (int _i = 0; _i < NKI; ++_i) __builtin_amdgcn_global_load_lds((const unsigned*)(_kb + koff[_i]), (LAS unsigned*)(lds + (sk) * KBYTES + _i * 8192 + wid * 1024), 16, 0, 0); \
        _Pragma("unroll") for (int _i = 0; _i < 2; ++_i) __builtin_amdgcn_global_load_lds((const unsigned*)(_vb + voff[_i]), (LAS unsigned*)(lds + VOFF + (sv) * 16384 + _i * 8192 + wid * 1024), 16, 0, 0); } while (0)
    bf16x8 qr[ND0];
    { const bf16_t* Qw = Qg + (size_t)(q0 + wid * 32 + r32) * ldq + hi * 8;
#pragma unroll
      for (int d0 = 0; d0 < ND0; ++d0) qr[d0] = *(const bf16x8*)(Qw + d0 * 16); }
    float m_reg = 0.f, l_reg = 0.f;
    f32x16 cm;
#pragma unroll
    for (int r = 0; r < 16; ++r) cm[r] = 0.f;
#pragma unroll
    for (int d = 0; d < 4; ++d)
#pragma unroll
        for (int r = 0; r < 16; ++r) o[d][r] = 0.f;
    const unsigned ksw = (unsigned)((r32 >> 1) & 7), kb0 = (unsigned)r32 * RB, vrb = (unsigned)v_rd_base(lane);
    bf16x8 pa0, pa1, pa2, pa3;
#define AT_PV(sv) do { const unsigned vb = (unsigned)(uintptr_t)(lds + VOFF + (sv) * 16384) + vrb; \
        pv_one<0>(o[0], vb, pa0, pa1, pa2, pa3); pv_one<1>(o[1], vb, pa0, pa1, pa2, pa3); pv_one<2>(o[2], vb, pa0, pa1, pa2, pa3); pv_one<3>(o[3], vb, pa0, pa1, pa2, pa3); } while (0)
    AT_ISSUE(0, 0, 0); AT_ISSUE(1, 1, 1);
    if constexpr (NKI == 3) asm volatile("s_waitcnt vmcnt(5)" ::: "memory"); else asm volatile("s_waitcnt vmcnt(3)" ::: "memory");
    if (half) { __builtin_amdgcn_s_barrier(); }
    int sk = 0, sv = 0;
    for (int j = 0; j < NT; ++j) {
        __builtin_amdgcn_s_barrier(); asm volatile("" ::: "memory");
        __builtin_amdgcn_s_setprio(1);
#define AT_SB __builtin_amdgcn_sched_barrier(0)
#define AT_RK(d0, KF) do { const unsigned cb = (((unsigned)(2 * (d0) + hi)) ^ ksw) << 4; KF[0] = *(const LAS bf16x8*)(Ks + cb); KF[1] = *(const LAS bf16x8*)(Ks + 32 * RB + cb); } while (0)
        const LAS unsigned char* Ks = lds + sk * KBYTES + kb0;
        bf16x8 kf[2][2];
        if (j > 0) {
            const LAS unsigned char* vbp = lds + VOFF + ((sv + 3) & 3) * 16384 + vrb;
            VFrag fa, fb;
            rd_v<0>(fa, vbp); rd_v<1>(fb, vbp); AT_SB;
            mm_pv(o[0], fa, pa0, pa1, pa2, pa3); AT_SB;
            rd_v<2>(fa, vbp); AT_SB;
            mm_pv(o[1], fb, pa0, pa1, pa2, pa3); AT_SB;
            rd_v<3>(fb, vbp); AT_SB;
            mm_pv(o[2], fa, pa0, pa1, pa2, pa3); AT_SB;
            AT_RK(0, kf[0]); AT_SB;
            mm_pv(o[3], fb, pa0, pa1, pa2, pa3); AT_SB;
        } else { AT_RK(0, kf[0]); AT_SB; }
        f32x16 p0, p1;
        AT_RK(1, kf[1]); AT_SB;
        p0 = mfma_srcc(kf[0][0], qr[0], cm); p1 = mfma_srcc(kf[0][1], qr[0], cm); AT_SB;
#pragma unroll
        for (int d0 = 1; d0 < ND0; ++d0) {
            if (d0 + 1 < ND0) { AT_RK(d0 + 1, kf[(d0 + 1) & 1]); AT_SB; }
            p0 = __builtin_amdgcn_mfma_f32_32x32x16_bf16(kf[d0 & 1][0], qr[d0], p0, 0, 0, 0);
            p1 = __builtin_amdgcn_mfma_f32_32x32x16_bf16(kf[d0 & 1][1], qr[d0], p1, 0, 0, 0); AT_SB;
        }
#undef AT_RK
#undef AT_SB
        asm volatile("s_waitcnt vmcnt(0)" ::: "memory");
        __builtin_amdgcn_s_setprio(0);
        __builtin_amdgcn_s_barrier(); asm volatile("" ::: "memory");
        { const int sk2 = sk == 0 ? 2 : sk - 1; AT_ISSUE(j + 2, sk2, (sv + 2) & 3); }
        float pmax = p0[0];
#pragma unroll
        for (int r = 1; r < 16; ++r) pmax = fmaxf(pmax, p0[r]);
#pragma unroll
        for (int r = 0; r < 16; ++r) pmax = fmaxf(pmax, p1[r]);
        { auto rr = __builtin_amdgcn_permlane32_swap(__float_as_uint(pmax), __float_as_uint(pmax), false, false); pmax = fmaxf(__uint_as_float(rr[0]), __uint_as_float(rr[1])); }
        float alpha = 1.f;
        if (__builtin_expect(j == 0 || !__all(pmax <= THR2), 0)) {
            const float delta = j == 0 ? pmax : fmaxf(pmax, 0.f);
            if (j != 0) alpha = __builtin_amdgcn_exp2f(-delta);
            m_reg += delta;
#pragma unroll
            for (int r = 0; r < 16; ++r) { p0[r] -= delta; p1[r] -= delta; cm[r] = -m_reg; }
        }
#pragma unroll
        for (int r = 0; r < 16; ++r) { p0[r] = __builtin_amdgcn_exp2f(p0[r]); p1[r] = __builtin_amdgcn_exp2f(p1[r]); }
        float ps = 0.f;
#pragma unroll
        for (int r = 0; r < 16; ++r) ps += p0[r] + p1[r];
        l_reg = l_reg * alpha + ps;
#define AT_PK4(P, BASE, OUT) do { u32x4 w = {cvtpk(P[BASE + 0], P[BASE + 1]), cvtpk(P[BASE + 2], P[BASE + 3]), cvtpk(P[BASE + 4], P[BASE + 5]), cvtpk(P[BASE + 6], P[BASE + 7])}; OUT = *reinterpret_cast<bf16x8*>(&w); } while (0)
        AT_PK4(p0, 0, pa0); AT_PK4(p0, 8, pa1); AT_PK4(p1, 0, pa2); AT_PK4(p1, 8, pa3);
#undef AT_PK4
        if (__any(alpha < 1.f)) {
            if (hi == 0) al_l[r32] = alpha;
            asm volatile("s_waitcnt lgkmcnt(0)" ::: "memory");
            float av[16];
#pragma unroll
            for (int r = 0; r < 16; ++r) av[r] = al_l[crow(r, hi)];
#pragma unroll
            for (int d = 0; d < 4; ++d)
#pragma unroll
                for (int r = 0; r < 16; ++r) o[d][r] *= av[r];
        }
        sk = sk == 2 ? 0 : sk + 1; sv = (sv + 1) & 3;
    }
    __builtin_amdgcn_s_barrier(); asm volatile("" ::: "memory");
    AT_PV((sv + 3) & 3);
    if (!half) __builtin_amdgcn_s_barrier();
    asm volatile("s_waitcnt vmcnt(0)" ::: "memory");
    __builtin_amdgcn_s_barrier();
    asm volatile("" ::: "memory");
    { auto rr = __builtin_amdgcn_permlane32_swap(__float_as_uint(l_reg), __float_as_uint(l_reg), false, false); l_out = __uint_as_float(rr[0]) + __uint_as_float(rr[1]); }
#undef AT_ISSUE
#undef AT_PV
}
__device__ __forceinline__ void row_inv_l(LAS unsigned char* lds_scratch, float l_reg, float (&rli)[16]) {
    const int tid = otid(), wid = tid >> 6, lane = tid & 63, r32 = lane & 31, hi = lane >> 5;
    LAS float* li_l = (LAS float*)lds_scratch + wid * 64 + 32;
    if (hi == 0) li_l[r32] = l_reg;
    asm volatile("s_waitcnt lgkmcnt(0)" ::: "memory");
#pragma unroll
    for (int r = 0; r < 16; ++r) rli[r] = __builtin_amdgcn_rcpf(li_l[crow(r, hi)]);
}
}

__device__ __forceinline__ void attn_unit_mla(CKP& p, LAS unsigned char* lds, int q0, int h, const at::KeyMap km) {
    const bf16_t* qm = (const bf16_t*)(p.ws + WS_QM); const bf16_t* kmb = (const bf16_t*)(p.ws + WS_KM); const bf16_t* vmb = (const bf16_t*)(p.ws + WS_VM); bf16_t* ya = (bf16_t*)(p.ws + WS_YBR);
    f32x16 o[4]; float l;
    at::attn_body<192>(lds, qm + h * 192, 768, q0, kmb + h * 192, 768, vmb + h * 128, 512, km, o, l);
    float rli[16]; at::row_inv_l(lds + 3 * 64 * 384 + 4 * 16384, l, rli);
    const int tid_ = otid(); const int wid = tid_ >> 6, lane = tid_ & 63, r32 = lane & 31, hi = lane >> 5;
    bf16_t* yw = ya + (size_t)(q0 + wid * 32) * 512 + h * 128 + r32;
#pragma unroll
    for (int r = 0; r < 16; ++r) { const int orow = at::crow(r, hi);
#pragma unroll
        for (int d0 = 0; d0 < 4; ++d0) yw[(size_t)orow * 512 + d0 * 32] = f2bf(o[d0][r] * rli[r]); }
}
__device__ __forceinline__ void attn_unit_diff(CKP& p, LAS unsigned char* lds, int l_idx, int q0, int h, const at::KeyMap km) {
    const bf16_t* ubuf = (const bf16_t*)(p.ws + WS_R1); bf16_t* yc = (bf16_t*)(p.ws + WS_YBR) + (size_t)2 * MALL * 512;
    const float lam = ((const float*)(p.ws + WS_SCAL))[l_idx]; const float lam_init = 0.8f - 0.6f * expf(-0.3f * (float)l_idx);
    f32x16 o[4]; float l; float rli[16];
    at::attn_body<64>(lds, ubuf + U_CQ + (2 * h) * 64, NU, q0, ubuf + U_CK + (2 * h) * 64, NU, ubuf + U_CV + h * 128, NU, km, o, l);
    at::row_inv_l(lds + 3 * 64 * 128 + 4 * 16384, l, rli);
    const int tid_ = otid(); const int wid = tid_ >> 6, lane = tid_ & 63, r32 = lane & 31, hi = lane >> 5;
    bf16_t* yw = yc + (size_t)(q0 + wid * 32) * 512 + h * 128 + r32;
#pragma unroll
    for (int r = 0; r < 16; ++r) { const int orow = at::crow(r, hi);
#pragma unroll
        for (int d0 = 0; d0 < 4; ++d0) yw[(size_t)orow * 512 + d0 * 32] = f2bf(o[d0][r] * rli[r]); }
    at::attn_body<64>(lds, ubuf + U_CQ + (2 * h + 1) * 64, NU, q0, ubuf + U_CK + (2 * h + 1) * 64, NU, ubuf + U_CV + h * 128, NU, km, o, l);
    at::row_inv_l(lds + 3 * 64 * 128 + 4 * 16384, l, rli);
    { const int t2 = otid(); yw = yc + (size_t)(q0 + (t2 >> 6) * 32) * 512 + h * 128 + (t2 & 31); }
    float ss[16];
#pragma unroll
    for (int r = 0; r < 16; ++r) { const int orow = at::crow(r, hi); float s = 0.f;
#pragma unroll
        for (int d = 0; d < 4; ++d) { const float v = bf2f(yw[(size_t)orow * 512 + d * 32]) - lam * (o[d][r] * rli[r]); o[d][r] = v; s += v * v; }
        ss[r] = s; }
#pragma unroll
    for (int r = 0; r < 16; ++r) {
#pragma unroll
        for (int x = 16; x >= 1; x >>= 1) ss[r] += shx(ss[r], x, lane); }
    const float* sub = p.in[I_SUBLN] + l_idx * 128; float sg[4];
#pragma unroll
    for (int d = 0; d < 4; ++d) sg[d] = sub[d * 32 + r32] * (1.0f - lam_init);
#pragma unroll
    for (int r = 0; r < 16; ++r) { const int orow = at::crow(r, hi); const float rn = rsqrtf(ss[r] * (1.0f / 128.0f) + EPS);
#pragma unroll
        for (int d0 = 0; d0 < 4; ++d0) yw[(size_t)orow * 512 + d0 * 32] = f2bf(o[d0][r] * rn * sg[d0]); }
}

__device__ __forceinline__ void lds_barrier() { asm volatile("s_waitcnt lgkmcnt(0)" ::: "memory"); __builtin_amdgcn_s_barrier(); asm volatile("" ::: "memory"); }
namespace hg {
__device__ __forceinline__ bf16x8 gather8(const LAS bf16_t* p, int stride) { bf16x8 r;
#pragma unroll
    for (int i = 0; i < 8; ++i) r[i] = (short)p[i * stride];
    return r; }
__device__ __forceinline__ void gates16(const bf16_t* zp  , float lbk, int dd, float (&gi)[16], float (&kf)[16], float& tot) {
    float g[16];
#pragma unroll
    for (int i = 0; i < 16; ++i) { const float z = bf2f(zp[(size_t)i * NU]); const float sg = sigmoidf_(z); g[i] = flog(lbk + (1.0f - lbk) * sg); kf[i] = (1.0f - lbk) * frcp(1.0f + __expf(z)); }
    float run = 0.f;
    if (dd == 0) {
#pragma unroll
        for (int i = 0; i < 16; ++i) { run += g[i]; gi[i] = run; }
    } else {
#pragma unroll
        for (int i = 15; i >= 0; --i) { run += g[i]; gi[i] = run; }
    }
    tot = run;
}
__device__ __forceinline__ void gates16r(const bf16_t (&zr)[16], float lbk, int dd, float (&gi)[16], float (&kf)[16], float& tot) {
    float g[16];
#pragma unroll
    for (int i = 0; i < 16; ++i) { const float z = bf2f(zr[i]); const float sg = sigmoidf_(z); g[i] = flog(lbk + (1.0f - lbk) * sg); kf[i] = (1.0f - lbk) * frcp(1.0f + __expf(z)); }
    float run = 0.f;
    if (dd == 0) {
#pragma unroll
        for (int i = 0; i < 16; ++i) { run += g[i]; gi[i] = run; }
    } else {
#pragma unroll
        for (int i = 15; i >= 0; --i) { run += g[i]; gi[i] = run; }
    }
    tot = run;
}
__device__ __forceinline__ void pack16_store(LAS bf16_t* dst, const float (&v)[16]) {
    u32x4 a, b; a.x = cvt_pk_bf16(v[0], v[1]); a.y = cvt_pk_bf16(v[2], v[3]); a.z = cvt_pk_bf16(v[4], v[5]); a.w = cvt_pk_bf16(v[6], v[7]);
    b.x = cvt_pk_bf16(v[8], v[9]); b.y = cvt_pk_bf16(v[10], v[11]); b.z = cvt_pk_bf16(v[12], v[13]); b.w = cvt_pk_bf16(v[14], v[15]);
    *(LAS u32x4*)dst = a; *(LAS u32x4*)(dst + 8) = b;
}
__device__ __forceinline__ void stage_vT(LAS bf16_t* VsT, const bf16_t* vp  , int v, int part) {
    unsigned short h[16];
#pragma unroll
    for (int i = 0; i < 16; ++i) h[i] = vp[(size_t)i * NU];
    u32x4 a, b; a.x = h[0] | ((unsigned)h[1] << 16); a.y = h[2] | ((unsigned)h[3] << 16); a.z = h[4] | ((unsigned)h[5] << 16); a.w = h[6] | ((unsigned)h[7] << 16);
    b.x = h[8] | ((unsigned)h[9] << 16); b.y = h[10] | ((unsigned)h[11] << 16); b.z = h[12] | ((unsigned)h[13] << 16); b.w = h[14] | ((unsigned)h[15] << 16);
    *(LAS u32x4*)(VsT + v * 72 + part * 16) = a; *(LAS u32x4*)(VsT + v * 72 + part * 16 + 8) = b;
}
__device__ __forceinline__ void pass1_unit(CKP& p, LAS unsigned char* lds, const float* lb, int cid, int hh) {
    const bf16_t* ubuf = (const bf16_t*)(p.ws + WS_R1); bf16_t* HS = (bf16_t*)(p.ws + WS_YBUF); float* HD = (float*)(p.ws + WS_HD);
    LAS bf16_t* VsT = (LAS bf16_t*)lds; LAS bf16_t* KtT = (LAS bf16_t*)(lds + 18432); LAS float* ptot = (LAS float*)(lds + 36864);
    const int tid = otid(), wid = tid >> 6, lane = tid & 63, row0 = cid * 64;
    const int k = tid & 127, part = tid >> 7; const float lbk = lb[hh * 128 + k];
    bf16_t zf[16], zb[16];
    { const bf16_t* zp = ubuf + (size_t)(row0 + part * 16) * NU + hh * 128 + k;
#pragma unroll
      for (int i = 0; i < 16; ++i) { zf[i] = zp[(size_t)i * NU + U_DFF]; zb[i] = zp[(size_t)i * NU + U_DFB]; } }
    stage_vT(VsT, ubuf + (size_t)(row0 + part * 16) * NU + U_DI + hh * 128 + k, k, part);
#pragma unroll 1
    for (int dd = 0; dd < 2; ++dd) {
        float gi[16], kf[16], tot;
        { bf16_t zr[16];
#pragma unroll
          for (int i = 0; i < 16; ++i) zr[i] = dd ? zb[i] : zf[i];
          gates16r(zr, lbk, dd, gi, kf, tot); }
        ptot[part * 128 + k] = tot;
        lds_barrier();
        float off = 0.f, gt = 0.f;
#pragma unroll
        for (int q = 0; q < 4; ++q) { const float v = ptot[q * 128 + k]; gt += v; if (dd == 0 ? (q < part) : (q > part)) off += v; }
#pragma unroll
        for (int i = 0; i < 16; ++i) kf[i] = kf[i] * __expf(gt - (off + gi[i]));
        pack16_store(KtT + k * 72 + part * 16, kf);
        if (part == 0) HD[(size_t)((cid * 4 + hh) * 2 + dd) * 128 + k] = __expf(gt);
        lds_barrier();
        {
            const int l15 = lane & 15, kg = lane >> 4;
            bf16x8 vf[2];
#pragma unroll
            for (int ks = 0; ks < 2; ++ks) vf[ks] = *(const LAS bf16x8*)(VsT + (wid * 16 + l15) * 72 + ks * 32 + kg * 8);
            bf16_t* dst = HS + ((size_t)((cid * 4 + hh) * 2 + dd) * 128 + wid * 16 + l15) * 128;
            bf16x8 kfr[8][2];
#pragma unroll
            for (int kb = 0; kb < 8; ++kb)
#pragma unroll
                for (int ks = 0; ks < 2; ++ks) kfr[kb][ks] = *(const LAS bf16x8*)(KtT + (kb * 16 + l15) * 72 + ks * 32 + kg * 8);
            asm volatile("" ::: "memory");
#pragma unroll
            for (int kb = 0; kb < 8; ++kb) {
                f32x4 c = {0.f, 0.f, 0.f, 0.f};
#pragma unroll
                for (int ks = 0; ks < 2; ++ks) c = __builtin_amdgcn_mfma_f32_16x16x32_bf16(kfr[kb][ks], vf[ks], c, 0, 0, 0);
                u32x2 w; w.x = cvt_pk_bf16(c[0], c[1]); w.y = cvt_pk_bf16(c[2], c[3]);
                *(u32x2*)(dst + kb * 16 + kg * 4) = w;
            }
        }
        lds_barrier();
    }
}
__device__ __forceinline__ void carry_unit(CKP& p, int u) {
    bf16_t* HS = (bf16_t*)(p.ws + WS_YBUF); const float* HD = (const float*)(p.ws + WS_HD);
    const int combo = u >> 4, sub = u & 15, b = combo >> 3, hh = (combo >> 1) & 3, dd = combo & 1;
    const int tid_ = otid(); const int v = sub * 8 + (tid_ >> 6), k = 2 * (tid_ & 63);
    float s0 = 0.f, s1 = 0.f;
#pragma unroll 1
    for (int s0i = 0; s0i < 260; s0i += 52) {
        unsigned uw[52]; f32x2 d2[52];
#pragma unroll
        for (int q = 0; q < 52; ++q) { const int st = s0i + q;
            const int cid = dd == 0 ? (st < 4 ? 512 + b * 4 + st : b * 256 + (st - 4)) : (st < 4 ? 512 + b * 4 + (3 - st) : b * 256 + (259 - st));
            const size_t base = (size_t)((cid * 4 + hh) * 2 + dd) * 128;
            uw[q] = *(const unsigned*)(HS + (base + v) * 128 + k); d2[q] = *(const f32x2*)(HD + base + k); }
#pragma unroll
        for (int q = 0; q < 52; ++q) { const int st = s0i + q;
            const int cid = dd == 0 ? (st < 4 ? 512 + b * 4 + st : b * 256 + (st - 4)) : (st < 4 ? 512 + b * 4 + (3 - st) : b * 256 + (259 - st));
            const size_t base = (size_t)((cid * 4 + hh) * 2 + dd) * 128;
            *(unsigned*)(HS + (base + v) * 128 + k) = cvt_pk_bf16(s0, s1);
            s0 = d2[q][0] * s0 + bflo(uw[q]); s1 = d2[q][1] * s1 + bfhi(uw[q]); }
    }
}
constexpr int O_QS = 0, O_KF = 17408, O_VS = 34816, O_GS = 53248, O_ST = 87040, O_AS = 121856, O_R = 140288, O_PT = 142336, O_RS = 144384;
static_assert(O_RS + 512 <= LDS_MISC, "HGRN LDS");
__device__ __forceinline__ void out_unit(CKP& p, LAS unsigned char* lds, const float* lb, const float* gnorm, int cid, int hh) {
    const bf16_t* ubuf = (const bf16_t*)(p.ws + WS_R1); const bf16_t* HS = (const bf16_t*)(p.ws + WS_YBUF); bf16_t* yd = (bf16_t*)(p.ws + WS_YBR) + (size_t)3 * MALL * 512;
    LAS bf16_t* qs = (LAS bf16_t*)(lds + O_QS); LAS bf16_t* kfs = (LAS bf16_t*)(lds + O_KF); LAS bf16_t* Vs = (LAS bf16_t*)(lds + O_VS); LAS float* Gs = (LAS float*)(lds + O_GS);
    LAS bf16_t* St = (LAS bf16_t*)(lds + O_ST); LAS float* Rr = (LAS float*)(lds + O_R); LAS float* ptot = (LAS float*)(lds + O_PT); LAS float* rss = (LAS float*)(lds + O_RS);
    const int tid = otid(), wid = tid >> 6, lane = tid & 63, row0 = cid * 64, l15 = lane & 15, kg = lane >> 4;
    LAS bf16_t* Asc = (LAS bf16_t*)(lds + O_AS) + wid * (16 * 72);
    const int k = tid & 127, part = tid >> 7; const float lbk = lb[hh * 128 + k];
    bf16_t zf[16], zb[16]; u32x4 sin0[4], sin1[4];
    { const bf16_t* zp = ubuf + (size_t)(row0 + part * 16) * NU + hh * 128 + k;
#pragma unroll
      for (int i = 0; i < 16; ++i) { zf[i] = zp[(size_t)i * NU + U_DFF]; zb[i] = zp[(size_t)i * NU + U_DFB]; }
      const int v_ = tid >> 2, seg_ = tid & 3; const bf16_t* src = HS + ((size_t)((cid * 4 + hh) * 2) * 128 + v_) * 128 + seg_ * 32;
#pragma unroll
      for (int i = 0; i < 4; ++i) { sin0[i] = *(const u32x4*)(src + i * 8); sin1[i] = *(const u32x4*)(src + (size_t)128 * 128 + i * 8); } }
    stage_vT(Vs, ubuf + (size_t)(row0 + part * 16) * NU + U_DI + hh * 128 + k, k, part);
#pragma unroll
    for (int i = 0; i < 16; ++i) { const int t = part * 16 + i; qs[t * 136 + k] = f2bf(siluf_(bf2f(ubuf[(size_t)(row0 + t) * NU + U_DQ + hh * 128 + k]))); }
    const int bi = wid >> 1, vh = wid & 1;
    f32x4 o[4];
#pragma unroll
    for (int nb = 0; nb < 4; ++nb) o[nb] = (f32x4){0.f, 0.f, 0.f, 0.f};
#pragma unroll 1
    for (int dd = 0; dd < 2; ++dd) {
        {
            float gi[16], kf[16], tot;
            { bf16_t zr[16];
#pragma unroll
              for (int i = 0; i < 16; ++i) zr[i] = dd ? zb[i] : zf[i];
              gates16r(zr, lbk, dd, gi, kf, tot); }
            ptot[part * 128 + k] = tot;
            lds_barrier();
            float off = 0.f;
#pragma unroll
            for (int q = 0; q < 4; ++q) { const float v = ptot[q * 128 + k]; if (dd == 0 ? (q < part) : (q > part)) off += v; }
#pragma unroll
            for (int i = 0; i < 16; ++i) { const int t = part * 16 + i; Gs[t * 132 + k] = off + gi[i]; kfs[t * 136 + k] = f2bf(kf[i]); }
            Rr[part * 128 + k] = off;
        }
        {
            const int v = tid >> 2, seg = tid & 3;
#pragma unroll
            for (int i = 0; i < 4; ++i) *(LAS u32x4*)(St + v * 136 + seg * 32 + i * 8) = dd ? sin1[i] : sin0[i];
        }
        lds_barrier();
        const int ti = bi * 16 + l15;
        u32x4 awq[4];
#pragma unroll
        for (int ks = 0; ks < 4; ++ks) { const int kc = ks * 32 + kg * 8;
            const u32x4 qw = *(const LAS u32x4*)(qs + ti * 136 + kc);
            const f32x4 g0 = *(const LAS f32x4*)(Gs + ti * 132 + kc), g1 = *(const LAS f32x4*)(Gs + ti * 132 + kc + 4), r0 = *(const LAS f32x4*)(Rr + bi * 128 + kc), r1 = *(const LAS f32x4*)(Rr + bi * 128 + kc + 4);
            const float qv[8] = {bflo(qw.x), bfhi(qw.x), bflo(qw.y), bfhi(qw.y), bflo(qw.z), bfhi(qw.z), bflo(qw.w), bfhi(qw.w)}; float qa[8];
#pragma unroll
            for (int e = 0; e < 4; ++e) { qa[e] = qv[e] * __expf(g0[e] - r0[e]); qa[4 + e] = qv[4 + e] * __expf(g1[e] - r1[e]); }
            awq[ks].x = cvt_pk_bf16(qa[0], qa[1]); awq[ks].y = cvt_pk_bf16(qa[2], qa[3]); awq[ks].z = cvt_pk_bf16(qa[4], qa[5]); awq[ks].w = cvt_pk_bf16(qa[6], qa[7]); }
#pragma unroll 1
        for (int j = 0; j < 4; ++j) {
            const bool use = dd == 0 ? (j <= bi) : (j >= bi);
            f32x4 c = {0.f, 0.f, 0.f, 0.f};
            if (use) {
                const int sj = j * 16 + l15;
#pragma unroll
                for (int ks = 0; ks < 4; ++ks) {
                    const int kc = ks * 32 + kg * 8;
                    const u32x4 kw = *(const LAS u32x4*)(kfs + sj * 136 + kc);
                    const f32x4 h0 = *(const LAS f32x4*)(Gs + sj * 132 + kc), h1 = *(const LAS f32x4*)(Gs + sj * 132 + kc + 4);
                    const f32x4 r0 = *(const LAS f32x4*)(Rr + bi * 128 + kc), r1 = *(const LAS f32x4*)(Rr + bi * 128 + kc + 4);
                    const float kv[8] = {bflo(kw.x), bfhi(kw.x), bflo(kw.y), bfhi(kw.y), bflo(kw.z), bfhi(kw.z), bflo(kw.w), bfhi(kw.w)};
                    float ka[8];
#pragma unroll
                    for (int e = 0; e < 4; ++e) { ka[e] = kv[e] * __expf(r0[e] - h0[e]); ka[4 + e] = kv[4 + e] * __expf(r1[e] - h1[e]); }
                    u32x4 aw = awq[ks], bw;
                    bw.x = cvt_pk_bf16(ka[0], ka[1]); bw.y = cvt_pk_bf16(ka[2], ka[3]); bw.z = cvt_pk_bf16(ka[4], ka[5]); bw.w = cvt_pk_bf16(ka[6], ka[7]);
                    c = __builtin_amdgcn_mfma_f32_16x16x32_bf16(*reinterpret_cast<bf16x8*>(&aw), *reinterpret_cast<bf16x8*>(&bw), c, 0, 0, 0);
                }
                if (j == bi) {
#pragma unroll
                    for (int e = 0; e < 4; ++e) { const int tl = 4 * kg + e; const bool keep = dd == 0 ? (l15 <= tl) : (l15 >= tl); c[e] = keep ? c[e] : 0.f; }
                }
            }
#pragma unroll
            for (int e = 0; e < 4; ++e) Asc[(4 * kg + e) * 72 + j * 16 + l15] = f2bf(c[e]);
        }
        bf16x8 af[2], qf[4];
#pragma unroll
        for (int ks = 0; ks < 2; ++ks) af[ks] = *(const LAS bf16x8*)(Asc + l15 * 72 + ks * 32 + kg * 8);
#pragma unroll
        for (int ks = 0; ks < 4; ++ks) { const int kc = ks * 32 + kg * 8;
            const u32x4 qw = *(const LAS u32x4*)(qs + ti * 136 + kc); const f32x4 g0 = *(const LAS f32x4*)(Gs + ti * 132 + kc), g1 = *(const LAS f32x4*)(Gs + ti * 132 + kc + 4);
            u32x4 aw; aw.x = cvt_pk_bf16(bflo(qw.x) * __expf(g0[0]), bfhi(qw.x) * __expf(g0[1])); aw.y = cvt_pk_bf16(bflo(qw.y) * __expf(g0[2]), bfhi(qw.y) * __expf(g0[3]));
            aw.z = cvt_pk_bf16(bflo(qw.z) * __expf(g1[0]), bfhi(qw.z) * __expf(g1[1])); aw.w = cvt_pk_bf16(bflo(qw.w) * __expf(g1[2]), bfhi(qw.w) * __expf(g1[3]));
            qf[ks] = *reinterpret_cast<bf16x8*>(&aw); }
#pragma unroll
        for (int nb = 0; nb < 4; ++nb) { const int vcol = vh * 64 + nb * 16 + l15;
            bf16x8 vf[2], sf[4];
#pragma unroll
            for (int ks = 0; ks < 2; ++ks) vf[ks] = *(const LAS bf16x8*)(Vs + vcol * 72 + ks * 32 + kg * 8);
#pragma unroll
            for (int ks = 0; ks < 4; ++ks) sf[ks] = *(const LAS bf16x8*)(St + vcol * 136 + ks * 32 + kg * 8);
            asm volatile("" ::: "memory");
#pragma unroll
            for (int ks = 0; ks < 2; ++ks) o[nb] = __builtin_amdgcn_mfma_f32_16x16x32_bf16(af[ks], vf[ks], o[nb], 0, 0, 0);
#pragma unroll
            for (int ks = 0; ks < 4; ++ks) o[nb] = __builtin_amdgcn_mfma_f32_16x16x32_bf16(qf[ks], sf[ks], o[nb], 0, 0, 0);
        }
        lds_barrier();
    }
    bf16_t ogr[4][4]; float gn[4];
#pragma unroll
    for (int e = 0; e < 4; ++e)
#pragma unroll
        for (int nb = 0; nb < 4; ++nb) ogr[e][nb] = ubuf[(size_t)(row0 + bi * 16 + 4 * kg + e) * NU + U_DG + hh * 128 + vh * 64 + nb * 16 + l15];
#pragma unroll
    for (int nb = 0; nb < 4; ++nb) gn[nb] = gnorm[vh * 64 + nb * 16 + l15];
    float ss[4];
#pragma unroll
    for (int e = 0; e < 4; ++e) { float s = 0.f;
#pragma unroll
        for (int nb = 0; nb < 4; ++nb) s += o[nb][e] * o[nb][e];
#pragma unroll
        for (int x = 8; x >= 1; x >>= 1) s += shx(s, x, lane);
        ss[e] = s; }
    if (l15 == 0) {
#pragma unroll
        for (int e = 0; e < 4; ++e) rss[vh * 64 + bi * 16 + 4 * kg + e] = ss[e]; }
    lds_barrier();
#pragma unroll
    for (int e = 0; e < 4; ++e) { const int tl = bi * 16 + 4 * kg + e; const float tot = rss[tl] + rss[64 + tl]; const float rn = rsqrtf(tot * (1.0f / 128.0f) + EPS);
        const size_t row = (size_t)(row0 + tl);
#pragma unroll
        for (int nb = 0; nb < 4; ++nb) { const int v = vh * 64 + nb * 16 + l15; const float og = bf2f(ogr[e][nb]);
            yd[row * 512 + hh * 128 + v] = f2bf(o[nb][e] * rn * gn[nb] * siluf_(og)); } }
    lds_barrier();
}
}

constexpr int PH_PER_LAYER = 14, N_PHASES = 1 + PH_PER_LAYER * NL + 1;
#ifndef MK_LAUNCHES
#define MK_LAUNCHES 1
#endif

__global__ void __launch_bounds__(NTHR, 2) fwd_kernel(KP karg) {
    extern __shared__ __attribute__((aligned(16))) unsigned char lds_raw[];
    LAS unsigned char* lds0 = (LAS unsigned char*)lds_raw;
    const int tid = otid(), G = gridDim.x, c = obid();
    volatile LAS unsigned* bst = (volatile LAS unsigned*)(lds0 + LDS_MISC);
    if (tid < 4) bst[tid] = 0u;
    __syncthreads();
    const int lo = karg.ph_lo, hi = karg.ph_hi;
    const bool fused = (MK_LAUNCHES == 1) || (hi - lo) > 1;
    XcdBarrier bar; bar.bar = (unsigned*)(karg.ws + WS_CTL); bar.x = 0; bar.st = bst;
    if (fused) bar = xcd_barrier_post((unsigned*)(karg.ws + WS_CTL), bst);
#ifndef ONLY_PH
#define ONLY_PH (-1)
#endif
#ifndef SUBMASK
#define SUBMASK 0xff
#endif
#define SUB(b) ((SUBMASK >> (b)) & 1)
#define EN(x) (ONLY_PH < 0 || ONLY_PH == (x))
#ifndef REPX
#define REPX (-1)
#define REPN 1
#endif
#define REPEAT(x) _Pragma("unroll 1") for (int rep_ = 0; rep_ < (REPX == (x) ? REPN : 1); ++rep_)
#define IN(k) ((MK_LAUNCHES == 1) || (lo <= (k) && (k) < hi))
#define INL(x) (EN(x) && IN(pb + (x)))
#define SEAM(k) do { if (IN((k) + 1)) xcd_barrier(bar); } while (0)

#define PH_LOCALS CKP& p = kp_here(); const int c = obid(); unsigned char* ws = p.ws; LAS unsigned char* lds = lds_here(lds_raw); \
    float* mod = (float*)(ws + WS_MOD); const float* rope = (const float*)(ws + WS_ROPE); const float* scal = (const float*)(ws + WS_SCAL); \
    bf16_t* hbuf = (bf16_t*)(ws + WS_HBUF); bf16_t* act = (bf16_t*)(ws + WS_R1); bf16_t* ubuf = (bf16_t*)(ws + WS_R1); bf16_t* mrg = (bf16_t*)(ws + WS_R1); bf16_t* ybuf = (bf16_t*)(ws + WS_YBUF); \
    float* xc = (float*)(ws + WS_XC); const float* modl = mod + (size_t)l * 3 * NMOD * DM; \
    (void)rope; (void)scal; (void)hbuf; (void)act; (void)ubuf; (void)mrg; (void)ybuf; (void)xc; (void)modl;

    if (EN(100) && IN(0)) { CKP& p = kp_here(); LAS unsigned char* lds = lds_here(lds_raw); job_tables(p); job_colmax(p); job_mod(p, lds); SEAM(0); }

#pragma unroll 1
    for (int l = 0; l < NL; ++l) {
        const int pb = 1 + PH_PER_LAYER * l; const bool need_ctx = l < NL - 1; const int nrt = need_ctx ? NRT : 128;
        if (INL(0)) { PH_LOCALS
            RNArgs a{};
            if (l == 0) { a.xs_lat = p.in[I_X]; a.xs_ctx = p.in[I_CTX]; a.xd_lat = p.out; a.xd_ctx = xc; a.y = nullptr; }
            else { a.xs_lat = p.out; a.xs_ctx = xc; a.xd_lat = p.out; a.xd_ctx = xc; a.y = ybuf; a.wres = 0.5f; a.modl_res = mod + (size_t)(l - 1) * 3 * NMOD * DM; a.jres = 2; a.postg = p.in[I_POST] + ((l - 1) * 3 + 2) * DM; }
            a.do_norm = true; a.modl_norm = modl; a.jn = 0; a.preg = p.in[I_PRE] + (l * 3 + 0) * DM; a.h = nullptr; a.h8 = (signed char*)hbuf; a.nrows = MALL; a.hsc = (float*)(ws + WS_HSC);
            job_resnorm(a, lds);
            job_convert(p, lds, l);
            SEAM(pb + 0);
        }
        if (INL(1)) { PH_LOCALS
            SchedPlain S; S.T.init(NRT, 44, G, c); S.A = (const char*)hbuf; S.B = (const char*)(ws + WS_WGU); S.lda2 = DM; S.ldb2 = DM; S.nt = DM / 128;
            REPEAT(1) { EpiGateUpI8 E{act, (const float*)(ws + WS_HSC), (const float*)(ws + WS_WSC)}; gm::gemm_stream<false>(lds, S, E); } SEAM(pb + 1);
        }
        if (INL(2)) { PH_LOCALS
            const bool spl = G == 256 && MK_LAUNCHES == 1; float* ypart = (float*)(ws + WS_R1 + (size_t)MALL * DFF * 2);
            SchedSplitK S; S.T.init(spl ? 128 : NRT, 8, G, c, 4); S.A = (const char*)act; S.B = (const char*)(ws + WS_WD); S.lda2 = DFF * 2; S.ldb2 = DFF * 2; S.nt = DFF / 64; S.xe = (spl && c < 64) ? c : -1;
            REPEAT(2) { EpiStoreK E{ybuf, ypart}; gm::gemm_stream<false>(lds, S, E); } SEAM(pb + 2);
            if (spl) { job_splitk_reduce(ypart, ybuf); xcd_barrier(bar); }
        }
        if (INL(3)) { PH_LOCALS
            RNArgs a{};
            if (l == 0) { a.xs_lat = p.in[I_X]; a.xs_ctx = p.in[I_CTX]; } else { a.xs_lat = p.out; a.xs_ctx = xc; }
            a.xd_lat = p.out; a.xd_ctx = xc; a.y = ybuf; a.wres = 0.5f; a.modl_res = modl; a.jres = 0; a.postg = p.in[I_POST] + (l * 3 + 0) * DM;
            a.do_norm = true; a.modl_norm = modl; a.jn = 1; a.preg = p.in[I_PRE] + (l * 3 + 1) * DM; a.h = nullptr; a.h8 = (signed char*)(ws + WS_H8); a.hsc = (float*)(ws + WS_HSC2); a.nrows = MALL;
            job_resnorm(a, lds); SEAM(pb + 3);
        }
        if (INL(4)) { PH_LOCALS
            SchedPlain S; S.T.init(NRT, 24, G, c); S.A = (const char*)(ws + WS_H8); S.B = (const char*)(ws + WS_WIN); S.lda2 = DM; S.ldb2 = DM; S.nt = DM / 128;
            REPEAT(4) { EpiProj E{ubuf, (bf16_t*)(ws + WS_KM), rope, (const float*)(ws + WS_HSC2), (const float*)(ws + WS_WPS)}; gm::gemm_stream<false>(lds, S, E); } SEAM(pb + 4);
        }
        if (INL(5)) { PH_LOCALS job_stats_conv(p, l); SEAM(pb + 5); }
        if (INL(6)) { PH_LOCALS
            if (SUB(0)) { SchedPlain S; S.T.init(NRT, 3, G, c); S.A = (const char*)(ubuf + U_AQ); S.B = (const char*)(ws + WS_WUQ); S.lda2 = NU * 2; S.ldb2 = 512 * 2; S.nt = 8;
              EpiQup E{(bf16_t*)(ws + WS_QM), (const float*)(ws + WS_RSQ), rope}; gm::gemm_stream<false>(lds, S, E); }
            if (SUB(1)) { SchedPlain S; S.T.init(NRT, 4, G, G == 256 ? (c + 120) & 255 : c); S.A = (const char*)(ubuf + U_AKV); S.B = (const char*)(ws + WS_WUKV); S.lda2 = NU * 2; S.ldb2 = 256 * 2; S.nt = 4;
              EpiKVup E{(bf16_t*)(ws + WS_KM), (bf16_t*)(ws + WS_VM), (const float*)(ws + WS_RSQ) + MALL}; gm::gemm_stream<false>(lds, S, E); }
            if (SUB(2)) { SchedPlain S; S.T.init(NRT, 8, G, G == 256 ? (c + 112) & 255 : c); S.A = (const char*)(ws + WS_XCV); S.B = (const char*)(ws + WS_WRG); S.lda2 = 512 * 2; S.ldb2 = 512 * 2; S.nt = 8;
              EpiRG E{(const bf16_t*)(ws + WS_XCV), (bf16_t*)(ws + WS_LA), (bf16_t*)(ws + WS_BB), p.in[I_RGBR] + l * 1024, p.in[I_RGBI] + l * 1024, scal + 2048 + l * 1024}; gm::gemm_stream<false>(lds, S, E); }
            if (SUB(3)) for (int u = (G == 256 ? (c + 96) & 255 : c); u < 520 * 4; u += G) hg::pass1_unit(p, lds, scal + 256 + l * 512, u >> 2, u & 3);
            SEAM(pb + 6);
        }
        if (INL(7)) { PH_LOCALS job_rg_scan1(p); for (int u = c; u < 256; u += G) hg::carry_unit(p, u); SEAM(pb + 7); }
        if (INL(8)) { PH_LOCALS {
            REPEAT(81) if (SUB(0)) job_rg_out(p, nrt);
            REPEAT(82) if (SUB(1)) { const int ncu = need_ctx ? 520 * 4 : 512 * 4;
                if (G > nrt + 16) {
                    if (c < nrt) { for (int i = 0; i < 7; ++i) { const int u = c + i * nrt; hg::out_unit(p, lds, scal + 256 + l * 512, p.in[I_HNORM] + l * 128, u >> 2, u & 3); } }
                    else for (int u = 7 * nrt + (c - nrt); u < ncu; u += G - nrt) hg::out_unit(p, lds, scal + 256 + l * 512, p.in[I_HNORM] + l * 128, u >> 2, u & 3);
                } else for (int u = c; u < ncu; u += G) hg::out_unit(p, lds, scal + 256 + l * 512, p.in[I_HNORM] + l * 128, u >> 2, u & 3); }
            if (SUB(4) && need_ctx) for (int t = (G == 256 ? (c + 16) & 255 : c); t < 16; t += G) { const int bh = t & 7, b = bh >> 2, h = bh & 3; at::KeyMap km{MLAT + b * CTXL, 0, 4, 4};
                if (t < 8) attn_unit_mla(p, lds, MLAT + b * CTXL, h, km); else attn_unit_diff(p, lds, l, MLAT + b * CTXL, h, km); }
            REPEAT(83) if (SUB(2)) for (int t = c; t < 512; t += G) { const int bh = t & 7, qb = t >> 3, b = bh >> 2, h = bh & 3; at::KeyMap km{MLAT + b * CTXL, b * SEQ, 4, 260}; attn_unit_mla(p, lds, b * SEQ + qb * 256, h, km); }
            REPEAT(84) if (SUB(3)) for (int t = c; t < 512; t += G) { const int bh = t & 7, qb = t >> 3, b = bh >> 2, h = bh & 3; at::KeyMap km{MLAT + b * CTXL, b * SEQ, 4, 260}; attn_unit_diff(p, lds, l, b * SEQ + qb * 256, h, km); }
            }
            SEAM(pb + 8);
        }
        if (INL(9)) { PH_LOCALS
            const bool bal = need_ctx && G == 256 && MK_LAUNCHES == 1;
            bf16_t* part = mrg + (size_t)2 * MALL * DM; bf16_t* gx = part + (size_t)4 * MCTX * DM;
            EpiMergeG EG{mrg + (size_t)MALL * DM, p.in[I_MB] + l * 4 * DM, (const float*)(ws + WS_HSC2), (const float*)(ws + WS_WGS), bal, gx};
            EpiMergeY EY{mrg, mrg + (size_t)MALL * DM, bal, gx, part};
            REPEAT(9) {
#pragma unroll 1
            for (int n = 0; n < 4; ++n) { const int xe = (bal && c >= 16 * n && c < 16 * n + 16) ? c - 16 * n : -1, nrm = bal ? 128 : nrt;
                { SchedMergeG S; S.T.init(nrm, 8, G, c); S.h8 = (const char*)(ws + WS_H8); S.wg = (const char*)(ws + WS_WIN) + (size_t)NU * DM; S.n = n; S.xe = xe; gm::gemm_stream<false>(lds, S, EG); }
                { SchedMergeY S; S.T.init(nrm, 8, G, c); S.ybr = (const char*)(ws + WS_YBR); S.wbr = (const char*)(ws + WS_WBR); S.n = n; S.xe = xe; gm::gemm_stream<false>(lds, S, EY); }
            } }
            SEAM(pb + 9);
            if (bal) {
                const int tid = otid();
                for (int idx = c * 512 + tid; idx < MCTX * 256; idx += G * 512) { const int row = idx >> 8, q = idx & 255; float sm[8] = {0.f, 0.f, 0.f, 0.f, 0.f, 0.f, 0.f, 0.f};
#pragma unroll
                    for (int n = 0; n < 4; ++n) { const u32x4 w = *(const u32x4*)(part + ((size_t)n * MCTX + row) * DM + q * 8);
                        sm[0] += bflo(w.x); sm[1] += bfhi(w.x); sm[2] += bflo(w.y); sm[3] += bfhi(w.y); sm[4] += bflo(w.z); sm[5] += bfhi(w.z); sm[6] += bflo(w.w); sm[7] += bfhi(w.w); }
                    u32x4 o; o.x = cvt_pk_bf16(sm[0], sm[1]); o.y = cvt_pk_bf16(sm[2], sm[3]); o.z = cvt_pk_bf16(sm[4], sm[5]); o.w = cvt_pk_bf16(sm[6], sm[7]);
                    *(u32x4*)(mrg + (size_t)(MLAT + row) * DM + q * 8) = o; }
                xcd_barrier(bar);
            }
        }
        if (INL(10)) { PH_LOCALS
            const bool spl = need_ctx && G == 256 && MK_LAUNCHES == 1; float* ypart = (float*)(ws + WS_R1 + (size_t)MALL * DFF * 2);
            SchedSplitK S; S.T.init(spl ? 128 : nrt, 8, G, c, 4); S.A = (const char*)mrg; S.B = (const char*)(ws + WS_WOUT); S.lda2 = DM * 2; S.ldb2 = DM * 2; S.nt = DM / 64; S.xe = (spl && c < 64) ? c : -1;
            EpiStoreK E{ybuf, ypart}; gm::gemm_stream<false>(lds, S, E); SEAM(pb + 10);
            if (spl) { job_splitk_reduce(ypart, ybuf); xcd_barrier(bar); }
        }
        if (INL(11)) { PH_LOCALS
            RNArgs a{}; a.xs_lat = p.out; a.xs_ctx = xc; a.xd_lat = p.out; a.xd_ctx = xc; a.y = ybuf; a.wres = 1.0f; a.modl_res = modl; a.jres = 1; a.postg = p.in[I_POST] + (l * 3 + 1) * DM;
            a.do_norm = true; a.modl_norm = modl; a.jn = 2; a.preg = p.in[I_PRE] + (l * 3 + 2) * DM; a.h = nullptr; a.h8 = (signed char*)hbuf; a.nrows = nrt * 256; a.hsc = (float*)(ws + WS_HSC);
            job_resnorm(a, lds); SEAM(pb + 11);
        }
        if (INL(12)) { PH_LOCALS
            SchedPlain S; S.T.init(nrt, 44, G, c); S.A = (const char*)hbuf; S.B = (const char*)(ws + WS_WGU) + (size_t)11264 * 2048; S.lda2 = DM; S.ldb2 = DM; S.nt = DM / 128;
            EpiGateUpI8 E{act, (const float*)(ws + WS_HSC), (const float*)(ws + WS_WSC) + 11264}; gm::gemm_stream<false>(lds, S, E); SEAM(pb + 12);
        }
        if (INL(13)) { PH_LOCALS
            const bool spl = need_ctx && G == 256 && MK_LAUNCHES == 1; float* ypart = (float*)(ws + WS_R1 + (size_t)MALL * DFF * 2);
            SchedSplitK S; S.T.init(spl ? 128 : nrt, 8, G, c, 4); S.A = (const char*)act; S.B = (const char*)(ws + WS_WD) + (size_t)2048 * 5632 * 2; S.lda2 = DFF * 2; S.ldb2 = DFF * 2; S.nt = DFF / 64; S.xe = (spl && c < 64) ? c : -1;
            EpiStoreK E{ybuf, ypart}; gm::gemm_stream<false>(lds, S, E); SEAM(pb + 13);
            if (spl) { job_splitk_reduce(ypart, ybuf); xcd_barrier(bar); }
        }
    }
    if (EN(101) && IN(N_PHASES - 1)) {
        const int l = NL - 1; PH_LOCALS
        RNArgs a{}; a.xs_lat = p.out; a.xs_ctx = xc; a.xd_lat = p.out; a.xd_ctx = xc; a.y = ybuf; a.wres = 0.5f; a.modl_res = mod + (size_t)l * 3 * NMOD * DM; a.jres = 2; a.postg = p.in[I_POST] + (l * 3 + 2) * DM;
        a.do_norm = false; a.modl_norm = a.modl_res; a.jn = 0; a.preg = nullptr; a.h = nullptr; a.nrows = MLAT;
        job_resnorm(a, lds);
    }
#undef PH_LOCALS
#undef IN
#undef INL
#undef EN
#undef SEAM
}


#ifdef DBG_K
__global__ void dbg_dump(float* out, const unsigned char* ws, size_t off, size_t nelem, int is_bf16) {
    const size_t N = (size_t)MLAT * DM;
    for (size_t i = (size_t)obid() * blockDim.x + threadIdx.x; i < N; i += (size_t)gridDim.x * blockDim.x) {
        float s = 0.f;
        for (size_t j = i; j < nelem; j += N) s += is_bf16 ? bf2f(((const bf16_t*)(ws + off))[j]) : ((const float*)(ws + off))[j];
        out[i] = (s - s == 0.f) ? s : 12345.0f;
    }
}
#endif

extern "C" void kernel_launch(void* const* d_in, const int* in_sizes, int n_in, void* d_out, int out_size, void* d_ws, size_t ws_size, hipStream_t stream) {
    static int grid = 0;
    if (grid == 0) {
        if (n_in != 30 || out_size != MLAT * DM || ws_size < WS_END) { fprintf(stderr, "kernel_launch: unexpected shapes: n_in %d out %d ws %zu (need %zu)\n", n_in, out_size, ws_size, (size_t)WS_END); grid = -1; return; }
        int dev = 0, cus = 0;
        if (hipGetDevice(&dev) != hipSuccess || hipDeviceGetAttribute(&cus, hipDeviceAttributeMultiprocessorCount, dev) != hipSuccess) { grid = -1; return; }
        if (hipFuncSetAttribute((const void*)fwd_kernel, hipFuncAttributeMaxDynamicSharedMemorySize, LDS_BYTES) != hipSuccess) { fprintf(stderr, "kernel_launch: hipFuncSetAttribute failed\n"); grid = -1; return; }
        int per_cu = 0; (void)hipOccupancyMaxActiveBlocksPerMultiprocessor(&per_cu, (const void*)fwd_kernel, NTHR, LDS_BYTES); (void)hipGetLastError();
        grid = cus;
    }
    if (grid < 0) return;
    (void)hipMemsetAsync((char*)d_ws + WS_CTL, 0, WS_ZERO_BYTES, stream);
    KP p{};
    for (int i = 0; i < 30; ++i) p.in[i] = (const float*)d_in[i];
    p.out = (float*)d_out; p.ws = (unsigned char*)d_ws;
#ifdef DBG_K
    for (int k = 0; k < DBG_K; ++k) { p.ph_lo = k; p.ph_hi = k + 1; hipLaunchKernelGGL(fwd_kernel, dim3(grid), dim3(NTHR), LDS_BYTES, stream, p); }
    hipLaunchKernelGGL(dbg_dump, dim3(2048), dim3(256), 0, stream, (float*)d_out, (const unsigned char*)d_ws, (size_t)(DBG_OFF), (size_t)(DBG_N), (int)(DBG_BF));
#elif MK_LAUNCHES == 1
    p.ph_lo = 0; p.ph_hi = N_PHASES;
    hipLaunchKernelGGL(fwd_kernel, dim3(grid), dim3(NTHR), LDS_BYTES, stream, p);
#else
    for (int k = 0; k < N_PHASES; ++k) { p.ph_lo = k; p.ph_hi = k + 1; hipLaunchKernelGGL(fwd_kernel, dim3(grid), dim3(NTHR), LDS_BYTES, stream, p); }
#endif
}
```

```cpp
#include <hip/hip_runtime.h>
#include <stdint.h>
#include <stdio.h>

#define LAS __attribute__((address_space(3)))
typedef unsigned short bf16_t;
typedef short bf16x8 __attribute__((ext_vector_type(8)));
typedef short s16x4 __attribute__((ext_vector_type(4)));
typedef float f32x2 __attribute__((ext_vector_type(2)));
typedef float f32x4 __attribute__((ext_vector_type(4)));
typedef float f32x16 __attribute__((ext_vector_type(16)));
typedef unsigned u32x2 __attribute__((ext_vector_type(2)));
typedef unsigned u32x4 __attribute__((ext_vector_type(4)));
typedef int i32x4 __attribute__((ext_vector_type(4)));

constexpr int DM = 2048, NB = 2, SEQ = 16384, NL = 2, CTXL = 256, DFF = 5632, NMOD = 9;
constexpr int MLAT = NB * SEQ, MCTX = NB * CTXL, MALL = MLAT + MCTX;
constexpr int NRT = MALL / 256;
constexpr int DIN = 14144, NU = 6144;
constexpr float EPS = 1e-6f;
constexpr int U_AQ = 0, U_BX = 512, U_BG = 1024, U_CQ = 1536, U_CK = 2048, U_CV = 2560, U_DQ = 3072, U_DFF = 3584, U_DFB = 4096, U_DI = 4608, U_DG = 5120, U_AKV = 5632, U_AKR = 5888;

constexpr size_t al256(size_t x) { return (x + 255) / 256 * 256; }
constexpr size_t WS_CTL = 0;
constexpr size_t WS_CMAX = 16384;
constexpr size_t WS_CMAX2 = WS_CMAX + (size_t)NL * 2 * 2 * 5632 * 4;
constexpr size_t WS_ZERO_BYTES = 524288;
static_assert(WS_CMAX2 + (size_t)NL * 14336 * 4 <= WS_ZERO_BYTES, "column maxima inside the zeroed region");
constexpr size_t WS_MOD = 524288;
constexpr size_t WS_ROPE = WS_MOD + al256((size_t)NL * 3 * NMOD * DM * 4);
constexpr size_t WS_SCAL = WS_ROPE + 32768;
constexpr size_t WS_RSQ = WS_SCAL + 32768;
constexpr size_t WS_RGS = WS_RSQ + al256((size_t)MALL * 8);
constexpr size_t WS_HD = WS_RGS + al256((size_t)NRT * 2 * 512 * 8);
constexpr size_t WS_XC = WS_HD + al256((size_t)520 * 4 * 2 * 128 * 4);
constexpr size_t WS_WGU = WS_XC + (size_t)MCTX * DM * 4;
constexpr size_t WS_WD = WS_WGU + (size_t)2 * 11264 * 2048 * 2;
constexpr size_t WS_WIN = WS_WD + (size_t)2 * 2048 * 5632 * 2;
constexpr size_t WS_WUQ = WS_WIN + (size_t)14336 * 2048 * 2;
constexpr size_t WS_WUKV = WS_WUQ + (size_t)768 * 512 * 2;
constexpr size_t WS_WRG = WS_WUKV + (size_t)1024 * 256 * 2;
constexpr size_t WS_WBR = WS_WRG + (size_t)2048 * 512 * 2;
constexpr size_t WS_WOUT = WS_WBR + (size_t)4 * 2048 * 512 * 2;
constexpr size_t WS_HBUF = WS_WOUT + (size_t)2048 * 2048 * 2;
constexpr size_t WS_R1 = WS_HBUF + (size_t)MALL * DM * 2;
constexpr size_t WS_YBUF = WS_R1 + (size_t)MALL * NU * 2;
constexpr size_t WS_QM = WS_YBUF + (size_t)MALL * DM * 2;
constexpr size_t WS_KM = WS_QM + (size_t)MALL * 768 * 2;
constexpr size_t WS_VM = WS_KM + (size_t)MALL * 768 * 2;
constexpr size_t WS_YBR = WS_VM + (size_t)MALL * 512 * 2;
constexpr size_t WS_XCV = WS_YBR + (size_t)4 * MALL * 512 * 2;
constexpr size_t WS_LA = WS_XCV + (size_t)MALL * 512 * 2;
constexpr size_t WS_BB = WS_LA + (size_t)MALL * 1024 * 2;
constexpr size_t WS_WSC = WS_BB + (size_t)MALL * 1024 * 2;
constexpr size_t WS_HSC = WS_WSC + al256((size_t)2 * 11264 * 4);
constexpr size_t WS_HSC2 = WS_HSC + al256((size_t)MALL * 4);
constexpr size_t WS_WGS = WS_HSC2 + al256((size_t)MALL * 4);
constexpr size_t WS_WPS = WS_WGS + 32768;
constexpr size_t WS_H8 = WS_WPS + 32768;
constexpr size_t WS_END = WS_H8 + (size_t)MALL * DM;

constexpr int NTHR = 512;
constexpr int LDS_BYTES = 147456;
constexpr int LDS_MISC = 147456 - 64;

typedef __bf16 bf16x2n __attribute__((ext_vector_type(2)));
__device__ __forceinline__ unsigned cvt_pk_bf16(float lo, float hi) { const f32x2 v = {lo, hi}; const bf16x2n b = __builtin_convertvector(v, bf16x2n); return __builtin_bit_cast(unsigned, b); }
__device__ __forceinline__ bf16_t f2bf(float x) { return (bf16_t)(cvt_pk_bf16(x, 0.f) & 0xffffu); }
__device__ __forceinline__ float bf2f(bf16_t b) { return __uint_as_float(((unsigned)b) << 16); }
__device__ __forceinline__ float bflo(unsigned w) { return __uint_as_float(w << 16); }
__device__ __forceinline__ float bfhi(unsigned w) { return __uint_as_float(w & 0xffff0000u); }
__device__ __forceinline__ float frcp(float x) { return __builtin_amdgcn_rcpf(x); }
__device__ __forceinline__ float flog(float x) { return __builtin_amdgcn_logf(x) * 0.6931471805599453f; }
__device__ __forceinline__ float sigmoidf_(float x) { return frcp(1.0f + __expf(-x)); }
__device__ __forceinline__ float siluf_(float x) { return x * sigmoidf_(x); }
__device__ __forceinline__ float gelu_tanh(float x) { const float u = 0.7978845608028654f * (x + 0.044715f * x * x * x); const float t = 1.0f - 2.0f * frcp(1.0f + __expf(2.0f * u)); return 0.5f * x * (1.0f + t); }
__device__ __forceinline__ float shx(float v, int mask, int lane) { return __int_as_float(__builtin_amdgcn_ds_bpermute((lane ^ mask) << 2, __float_as_int(v))); }
__device__ __forceinline__ float wave_sum(float v, int lane) {
#pragma unroll
    for (int o = 32; o >= 1; o >>= 1) v += shx(v, o, lane);
    return v;
}
__device__ __forceinline__ int obid() { int b = blockIdx.x; asm volatile("" : "+s"(b)); return b; }
__device__ __forceinline__ int otid() { int t = threadIdx.x; asm volatile("" : "+v"(t)); return t; }
#define WAIT_VM0() asm volatile("s_waitcnt vmcnt(0)" ::: "memory")
#define WAIT_LGKM0() asm volatile("s_waitcnt lgkmcnt(0)" ::: "memory")

#define XB_TMO      128
#define XB_XCNT(j)  (256  + 64 * (j))
#define XB_XSUB(j)  (1280 + 64 * (j))
#define XB_XGEN(j)  (2304 + 64 * (j))
#define XB_TOP      3328
#define XB_TOPGEN   3392
#define XCD_BAR_WORDS 3456
#define XB_SPIN_CAP (1u << 22)
__device__ __forceinline__ unsigned xb_ld(unsigned* p)              { return __hip_atomic_load(p, __ATOMIC_RELAXED, __HIP_MEMORY_SCOPE_AGENT); }
__device__ __forceinline__ unsigned xb_add(unsigned* p, unsigned v) { return __hip_atomic_fetch_add(p, v, __ATOMIC_RELAXED, __HIP_MEMORY_SCOPE_AGENT); }
__device__ __forceinline__ unsigned xb_xcc_id() { return (unsigned)__builtin_amdgcn_s_getreg((3 << 11) | 20) & 0xFu; }
#define XB_SPIN(cond, bar) do { unsigned _sp = 0; while (cond) { __builtin_amdgcn_s_sleep(1); \
    if ((++_sp & 255u) == 0u) { if (xb_ld(&(bar)[XB_TMO])) break; if (_sp > XB_SPIN_CAP) { atomicAdd(&(bar)[XB_TMO], 1u); break; } } } } while (0)
struct XcdBarrier { unsigned* bar; unsigned x; volatile LAS unsigned* st; };
__device__ __forceinline__ XcdBarrier xcd_barrier_post(unsigned* bar, volatile LAS unsigned* st) {
    XcdBarrier b; b.bar = bar; b.x = xb_xcc_id(); b.st = st;
    if (threadIdx.x == 0) (void)xb_add(&bar[XB_XCNT(b.x)], 1u);
    return b;
}
__device__ __forceinline__ void xcd_barrier_complete(unsigned* bar, unsigned x, unsigned& nloc, unsigned& nx) {
    const unsigned G = gridDim.x * gridDim.y * gridDim.z;
    unsigned sum, cnt, mine, sp = 0u;
    for (;;) {
        sum = 0u; cnt = 0u; mine = 0u;
#pragma unroll 1
        for (unsigned j = 0; j < 16; ++j) { const unsigned c = xb_ld(&bar[XB_XCNT(j)]); sum += c; cnt += (c > 0u) ? 1u : 0u; mine = (j == x) ? c : mine; }
        if (sum == G) break;
        __builtin_amdgcn_s_sleep(1);
        if ((++sp & 255u) == 0u) { if (xb_ld(&bar[XB_TMO])) break; if (sp > XB_SPIN_CAP) { atomicAdd(&bar[XB_TMO], 1u); break; } }
    }
    nloc = mine > 0u ? mine : 1u; nx = cnt > 0u ? cnt : 1u;
}
__device__ __forceinline__ void xcd_barrier(const XcdBarrier& b) {
    asm volatile("s_waitcnt vmcnt(0)" ::: "memory");
    __syncthreads();
    if (threadIdx.x == 0) {
        unsigned* bar = b.bar; unsigned bx = b.x;
        asm volatile("" : "+s"(bar), "+s"(bx));
        __builtin_amdgcn_s_waitcnt(0);
        unsigned nloc = b.st[0], nx = b.st[1];
        if (nloc == 0u) { xcd_barrier_complete(bar, bx, nloc, nx); b.st[0] = nloc; b.st[1] = nx; }
        const unsigned old = xb_add(&bar[XB_XSUB(bx)], 1u);
        const unsigned gen = old / nloc;
        if (old + 1u == (gen + 1u) * nloc) {
            __builtin_amdgcn_fence(__ATOMIC_RELEASE, "agent");
            asm volatile("s_waitcnt vmcnt(0)" ::: "memory");
            const unsigned og = xb_add(&bar[XB_TOP], 1u);
            const unsigned tg = og / nx;
            if (og + 1u == (tg + 1u) * nx) xb_add(&bar[XB_TOPGEN], 1u);
            else XB_SPIN(xb_ld(&bar[XB_TOPGEN]) == tg, bar);
            __builtin_amdgcn_fence(__ATOMIC_ACQUIRE, "agent");
            xb_add(&bar[XB_XGEN(bx)], 1u);
            asm volatile("s_waitcnt vmcnt(0)" ::: "memory");
        } else {
            XB_SPIN(xb_ld(&bar[XB_XGEN(bx)]) == gen, bar);
            __builtin_amdgcn_fence(__ATOMIC_ACQUIRE, "agent");
            asm volatile("s_waitcnt vmcnt(0)" ::: "memory");
        }
    }
    __syncthreads();
}

constexpr float MLA_QC = 0.07216878364870322f * 1.4426950408889634f, DIFF_QC = 0.125f * 1.4426950408889634f;
namespace gm {
constexpr int BM = 256, BK = 64, HALF = 128, HTB = HALF * BK * 2, STAGE_BYTES = 8 * HTB;
__device__ __forceinline__ int lds_byte(int r, int c) { const int st = (r >> 4) * 2 + (c >> 5), rr = r & 15, cc = c & 31, ob = rr * 64 + cc * 2; return st * 1024 + (ob ^ (((ob >> 9) & 1) << 5)); }
__device__ __forceinline__ void stage_rc(int b, int& R, int& C) { const int st = b / 1024, sb = b % 1024, swz = sb ^ (((sb >> 9) & 1) << 5); R = (st >> 1) * 16 + swz / 64; C = (st & 1) * 32 + (swz % 64) / 2; }
__device__ __forceinline__ int perm32(int rho) { const int n = rho >> 4, i = rho & 15; return 8 * (i >> 2) + 4 * n + (i & 3); }

struct Unit { const char* A; const char* B; unsigned lda2, ldb2; int nt; int pm, pn, tag; };

struct TileOrder {
    int nM, nN, nwg, G, c, wgm;
    __device__ __forceinline__ void init(int nM_, int nN_, int G_, int c_, int wgm_ = 8) { nM = nM_; nN = nN_; nwg = nM * nN; G = G_; c = c_; wgm = wgm_; }
    __device__ __forceinline__ bool tile(int i, int& pm, int& pn) const {
        const long L = (long)i * G + c; if (L >= nwg) return false;
        int wgid = (int)L; { const int q = nwg / 8, r = nwg % 8, xcd = wgid % 8, off = wgid / 8; wgid = (xcd < r ? xcd * (q + 1) : r * (q + 1) + (xcd - r) * q) + off; }
        const int nig = wgm * nN, gid = wgid / nig, fm = gid * wgm, gsz = (nM - fm) < wgm ? (nM - fm) : wgm;
        pm = fm + ((wgid % nig) % gsz); pn = (wgid % nig) / gsz; return true;
    }
};

typedef i32x4 AccI[2][2][4][2];
__device__ __forceinline__ void zero_acc(AccI& acc) {
#pragma unroll
    for (int a = 0; a < 2; ++a)
#pragma unroll
        for (int b = 0; b < 2; ++b)
#pragma unroll
            for (int m = 0; m < 4; ++m)
#pragma unroll
                for (int n = 0; n < 2; ++n) acc[a][b][m][n] = (i32x4){0, 0, 0, 0};
}
template <class E> struct is_mixed { static constexpr bool v = false; };
typedef f32x4 Acc[2][2][4][2];
__device__ __forceinline__ void zero_acc(Acc& acc) {
#pragma unroll
    for (int a = 0; a < 2; ++a)
#pragma unroll
        for (int b = 0; b < 2; ++b)
#pragma unroll
            for (int m = 0; m < 4; ++m)
#pragma unroll
                for (int n = 0; n < 2; ++n) acc[a][b][m][n] = (f32x4){0.f, 0.f, 0.f, 0.f};
}

template <bool HALFN, class Sched, class Epi>
__device__ __forceinline__ void gemm_stream(LAS unsigned char* lds, const Sched& S, Epi& E) {
    const int tid = otid(), wid = __builtin_amdgcn_readfirstlane(tid >> 6), lane = tid & 63, wr = wid >> 2, wc = wid & 3, fr = lane & 15, fq = lane >> 4;
    int R0, C0; stage_rc(tid * 16, R0, C0);
    const int Rb0 = Epi::PERM ? ((R0 & ~31) + perm32(R0 & 31)) : R0;
    const unsigned ldsw = (unsigned)wid * 1024u;
    const int aoff = lds_byte(wr * 64 + fr, fq * 8), boff = lds_byte(wc * 32 + fr, fq * 8);
#define GM_SA(b, h) (((b) * 2 + (h)) * HTB)
#define GM_SB(b, h) ((4 + (b) * 2 + (h)) * HTB)
#define GM_STAGE(bufoff, gbase, voff, ld2) do { _Pragma("unroll") for (int _i = 0; _i < 2; ++_i) \
        __builtin_amdgcn_global_load_lds((const unsigned*)((const char*)(gbase) + (size_t)_i * 64 * (ld2) + (voff)), (LAS unsigned*)(lds + (bufoff) + ldsw + _i * 8192), 16, 0, 0); } while (0)
#define GM_LDA(dst, b, h) do { _Pragma("unroll") for (int m = 0; m < 4; ++m) _Pragma("unroll") for (int k = 0; k < 2; ++k) dst[m][k] = *(const LAS bf16x8*)(lds + GM_SA(b, h) + aoff + m * 2048 + k * 1024); } while (0)
#define GM_LDB(dst, b, h) do { _Pragma("unroll") for (int n = 0; n < 2; ++n) _Pragma("unroll") for (int k = 0; k < 2; ++k) dst[n][k] = *(const LAS bf16x8*)(lds + GM_SB(b, h) + boff + n * 2048 + k * 1024); } while (0)
#define GM_MMA_I8(ai, bj, At, Bt) do { _Pragma("unroll") for (int m = 0; m < 4; ++m) _Pragma("unroll") for (int n = 0; n < 2; ++n) _Pragma("unroll") for (int k = 0; k < 2; ++k) \
        acc[ai][bj][m][n] = __builtin_bit_cast(typename Epi::AccT_elem, __builtin_amdgcn_mfma_i32_16x16x64_i8(__builtin_bit_cast(i32x4, Bt[n][k]), __builtin_bit_cast(i32x4, At[m][k]), __builtin_bit_cast(i32x4, acc[ai][bj][m][n]), 0, 0, 0)); } while (0)
#define GM_MMA_BF(ai, bj, At, Bt) do { _Pragma("unroll") for (int m = 0; m < 4; ++m) _Pragma("unroll") for (int n = 0; n < 2; ++n) _Pragma("unroll") for (int k = 0; k < 2; ++k) \
        acc[ai][bj][m][n] = __builtin_bit_cast(typename Epi::AccT_elem, __builtin_amdgcn_mfma_f32_16x16x32_bf16(Bt[n][k], At[m][k], __builtin_bit_cast(f32x4, acc[ai][bj][m][n]), 0, 0, 0)); } while (0)
#define GM_MMA(ai, bj, At, Bt) do { __builtin_amdgcn_s_setprio(1); \
        if constexpr (is_mixed<Epi>::v) { if (cur_i8) GM_MMA_I8(ai, bj, At, Bt); else GM_MMA_BF(ai, bj, At, Bt); } \
        else if constexpr (Epi::I8) GM_MMA_I8(ai, bj, At, Bt); else GM_MMA_BF(ai, bj, At, Bt); \
        __builtin_amdgcn_s_setprio(0); } while (0)
#define GM_WAIT_V(n) asm volatile("s_waitcnt vmcnt(" #n ")" ::: "memory")
#define GM_WAIT_L(n) asm volatile("s_waitcnt lgkmcnt(" #n ")" ::: "memory")
#define GM_BAR __builtin_amdgcn_s_barrier()
#define GM_SCHED __builtin_amdgcn_sched_barrier(0)
    Unit cur, nxt; int ui = 0;
    if (!S.next(0, cur)) return;
    typename Epi::AccT acc;
    bf16x8 At[4][2], B0[2][2], B1[2][2];
    unsigned voffA = (unsigned)R0 * cur.lda2 + (unsigned)C0 * 2u, voffB = (unsigned)Rb0 * cur.ldb2 + (unsigned)C0 * 2u;
    const char* cA = cur.A; const char* cB = cur.B;
    {
        const size_t hA = (size_t)HALF * cur.lda2, hB = (size_t)HALF * cur.ldb2;
        GM_STAGE(GM_SB(0, 0), cB, voffB, cur.ldb2); GM_STAGE(GM_SA(0, 0), cA, voffA, cur.lda2);
        if constexpr (!HALFN) GM_STAGE(GM_SB(0, 1), cB + hB, voffB, cur.ldb2);
        GM_STAGE(GM_SA(0, 1), cA + hA, voffA, cur.lda2);
        if (wr == 1) GM_BAR;
        if constexpr (HALFN) GM_WAIT_V(2); else GM_WAIT_V(4);
        GM_BAR;
        GM_STAGE(GM_SB(1, 0), cB + 128, voffB, cur.ldb2); GM_STAGE(GM_SA(1, 0), cA + 128, voffA, cur.lda2);
        if constexpr (!HALFN) GM_STAGE(GM_SB(1, 1), cB + hB + 128, voffB, cur.ldb2);
        if constexpr (HALFN) GM_WAIT_V(4); else GM_WAIT_V(6);
        GM_BAR;
    }
#define GM_UNIT(BJ) { \
        if constexpr (HALFN) { _Pragma("unroll") for (int _a = 0; _a < 2; ++_a) _Pragma("unroll") for (int _m = 0; _m < 4; ++_m) _Pragma("unroll") for (int _n = 0; _n < 2; ++_n) acc[_a][0][_m][_n] = (f32x4){0.f, 0.f, 0.f, 0.f}; } \
        else zero_acc(acc); \
        const bool cur_i8 = (cur.tag & 1) == 0; (void)cur_i8; \
        const bool has_next = S.next(ui + 1, nxt); \
        const char* nA = has_next ? nxt.A : cA; const char* nB = has_next ? nxt.B : cB; \
        const unsigned nlda2 = has_next ? nxt.lda2 : cur.lda2, nldb2 = has_next ? nxt.ldb2 : cur.ldb2; \
        const unsigned nvoffA = (unsigned)R0 * nlda2 + (unsigned)C0 * 2u, nvoffB = (unsigned)Rb0 * nldb2 + (unsigned)C0 * 2u; \
        const size_t hA = (size_t)HALF * cur.lda2, hB = (size_t)HALF * cur.ldb2, nhA = (size_t)HALF * nlda2, nhB = (size_t)HALF * nldb2; \
        const int nt = cur.nt; \
        for (int t = 0; t < nt; t += 2) { \
            const bool last = (t == nt - 2); \
            const char* a1 = cA + (size_t)(t + 1) * 128; \
            const char* a2 = last ? nA : cA + (size_t)(t + 2) * 128; const char* b2 = last ? nB : cB + (size_t)(t + 2) * 128; \
            const char* a3 = a2 + 128; const char* b3 = b2 + 128; \
            const unsigned vA2 = last ? nvoffA : voffA, vB2 = last ? nvoffB : voffB; \
            const unsigned lA2 = last ? nlda2 : cur.lda2, lB2 = last ? nldb2 : cur.ldb2; \
            const size_t hA2 = last ? nhA : hA, hB2 = last ? nhB : hB; \
              \
            GM_LDB(B0, 0, 0); GM_SCHED; GM_LDA(At, 0, 0); GM_STAGE(GM_SA(1, 1), a1 + hA, voffA, cur.lda2); \
            GM_WAIT_L(8); GM_BAR; GM_WAIT_L(0); GM_MMA(0, 0, At, B0); GM_BAR; GM_SCHED; \
              \
            if constexpr (!HALFN) GM_LDB(B1, 0, 1); \
            GM_STAGE(GM_SB(0, 0), b2, vB2, lB2); \
            GM_BAR; GM_WAIT_L(0); if constexpr (!HALFN) GM_MMA(0, 1, At, B1); GM_BAR; \
              \
            GM_LDA(At, 0, 1); GM_STAGE(GM_SA(0, 0), a2, vA2, lA2); \
            GM_BAR; GM_WAIT_L(0); GM_MMA(1, 0, At, B0); GM_BAR; GM_SCHED; \
              \
            if constexpr (!HALFN) { GM_STAGE(GM_SB(0, 1), b2 + hB2, vB2, lB2); GM_WAIT_V(6); } else { GM_WAIT_V(4); } \
            GM_BAR; if constexpr (!HALFN) GM_MMA(1, 1, At, B1); GM_BAR; \
              \
            GM_LDB(B0, 1, 0); GM_SCHED; GM_LDA(At, 1, 0); GM_STAGE(GM_SA(0, 1), a2 + hA2, vA2, lA2); \
            GM_WAIT_L(8); GM_BAR; GM_WAIT_L(0); GM_MMA(0, 0, At, B0); GM_BAR; GM_SCHED; \
              \
            if constexpr (!HALFN) GM_LDB(B1, 1, 1); \
            GM_STAGE(GM_SB(1, 0), b3, vB2, lB2); \
            GM_BAR; GM_WAIT_L(0); if constexpr (!HALFN) GM_MMA(0, 1, At, B1); GM_BAR; \
              \
            GM_LDA(At, 1, 1); GM_STAGE(GM_SA(1, 0), a3, vA2, lA2); \
            GM_BAR; GM_WAIT_L(0); GM_MMA(1, 0, At, B0); GM_BAR; GM_SCHED; \
              \
            if constexpr (!HALFN) { GM_STAGE(GM_SB(1, 1), b3 + hB2, vB2, lB2); GM_WAIT_V(6); } else { GM_WAIT_V(4); } \
            GM_BAR; if constexpr (!HALFN) GM_MMA(1, 1, At, B1); GM_BAR; \
        } \
        { const int tz_ = otid(); const int wz_ = __builtin_amdgcn_readfirstlane(tz_ >> 6), lz_ = tz_ & 63; E.template post<BJ>(acc, cur, wz_ >> 2, wz_ & 3, lz_ & 15, lz_ >> 4); } \
        if (!has_next) break; \
        cur = nxt; cA = nA; cB = nB; voffA = nvoffA; voffB = nvoffB; ++ui; \
    }
    for (;;) {
        GM_UNIT(0)
    }
    GM_WAIT_V(0);
    if (wr == 0) GM_BAR;
    GM_BAR;
#undef GM_UNIT
#undef GM_SA
#undef GM_SB
#undef GM_STAGE
#undef GM_LDA
#undef GM_LDB
#undef GM_MMA
#undef GM_MMA_I8
#undef GM_MMA_BF
#undef GM_WAIT_V
#undef GM_WAIT_L
#undef GM_BAR
#undef GM_SCHED
}
}

struct SchedPlain {
    gm::TileOrder T; const char* A; const char* B; unsigned lda2, ldb2; int nt;
    __device__ __forceinline__ bool next(int i, gm::Unit& u) const {
        int pm, pn; if (!T.tile(i, pm, pn)) return false;
        u.A = A + (size_t)pm * 256 * lda2; u.B = B + (size_t)pn * 256 * ldb2; u.lda2 = lda2; u.ldb2 = ldb2; u.nt = nt; u.pm = pm; u.pn = pn; u.tag = 0; return true;
    }
};
struct SchedSplitK {
    gm::TileOrder T; const char* A; const char* B; unsigned lda2, ldb2; int nt, xe, ns;
    __device__ __forceinline__ bool next(int i, gm::Unit& u) const {
        int pm, pn; u.lda2 = lda2; u.ldb2 = ldb2;
        if (T.tile(i, pm, pn)) { u.A = A + (size_t)pm * 256 * lda2; u.B = B + (size_t)pn * 256 * ldb2; u.nt = nt; u.pm = pm; u.pn = pn; u.tag = 0; return true; }
        if (xe < 0 || i != 4) return false;
        const int e = xe / ns, sl = xe % ns, ks = nt / ns; pm = 128 + (e & 1); pn = e >> 1;
        u.A = A + (size_t)pm * 256 * lda2 + (size_t)sl * ks * 128; u.B = B + (size_t)pn * 256 * ldb2 + (size_t)sl * ks * 128; u.nt = ks; u.pm = pm; u.pn = pn; u.tag = 1 + sl; return true;
    }
};
struct SchedMergeG {
    gm::TileOrder T; const char* h8; const char* wg; int n, xe;
    __device__ __forceinline__ bool next(int i, gm::Unit& u) const {
        int pm, pn; if (!T.tile(i, pm, pn)) { if (xe < 0 || i != 4) return false; pm = 128 + (xe & 1); pn = xe >> 1; }
        u.A = h8 + (size_t)pm * 256 * 2048; u.lda2 = 2048; u.nt = 16; u.B = wg + ((size_t)n * 2048 + (size_t)pn * 256) * 2048; u.ldb2 = 2048; u.pm = pm; u.pn = pn; u.tag = n; return true;
    }
};
struct SchedMergeY {
    gm::TileOrder T; const char* ybr; const char* wbr; int n, xe;
    __device__ __forceinline__ bool next(int i, gm::Unit& u) const {
        int pm, pn; if (!T.tile(i, pm, pn)) { if (xe < 0 || i != 4) return false; pm = 128 + (xe & 1); pn = xe >> 1; }
        u.A = ybr + (size_t)n * MALL * 1024 + (size_t)pm * 256 * 1024; u.lda2 = 1024; u.nt = 8; u.B = wbr + ((size_t)n * 2048 + (size_t)pn * 256) * 1024; u.ldb2 = 1024; u.pm = pm; u.pn = pn; u.tag = n; return true;
    }
};

struct EpiGateUp {
    static constexpr bool PERM = true, I8 = false; typedef gm::Acc AccT; typedef f32x4 AccT_elem; bf16_t* act;
    template <int BJ> __device__ __forceinline__ void post(gm::Acc& acc, const gm::Unit& u, int wr, int wc, int fr, int fq) {
        const int row0 = u.pm * 256 + wr * 64 + fr, col0 = u.pn * 128 + wc * 32 + 8 * fq;
#pragma unroll
        for (int ai = 0; ai < 2; ++ai)
#pragma unroll
            for (int m = 0; m < 4; ++m) {
                float v[8];
#pragma unroll
                for (int n = 0; n < 2; ++n)
#pragma unroll
                    for (int j = 0; j < 4; ++j) v[n * 4 + j] = siluf_(acc[ai][0][m][n][j]) * acc[ai][1][m][n][j];
                u32x4 w; w.x = cvt_pk_bf16(v[0], v[1]); w.y = cvt_pk_bf16(v[2], v[3]); w.z = cvt_pk_bf16(v[4], v[5]); w.w = cvt_pk_bf16(v[6], v[7]);
                *(u32x4*)(act + (size_t)(row0 + ai * 128 + m * 16) * DFF + col0) = w;
            }
    }
};
struct EpiGateUpI8 {
    static constexpr bool PERM = true, I8 = true; typedef gm::AccI AccT; typedef i32x4 AccT_elem; bf16_t* act; const float* hsc; const float* wsc;
    template <int BJ> __device__ __forceinline__ void post(gm::AccI& acc, const gm::Unit& u, int wr, int wc, int fr, int fq) {
        const int row0 = u.pm * 256 + wr * 64 + fr, col0 = u.pn * 128 + wc * 32 + 8 * fq, wrow = u.pn * 256 + wc * 32 + 8 * fq;
        float sg[8], su[8];
#pragma unroll
        for (int j = 0; j < 8; ++j) { sg[j] = wsc[wrow + j]; su[j] = wsc[wrow + 128 + j]; }
        float hsv[8];
#pragma unroll
        for (int i = 0; i < 8; ++i) hsv[i] = hsc[row0 + (i >> 2) * 128 + (i & 3) * 16];
#pragma unroll
        for (int ai = 0; ai < 2; ++ai)
#pragma unroll
            for (int m = 0; m < 4; ++m) {
                const int row = row0 + ai * 128 + m * 16; const float hs = hsv[ai * 4 + m];
                float v[8];
#pragma unroll
                for (int n = 0; n < 2; ++n)
#pragma unroll
                    for (int j = 0; j < 4; ++j) { const float g = (float)acc[ai][0][m][n][j] * (hs * sg[n * 4 + j]), up = (float)acc[ai][1][m][n][j] * (hs * su[n * 4 + j]); v[n * 4 + j] = siluf_(g) * up; }
                u32x4 w; w.x = cvt_pk_bf16(v[0], v[1]); w.y = cvt_pk_bf16(v[2], v[3]); w.z = cvt_pk_bf16(v[4], v[5]); w.w = cvt_pk_bf16(v[6], v[7]);
                *(u32x4*)(act + (size_t)row * DFF + col0) = w;
            }
    }
};
struct EpiStore {
    static constexpr bool PERM = true, I8 = false; typedef gm::Acc AccT; typedef f32x4 AccT_elem; bf16_t* O; int ldc;
    template <int BJ> __device__ __forceinline__ void post(gm::Acc& acc, const gm::Unit& u, int wr, int wc, int fr, int fq) {
        const int row0 = u.pm * 256 + wr * 64 + fr, col0 = u.pn * 256 + wc * 32 + 8 * fq;
#pragma unroll
        for (int ai = 0; ai < 2; ++ai)
#pragma unroll
            for (int m = 0; m < 4; ++m)
#pragma unroll
                for (int bj = 0; bj < 2; ++bj) {
                    const f32x4 a = acc[ai][bj][m][0], b = acc[ai][bj][m][1];
                    u32x4 w; w.x = cvt_pk_bf16(a[0], a[1]); w.y = cvt_pk_bf16(a[2], a[3]); w.z = cvt_pk_bf16(b[0], b[1]); w.w = cvt_pk_bf16(b[2], b[3]);
                    *(u32x4*)(O + (size_t)(row0 + ai * 128 + m * 16) * ldc + col0 + bj * 128) = w;
                }
    }
};
struct EpiStoreK {
    static constexpr bool PERM = true, I8 = false; typedef gm::Acc AccT; typedef f32x4 AccT_elem; bf16_t* O; float* yp;
    template <int BJ> __device__ __forceinline__ void post(gm::Acc& acc, const gm::Unit& u, int wr, int wc, int fr, int fq) {
        const int row0 = u.pm * 256 + wr * 64 + fr, col0 = u.pn * 256 + wc * 32 + 8 * fq;
        if (u.tag == 0) {
#pragma unroll
            for (int ai = 0; ai < 2; ++ai)
#pragma unroll
                for (int m = 0; m < 4; ++m)
#pragma unroll
                    for (int bj = 0; bj < 2; ++bj) {
                        const f32x4 a = acc[ai][bj][m][0], b = acc[ai][bj][m][1];
                        u32x4 w; w.x = cvt_pk_bf16(a[0], a[1]); w.y = cvt_pk_bf16(a[2], a[3]); w.z = cvt_pk_bf16(b[0], b[1]); w.w = cvt_pk_bf16(b[2], b[3]);
                        *(u32x4*)(O + (size_t)(row0 + ai * 128 + m * 16) * DM + col0 + bj * 128) = w;
                    }
        } else {
            float* base = yp + (size_t)(u.tag - 1) * MCTX * DM;
#pragma unroll
            for (int ai = 0; ai < 2; ++ai)
#pragma unroll
                for (int m = 0; m < 4; ++m)
#pragma unroll
                    for (int bj = 0; bj < 2; ++bj) { float* o = base + (size_t)(row0 - MLAT + ai * 128 + m * 16) * DM + col0 + bj * 128;
                        *(f32x4*)o = acc[ai][bj][m][0]; *(f32x4*)(o + 4) = acc[ai][bj][m][1]; }
        }
    }
};
__device__ __forceinline__ void job_splitk_reduce(const float* yp, bf16_t* y, int ns) {
    const int c = obid(), tid = otid(), G = gridDim.x;
    for (int idx = c * 512 + tid; idx < MCTX * 256; idx += G * 512) { const int row = idx >> 8, q = idx & 255; f32x4 a = {0.f, 0.f, 0.f, 0.f}, b = a;
#pragma unroll 1
        for (int sl = 0; sl < ns; ++sl) { const float* s = yp + ((size_t)sl * MCTX + row) * DM + q * 8; a += *(const f32x4*)s; b += *(const f32x4*)(s + 4); }
        u32x4 o; o.x = cvt_pk_bf16(a[0], a[1]); o.y = cvt_pk_bf16(a[2], a[3]); o.z = cvt_pk_bf16(b[0], b[1]); o.w = cvt_pk_bf16(b[2], b[3]);
        *(u32x4*)(y + (size_t)(MLAT + row) * DM + q * 8) = o; }
}
__device__ __forceinline__ void rope4(f32x4& x0, f32x4& x1, const float* rope, int pos, int fq) {
    const f32x4 t0 = *(const f32x4*)(rope + pos * 32 + 8 * fq), t1 = *(const f32x4*)(rope + pos * 32 + 8 * fq + 4);
    const float c[4] = {t0[0], t0[2], t1[0], t1[2]}, s[4] = {t0[1], t0[3], t1[1], t1[3]};
#pragma unroll
    for (int j = 0; j < 4; ++j) { const float a = x0[j], b = x1[j]; x0[j] = a * c[j] - b * s[j]; x1[j] = a * s[j] + b * c[j]; }
}
__device__ __forceinline__ void rope4v(f32x4& x0, f32x4& x1, const f32x4 t0, const f32x4 t1) {
    const float c[4] = {t0[0], t0[2], t1[0], t1[2]}, s[4] = {t0[1], t0[3], t1[1], t1[3]};
#pragma unroll
    for (int j = 0; j < 4; ++j) { const float a = x0[j], b = x1[j]; x0[j] = a * c[j] - b * s[j]; x1[j] = a * s[j] + b * c[j]; }
}
struct EpiProj {
    static constexpr bool PERM = false, I8 = true; typedef gm::AccI AccT; typedef i32x4 AccT_elem; bf16_t* ubuf; bf16_t* km; const float* rope; const float* hsc; const float* wps;
    template <int BJ> __device__ __forceinline__ void post(gm::AccI& acc, const gm::Unit& u, int wr, int wc, int fr, int fq) {
        const int pn = u.pn; const bool lat = u.pm < 128, ropet = (pn >= 6 && pn <= 9), akr = (pn == 23);
        const int row0 = u.pm * 256 + wr * 64 + fr;
        f32x4 wsv[2][2];
#pragma unroll
        for (int bj = 0; bj < 2; ++bj)
#pragma unroll
            for (int n = 0; n < 2; ++n) wsv[bj][n] = *(const f32x4*)(wps + pn * 256 + bj * 128 + wc * 32 + 16 * n + 4 * fq);
        float hsv[8];
#pragma unroll
        for (int i = 0; i < 8; ++i) hsv[i] = hsc[row0 + (i >> 2) * 128 + (i & 3) * 16];
        const bool dor = lat && (ropet || (akr && wc < 2));
#pragma unroll
        for (int ai = 0; ai < 2; ++ai) {
            f32x4 rt[4][2];
            if (dor) {
#pragma unroll
                for (int m = 0; m < 4; ++m) { const int s = (row0 + ai * 128 + m * 16) & (SEQ - 1), pos = (wc & 1) ? (s & 63) : (s >> 6);
                    rt[m][0] = *(const f32x4*)(rope + pos * 32 + 8 * fq); rt[m][1] = *(const f32x4*)(rope + pos * 32 + 8 * fq + 4); }
            }
#pragma unroll
            for (int m = 0; m < 4; ++m) {
                const int row = row0 + ai * 128 + m * 16; const float hs = hsv[ai * 4 + m] * ((pn == 6 || pn == 7) ? DIFF_QC : 1.0f);
#pragma unroll
                for (int bj = 0; bj < 2; ++bj) {
                    f32x4 x0, x1;
#pragma unroll
                    for (int j = 0; j < 4; ++j) { x0[j] = (float)acc[ai][bj][m][0][j] * (hs * wsv[bj][0][j]); x1[j] = (float)acc[ai][bj][m][1][j] * (hs * wsv[bj][1][j]); }
                    const bool akr_blk = akr && bj == 0 && wc < 2;
                    if (lat && (ropet || akr_blk)) rope4v(x0, x1, rt[m][0], rt[m][1]);
                    u32x2 w0, w1; w0.x = cvt_pk_bf16(x0[0], x0[1]); w0.y = cvt_pk_bf16(x0[2], x0[3]); w1.x = cvt_pk_bf16(x1[0], x1[1]); w1.y = cvt_pk_bf16(x1[2], x1[3]);
                    if (!akr) { bf16_t* o = ubuf + (size_t)row * NU + pn * 256 + bj * 128 + wc * 32 + 4 * fq; *(u32x2*)o = w0; *(u32x2*)(o + 16) = w1; }
                    else if (akr_blk) {
#pragma unroll
                        for (int h = 0; h < 4; ++h) { bf16_t* o = km + (size_t)row * 768 + h * 192 + 128 + wc * 32 + 4 * fq; *(u32x2*)o = w0; *(u32x2*)(o + 16) = w1; }
                    }
                }
            }
        }
    }
};
struct EpiQup {
    static constexpr bool PERM = false, I8 = false; typedef gm::Acc AccT; typedef f32x4 AccT_elem; bf16_t* qm; const float* rsq; const float* rope;
    template <int BJ> __device__ __forceinline__ void post(gm::Acc& acc, const gm::Unit& u, int wr, int wc, int fr, int fq) {
        const bool lat = u.pm < 128; const int row0 = u.pm * 256 + wr * 64 + fr;
        float rsv[8];
#pragma unroll
        for (int i = 0; i < 8; ++i) rsv[i] = rsq[row0 + (i >> 2) * 128 + (i & 3) * 16];
#pragma unroll
        for (int ai = 0; ai < 2; ++ai)
#pragma unroll
            for (int m = 0; m < 4; ++m) {
                const int row = row0 + ai * 128 + m * 16, s = row & (SEQ - 1); const float rs = rsv[ai * 4 + m] * MLA_QC;
#pragma unroll
                for (int bj = 0; bj < 2; ++bj) {
                    const int b32 = 8 * u.pn + 4 * bj + wc, m6 = b32 % 6;
                    f32x4 x0 = acc[ai][bj][m][0] * rs, x1 = acc[ai][bj][m][1] * rs;
                    if (lat && m6 >= 4) rope4(x0, x1, rope, (m6 == 5) ? (s & 63) : (s >> 6), fq);
                    u32x2 w0, w1; w0.x = cvt_pk_bf16(x0[0], x0[1]); w0.y = cvt_pk_bf16(x0[2], x0[3]); w1.x = cvt_pk_bf16(x1[0], x1[1]); w1.y = cvt_pk_bf16(x1[2], x1[3]);
                    bf16_t* o = qm + (size_t)row * 768 + b32 * 32 + 4 * fq; *(u32x2*)o = w0; *(u32x2*)(o + 16) = w1;
                }
            }
    }
};
struct EpiKVup {
    static constexpr bool PERM = true, I8 = false; typedef gm::Acc AccT; typedef f32x4 AccT_elem; bf16_t* km; bf16_t* vm; const float* rsk;
    template <int BJ> __device__ __forceinline__ void post(gm::Acc& acc, const gm::Unit& u, int wr, int wc, int fr, int fq) {
        const int row0 = u.pm * 256 + wr * 64 + fr, h = u.pn, c0 = wc * 32 + 8 * fq;
        float rsv[8];
#pragma unroll
        for (int i = 0; i < 8; ++i) rsv[i] = rsk[row0 + (i >> 2) * 128 + (i & 3) * 16];
#pragma unroll
        for (int ai = 0; ai < 2; ++ai)
#pragma unroll
            for (int m = 0; m < 4; ++m) {
                const int row = row0 + ai * 128 + m * 16; const float rs = rsv[ai * 4 + m];
#pragma unroll
                for (int bj = 0; bj < 2; ++bj) {
                    const f32x4 a = acc[ai][bj][m][0] * rs, b = acc[ai][bj][m][1] * rs;
                    u32x4 w; w.x = cvt_pk_bf16(a[0], a[1]); w.y = cvt_pk_bf16(a[2], a[3]); w.z = cvt_pk_bf16(b[0], b[1]); w.w = cvt_pk_bf16(b[2], b[3]);
                    if (bj == 0) *(u32x4*)(km + (size_t)row * 768 + h * 192 + c0) = w; else *(u32x4*)(vm + (size_t)row * 512 + h * 128 + c0) = w;
                }
            }
    }
};
struct EpiRG {
    static constexpr bool PERM = true, I8 = false; typedef gm::Acc AccT; typedef f32x4 AccT_elem; const bf16_t* xcv; bf16_t* la; bf16_t* bb; const float* b_r; const float* b_i; const float* sp;
    template <int BJ> __device__ __forceinline__ void post(gm::Acc& acc, const gm::Unit& u, int wr, int wc, int fr, int fq) {
        const int d = u.pn >> 2, w0 = (u.pn & 3) * 128 + wc * 32 + 8 * fq, row0 = u.pm * 256 + wr * 64 + fr;
        float br[8], bi[8], sv[8];
#pragma unroll
        for (int j = 0; j < 8; ++j) { br[j] = b_r[d * 512 + w0 + j]; bi[j] = b_i[d * 512 + w0 + j]; sv[j] = sp[d * 512 + w0 + j]; }
        u32x4 xwv[8];
#pragma unroll
        for (int i = 0; i < 8; ++i) xwv[i] = *(const u32x4*)(xcv + (size_t)(row0 + (i >> 2) * 128 + (i & 3) * 16) * 512 + w0);
#pragma unroll
        for (int ai = 0; ai < 2; ++ai)
#pragma unroll
            for (int m = 0; m < 4; ++m) {
                const int row = row0 + ai * 128 + m * 16;
                const u32x4 xw = xwv[ai * 4 + m];
                const float xv[8] = {bflo(xw.x), bfhi(xw.x), bflo(xw.y), bfhi(xw.y), bflo(xw.z), bfhi(xw.z), bflo(xw.w), bfhi(xw.w)};
                float lo[8], bo[8];
#pragma unroll
                for (int n = 0; n < 2; ++n)
#pragma unroll
                    for (int j = 0; j < 4; ++j) {
                        const int k = n * 4 + j;
                        const float r = sigmoidf_(acc[ai][0][m][n][j] + br[k]), ig = sigmoidf_(acc[ai][1][m][n][j] + bi[k]);
                        const float l_a = -8.0f * r * sv[k], x2 = 2.0f * l_a;
                        const float om = (x2 > -0.3f) ? (-x2 * (1.0f + x2 * (0.5f + x2 * (0.16666667f + x2 * (0.041666668f + x2 * 0.0083333338f))))) : (1.0f - __expf(x2));
                        lo[k] = l_a; bo[k] = __builtin_amdgcn_sqrtf(om) * ig * xv[k];
                    }
                u32x4 wl, wb;
                wl.x = cvt_pk_bf16(lo[0], lo[1]); wl.y = cvt_pk_bf16(lo[2], lo[3]); wl.z = cvt_pk_bf16(lo[4], lo[5]); wl.w = cvt_pk_bf16(lo[6], lo[7]);
                wb.x = cvt_pk_bf16(bo[0], bo[1]); wb.y = cvt_pk_bf16(bo[2], bo[3]); wb.z = cvt_pk_bf16(bo[4], bo[5]); wb.w = cvt_pk_bf16(bo[6], bo[7]);
                *(u32x4*)(la + (size_t)row * 1024 + d * 512 + w0) = wl; *(u32x4*)(bb + (size_t)row * 1024 + d * 512 + w0) = wb;
            }
    }
};
struct EpiMergeG {
    static constexpr bool PERM = true, I8 = true; typedef gm::AccI AccT; typedef i32x4 AccT_elem; bf16_t* gtmp; const float* mb; const float* hsc; const float* wgs; bool bal; bf16_t* gx;
    template <int BJ> __device__ __forceinline__ void post(gm::AccI& acc, const gm::Unit& u, int wr, int wc, int fr, int fq) {
        const int col0 = u.pn * 256 + wc * 32 + 8 * fq, row0 = u.pm * 256 + wr * 64 + fr, nbr = u.tag;
        const bool ex = bal && u.pm >= 128; bf16_t* go = ex ? gx : gtmp; const int orow0 = ex ? nbr * 512 + row0 - MLAT : row0;
        f32x4 bv[2][2], sv[2][2];
#pragma unroll
        for (int bj = 0; bj < 2; ++bj)
#pragma unroll
            for (int n = 0; n < 2; ++n) { bv[bj][n] = *(const f32x4*)(mb + nbr * DM + col0 + bj * 128 + 4 * n); sv[bj][n] = *(const f32x4*)(wgs + nbr * DM + col0 + bj * 128 + 4 * n); }
        float hsv[8];
#pragma unroll
        for (int i = 0; i < 8; ++i) hsv[i] = hsc[row0 + (i >> 2) * 128 + (i & 3) * 16];
#pragma unroll
        for (int ai = 0; ai < 2; ++ai)
#pragma unroll
            for (int m = 0; m < 4; ++m) { const float hs = hsv[ai * 4 + m];
#pragma unroll
                for (int bj = 0; bj < 2; ++bj) { float g[8];
#pragma unroll
                    for (int n = 0; n < 2; ++n)
#pragma unroll
                        for (int j = 0; j < 4; ++j) g[n * 4 + j] = sigmoidf_((float)acc[ai][bj][m][n][j] * (hs * sv[bj][n][j]) + bv[bj][n][j]);
                    u32x4 w; w.x = cvt_pk_bf16(g[0], g[1]); w.y = cvt_pk_bf16(g[2], g[3]); w.z = cvt_pk_bf16(g[4], g[5]); w.w = cvt_pk_bf16(g[6], g[7]);
                    *(u32x4*)(go + (size_t)(orow0 + ai * 128 + m * 16) * DM + col0 + bj * 128) = w; } }
    }
};
struct EpiMergeY {
    static constexpr bool PERM = true, I8 = false; typedef gm::Acc AccT; typedef f32x4 AccT_elem; bf16_t* mrg; const bf16_t* gtmp; bool bal; const bf16_t* gx; bf16_t* part;
    template <int BJ> __device__ __forceinline__ void post(gm::Acc& acc, const gm::Unit& u, int wr, int wc, int fr, int fq) {
        const int col0 = u.pn * 256 + wc * 32 + 8 * fq, row0 = u.pm * 256 + wr * 64 + fr, nbr = u.tag;
        const bool ex = bal && u.pm >= 128; const bf16_t* gi = ex ? gx : gtmp; bf16_t* mo = ex ? part : mrg; const int orow0 = ex ? nbr * 512 + row0 - MLAT : row0;
        const bool rd = nbr > 0 && !ex;
#pragma unroll
        for (int ai = 0; ai < 2; ++ai) {
            u32x4 gwv[4][2], mwv[4][2];
#pragma unroll
            for (int m = 0; m < 4; ++m)
#pragma unroll
                for (int bj = 0; bj < 2; ++bj) { const size_t off = (size_t)(orow0 + ai * 128 + m * 16) * DM + col0 + bj * 128;
                    gwv[m][bj] = *(const u32x4*)(gi + off); mwv[m][bj] = (u32x4){0u, 0u, 0u, 0u}; if (rd) mwv[m][bj] = *(const u32x4*)(mo + off); }
#pragma unroll
            for (int m = 0; m < 4; ++m)
#pragma unroll
                for (int bj = 0; bj < 2; ++bj) {
                    const size_t off = (size_t)(orow0 + ai * 128 + m * 16) * DM + col0 + bj * 128;
                    const u32x4 gw = gwv[m][bj], mw = mwv[m][bj];
                    const float g[8] = {bflo(gw.x), bfhi(gw.x), bflo(gw.y), bfhi(gw.y), bflo(gw.z), bfhi(gw.z), bflo(gw.w), bfhi(gw.w)};
                    float mm[8] = {bflo(mw.x), bfhi(mw.x), bflo(mw.y), bfhi(mw.y), bflo(mw.z), bfhi(mw.z), bflo(mw.w), bfhi(mw.w)};
#pragma unroll
                    for (int n = 0; n < 2; ++n)
#pragma unroll
                        for (int j = 0; j < 4; ++j) mm[n * 4 + j] += g[n * 4 + j] * acc[ai][bj][m][n][j];
                    u32x4 w; w.x = cvt_pk_bf16(mm[0], mm[1]); w.y = cvt_pk_bf16(mm[2], mm[3]); w.z = cvt_pk_bf16(mm[4], mm[5]); w.w = cvt_pk_bf16(mm[6], mm[7]);
                    *(u32x4*)(mo + off) = w;
                }
        }
    }
};


struct KP { const float* in[30]; float* out; unsigned char* ws; int ph_lo, ph_hi; };
typedef const __attribute__((address_space(4))) KP CKP;
__device__ __forceinline__ LAS unsigned char* lds_here(unsigned char* raw) { unsigned a = (unsigned)(uintptr_t)(LAS unsigned char*)raw; asm volatile("" : "+s"(a)); return (LAS unsigned char*)(uintptr_t)a; }
__device__ __forceinline__ CKP& kp_here() { CKP* q = (CKP*)__builtin_amdgcn_kernarg_segment_ptr(); asm volatile("" : "+s"(q)); return *q; }
enum { I_X = 0, I_C, I_CTX, I_CCTX, I_ADAW, I_ADAB, I_PRE, I_POST, I_WG, I_WU, I_WDN, I_WIN, I_QNORM, I_WUQ, I_KVNORM, I_WUKV, I_CONVW, I_CONVB, I_RGWR, I_RGBR, I_RGWI, I_RGBI, I_RGLAM,
       I_DLAM, I_SUBLN, I_HLB, I_HNORM, I_MB, I_WBR, I_WOUT };

__device__ __forceinline__ void job_mod(CKP& p, LAS unsigned char* lds) {
    LAS float* sl = (LAS float*)lds;
    LAS float* red = (LAS float*)(lds + 24576);
    const int tid = otid(), lane = tid & 63, wave = tid >> 6;
    for (int i = tid; i < 3 * DM; i += NTHR) { const int g = i / DM, k = i % DM; const float c = g < 2 ? p.in[I_C][g * DM + k] : p.in[I_CCTX][k]; sl[i] = siluf_(c); }
    __syncthreads();
    float* mod = (float*)(p.ws + WS_MOD);
    for (int u = obid(); u < NL * 288; u += gridDim.x) {
        const int l = u / 288, col = (u % 288) * 64 + lane;
        const float* w = p.in[I_ADAW] + (size_t)l * DM * (NMOD * DM) + col;
        float a0 = 0.f, a1 = 0.f, a2 = 0.f;
        const int k0 = wave * 256;
#pragma unroll 1
        for (int k1 = k0; k1 < k0 + 256; k1 += 32) { float wv[32];
#pragma unroll
            for (int q = 0; q < 32; ++q) wv[q] = w[(size_t)(k1 + q) * (NMOD * DM)];
            asm volatile("" ::: "memory");
#pragma unroll
            for (int q = 0; q < 32; ++q) { const int k = k1 + q; a0 += sl[k] * wv[q]; a1 += sl[DM + k] * wv[q]; a2 += sl[2 * DM + k] * wv[q]; } }
        red[(wave * 3 + 0) * 64 + lane] = a0; red[(wave * 3 + 1) * 64 + lane] = a1; red[(wave * 3 + 2) * 64 + lane] = a2;
        __syncthreads();
        if (tid < 192) { const int g = tid >> 6; float s = 0.f;
#pragma unroll
            for (int w8 = 0; w8 < 8; ++w8) s += red[(w8 * 3 + g) * 64 + lane];
            mod[(size_t)(l * 3 + g) * (NMOD * DM) + col] = s + p.in[I_ADAB][l * (NMOD * DM) + col]; }
        __syncthreads();
    }
}
__device__ __forceinline__ void job_tables(CKP& p) {
    const int tid = otid();
    if (obid() == 0) {
        float* rope = (float*)(p.ws + WS_ROPE);
        for (int i = tid; i < 4096; i += NTHR) { const int pos = i >> 4, f = i & 15; const float inv = powf(10000.0f, -(float)f / 16.0f); const float ang = (float)pos * inv; float s, c; sincosf(ang, &s, &c); rope[2 * i] = c; rope[2 * i + 1] = s; }
    }
    if (obid() == 1 % gridDim.x) {
        float* sc = (float*)(p.ws + WS_SCAL);
        if (tid < NL) { const float* lv = p.in[I_DLAM] + tid * 256; float s01 = 0.f, s23 = 0.f; for (int i = 0; i < 64; ++i) { s01 += lv[i] * lv[64 + i]; s23 += lv[128 + i] * lv[192 + i]; }
            sc[tid] = expf(s01) - expf(s23) + (0.8f - 0.6f * expf(-0.3f * (float)tid)); }
        for (int k = tid; k < 512; k += NTHR) {
            float mx = -1e30f; for (int l = 0; l < NL; ++l) mx = fmaxf(mx, p.in[I_HLB][l * 512 + k]);
            float den = 0.f; for (int l = 0; l < NL; ++l) den += expf(p.in[I_HLB][l * 512 + k] - mx);
            float cum = 0.f; for (int l = 0; l < NL; ++l) { if (l > 0) cum += expf(p.in[I_HLB][l * 512 + k] - mx) / den; sc[256 + l * 512 + k] = cum; }
        }
        for (int i = tid; i < NL * 1024; i += NTHR) { const float x = -p.in[I_RGLAM][i]; sc[2048 + i] = fmaxf(x, 0.f) + log1pf(expf(-fabsf(x))); }
    }
}

__device__ __forceinline__ void job_colmax(CKP& p) {
    unsigned* cmax = (unsigned*)(p.ws + WS_CMAX);
    const int tid = otid(), c4 = (tid & 63) * 4, wv = tid >> 6;
    for (int u = obid(); u < NL * 2 * 2 * 22 * 4; u += gridDim.x) {
        const int kc = u & 3, cb = (u >> 2) % 22, mat = u / (4 * 22), which = mat & 1, lf = mat >> 1;
        const float* w = (which ? p.in[I_WU] : p.in[I_WG]) + (size_t)lf * DM * DFF + (size_t)(kc * 512 + wv * 64) * DFF + cb * 256 + c4;
        u32x4 mx = {0u, 0u, 0u, 0u};
#pragma unroll 1
        for (int k0 = 0; k0 < 64; k0 += 16) { u32x4 v[16];
#pragma unroll
            for (int k = 0; k < 16; ++k) v[k] = *(const u32x4*)(w + (size_t)(k0 + k) * DFF);
            asm volatile("" ::: "memory");
#pragma unroll
            for (int k = 0; k < 16; ++k) { mx.x = max(mx.x, v[k].x & 0x7fffffffu); mx.y = max(mx.y, v[k].y & 0x7fffffffu); mx.z = max(mx.z, v[k].z & 0x7fffffffu); mx.w = max(mx.w, v[k].w & 0x7fffffffu); } }
        unsigned* dst = cmax + (size_t)(lf * 2 + which) * DFF + cb * 256 + c4;
        atomicMax(dst, mx.x); atomicMax(dst + 1, mx.y); atomicMax(dst + 2, mx.z); atomicMax(dst + 3, mx.w);
    }
    unsigned* cmax2 = (unsigned*)(p.ws + WS_CMAX2);
    for (int u = obid(); u < NL * 56 * 4; u += gridDim.x) {
        const int kc = u & 3, cb = (u >> 2) % 56, l = u / (4 * 56), cc = cb * 256 + c4;
        if (cc < DIN) {
            const float* w = p.in[I_WIN] + (size_t)l * DM * DIN + (size_t)(kc * 512 + wv * 64) * DIN + cc;
            u32x4 mx = {0u, 0u, 0u, 0u};
#pragma unroll 1
            for (int k0 = 0; k0 < 64; k0 += 16) { u32x4 v[16];
#pragma unroll
                for (int k = 0; k < 16; ++k) v[k] = *(const u32x4*)(w + (size_t)(k0 + k) * DIN);
                asm volatile("" ::: "memory");
#pragma unroll
                for (int k = 0; k < 16; ++k) { mx.x = max(mx.x, v[k].x & 0x7fffffffu); mx.y = max(mx.y, v[k].y & 0x7fffffffu); mx.z = max(mx.z, v[k].z & 0x7fffffffu); mx.w = max(mx.w, v[k].w & 0x7fffffffu); } }
            unsigned* dst = cmax2 + (size_t)l * 14336 + cc;
            atomicMax(dst, mx.x); atomicMax(dst + 1, mx.y); atomicMax(dst + 2, mx.z); atomicMax(dst + 3, mx.w);
        }
    }
}
struct CvtDesc { const float* src; const float* ks; bf16_t* dst; int ldsrc, c0, k0, lddst, n0; const unsigned* q8max; float* q8scale; };
__device__ __forceinline__ void cvt_load(const CvtDesc& d, int tid, f32x4 (&v)[2]) {
    const int r = tid >> 4, c4 = (tid & 15) * 4;
#pragma unroll
    for (int ps = 0; ps < 2; ++ps) { const int k = r + 32 * ps; v[ps] = (f32x4){0.f, 0.f, 0.f, 0.f};
        if (d.src) { v[ps] = *(const f32x4*)(d.src + (size_t)(d.k0 + k) * d.ldsrc + d.c0 + c4); if (d.ks) v[ps] = v[ps] * d.ks[d.k0 + k]; } }
}
__device__ __forceinline__ void cvt_store(LAS float* tile, const CvtDesc& d, int tid, const f32x4 (&v)[2]) {
    { const int r = tid >> 4, c4 = (tid & 15) * 4;
#pragma unroll
      for (int ps = 0; ps < 2; ++ps) { const int k = r + 32 * ps; tile[k * 65 + c4 + 0] = v[ps][0]; tile[k * 65 + c4 + 1] = v[ps][1]; tile[k * 65 + c4 + 2] = v[ps][2]; tile[k * 65 + c4 + 3] = v[ps][3]; } }
    __syncthreads();
    { const int n = tid >> 3, k8 = (tid & 7) * 8; float x[8];
#pragma unroll
      for (int i = 0; i < 8; ++i) x[i] = tile[(k8 + i) * 65 + n];
      if (d.q8max) {
          const float mx = fmaxf(__uint_as_float(d.q8max[n]), 1e-30f), inv = 127.0f / mx;
          int q[8];
#pragma unroll
          for (int i = 0; i < 8; ++i) q[i] = (int)rintf(x[i] * inv) & 0xff;
          u32x2 w; w.x = (unsigned)q[0] | ((unsigned)q[1] << 8) | ((unsigned)q[2] << 16) | ((unsigned)q[3] << 24); w.y = (unsigned)q[4] | ((unsigned)q[5] << 8) | ((unsigned)q[6] << 16) | ((unsigned)q[7] << 24);
          *(u32x2*)((signed char*)d.dst + (size_t)(d.n0 + n) * d.lddst + d.k0 + k8) = w;
          if (d.k0 == 0 && k8 == 0) d.q8scale[n] = mx * (1.0f / 127.0f);
      } else {
          u32x4 w; w.x = cvt_pk_bf16(x[0], x[1]); w.y = cvt_pk_bf16(x[2], x[3]); w.z = cvt_pk_bf16(x[4], x[5]); w.w = cvt_pk_bf16(x[6], x[7]);
          *(u32x4*)(d.dst + (size_t)(d.n0 + n) * d.lddst + d.k0 + k8) = w; } }
    __syncthreads();
}
constexpr int CV_N0 = 2 * 176 * 32, CV_N1 = 2 * 32 * 88, CV_N2 = 224 * 32, CV_N3 = 12 * 8, CV_N4 = 16 * 4, CV_N5 = 4 * 32 * 8, CV_N6 = 32 * 32, CV_N7 = 1024;
constexpr int CV_BLOCKS = CV_N0 + CV_N1 + CV_N2 + CV_N3 + CV_N4 + CV_N5 + CV_N6;
__device__ __forceinline__ CvtDesc cvt_desc(CKP& p, int l, int b) {
    unsigned char* ws = p.ws; CvtDesc d; d.ks = nullptr; d.q8max = nullptr; d.q8scale = nullptr;
    if (b < CV_N0) { const int f = b / (176 * 32), rem = b % (176 * 32), nb = rem / 32, kb = rem % 32, t = nb >> 2, q = nb & 3;
        d.src = (q < 2 ? p.in[I_WG] : p.in[I_WU]) + (size_t)(l * 2 + f) * DM * DFF; d.ldsrc = DFF; d.c0 = 128 * t + (q & 1) * 64; d.k0 = kb * 64; d.dst = (bf16_t*)(ws + WS_WGU + (size_t)f * 11264 * 2048); d.lddst = 2048; d.n0 = nb * 64;
        d.q8max = (const unsigned*)(ws + WS_CMAX) + (size_t)((l * 2 + f) * 2 + (q < 2 ? 0 : 1)) * DFF + d.c0; d.q8scale = (float*)(ws + WS_WSC) + (size_t)f * 11264 + d.n0; return d; }
    b -= CV_N0;
    if (b < CV_N1) { const int f = b / (32 * 88), rem = b % (32 * 88), nb = rem / 88, kb = rem % 88;
        d.src = p.in[I_WDN] + (size_t)(l * 2 + f) * DFF * DM; d.ldsrc = DM; d.c0 = nb * 64; d.k0 = kb * 64; d.dst = (bf16_t*)(ws + WS_WD) + (size_t)f * 2048 * 5632; d.lddst = 5632; d.n0 = nb * 64; return d; }
    b -= CV_N1;
    if (b < CV_N2) { const int nb = b / 32, kb = b % 32, j0 = nb * 64; int sc;
        if (j0 < 512) sc = j0; else if (j0 < 5632) sc = 832 + (j0 - 512); else if (j0 < 5888) sc = 512 + (j0 - 5632); else if (j0 < 5952) sc = 768 + (j0 - 5888); else if (j0 < 6144) sc = -1; else sc = 5952 + (j0 - 6144);
        d.src = sc < 0 ? nullptr : p.in[I_WIN] + (size_t)l * DM * DIN; d.ldsrc = DIN; d.c0 = sc < 0 ? 0 : sc; d.k0 = kb * 64; d.dst = (bf16_t*)(ws + WS_WIN); d.lddst = 2048; d.n0 = j0;
        d.q8max = (const unsigned*)(ws + WS_CMAX2) + (size_t)l * 14336 + (sc < 0 ? DIN : sc);
        d.q8scale = j0 < 6144 ? (float*)(ws + WS_WPS) + j0 : (float*)(ws + WS_WGS) + (j0 - 6144);
        return d; }
    b -= CV_N2;
    if (b < CV_N3) { const int nb = b / 8, kb = b % 8;
        d.src = p.in[I_WUQ] + (size_t)l * 512 * 768; d.ldsrc = 768; d.c0 = nb * 64; d.k0 = kb * 64; d.ks = p.in[I_QNORM] + l * 512; d.dst = (bf16_t*)(ws + WS_WUQ); d.lddst = 512; d.n0 = nb * 64; return d; }
    b -= CV_N3;
    if (b < CV_N4) { const int nb = b / 4, kb = b % 4;
        d.src = p.in[I_WUKV] + (size_t)l * 256 * 1024; d.ldsrc = 1024; d.c0 = nb * 64; d.k0 = kb * 64; d.ks = p.in[I_KVNORM] + l * 256; d.dst = (bf16_t*)(ws + WS_WUKV); d.lddst = 256; d.n0 = nb * 64; return d; }
    b -= CV_N4;
    if (b < CV_N5) { const int n = b / 256, rem = b % 256, nb = rem / 8, kb = rem % 8;
        d.src = p.in[I_WBR] + (size_t)(l * 4 + n) * 512 * DM; d.ldsrc = DM; d.c0 = nb * 64; d.k0 = kb * 64; d.dst = (bf16_t*)(ws + WS_WBR) + (size_t)n * 2048 * 512; d.lddst = 512; d.n0 = nb * 64; return d; }
    b -= CV_N5;
    { const int nb = b / 32, kb = b % 32;
        d.src = p.in[I_WOUT] + (size_t)l * DM * DM; d.ldsrc = DM; d.c0 = nb * 64; d.k0 = kb * 64; d.dst = (bf16_t*)(ws + WS_WOUT); d.lddst = 2048; d.n0 = nb * 64; return d; }
}
__device__ __forceinline__ void job_convert(CKP& p, LAS unsigned char* lds, int l) {
    LAS float* tile = (LAS float*)lds;
    const int tid = otid();
    {
        int u = obid();
        if (u < CV_BLOCKS) {
            f32x4 vc[2]; { const CvtDesc d0 = cvt_desc(p, l, u); cvt_load(d0, tid, vc); }
            for (;;) {
                const int un = u + gridDim.x; const bool more = un < CV_BLOCKS;
                f32x4 vn[2] = {vc[0], vc[1]};
                if (more) { const CvtDesc dn = cvt_desc(p, l, un); cvt_load(dn, tid, vn); }
                { const CvtDesc dc = cvt_desc(p, l, u); cvt_store(tile, dc, tid, vc); }
                if (!more) break;
                vc[0] = vn[0]; vc[1] = vn[1]; u = un;
            }
        }
    }
    for (int b = obid(); b < CV_N7; b += gridDim.x) {
        bf16_t* dst = (bf16_t*)(p.ws + WS_WRG);
#pragma unroll
        for (int e = 0; e < 2; ++e) { const int idx = b * 1024 + e * 512 + tid, o = idx >> 9, k = idx & 511;
            const int t8 = o >> 8, d = t8 >> 2, blk = t8 & 3, g = (o >> 7) & 1, i = o & 127, kin = k - blk * 128;
            float v = 0.f; if (kin >= 0 && kin < 128) v = (g ? p.in[I_RGWI] : p.in[I_RGWR])[((size_t)((l * 2 + d) * 4 + blk) * 128 + kin) * 128 + i];
            dst[idx] = f2bf(v); }
    }
}

struct RNArgs {
    const float* xs_lat; const float* xs_ctx; float* xd_lat; float* xd_ctx;
    const bf16_t* y; float wres;
    const float* modl_res; int jres; const float* postg;
    bool do_norm; const float* modl_norm; int jn; const float* preg; bf16_t* h; int nrows; signed char* h8; float* hsc;
};
__device__ __forceinline__ void job_resnorm(const RNArgs& a, LAS unsigned char* lds) {
    const int tid_ = otid(); const int lane = tid_ & 63, gw = obid() * 8 + (tid_ >> 6), nw = gridDim.x * 8;
    LAS float* PA = (LAS float*)lds; LAS float* PB = PA + 3 * DM; LAS float* PC = PB + 3 * DM;
    for (int i = tid_; i < 3 * DM; i += NTHR) { const int g = i / DM, c = i % DM;
        if (a.y) PA[i] = a.modl_res[(size_t)g * (NMOD * DM) + (3 * a.jres + 2) * DM + c] * a.postg[c];
        if (a.do_norm) { const float* sh = a.modl_norm + (size_t)g * (NMOD * DM) + (3 * a.jn) * DM; PB[i] = a.preg[c] * (sh[DM + c] + 1.0f); PC[i] = sh[c]; } }
    __syncthreads();
    f32x4 xq[8]; u32x2 yq[8];
#define RN_LOAD(R, X, Y) do { const int r_ = (R); const float* xs_ = r_ < MLAT ? a.xs_lat + (size_t)r_ * DM : a.xs_ctx + (size_t)(r_ - MLAT) * DM; \
        _Pragma("unroll") for (int i = 0; i < 8; ++i) X[i] = *(const f32x4*)(xs_ + i * 256 + lane * 4); \
        if (a.y) { _Pragma("unroll") for (int i = 0; i < 8; ++i) Y[i] = *(const u32x2*)(a.y + (size_t)r_ * DM + i * 256 + lane * 4); } } while (0)
    if (gw < a.nrows) RN_LOAD(gw, xq, yq);
    for (int r = gw; r < a.nrows; r += nw) {
        const int g = r < SEQ ? 0 : (r < MLAT ? 1 : 2); const bool lat = r < MLAT;
        f32x4 x[8]; u32x2 yr[8];
#pragma unroll
        for (int i = 0; i < 8; ++i) { x[i] = xq[i]; yr[i] = yq[i]; }
        RN_LOAD(r + nw < a.nrows ? r + nw : r, xq, yq);
        if (a.y) {
            f32x4 yv[8]; float ss = 0.f;
#pragma unroll
            for (int i = 0; i < 8; ++i) { const u32x2 w = yr[i]; yv[i] = (f32x4){bflo(w.x), bfhi(w.x), bflo(w.y), bfhi(w.y)}; ss += yv[i][0] * yv[i][0] + yv[i][1] * yv[i][1] + yv[i][2] * yv[i][2] + yv[i][3] * yv[i][3]; }
            ss = wave_sum(ss, lane);
            const float rr = a.wres * rsqrtf(ss * (1.0f / DM) + EPS);
            float* xd = lat ? a.xd_lat + (size_t)r * DM : a.xd_ctx + (size_t)(r - MLAT) * DM;
#pragma unroll
            for (int i = 0; i < 8; ++i) { const int c = i * 256 + lane * 4; const f32x4 gp = *(const LAS f32x4*)(PA + g * DM + c);
                x[i] = x[i] + gp * (yv[i] * rr); *(f32x4*)(xd + c) = x[i]; }
        }
        if (a.do_norm) {
            float ss = 0.f;
#pragma unroll
            for (int i = 0; i < 8; ++i) ss += x[i][0] * x[i][0] + x[i][1] * x[i][1] + x[i][2] * x[i][2] + x[i][3] * x[i][3];
            ss = wave_sum(ss, lane);
            const float rr = rsqrtf(ss * (1.0f / DM) + EPS);
            float mx = 0.f;
#pragma unroll
            for (int i = 0; i < 8; ++i) { const int c = i * 256 + lane * 4; const f32x4 ps = *(const LAS f32x4*)(PB + g * DM + c), hv = *(const LAS f32x4*)(PC + g * DM + c);
                x[i] = (x[i] * rr) * ps + hv; mx = fmaxf(mx, fmaxf(fmaxf(fabsf(x[i][0]), fabsf(x[i][1])), fmaxf(fabsf(x[i][2]), fabsf(x[i][3]))));
                if (a.h) { u32x2 w; w.x = cvt_pk_bf16(x[i][0], x[i][1]); w.y = cvt_pk_bf16(x[i][2], x[i][3]); *(u32x2*)(a.h + (size_t)r * DM + c) = w; } }
            if (a.h8) {
#pragma unroll
                for (int o = 32; o >= 1; o >>= 1) mx = fmaxf(mx, shx(mx, o, lane));
                mx = fmaxf(mx, 1e-30f); const float inv = 127.0f / mx;
                if (lane == 0) a.hsc[r] = mx * (1.0f / 127.0f);
#pragma unroll
                for (int i = 0; i < 8; ++i) { const unsigned q0 = (unsigned)((int)rintf(x[i][0] * inv) & 0xff), q1 = (unsigned)((int)rintf(x[i][1] * inv) & 0xff), q2 = (unsigned)((int)rintf(x[i][2] * inv) & 0xff), q3 = (unsigned)((int)rintf(x[i][3] * inv) & 0xff);
                    *(unsigned*)(a.h8 + (size_t)r * DM + i * 256 + lane * 4) = q0 | (q1 << 8) | (q2 << 16) | (q3 << 24); }
            }
        }
    }
    __syncthreads();
#undef RN_LOAD
}

__device__ __forceinline__ void job_stats_conv(CKP& p, int l) {
    const bf16_t* ubuf = (const bf16_t*)(p.ws + WS_R1); float* rsq = (float*)(p.ws + WS_RSQ); float* rsk = rsq + MALL; bf16_t* xcv = (bf16_t*)(p.ws + WS_XCV);
    const int tid_ = otid(); const int lane = tid_ & 63, gw = obid() * 8 + (tid_ >> 6), nw = gridDim.x * 8;
    float cw[4][8], cb[8];
#pragma unroll
    for (int j = 0; j < 4; ++j)
#pragma unroll
        for (int i = 0; i < 8; ++i) cw[j][i] = p.in[I_CONVW][(l * 4 + j) * 512 + lane * 8 + i];
#pragma unroll
    for (int i = 0; i < 8; ++i) cb[i] = p.in[I_CONVB][l * 512 + lane * 8 + i];
    for (int r = gw; r < MALL; r += nw) {
        const bf16_t* ur = ubuf + (size_t)r * NU;
        const bool lat = r < MLAT; const int s = lat ? (r & (SEQ - 1)) : ((r - MLAT) & (CTXL - 1)), len = lat ? SEQ : CTXL;
        const u32x4 w = *(const u32x4*)(ur + U_AQ + lane * 8); const u32x4 w2 = *(const u32x4*)(ur + U_AKV + (lane & 31) * 8);
        u32x4 wt[4]; float okf[4];
#pragma unroll
        for (int j = 0; j < 4; ++j) { const int sj = s + j - 2; const bool ok = sj >= 0 && sj < len; okf[j] = ok ? 1.0f : 0.0f;
            wt[j] = *(const u32x4*)(ur + (ptrdiff_t)(ok ? j - 2 : 0) * NU + U_BX + lane * 8); }
        asm volatile("" ::: "memory");
        {
            float ss = 0.f;
            { const float v[8] = {bflo(w.x), bfhi(w.x), bflo(w.y), bfhi(w.y), bflo(w.z), bfhi(w.z), bflo(w.w), bfhi(w.w)};
#pragma unroll
              for (int i = 0; i < 8; ++i) ss += v[i] * v[i]; }
            ss = wave_sum(ss, lane);
            float s2 = 0.f;
            { const float v[8] = {bflo(w2.x), bfhi(w2.x), bflo(w2.y), bfhi(w2.y), bflo(w2.z), bfhi(w2.z), bflo(w2.w), bfhi(w2.w)};
#pragma unroll
              for (int i = 0; i < 8; ++i) s2 += v[i] * v[i]; }
            s2 = lane < 32 ? s2 : 0.f;
            s2 = wave_sum(s2, lane);
            if (lane == 0) { rsq[r] = rsqrtf(ss * (1.0f / 512.0f) + EPS); rsk[r] = rsqrtf(s2 * (1.0f / 256.0f) + EPS); }
        }
        {
            float acc[8];
#pragma unroll
            for (int i = 0; i < 8; ++i) acc[i] = cb[i];
#pragma unroll
            for (int j = 0; j < 4; ++j) { const u32x4 wj = wt[j];
                const float v[8] = {bflo(wj.x), bfhi(wj.x), bflo(wj.y), bfhi(wj.y), bflo(wj.z), bfhi(wj.z), bflo(wj.w), bfhi(wj.w)};
#pragma unroll
                for (int i = 0; i < 8; ++i) acc[i] += (cw[j][i] * okf[j]) * v[i]; }
            u32x4 o; o.x = cvt_pk_bf16(acc[0], acc[1]); o.y = cvt_pk_bf16(acc[2], acc[3]); o.z = cvt_pk_bf16(acc[4], acc[5]); o.w = cvt_pk_bf16(acc[6], acc[7]);
            *(u32x4*)(xcv + (size_t)r * 512 + lane * 8) = o;
        }
    }
}

__device__ __forceinline__ void job_rg_scan1(CKP& p) {
    const bf16_t* la = (const bf16_t*)(p.ws + WS_LA); const bf16_t* bb = (const bf16_t*)(p.ws + WS_BB); f32x2* rgs = (f32x2*)(p.ws + WS_RGS);
    const int w = otid();
    for (int u = obid(); u < NRT * 2; u += gridDim.x) {
        const int pm = u >> 1, d = u & 1;
        const bf16_t* lp = la + (size_t)pm * 256 * 1024 + d * 512 + w; const bf16_t* bp = bb + (size_t)pm * 256 * 1024 + d * 512 + w;
        float H = 0.f, sl = 0.f;
#pragma unroll 1
        for (int i0 = 0; i0 < 256; i0 += 32) { bf16_t lr[32], br[32];
#pragma unroll
            for (int q = 0; q < 32; ++q) { const int t = d ? 255 - (i0 + q) : i0 + q; lr[q] = lp[(size_t)t * 1024]; br[q] = bp[(size_t)t * 1024]; }
            asm volatile("" ::: "memory");
#pragma unroll
            for (int q = 0; q < 32; ++q) { const float lv = bf2f(lr[q]); H = __expf(lv) * H + bf2f(br[q]); sl += lv; } }
        rgs[(size_t)u * 512 + w] = (f32x2){__expf(sl), H};
    }
}
__device__ __forceinline__ void job_rg_out(CKP& p, int ntiles) {
    const bf16_t* la = (const bf16_t*)(p.ws + WS_LA); const bf16_t* bb = (const bf16_t*)(p.ws + WS_BB); const f32x2* rgs = (const f32x2*)(p.ws + WS_RGS);
    bf16_t* hf = (bf16_t*)(p.ws + WS_XCV); const bf16_t* ubuf = (const bf16_t*)(p.ws + WS_R1); bf16_t* yb = (bf16_t*)(p.ws + WS_YBR) + (size_t)1 * MALL * 512;
    const int w = otid();
    for (int u = obid(); u < ntiles; u += gridDim.x) {
        const int pm = (int)gridDim.x > ntiles ? u : u;
        const bool isctx = pm >= 128; const int b = isctx ? pm - 128 : (pm >> 6);
        float h = 0.f;
        if (!isctx) { h = rgs[(size_t)((128 + b) * 2 + 0) * 512 + w][1];
#pragma unroll 1
            for (int q0 = b * 64; q0 < pm; q0 += 16) { f32x2 sv[16];
#pragma unroll
                for (int k = 0; k < 16; ++k) { const int q = q0 + k < pm ? q0 + k : pm - 1; sv[k] = rgs[(size_t)(q * 2 + 0) * 512 + w]; }
                asm volatile("" ::: "memory");
#pragma unroll
                for (int k = 0; k < 16; ++k) if (q0 + k < pm) h = sv[k][0] * h + sv[k][1]; } }
        const size_t r0 = (size_t)pm * 256;
#pragma unroll 1
        for (int t0 = 0; t0 < 256; t0 += 64) { bf16_t lr[64], br[64];
#pragma unroll
            for (int k = 0; k < 64; ++k) { lr[k] = la[(r0 + t0 + k) * 1024 + w]; br[k] = bb[(r0 + t0 + k) * 1024 + w]; }
            asm volatile("" ::: "memory");
#pragma unroll
            for (int k = 0; k < 64; ++k) { h = __expf(bf2f(lr[k])) * h + bf2f(br[k]); hf[(r0 + t0 + k) * 512 + w] = f2bf(h); } }
        float hb = 0.f;
        if (!isctx) { hb = rgs[(size_t)((128 + b) * 2 + 1) * 512 + w][1];
#pragma unroll 1
            for (int q0 = b * 64 + 63; q0 > pm; q0 -= 16) { f32x2 sv[16];
#pragma unroll
                for (int k = 0; k < 16; ++k) { const int q = q0 - k > pm ? q0 - k : pm + 1; sv[k] = rgs[(size_t)(q * 2 + 1) * 512 + w]; }
                asm volatile("" ::: "memory");
#pragma unroll
                for (int k = 0; k < 16; ++k) if (q0 - k > pm) hb = sv[k][0] * hb + sv[k][1]; } }
#pragma unroll 1
        for (int i0 = 0; i0 < 256; i0 += 32) { bf16_t lr[32], br[32], gr[32], fr[32];
#pragma unroll
            for (int k = 0; k < 32; ++k) { const size_t t = r0 + 255 - i0 - k; lr[k] = la[t * 1024 + 512 + w]; br[k] = bb[t * 1024 + 512 + w]; gr[k] = ubuf[t * NU + U_BG + w]; fr[k] = hf[t * 512 + w]; }
#pragma unroll
            for (int k = 0; k < 32; ++k) { const size_t t = r0 + 255 - i0 - k; hb = __expf(bf2f(lr[k])) * hb + bf2f(br[k]); yb[t * 512 + w] = f2bf((bf2f(fr[k]) + hb) * gelu_tanh(bf2f(gr[k]))); } }
    }
}

namespace at {
constexpr float THR2 = 8.f * 1.4426950408889634f;
__device__ __forceinline__ int crow(int r, int hi) { return (r & 3) + 8 * (r >> 2) + 4 * hi; }
__device__ __forceinline__ unsigned cvtpk(float lo, float hi) { return cvt_pk_bf16(lo, hi); }
__device__ __forceinline__ int v_rd_base(int lane) { return ((lane & 3) << 3) | (((lane >> 2) & 3) << 6) | (((lane >> 4) & 1) << 5) | (((lane >> 5) & 1) << 8); }
constexpr int v_rd_off(int d0, int ks, int half) { return d0 * 512 + ks * 4096 + half * 2048; }
template <int OFF> __device__ __forceinline__ s16x4 tr_read(unsigned vb) { s16x4 r; asm volatile("ds_read_b64_tr_b16 %0, %1 offset:%2" : "=&v"(r) : "v"(vb), "i"(OFF) : "memory"); return r; }
template <int D0> __device__ __forceinline__ void pv_one(f32x16& od, unsigned vb, bf16x8 pa0, bf16x8 pa1, bf16x8 pa2, bf16x8 pa3) {
    const s16x4 l0 = tr_read<v_rd_off(D0, 0, 0)>(vb), h0 = tr_read<v_rd_off(D0, 0, 1)>(vb), l1 = tr_read<v_rd_off(D0, 1, 0)>(vb), h1 = tr_read<v_rd_off(D0, 1, 1)>(vb);
    const s16x4 l2 = tr_read<v_rd_off(D0, 2, 0)>(vb), h2 = tr_read<v_rd_off(D0, 2, 1)>(vb), l3 = tr_read<v_rd_off(D0, 3, 0)>(vb), h3 = tr_read<v_rd_off(D0, 3, 1)>(vb);
    asm volatile("s_waitcnt lgkmcnt(0)" ::: "memory"); __builtin_amdgcn_sched_barrier(0);
#define AT_PK(L, H) (bf16x8){L[0], L[1], L[2], L[3], H[0], H[1], H[2], H[3]}
    od = __builtin_amdgcn_mfma_f32_32x32x16_bf16(pa0, AT_PK(l0, h0), od, 0, 0, 0);
    od = __builtin_amdgcn_mfma_f32_32x32x16_bf16(pa1, AT_PK(l1, h1), od, 0, 0, 0);
    od = __builtin_amdgcn_mfma_f32_32x32x16_bf16(pa2, AT_PK(l2, h2), od, 0, 0, 0);
    od = __builtin_amdgcn_mfma_f32_32x32x16_bf16(pa3, AT_PK(l3, h3), od, 0, 0, 0);
#undef AT_PK
}
struct VFrag { s16x4 l[4], h[4]; };
template <int D0> __device__ __forceinline__ void rd_v(VFrag& f, const LAS unsigned char* vbp) {
#pragma unroll
    for (int ks = 0; ks < 4; ++ks) {
        f.l[ks] = __builtin_amdgcn_ds_read_tr16_b64_v4i16((LAS s16x4*)(vbp + v_rd_off(D0, ks, 0)));
        f.h[ks] = __builtin_amdgcn_ds_read_tr16_b64_v4i16((LAS s16x4*)(vbp + v_rd_off(D0, ks, 1))); }
}
__device__ __forceinline__ void mm_pv(f32x16& od, const VFrag& f, bf16x8 pa0, bf16x8 pa1, bf16x8 pa2, bf16x8 pa3) {
#define AT_PK(L, H) (bf16x8){L[0], L[1], L[2], L[3], H[0], H[1], H[2], H[3]}
    od = __builtin_amdgcn_mfma_f32_32x32x16_bf16(pa0, AT_PK(f.l[0], f.h[0]), od, 0, 0, 0);
    od = __builtin_amdgcn_mfma_f32_32x32x16_bf16(pa1, AT_PK(f.l[1], f.h[1]), od, 0, 0, 0);
    od = __builtin_amdgcn_mfma_f32_32x32x16_bf16(pa2, AT_PK(f.l[2], f.h[2]), od, 0, 0, 0);
    od = __builtin_amdgcn_mfma_f32_32x32x16_bf16(pa3, AT_PK(f.l[3], f.h[3]), od, 0, 0, 0);
#undef AT_PK
}
__device__ __forceinline__ f32x16 mfma_srcc(bf16x8 a, bf16x8 b, const f32x16& c) { f32x16 d; asm("v_mfma_f32_32x32x16_bf16 %0, %1, %2, %3" : "=&v"(d) : "v"(a), "v"(b), "v"(c)); return d; }
struct KeyMap { int ctx_row0, lat_row0, nctx, nt; __device__ __forceinline__ int row(int j) const { return j < nctx ? ctx_row0 + 64 * j : lat_row0 + 64 * (j - nctx); } };

template <int DQK>
__device__ __forceinline__ void attn_body(LAS unsigned char* lds, const bf16_t* Qg, int ldq, int q0, const bf16_t* Kg, int ldk, const bf16_t* Vg, int ldv, const KeyMap km,
                                          f32x16 (&o)[4], float& l_out) {
    constexpr int RB = DQK * 2, CPR = RB / 16, NKI = 64 * RB / 8192, KBYTES = 64 * RB, VOFF = 3 * KBYTES, SCR = VOFF + 4 * 16384, ND0 = DQK / 16;
    static_assert(SCR + 2048 <= LDS_MISC, "attention LDS");
    const int tid = otid(), wid = __builtin_amdgcn_readfirstlane(tid >> 6), lane = tid & 63, r32 = lane & 31, hi = lane >> 5, half = wid >> 2;
    LAS float* wsl = (LAS float*)(lds + SCR) + wid * 64; LAS float* al_l = wsl;
    unsigned koff[NKI], voff[2];
#pragma unroll
    for (int i = 0; i < NKI; ++i) { const int q = i * 512 + wid * 64 + lane, row = q / CPR, cp = q % CPR, ch = cp ^ ((row >> 1) & 7); koff[i] = (unsigned)row * (unsigned)(ldk * 2) + (unsigned)ch * 16u; }
#pragma unroll
    for (int i = 0; i < 2; ++i) { const int q = i * 512 + wid * 64 + lane, sub = q >> 5, wi = q & 31, k = (sub >> 2) * 8 + (wi >> 2), c = (sub & 3) * 32 + (wi & 3) * 8;
        voff[i] = (unsigned)k * (unsigned)(ldv * 2) + (unsigned)c * 2u; }
    const int NT = km.nt;
#define AT_ISSUE(j, sk, sv) do { const int _j = (j) < NT ? (j) : NT - 1; const int _kr = km.row(_j); const char* _kb = (const char*)Kg + (size_t)_kr * ldk * 2; const char* _vb = (const char*)Vg + (size_t)_kr * ldv * 2; \
        _Pragma("unroll") for (int _i = 0; _i < NKI; ++_i) __builtin_amdgcn_global_load_lds((const unsigned*)(_kb + koff[_i]), (LAS unsigned*)(lds + (sk) * KBYTES + _i * 8192 + wid * 1024), 16, 0, 0); \
        _Pragma("unroll") for (int _i = 0; _i < 2; ++_i) __builtin_amdgcn_global_load_lds((const unsigned*)(_vb + voff[_i]), (LAS unsigned*)(lds + VOFF + (sv) * 16384 + _i * 8192 + wid * 1024), 16, 0, 0); } while (0)
    bf16x8 qr[ND0];
    { const bf16_t* Qw = Qg + (size_t)(q0 + wid * 32 + r32) * ldq + hi * 8;
#pragma unroll
      for (int d0 = 0; d0 < ND0; ++d0) qr[d0] = *(const bf16x8*)(Qw + d0 * 16); }
    float m_reg = 0.f, l_reg = 0.f;
    f32x16 cm;
#pragma unroll
    for (int r = 0; r < 16; ++r) cm[r] = 0.f;
#pragma unroll
    for (int d = 0; d < 4; ++d)
#pragma unroll
        for (int r = 0; r < 16; ++r) o[d][r] = 0.f;
    const unsigned ksw = (unsigned)((r32 >> 1) & 7), kb0 = (unsigned)r32 * RB, vrb = (unsigned)v_rd_base(lane);
    bf16x8 pa0, pa1, pa2, pa3;
#define AT_PV(sv) do { const unsigned vb = (unsigned)(uintptr_t)(lds + VOFF + (sv) * 16384) + vrb; \
        pv_one<0>(o[0], vb, pa0, pa1, pa2, pa3); pv_one<1>(o[1], vb, pa0, pa1, pa2, pa3); pv_one<2>(o[2], vb, pa0, pa1, pa2, pa3); pv_one<3>(o[3], vb, pa0, pa1, pa2, pa3); } while (0)
    AT_ISSUE(0, 0, 0); AT_ISSUE(1, 1, 1);
    if constexpr (NKI == 3) asm volatile("s_waitcnt vmcnt(5)" ::: "memory"); else asm volatile("s_waitcnt vmcnt(3)" ::: "memory");
    if (half) { __builtin_amdgcn_s_barrier(); }
    int sk = 0, sv = 0;
    for (int j = 0; j < NT; ++j) {
        __builtin_amdgcn_s_barrier(); asm volatile("" ::: "memory");
        __builtin_amdgcn_s_setprio(1);
#define AT_SB __builtin_amdgcn_sched_barrier(0)
#define AT_RK(d0, KF) do { const unsigned cb = (((unsigned)(2 * (d0) + hi)) ^ ksw) << 4; KF[0] = *(const LAS bf16x8*)(Ks + cb); KF[1] = *(const LAS bf16x8*)(Ks + 32 * RB + cb); } while (0)
        const LAS unsigned char* Ks = lds + sk * KBYTES + kb0;
        bf16x8 kf[2][2];
        if (j > 0) {
            const LAS unsigned char* vbp = lds + VOFF + ((sv + 3) & 3) * 16384 + vrb;
            VFrag fa, fb;
            rd_v<0>(fa, vbp); rd_v<1>(fb, vbp); AT_SB;
            mm_pv(o[0], fa, pa0, pa1, pa2, pa3); AT_SB;
            rd_v<2>(fa, vbp); AT_SB;
            mm_pv(o[1], fb, pa0, pa1, pa2, pa3); AT_SB;
            rd_v<3>(fb, vbp); AT_SB;
            mm_pv(o[2], fa, pa0, pa1, pa2, pa3); AT_SB;
            AT_RK(0, kf[0]); AT_SB;
            mm_pv(o[3], fb, pa0, pa1, pa2, pa3); AT_SB;
        } else { AT_RK(0, kf[0]); AT_SB; }
        f32x16 p0, p1;
        AT_RK(1, kf[1]); AT_SB;
        p0 = mfma_srcc(kf[0][0], qr[0], cm); p1 = mfma_srcc(kf[0][1], qr[0], cm); AT_SB;
#pragma unroll
        for (int d0 = 1; d0 < ND0; ++d0) {
            if (d0 + 1 < ND0) { AT_RK(d0 + 1, kf[(d0 + 1) & 1]); AT_SB; }
            p0 = __builtin_amdgcn_mfma_f32_32x32x16_bf16(kf[d0 & 1][0], qr[d0], p0, 0, 0, 0);
            p1 = __builtin_amdgcn_mfma_f32_32x32x16_bf16(kf[d0 & 1][1], qr[d0], p1, 0, 0, 0); AT_SB;
        }
#undef AT_RK
#undef AT_SB
        asm volatile("s_waitcnt vmcnt(0)" ::: "memory");
        __builtin_amdgcn_s_setprio(0);
        __builtin_amdgcn_s_barrier(); asm volatile("" ::: "memory");
        { const int sk2 = sk == 0 ? 2 : sk - 1; AT_ISSUE(j + 2, sk2, (sv + 2) & 3); }
        float pmax = p0[0];
#pragma unroll
        for (int r = 1; r < 16; ++r) pmax = fmaxf(pmax, p0[r]);
#pragma unroll
        for (int r = 0; r < 16; ++r) pmax = fmaxf(pmax, p1[r]);
        { auto rr = __builtin_amdgcn_permlane32_swap(__float_as_uint(pmax), __float_as_uint(pmax), false, false); pmax = fmaxf(__uint_as_float(rr[0]), __uint_as_float(rr[1])); }
        float alpha = 1.f;
        if (__builtin_expect(j == 0 || !__all(pmax <= THR2), 0)) {
            const float delta = j == 0 ? pmax : fmaxf(pmax, 0.f);
            if (j != 0) alpha = __builtin_amdgcn_exp2f(-delta);
            m_reg += delta;
#pragma unroll
            for (int r = 0; r < 16; ++r) { p0[r] -= delta; p1[r] -= delta; cm[r] = -m_reg; }
        }
#pragma unroll
        for (int r = 0; r < 16; ++r) { p0[r] = __builtin_amdgcn_exp2f(p0[r]); p1[r] = __builtin_amdgcn_exp2f(p1[r]); }
        float ps = 0.f;
#pragma unroll
        for (int r = 0; r < 16; ++r) ps += p0[r] + p1[r];
        l_reg = l_reg * alpha + ps;
#define AT_PK4(P, BASE, OUT) do { u32x4 w = {cvtpk(P[BASE + 0], P[BASE + 1]), cvtpk(P[BASE + 2], P[BASE + 3]), cvtpk(P[BASE + 4], P[BASE + 5]), cvtpk(P[BASE + 6], P[BASE + 7])}; OUT = *reinterpret_cast<bf16x8*>(&w); } while (0)
        AT_PK4(p0, 0, pa0); AT_PK4(p0, 8, pa1); AT_PK4(p1, 0, pa2); AT_PK4(p1, 8, pa3);
#undef AT_PK4
        if (__any(alpha < 1.f)) {
            if (hi == 0) al_l[r32] = alpha;
            asm volatile("s_waitcnt lgkmcnt(0)" ::: "memory");
            float av[16];
#pragma unroll
            for (int r = 0; r < 16; ++r) av[r] = al_l[crow(r, hi)];
#pragma unroll
            for (int d = 0; d < 4; ++d)
#pragma unroll
                for (int r = 0; r < 16; ++r) o[d][r] *= av[r];
        }
        sk = sk == 2 ? 0 : sk + 1; sv = (sv + 1) & 3;
    }
    __builtin_amdgcn_s_barrier(); asm volatile("" ::: "memory");
    AT_PV((sv + 3) & 3);
    if (!half) __builtin_amdgcn_s_barrier();
    asm volatile("s_waitcnt vmcnt(0)" ::: "memory");
    __builtin_amdgcn_s_barrier();
    asm volatile("" ::: "memory");
    { auto rr = __builtin_amdgcn_permlane32_swap(__float_as_uint(l_reg), __float_as_uint(l_reg), false, false); l_out = __uint_as_float(rr[0]) + __uint_as_float(rr[1]); }
#undef AT_ISSUE
#undef AT_PV
}
__device__ __forceinline__ void row_inv_l(LAS unsigned char* lds_scratch, float l_reg, float (&rli)[16]) {
    const int tid = otid(), wid = tid >> 6, lane = tid & 63, r32 = lane & 31, hi = lane >> 5;
    LAS float* li_l = (LAS float*)lds_scratch + wid * 64 + 32;
    if (hi == 0) li_l[r32] = l_reg;
    asm volatile("s_waitcnt lgkmcnt(0)" ::: "memory");
#pragma unroll
    for (int r = 0; r < 16; ++r) rli[r] = __builtin_amdgcn_rcpf(li_l[crow(r, hi)]);
}
}

__device__ __forceinline__ void attn_unit_mla(CKP& p, LAS unsigned char* lds, int q0, int h, const at::KeyMap km) {
    const bf16_t* qm = (const bf16_t*)(p.ws + WS_QM); const bf16_t* kmb = (const bf16_t*)(p.ws + WS_KM); const bf16_t* vmb = (const bf16_t*)(p.ws + WS_VM); bf16_t* ya = (bf16_t*)(p.ws + WS_YBR);
    f32x16 o[4]; float l;
    at::attn_body<192>(lds, qm + h * 192, 768, q0, kmb + h * 192, 768, vmb + h * 128, 512, km, o, l);
    float rli[16]; at::row_inv_l(lds + 3 * 64 * 384 + 4 * 16384, l, rli);
    const int tid_ = otid(); const int wid = tid_ >> 6, lane = tid_ & 63, r32 = lane & 31, hi = lane >> 5;
    bf16_t* yw = ya + (size_t)(q0 + wid * 32) * 512 + h * 128 + r32;
#pragma unroll
    for (int r = 0; r < 16; ++r) { const int orow = at::crow(r, hi);
#pragma unroll
        for (int d0 = 0; d0 < 4; ++d0) yw[(size_t)orow * 512 + d0 * 32] = f2bf(o[d0][r] * rli[r]); }
}
__device__ __forceinline__ void attn_unit_diff(CKP& p, LAS unsigned char* lds, int l_idx, int q0, int h, const at::KeyMap km) {
    const bf16_t* ubuf = (const bf16_t*)(p.ws + WS_R1); bf16_t* yc = (bf16_t*)(p.ws + WS_YBR) + (size_t)2 * MALL * 512;
    const float lam = ((const float*)(p.ws + WS_SCAL))[l_idx]; const float lam_init = 0.8f - 0.6f * expf(-0.3f * (float)l_idx);
    f32x16 o[4]; float l; float rli[16];
    at::attn_body<64>(lds, ubuf + U_CQ + (2 * h) * 64, NU, q0, ubuf + U_CK + (2 * h) * 64, NU, ubuf + U_CV + h * 128, NU, km, o, l);
    at::row_inv_l(lds + 3 * 64 * 128 + 4 * 16384, l, rli);
    const int tid_ = otid(); const int wid = tid_ >> 6, lane = tid_ & 63, r32 = lane & 31, hi = lane >> 5;
    bf16_t* yw = yc + (size_t)(q0 + wid * 32) * 512 + h * 128 + r32;
#pragma unroll
    for (int r = 0; r < 16; ++r) { const int orow = at::crow(r, hi);
#pragma unroll
        for (int d0 = 0; d0 < 4; ++d0) yw[(size_t)orow * 512 + d0 * 32] = f2bf(o[d0][r] * rli[r]); }
    at::attn_body<64>(lds, ubuf + U_CQ + (2 * h + 1) * 64, NU, q0, ubuf + U_CK + (2 * h + 1) * 64, NU, ubuf + U_CV + h * 128, NU, km, o, l);
    at::row_inv_l(lds + 3 * 64 * 128 + 4 * 16384, l, rli);
    { const int t2 = otid(); yw = yc + (size_t)(q0 + (t2 >> 6) * 32) * 512 + h * 128 + (t2 & 31); }
    float ss[16];
#pragma unroll
    for (int r = 0; r < 16; ++r) { const int orow = at::crow(r, hi); float s = 0.f;
#pragma unroll
        for (int d = 0; d < 4; ++d) { const float v = bf2f(yw[(size_t)orow * 512 + d * 32]) - lam * (o[d][r] * rli[r]); o[d][r] = v; s += v * v; }
        ss[r] = s; }
#pragma unroll
    for (int r = 0; r < 16; ++r) {
#pragma unroll
        for (int x = 16; x >= 1; x >>= 1) ss[r] += shx(ss[r], x, lane); }
    const float* sub = p.in[I_SUBLN] + l_idx * 128; float sg[4];
#pragma unroll
    for (int d = 0; d < 4; ++d) sg[d] = sub[d * 32 + r32] * (1.0f - lam_init);
#pragma unroll
    for (int r = 0; r < 16; ++r) { const int orow = at::crow(r, hi); const float rn = rsqrtf(ss[r] * (1.0f / 128.0f) + EPS);
#pragma unroll
        for (int d0 = 0; d0 < 4; ++d0) yw[(size_t)orow * 512 + d0 * 32] = f2bf(o[d0][r] * rn * sg[d0]); }
}

__device__ __forceinline__ void lds_barrier() { asm volatile("s_waitcnt lgkmcnt(0)" ::: "memory"); __builtin_amdgcn_s_barrier(); asm volatile("" ::: "memory"); }
namespace hg {
__device__ __forceinline__ bf16x8 gather8(const LAS bf16_t* p, int stride) { bf16x8 r;
#pragma unroll
    for (int i = 0; i < 8; ++i) r[i] = (short)p[i * stride];
    return r; }
__device__ __forceinline__ void gates16(const bf16_t* zp  , float lbk, int dd, float (&gi)[16], float (&kf)[16], float& tot) {
    float g[16];
#pragma unroll
    for (int i = 0; i < 16; ++i) { const float z = bf2f(zp[(size_t)i * NU]); const float sg = sigmoidf_(z); g[i] = flog(lbk + (1.0f - lbk) * sg); kf[i] = (1.0f - lbk) * frcp(1.0f + __expf(z)); }
    float run = 0.f;
    if (dd == 0) {
#pragma unroll
        for (int i = 0; i < 16; ++i) { run += g[i]; gi[i] = run; }
    } else {
#pragma unroll
        for (int i = 15; i >= 0; --i) { run += g[i]; gi[i] = run; }
    }
    tot = run;
}
__device__ __forceinline__ void gates16r(const bf16_t (&zr)[16], float lbk, int dd, float (&gi)[16], float (&kf)[16], float& tot) {
    float g[16];
#pragma unroll
    for (int i = 0; i < 16; ++i) { const float z = bf2f(zr[i]); const float sg = sigmoidf_(z); g[i] = flog(lbk + (1.0f - lbk) * sg); kf[i] = (1.0f - lbk) * frcp(1.0f + __expf(z)); }
    float run = 0.f;
    if (dd == 0) {
#pragma unroll
        for (int i = 0; i < 16; ++i) { run += g[i]; gi[i] = run; }
    } else {
#pragma unroll
        for (int i = 15; i >= 0; --i) { run += g[i]; gi[i] = run; }
    }
    tot = run;
}
__device__ __forceinline__ void pack16_store(LAS bf16_t* dst, const float (&v)[16]) {
    u32x4 a, b; a.x = cvt_pk_bf16(v[0], v[1]); a.y = cvt_pk_bf16(v[2], v[3]); a.z = cvt_pk_bf16(v[4], v[5]); a.w = cvt_pk_bf16(v[6], v[7]);
    b.x = cvt_pk_bf16(v[8], v[9]); b.y = cvt_pk_bf16(v[10], v[11]); b.z = cvt_pk_bf16(v[12], v[13]); b.w = cvt_pk_bf16(v[14], v[15]);
    *(LAS u32x4*)dst = a; *(LAS u32x4*)(dst + 8) = b;
}
__device__ __forceinline__ void stage_vT(LAS bf16_t* VsT, const bf16_t* vp  , int v, int part) {
    unsigned short h[16];
#pragma unroll
    for (int i = 0; i < 16; ++i) h[i] = vp[(size_t)i * NU];
    u32x4 a, b; a.x = h[0] | ((unsigned)h[1] << 16); a.y = h[2] | ((unsigned)h[3] << 16); a.z = h[4] | ((unsigned)h[5] << 16); a.w = h[6] | ((unsigned)h[7] << 16);
    b.x = h[8] | ((unsigned)h[9] << 16); b.y = h[10] | ((unsigned)h[11] << 16); b.z = h[12] | ((unsigned)h[13] << 16); b.w = h[14] | ((unsigned)h[15] << 16);
    *(LAS u32x4*)(VsT + v * 72 + part * 16) = a; *(LAS u32x4*)(VsT + v * 72 + part * 16 + 8) = b;
}
__device__ __forceinline__ void pass1_unit(CKP& p, LAS unsigned char* lds, const float* lb, int cid, int hh) {
    const bf16_t* ubuf = (const bf16_t*)(p.ws + WS_R1); bf16_t* HS = (bf16_t*)(p.ws + WS_YBUF); float* HD = (float*)(p.ws + WS_HD);
    LAS bf16_t* VsT = (LAS bf16_t*)lds; LAS bf16_t* KtT = (LAS bf16_t*)(lds + 18432); LAS float* ptot = (LAS float*)(lds + 36864);
    const int tid = otid(), wid = tid >> 6, lane = tid & 63, row0 = cid * 64;
    const int k = tid & 127, part = tid >> 7; const float lbk = lb[hh * 128 + k];
    bf16_t zf[16], zb[16];
    { const bf16_t* zp = ubuf + (size_t)(row0 + part * 16) * NU + hh * 128 + k;
#pragma unroll
      for (int i = 0; i < 16; ++i) { zf[i] = zp[(size_t)i * NU + U_DFF]; zb[i] = zp[(size_t)i * NU + U_DFB]; } }
    stage_vT(VsT, ubuf + (size_t)(row0 + part * 16) * NU + U_DI + hh * 128 + k, k, part);
#pragma unroll 1
    for (int dd = 0; dd < 2; ++dd) {
        float gi[16], kf[16], tot;
        { bf16_t zr[16];
#pragma unroll
          for (int i = 0; i < 16; ++i) zr[i] = dd ? zb[i] : zf[i];
          gates16r(zr, lbk, dd, gi, kf, tot); }
        ptot[part * 128 + k] = tot;
        lds_barrier();
        float off = 0.f, gt = 0.f;
#pragma unroll
        for (int q = 0; q < 4; ++q) { const float v = ptot[q * 128 + k]; gt += v; if (dd == 0 ? (q < part) : (q > part)) off += v; }
#pragma unroll
        for (int i = 0; i < 16; ++i) kf[i] = kf[i] * __expf(gt - (off + gi[i]));
        pack16_store(KtT + k * 72 + part * 16, kf);
        if (part == 0) HD[(size_t)((cid * 4 + hh) * 2 + dd) * 128 + k] = __expf(gt);
        lds_barrier();
        {
            const int l15 = lane & 15, kg = lane >> 4;
            bf16x8 vf[2];
#pragma unroll
            for (int ks = 0; ks < 2; ++ks) vf[ks] = *(const LAS bf16x8*)(VsT + (wid * 16 + l15) * 72 + ks * 32 + kg * 8);
            bf16_t* dst = HS + ((size_t)((cid * 4 + hh) * 2 + dd) * 128 + wid * 16 + l15) * 128;
            bf16x8 kfr[8][2];
#pragma unroll
            for (int kb = 0; kb < 8; ++kb)
#pragma unroll
                for (int ks = 0; ks < 2; ++ks) kfr[kb][ks] = *(const LAS bf16x8*)(KtT + (kb * 16 + l15) * 72 + ks * 32 + kg * 8);
            asm volatile("" ::: "memory");
#pragma unroll
            for (int kb = 0; kb < 8; ++kb) {
                f32x4 c = {0.f, 0.f, 0.f, 0.f};
#pragma unroll
                for (int ks = 0; ks < 2; ++ks) c = __builtin_amdgcn_mfma_f32_16x16x32_bf16(kfr[kb][ks], vf[ks], c, 0, 0, 0);
                u32x2 w; w.x = cvt_pk_bf16(c[0], c[1]); w.y = cvt_pk_bf16(c[2], c[3]);
                *(u32x2*)(dst + kb * 16 + kg * 4) = w;
            }
        }
        lds_barrier();
    }
}
__device__ __forceinline__ void carry_unit(CKP& p, int u) {
    bf16_t* HS = (bf16_t*)(p.ws + WS_YBUF); const float* HD = (const float*)(p.ws + WS_HD);
    const int combo = u >> 4, sub = u & 15, b = combo >> 3, hh = (combo >> 1) & 3, dd = combo & 1;
    const int tid_ = otid(); const int v = sub * 8 + (tid_ >> 6), k = 2 * (tid_ & 63);
    float s0 = 0.f, s1 = 0.f;
#pragma unroll 1
    for (int s0i = 0; s0i < 260; s0i += 52) {
        unsigned uw[52]; f32x2 d2[52];
#pragma unroll
        for (int q = 0; q < 52; ++q) { const int st = s0i + q;
            const int cid = dd == 0 ? (st < 4 ? 512 + b * 4 + st : b * 256 + (st - 4)) : (st < 4 ? 512 + b * 4 + (3 - st) : b * 256 + (259 - st));
            const size_t base = (size_t)((cid * 4 + hh) * 2 + dd) * 128;
            uw[q] = *(const unsigned*)(HS + (base + v) * 128 + k); d2[q] = *(const f32x2*)(HD + base + k); }
#pragma unroll
        for (int q = 0; q < 52; ++q) { const int st = s0i + q;
            const int cid = dd == 0 ? (st < 4 ? 512 + b * 4 + st : b * 256 + (st - 4)) : (st < 4 ? 512 + b * 4 + (3 - st) : b * 256 + (259 - st));
            const size_t base = (size_t)((cid * 4 + hh) * 2 + dd) * 128;
            *(unsigned*)(HS + (base + v) * 128 + k) = cvt_pk_bf16(s0, s1);
            s0 = d2[q][0] * s0 + bflo(uw[q]); s1 = d2[q][1] * s1 + bfhi(uw[q]); }
    }
}
constexpr int O_QS = 0, O_KF = 17408, O_VS = 34816, O_GS = 53248, O_ST = 87040, O_AS = 121856, O_R = 140288, O_PT = 142336, O_RS = 144384;
static_assert(O_RS + 512 <= LDS_MISC, "HGRN LDS");
__device__ __forceinline__ void out_unit(CKP& p, LAS unsigned char* lds, const float* lb, const float* gnorm, int cid, int hh) {
    const bf16_t* ubuf = (const bf16_t*)(p.ws + WS_R1); const bf16_t* HS = (const bf16_t*)(p.ws + WS_YBUF); bf16_t* yd = (bf16_t*)(p.ws + WS_YBR) + (size_t)3 * MALL * 512;
    LAS bf16_t* qs = (LAS bf16_t*)(lds + O_QS); LAS bf16_t* kfs = (LAS bf16_t*)(lds + O_KF); LAS bf16_t* Vs = (LAS bf16_t*)(lds + O_VS); LAS float* Gs = (LAS float*)(lds + O_GS);
    LAS bf16_t* St = (LAS bf16_t*)(lds + O_ST); LAS float* Rr = (LAS float*)(lds + O_R); LAS float* ptot = (LAS float*)(lds + O_PT); LAS float* rss = (LAS float*)(lds + O_RS);
    const int tid = otid(), wid = tid >> 6, lane = tid & 63, row0 = cid * 64, l15 = lane & 15, kg = lane >> 4;
    LAS bf16_t* Asc = (LAS bf16_t*)(lds + O_AS) + wid * (16 * 72);
    const int k = tid & 127, part = tid >> 7; const float lbk = lb[hh * 128 + k];
    bf16_t zf[16], zb[16]; u32x4 sin0[4], sin1[4];
    { const bf16_t* zp = ubuf + (size_t)(row0 + part * 16) * NU + hh * 128 + k;
#pragma unroll
      for (int i = 0; i < 16; ++i) { zf[i] = zp[(size_t)i * NU + U_DFF]; zb[i] = zp[(size_t)i * NU + U_DFB]; }
      const int v_ = tid >> 2, seg_ = tid & 3; const bf16_t* src = HS + ((size_t)((cid * 4 + hh) * 2) * 128 + v_) * 128 + seg_ * 32;
#pragma unroll
      for (int i = 0; i < 4; ++i) { sin0[i] = *(const u32x4*)(src + i * 8); sin1[i] = *(const u32x4*)(src + (size_t)128 * 128 + i * 8); } }
    stage_vT(Vs, ubuf + (size_t)(row0 + part * 16) * NU + U_DI + hh * 128 + k, k, part);
#pragma unroll
    for (int i = 0; i < 16; ++i) { const int t = part * 16 + i; qs[t * 136 + k] = f2bf(siluf_(bf2f(ubuf[(size_t)(row0 + t) * NU + U_DQ + hh * 128 + k]))); }
    const int bi = wid >> 1, vh = wid & 1;
    f32x4 o[4];
#pragma unroll
    for (int nb = 0; nb < 4; ++nb) o[nb] = (f32x4){0.f, 0.f, 0.f, 0.f};
#pragma unroll 1
    for (int dd = 0; dd < 2; ++dd) {
        {
            float gi[16], kf[16], tot;
            { bf16_t zr[16];
#pragma unroll
              for (int i = 0; i < 16; ++i) zr[i] = dd ? zb[i] : zf[i];
              gates16r(zr, lbk, dd, gi, kf, tot); }
            ptot[part * 128 + k] = tot;
            lds_barrier();
            float off = 0.f;
#pragma unroll
            for (int q = 0; q < 4; ++q) { const float v = ptot[q * 128 + k]; if (dd == 0 ? (q < part) : (q > part)) off += v; }
#pragma unroll
            for (int i = 0; i < 16; ++i) { const int t = part * 16 + i; Gs[t * 132 + k] = off + gi[i]; kfs[t * 136 + k] = f2bf(kf[i]); }
            Rr[part * 128 + k] = off;
        }
        {
            const int v = tid >> 2, seg = tid & 3;
#pragma unroll
            for (int i = 0; i < 4; ++i) *(LAS u32x4*)(St + v * 136 + seg * 32 + i * 8) = dd ? sin1[i] : sin0[i];
        }
        lds_barrier();
        const int ti = bi * 16 + l15;
        u32x4 awq[4];
#pragma unroll
        for (int ks = 0; ks < 4; ++ks) { const int kc = ks * 32 + kg * 8;
            const u32x4 qw = *(const LAS u32x4*)(qs + ti * 136 + kc);
            const f32x4 g0 = *(const LAS f32x4*)(Gs + ti * 132 + kc), g1 = *(const LAS f32x4*)(Gs + ti * 132 + kc + 4), r0 = *(const LAS f32x4*)(Rr + bi * 128 + kc), r1 = *(const LAS f32x4*)(Rr + bi * 128 + kc + 4);
            const float qv[8] = {bflo(qw.x), bfhi(qw.x), bflo(qw.y), bfhi(qw.y), bflo(qw.z), bfhi(qw.z), bflo(qw.w), bfhi(qw.w)}; float qa[8];
#pragma unroll
            for (int e = 0; e < 4; ++e) { qa[e] = qv[e] * __expf(g0[e] - r0[e]); qa[4 + e] = qv[4 + e] * __expf(g1[e] - r1[e]); }
            awq[ks].x = cvt_pk_bf16(qa[0], qa[1]); awq[ks].y = cvt_pk_bf16(qa[2], qa[3]); awq[ks].z = cvt_pk_bf16(qa[4], qa[5]); awq[ks].w = cvt_pk_bf16(qa[6], qa[7]); }
#pragma unroll 1
        for (int j = 0; j < 4; ++j) {
            const bool use = dd == 0 ? (j <= bi) : (j >= bi);
            f32x4 c = {0.f, 0.f, 0.f, 0.f};
            if (use) {
                const int sj = j * 16 + l15;
#pragma unroll
                for (int ks = 0; ks < 4; ++ks) {
                    const int kc = ks * 32 + kg * 8;
                    const u32x4 kw = *(const LAS u32x4*)(kfs + sj * 136 + kc);
                    const f32x4 h0 = *(const LAS f32x4*)(Gs + sj * 132 + kc), h1 = *(const LAS f32x4*)(Gs + sj * 132 + kc + 4);
                    const f32x4 r0 = *(const LAS f32x4*)(Rr + bi * 128 + kc), r1 = *(const LAS f32x4*)(Rr + bi * 128 + kc + 4);
                    const float kv[8] = {bflo(kw.x), bfhi(kw.x), bflo(kw.y), bfhi(kw.y), bflo(kw.z), bfhi(kw.z), bflo(kw.w), bfhi(kw.w)};
                    float ka[8];
#pragma unroll
                    for (int e = 0; e < 4; ++e) { ka[e] = kv[e] * __expf(r0[e] - h0[e]); ka[4 + e] = kv[4 + e] * __expf(r1[e] - h1[e]); }
                    u32x4 aw = awq[ks], bw;
                    bw.x = cvt_pk_bf16(ka[0], ka[1]); bw.y = cvt_pk_bf16(ka[2], ka[3]); bw.z = cvt_pk_bf16(ka[4], ka[5]); bw.w = cvt_pk_bf16(ka[6], ka[7]);
                    c = __builtin_amdgcn_mfma_f32_16x16x32_bf16(*reinterpret_cast<bf16x8*>(&aw), *reinterpret_cast<bf16x8*>(&bw), c, 0, 0, 0);
                }
                if (j == bi) {
#pragma unroll
                    for (int e = 0; e < 4; ++e) { const int tl = 4 * kg + e; const bool keep = dd == 0 ? (l15 <= tl) : (l15 >= tl); c[e] = keep ? c[e] : 0.f; }
                }
            }
#pragma unroll
            for (int e = 0; e < 4; ++e) Asc[(4 * kg + e) * 72 + j * 16 + l15] = f2bf(c[e]);
        }
        bf16x8 af[2], qf[4];
#pragma unroll
        for (int ks = 0; ks < 2; ++ks) af[ks] = *(const LAS bf16x8*)(Asc + l15 * 72 + ks * 32 + kg * 8);
#pragma unroll
        for (int ks = 0; ks < 4; ++ks) { const int kc = ks * 32 + kg * 8;
            const u32x4 qw = *(const LAS u32x4*)(qs + ti * 136 + kc); const f32x4 g0 = *(const LAS f32x4*)(Gs + ti * 132 + kc), g1 = *(const LAS f32x4*)(Gs + ti * 132 + kc + 4);
            u32x4 aw; aw.x = cvt_pk_bf16(bflo(qw.x) * __expf(g0[0]), bfhi(qw.x) * __expf(g0[1])); aw.y = cvt_pk_bf16(bflo(qw.y) * __expf(g0[2]), bfhi(qw.y) * __expf(g0[3]));
            aw.z = cvt_pk_bf16(bflo(qw.z) * __expf(g1[0]), bfhi(qw.z) * __expf(g1[1])); aw.w = cvt_pk_bf16(bflo(qw.w) * __expf(g1[2]), bfhi(qw.w) * __expf(g1[3]));
            qf[ks] = *reinterpret_cast<bf16x8*>(&aw); }
#pragma unroll
        for (int nb = 0; nb < 4; ++nb) { const int vcol = vh * 64 + nb * 16 + l15;
            bf16x8 vf[2], sf[4];
#pragma unroll
            for (int ks = 0; ks < 2; ++ks) vf[ks] = *(const LAS bf16x8*)(Vs + vcol * 72 + ks * 32 + kg * 8);
#pragma unroll
            for (int ks = 0; ks < 4; ++ks) sf[ks] = *(const LAS bf16x8*)(St + vcol * 136 + ks * 32 + kg * 8);
            asm volatile("" ::: "memory");
#pragma unroll
            for (int ks = 0; ks < 2; ++ks) o[nb] = __builtin_amdgcn_mfma_f32_16x16x32_bf16(af[ks], vf[ks], o[nb], 0, 0, 0);
#pragma unroll
            for (int ks = 0; ks < 4; ++ks) o[nb] = __builtin_amdgcn_mfma_f32_16x16x32_bf16(qf[ks], sf[ks], o[nb], 0, 0, 0);
        }
        lds_barrier();
    }
    bf16_t ogr[4][4]; float gn[4];
#pragma unroll
    for (int e = 0; e < 4; ++e)
#pragma unroll
        for (int nb = 0; nb < 4; ++nb) ogr[e][nb] = ubuf[(size_t)(row0 + bi * 16 + 4 * kg + e) * NU + U_DG + hh * 128 + vh * 64 + nb * 16 + l15];
#pragma unroll
    for (int nb = 0; nb < 4; ++nb) gn[nb] = gnorm[vh * 64 + nb * 16 + l15];
    float ss[4];
#pragma unroll
    for (int e = 0; e < 4; ++e) { float s = 0.f;
#pragma unroll
        for (int nb = 0; nb < 4; ++nb) s += o[nb][e] * o[nb][e];
#pragma unroll
        for (int x = 8; x >= 1; x >>= 1) s += shx(s, x, lane);
        ss[e] = s; }
    if (l15 == 0) {
#pragma unroll
        for (int e = 0; e < 4; ++e) rss[vh * 64 + bi * 16 + 4 * kg + e] = ss[e]; }
    lds_barrier();
#pragma unroll
    for (int e = 0; e < 4; ++e) { const int tl = bi * 16 + 4 * kg + e; const float tot = rss[tl] + rss[64 + tl]; const float rn = rsqrtf(tot * (1.0f / 128.0f) + EPS);
        const size_t row = (size_t)(row0 + tl);
#pragma unroll
        for (int nb = 0; nb < 4; ++nb) { const int v = vh * 64 + nb * 16 + l15; const float og = bf2f(ogr[e][nb]);
            yd[row * 512 + hh * 128 + v] = f2bf(o[nb][e] * rn * gn[nb] * siluf_(og)); } }
    lds_barrier();
}
}

constexpr int PH_PER_LAYER = 14, N_PHASES = 1 + PH_PER_LAYER * NL + 1;
#ifndef MK_LAUNCHES
#define MK_LAUNCHES 1
#endif

__global__ void __launch_bounds__(NTHR, 2) fwd_kernel(KP karg) {
    extern __shared__ __attribute__((aligned(16))) unsigned char lds_raw[];
    LAS unsigned char* lds0 = (LAS unsigned char*)lds_raw;
    const int tid = otid(), G = gridDim.x, c = obid();
    volatile LAS unsigned* bst = (volatile LAS unsigned*)(lds0 + LDS_MISC);
    if (tid < 4) bst[tid] = 0u;
    __syncthreads();
    const int lo = karg.ph_lo, hi = karg.ph_hi;
    const bool fused = (MK_LAUNCHES == 1) || (hi - lo) > 1;
    XcdBarrier bar; bar.bar = (unsigned*)(karg.ws + WS_CTL); bar.x = 0; bar.st = bst;
    if (fused) bar = xcd_barrier_post((unsigned*)(karg.ws + WS_CTL), bst);
#ifndef ONLY_PH
#define ONLY_PH (-1)
#endif
#ifndef SUBMASK
#define SUBMASK 0xff
#endif
#define SUB(b) ((SUBMASK >> (b)) & 1)
#define EN(x) (ONLY_PH < 0 || ONLY_PH == (x))
#ifndef REPX
#define REPX (-1)
#define REPN 1
#endif
#define REPEAT(x) _Pragma("unroll 1") for (int rep_ = 0; rep_ < (REPX == (x) ? REPN : 1); ++rep_)
#define IN(k) ((MK_LAUNCHES == 1) || (lo <= (k) && (k) < hi))
#define INL(x) (EN(x) && IN(pb + (x)))
#define SEAM(k) do { if (IN((k) + 1)) xcd_barrier(bar); } while (0)

#define PH_LOCALS CKP& p = kp_here(); const int c = obid(); unsigned char* ws = p.ws; LAS unsigned char* lds = lds_here(lds_raw); \
    float* mod = (float*)(ws + WS_MOD); const float* rope = (const float*)(ws + WS_ROPE); const float* scal = (const float*)(ws + WS_SCAL); \
    bf16_t* hbuf = (bf16_t*)(ws + WS_HBUF); bf16_t* act = (bf16_t*)(ws + WS_R1); bf16_t* ubuf = (bf16_t*)(ws + WS_R1); bf16_t* mrg = (bf16_t*)(ws + WS_R1); bf16_t* ybuf = (bf16_t*)(ws + WS_YBUF); \
    float* xc = (float*)(ws + WS_XC); const float* modl = mod + (size_t)l * 3 * NMOD * DM; \
    (void)rope; (void)scal; (void)hbuf; (void)act; (void)ubuf; (void)mrg; (void)ybuf; (void)xc; (void)modl;

    if (EN(100) && IN(0)) { CKP& p = kp_here(); LAS unsigned char* lds = lds_here(lds_raw); job_tables(p); job_colmax(p); job_mod(p, lds); SEAM(0); }

#pragma unroll 1
    for (int l = 0; l < NL; ++l) {
        const int pb = 1 + PH_PER_LAYER * l; const bool need_ctx = l < NL - 1; const int nrt = need_ctx ? NRT : 128;
        if (INL(0)) { PH_LOCALS
            RNArgs a{};
            if (l == 0) { a.xs_lat = p.in[I_X]; a.xs_ctx = p.in[I_CTX]; a.xd_lat = p.out; a.xd_ctx = xc; a.y = nullptr; }
            else { a.xs_lat = p.out; a.xs_ctx = xc; a.xd_lat = p.out; a.xd_ctx = xc; a.y = ybuf; a.wres = 0.5f; a.modl_res = mod + (size_t)(l - 1) * 3 * NMOD * DM; a.jres = 2; a.postg = p.in[I_POST] + ((l - 1) * 3 + 2) * DM; }
            a.do_norm = true; a.modl_norm = modl; a.jn = 0; a.preg = p.in[I_PRE] + (l * 3 + 0) * DM; a.h = nullptr; a.h8 = (signed char*)hbuf; a.nrows = MALL; a.hsc = (float*)(ws + WS_HSC);
            job_resnorm(a, lds);
            job_convert(p, lds, l);
            SEAM(pb + 0);
        }
        if (INL(1)) { PH_LOCALS
            SchedPlain S; S.T.init(NRT, 44, G, c); S.A = (const char*)hbuf; S.B = (const char*)(ws + WS_WGU); S.lda2 = DM; S.ldb2 = DM; S.nt = DM / 128;
            REPEAT(1) { EpiGateUpI8 E{act, (const float*)(ws + WS_HSC), (const float*)(ws + WS_WSC)}; gm::gemm_stream<false>(lds, S, E); } SEAM(pb + 1);
        }
        if (INL(2)) { PH_LOCALS
            const bool spl = G == 256 && MK_LAUNCHES == 1; float* ypart = (float*)(ws + WS_QM);
            SchedSplitK S; S.T.init(spl ? 128 : NRT, 8, G, c, 4); S.A = (const char*)act; S.B = (const char*)(ws + WS_WD); S.lda2 = DFF * 2; S.ldb2 = DFF * 2; S.nt = DFF / 64; S.ns = 11; S.xe = (spl && c < 176) ? c : -1;
            REPEAT(2) { EpiStoreK E{ybuf, ypart}; gm::gemm_stream<false>(lds, S, E); } SEAM(pb + 2);
            if (spl) { job_splitk_reduce(ypart, ybuf, 11); xcd_barrier(bar); }
        }
        if (INL(3)) { PH_LOCALS
            RNArgs a{};
            if (l == 0) { a.xs_lat = p.in[I_X]; a.xs_ctx = p.in[I_CTX]; } else { a.xs_lat = p.out; a.xs_ctx = xc; }
            a.xd_lat = p.out; a.xd_ctx = xc; a.y = ybuf; a.wres = 0.5f; a.modl_res = modl; a.jres = 0; a.postg = p.in[I_POST] + (l * 3 + 0) * DM;
            a.do_norm = true; a.modl_norm = modl; a.jn = 1; a.preg = p.in[I_PRE] + (l * 3 + 1) * DM; a.h = nullptr; a.h8 = (signed char*)(ws + WS_H8); a.hsc = (float*)(ws + WS_HSC2); a.nrows = MALL;
            job_resnorm(a, lds); SEAM(pb + 3);
        }
        if (INL(4)) { PH_LOCALS
            SchedPlain S; S.T.init(NRT, 24, G, c); S.A = (const char*)(ws + WS_H8); S.B = (const char*)(ws + WS_WIN); S.lda2 = DM; S.ldb2 = DM; S.nt = DM / 128;
            REPEAT(4) { EpiProj E{ubuf, (bf16_t*)(ws + WS_KM), rope, (const float*)(ws + WS_HSC2), (const float*)(ws + WS_WPS)}; gm::gemm_stream<false>(lds, S, E); } SEAM(pb + 4);
        }
        if (INL(5)) { PH_LOCALS job_stats_conv(p, l); SEAM(pb + 5); }
        if (INL(6)) { PH_LOCALS
            if (SUB(0)) { SchedPlain S; S.T.init(NRT, 3, G, c); S.A = (const char*)(ubuf + U_AQ); S.B = (const char*)(ws + WS_WUQ); S.lda2 = NU * 2; S.ldb2 = 512 * 2; S.nt = 8;
              EpiQup E{(bf16_t*)(ws + WS_QM), (const float*)(ws + WS_RSQ), rope}; gm::gemm_stream<false>(lds, S, E); }
            if (SUB(1)) { SchedPlain S; S.T.init(NRT, 4, G, G == 256 ? (c + 120) & 255 : c); S.A = (const char*)(ubuf + U_AKV); S.B = (const char*)(ws + WS_WUKV); S.lda2 = NU * 2; S.ldb2 = 256 * 2; S.nt = 4;
              EpiKVup E{(bf16_t*)(ws + WS_KM), (bf16_t*)(ws + WS_VM), (const float*)(ws + WS_RSQ) + MALL}; gm::gemm_stream<false>(lds, S, E); }
            if (SUB(2)) { SchedPlain S; S.T.init(NRT, 8, G, G == 256 ? (c + 112) & 255 : c); S.A = (const char*)(ws + WS_XCV); S.B = (const char*)(ws + WS_WRG); S.lda2 = 512 * 2; S.ldb2 = 512 * 2; S.nt = 8;
              EpiRG E{(const bf16_t*)(ws + WS_XCV), (bf16_t*)(ws + WS_LA), (bf16_t*)(ws + WS_BB), p.in[I_RGBR] + l * 1024, p.in[I_RGBI] + l * 1024, scal + 2048 + l * 1024}; gm::gemm_stream<false>(lds, S, E); }
            if (SUB(3)) for (int u = (G == 256 ? (c + 96) & 255 : c); u < 520 * 4; u += G) hg::pass1_unit(p, lds, scal + 256 + l * 512, u >> 2, u & 3);
            SEAM(pb + 6);
        }
        if (INL(7)) { PH_LOCALS job_rg_scan1(p); for (int u = c; u < 256; u += G) hg::carry_unit(p, u); SEAM(pb + 7); }
        if (INL(8)) { PH_LOCALS {
            REPEAT(81) if (SUB(0)) job_rg_out(p, nrt);
            REPEAT(82) if (SUB(1)) { const int ncu = need_ctx ? 520 * 4 : 512 * 4;
                if (G > nrt + 16) {
                    if (c < nrt) { for (int i = 0; i < 7; ++i) { const int u = c + i * nrt; hg::out_unit(p, lds, scal + 256 + l * 512, p.in[I_HNORM] + l * 128, u >> 2, u & 3); } }
                    else for (int u = 7 * nrt + (c - nrt); u < ncu; u += G - nrt) hg::out_unit(p, lds, scal + 256 + l * 512, p.in[I_HNORM] + l * 128, u >> 2, u & 3);
                } else for (int u = c; u < ncu; u += G) hg::out_unit(p, lds, scal + 256 + l * 512, p.in[I_HNORM] + l * 128, u >> 2, u & 3); }
            if (SUB(4) && need_ctx) for (int t = (G == 256 ? (c + 16) & 255 : c); t < 16; t += G) { const int bh = t & 7, b = bh >> 2, h = bh & 3; at::KeyMap km{MLAT + b * CTXL, 0, 4, 4};
                if (t < 8) attn_unit_mla(p, lds, MLAT + b * CTXL, h, km); else attn_unit_diff(p, lds, l, MLAT + b * CTXL, h, km); }
            REPEAT(83) if (SUB(2)) for (int t = c; t < 512; t += G) { const int bh = t & 7, qb = t >> 3, b = bh >> 2, h = bh & 3; at::KeyMap km{MLAT + b * CTXL, b * SEQ, 4, 260}; attn_unit_mla(p, lds, b * SEQ + qb * 256, h, km); }
            REPEAT(84) if (SUB(3)) for (int t = c; t < 512; t += G) { const int bh = t & 7, qb = t >> 3, b = bh >> 2, h = bh & 3; at::KeyMap km{MLAT + b * CTXL, b * SEQ, 4, 260}; attn_unit_diff(p, lds, l, b * SEQ + qb * 256, h, km); }
            }
            SEAM(pb + 8);
        }
        if (INL(9)) { PH_LOCALS
            const bool bal = need_ctx && G == 256 && MK_LAUNCHES == 1;
            bf16_t* part = mrg + (size_t)2 * MALL * DM; bf16_t* gx = part + (size_t)4 * MCTX * DM;
            EpiMergeG EG{mrg + (size_t)MALL * DM, p.in[I_MB] + l * 4 * DM, (const float*)(ws + WS_HSC2), (const float*)(ws + WS_WGS), bal, gx};
            EpiMergeY EY{mrg, mrg + (size_t)MALL * DM, bal, gx, part};
            REPEAT(9) {
#pragma unroll 1
            for (int n = 0; n < 4; ++n) { const int xe = (bal && c >= 16 * n && c < 16 * n + 16) ? c - 16 * n : -1, nrm = bal ? 128 : nrt;
                { SchedMergeG S; S.T.init(nrm, 8, G, c); S.h8 = (const char*)(ws + WS_H8); S.wg = (const char*)(ws + WS_WIN) + (size_t)NU * DM; S.n = n; S.xe = xe; gm::gemm_stream<false>(lds, S, EG); }
                { SchedMergeY S; S.T.init(nrm, 8, G, c); S.ybr = (const char*)(ws + WS_YBR); S.wbr = (const char*)(ws + WS_WBR); S.n = n; S.xe = xe; gm::gemm_stream<false>(lds, S, EY); }
            } }
            SEAM(pb + 9);
            if (bal) {
                const int tid = otid();
                for (int idx = c * 512 + tid; idx < MCTX * 256; idx += G * 512) { const int row = idx >> 8, q = idx & 255; float sm[8] = {0.f, 0.f, 0.f, 0.f, 0.f, 0.f, 0.f, 0.f};
#pragma unroll
                    for (int n = 0; n < 4; ++n) { const u32x4 w = *(const u32x4*)(part + ((size_t)n * MCTX + row) * DM + q * 8);
                        sm[0] += bflo(w.x); sm[1] += bfhi(w.x); sm[2] += bflo(w.y); sm[3] += bfhi(w.y); sm[4] += bflo(w.z); sm[5] += bfhi(w.z); sm[6] += bflo(w.w); sm[7] += bfhi(w.w); }
                    u32x4 o; o.x = cvt_pk_bf16(sm[0], sm[1]); o.y = cvt_pk_bf16(sm[2], sm[3]); o.z = cvt_pk_bf16(sm[4], sm[5]); o.w = cvt_pk_bf16(sm[6], sm[7]);
                    *(u32x4*)(mrg + (size_t)(MLAT + row) * DM + q * 8) = o; }
                xcd_barrier(bar);
            }
        }
        if (INL(10)) { PH_LOCALS
            const bool spl = need_ctx && G == 256 && MK_LAUNCHES == 1; float* ypart = (float*)(ws + WS_R1 + (size_t)MALL * DFF * 2);
            SchedSplitK S; S.T.init(spl ? 128 : nrt, 8, G, c, 4); S.A = (const char*)mrg; S.B = (const char*)(ws + WS_WOUT); S.lda2 = DM * 2; S.ldb2 = DM * 2; S.nt = DM / 64; S.ns = 4; S.xe = (spl && c < 64) ? c : -1;
            EpiStoreK E{ybuf, ypart}; gm::gemm_stream<false>(lds, S, E); SEAM(pb + 10);
            if (spl) { job_splitk_reduce(ypart, ybuf, 4); xcd_barrier(bar); }
        }
        if (INL(11)) { PH_LOCALS
            RNArgs a{}; a.xs_lat = p.out; a.xs_ctx = xc; a.xd_lat = p.out; a.xd_ctx = xc; a.y = ybuf; a.wres = 1.0f; a.modl_res = modl; a.jres = 1; a.postg = p.in[I_POST] + (l * 3 + 1) * DM;
            a.do_norm = true; a.modl_norm = modl; a.jn = 2; a.preg = p.in[I_PRE] + (l * 3 + 2) * DM; a.h = nullptr; a.h8 = (signed char*)hbuf; a.nrows = nrt * 256; a.hsc = (float*)(ws + WS_HSC);
            job_resnorm(a, lds); SEAM(pb + 11);
        }
        if (INL(12)) { PH_LOCALS
            SchedPlain S; S.T.init(nrt, 44, G, c); S.A = (const char*)hbuf; S.B = (const char*)(ws + WS_WGU) + (size_t)11264 * 2048; S.lda2 = DM; S.ldb2 = DM; S.nt = DM / 128;
            EpiGateUpI8 E{act, (const float*)(ws + WS_HSC), (const float*)(ws + WS_WSC) + 11264}; gm::gemm_stream<false>(lds, S, E); SEAM(pb + 12);
        }
        if (INL(13)) { PH_LOCALS
            const bool spl = need_ctx && G == 256 && MK_LAUNCHES == 1; float* ypart = (float*)(ws + WS_QM);
            SchedSplitK S; S.T.init(spl ? 128 : nrt, 8, G, c, 4); S.A = (const char*)act; S.B = (const char*)(ws + WS_WD) + (size_t)2048 * 5632 * 2; S.lda2 = DFF * 2; S.ldb2 = DFF * 2; S.nt = DFF / 64; S.ns = 11; S.xe = (spl && c < 176) ? c : -1;
            EpiStoreK E{ybuf, ypart}; gm::gemm_stream<false>(lds, S, E); SEAM(pb + 13);
            if (spl) { job_splitk_reduce(ypart, ybuf, 11); xcd_barrier(bar); }
        }
    }
    if (EN(101) && IN(N_PHASES - 1)) {
        const int l = NL - 1; PH_LOCALS
        RNArgs a{}; a.xs_lat = p.out; a.xs_ctx = xc; a.xd_lat = p.out; a.xd_ctx = xc; a.y = ybuf; a.wres = 0.5f; a.modl_res = mod + (size_t)l * 3 * NMOD * DM; a.jres = 2; a.postg = p.in[I_POST] + (l * 3 + 2) * DM;
        a.do_norm = false; a.modl_norm = a.modl_res; a.jn = 0; a.preg = nullptr; a.h = nullptr; a.nrows = MLAT;
        job_resnorm(a, lds);
    }
#undef PH_LOCALS
#undef IN
#undef INL
#undef EN
#undef SEAM
}


#ifdef DBG_K
__global__ void dbg_dump(float* out, const unsigned char* ws, size_t off, size_t nelem, int is_bf16) {
    const size_t N = (size_t)MLAT * DM;
    for (size_t i = (size_t)obid() * blockDim.x + threadIdx.x; i < N; i += (size_t)gridDim.x * blockDim.x) {
        float s = 0.f;
        for (size_t j = i; j < nelem; j += N) s += is_bf16 ? bf2f(((const bf16_t*)(ws + off))[j]) : ((const float*)(ws + off))[j];
        out[i] = (s - s == 0.f) ? s : 12345.0f;
    }
}
#endif

extern "C" void kernel_launch(void* const* d_in, const int* in_sizes, int n_in, void* d_out, int out_size, void* d_ws, size_t ws_size, hipStream_t stream) {
    static int grid = 0;
    if (grid == 0) {
        if (n_in != 30 || out_size != MLAT * DM || ws_size < WS_END) { fprintf(stderr, "kernel_launch: unexpected shapes: n_in %d out %d ws %zu (need %zu)\n", n_in, out_size, ws_size, (size_t)WS_END); grid = -1; return; }
        int dev = 0, cus = 0;
        if (hipGetDevice(&dev) != hipSuccess || hipDeviceGetAttribute(&cus, hipDeviceAttributeMultiprocessorCount, dev) != hipSuccess) { grid = -1; return; }
        if (hipFuncSetAttribute((const void*)fwd_kernel, hipFuncAttributeMaxDynamicSharedMemorySize, LDS_BYTES) != hipSuccess) { fprintf(stderr, "kernel_launch: hipFuncSetAttribute failed\n"); grid = -1; return; }
        int per_cu = 0; (void)hipOccupancyMaxActiveBlocksPerMultiprocessor(&per_cu, (const void*)fwd_kernel, NTHR, LDS_BYTES); (void)hipGetLastError();
        grid = cus;
    }
    if (grid < 0) return;
    (void)hipMemsetAsync((char*)d_ws + WS_CTL, 0, WS_ZERO_BYTES, stream);
    KP p{};
    for (int i = 0; i < 30; ++i) p.in[i] = (const float*)d_in[i];
    p.out = (float*)d_out; p.ws = (unsigned char*)d_ws;
#ifdef DBG_K
    for (int k = 0; k < DBG_K; ++k) { p.ph_lo = k; p.ph_hi = k + 1; hipLaunchKernelGGL(fwd_kernel, dim3(grid), dim3(NTHR), LDS_BYTES, stream, p); }
    hipLaunchKernelGGL(dbg_dump, dim3(2048), dim3(256), 0, stream, (float*)d_out, (const unsigned char*)d_ws, (size_t)(DBG_OFF), (size_t)(DBG_N), (int)(DBG_BF));
#elif MK_LAUNCHES == 1
    p.ph_lo = 0; p.ph_hi = N_PHASES;
    hipLaunchKernelGGL(fwd_kernel, dim3(grid), dim3(NTHR), LDS_BYTES, stream, p);
#else
    for (int k = 0; k < N_PHASES; ++k) { p.ph_lo = k; p.ph_hi = k + 1; hipLaunchKernelGGL(fwd_kernel, dim3(grid), dim3(NTHR), LDS_BYTES, stream, p); }
#endif
}
```

```cpp
#include <hip/hip_runtime.h>
#include <stdint.h>
#include <stdio.h>

#define LAS __attribute__((address_space(3)))
typedef unsigned short bf16_t;
typedef short bf16x8 __attribute__((ext_vector_type(8)));
typedef short s16x4 __attribute__((ext_vector_type(4)));
typedef float f32x2 __attribute__((ext_vector_type(2)));
typedef float f32x4 __attribute__((ext_vector_type(4)));
typedef float f32x16 __attribute__((ext_vector_type(16)));
typedef unsigned u32x2 __attribute__((ext_vector_type(2)));
typedef unsigned u32x4 __attribute__((ext_vector_type(4)));
typedef int i32x4 __attribute__((ext_vector_type(4)));

constexpr int DM = 2048, NB = 2, SEQ = 16384, NL = 2, CTXL = 256, DFF = 5632, NMOD = 9;
constexpr int MLAT = NB * SEQ, MCTX = NB * CTXL, MALL = MLAT + MCTX;
constexpr int NRT = MALL / 256;
constexpr int DIN = 14144, NU = 6144;
constexpr float EPS = 1e-6f;
constexpr int U_AQ = 0, U_BX = 512, U_BG = 1024, U_CQ = 1536, U_CK = 2048, U_CV = 2560, U_DQ = 3072, U_DFF = 3584, U_DFB = 4096, U_DI = 4608, U_DG = 5120, U_AKV = 5632, U_AKR = 5888;

constexpr size_t al256(size_t x) { return (x + 255) / 256 * 256; }
constexpr size_t WS_CTL = 0;
constexpr size_t WS_CMAX = 16384;
constexpr size_t WS_CMAX2 = WS_CMAX + (size_t)NL * 2 * 2 * 5632 * 4;
constexpr size_t WS_ZERO_BYTES = 524288;
static_assert(WS_CMAX2 + (size_t)NL * 14336 * 4 <= WS_ZERO_BYTES, "column maxima inside the zeroed region");
constexpr size_t WS_MOD = 524288;
constexpr size_t WS_ROPE = WS_MOD + al256((size_t)NL * 3 * NMOD * DM * 4);
constexpr size_t WS_SCAL = WS_ROPE + 32768;
constexpr size_t WS_RSQ = WS_SCAL + 32768;
constexpr size_t WS_RGS = WS_RSQ + al256((size_t)MALL * 8);
constexpr size_t WS_HD = WS_RGS + al256((size_t)NRT * 2 * 512 * 8);
constexpr size_t WS_XC = WS_HD + al256((size_t)520 * 4 * 2 * 128 * 4);
constexpr size_t WS_WGU = WS_XC + (size_t)MCTX * DM * 4;
constexpr size_t WS_WD = WS_WGU + (size_t)2 * 11264 * 2048 * 2;
constexpr size_t WS_WIN = WS_WD + (size_t)2 * 2048 * 5632 * 2;
constexpr size_t WS_WUQ = WS_WIN + (size_t)14336 * 2048 * 2;
constexpr size_t WS_WUKV = WS_WUQ + (size_t)768 * 512 * 2;
constexpr size_t WS_WRG = WS_WUKV + (size_t)1024 * 256 * 2;
constexpr size_t WS_WBR = WS_WRG + (size_t)2048 * 512 * 2;
constexpr size_t WS_WOUT = WS_WBR + (size_t)4 * 2048 * 512 * 2;
constexpr size_t WS_HBUF = WS_WOUT + (size_t)2048 * 2048 * 2;
constexpr size_t WS_R1 = WS_HBUF + (size_t)MALL * DM * 2;
constexpr size_t WS_YBUF = WS_R1 + (size_t)MALL * NU * 2;
constexpr size_t WS_QM = WS_YBUF + (size_t)MALL * DM * 2;
constexpr size_t WS_KM = WS_QM + (size_t)MALL * 768 * 2;
constexpr size_t WS_VM = WS_KM + (size_t)MALL * 768 * 2;
constexpr size_t WS_YBR = WS_VM + (size_t)MALL * 512 * 2;
constexpr size_t WS_XCV = WS_YBR + (size_t)4 * MALL * 512 * 2;
constexpr size_t WS_LA = WS_XCV + (size_t)MALL * 512 * 2;
constexpr size_t WS_BB = WS_LA + (size_t)MALL * 1024 * 2;
constexpr size_t WS_WSC = WS_BB + (size_t)MALL * 1024 * 2;
constexpr size_t WS_HSC = WS_WSC + al256((size_t)2 * 11264 * 4);
constexpr size_t WS_HSC2 = WS_HSC + al256((size_t)MALL * 4);
constexpr size_t WS_WGS = WS_HSC2 + al256((size_t)MALL * 4);
constexpr size_t WS_WPS = WS_WGS + 32768;
constexpr size_t WS_H8 = WS_WPS + 32768;
constexpr size_t WS_END = WS_H8 + (size_t)MALL * DM;

constexpr int NTHR = 512;
constexpr int LDS_BYTES = 147456;
constexpr int LDS_MISC = 147456 - 64;

typedef __bf16 bf16x2n __attribute__((ext_vector_type(2)));
__device__ __forceinline__ unsigned cvt_pk_bf16(float lo, float hi) { const f32x2 v = {lo, hi}; const bf16x2n b = __builtin_convertvector(v, bf16x2n); return __builtin_bit_cast(unsigned, b); }
__device__ __forceinline__ bf16_t f2bf(float x) { return (bf16_t)(cvt_pk_bf16(x, 0.f) & 0xffffu); }
__device__ __forceinline__ float bf2f(bf16_t b) { return __uint_as_float(((unsigned)b) << 16); }
__device__ __forceinline__ float bflo(unsigned w) { return __uint_as_float(w << 16); }
__device__ __forceinline__ float bfhi(unsigned w) { return __uint_as_float(w & 0xffff0000u); }
__device__ __forceinline__ float frcp(float x) { return __builtin_amdgcn_rcpf(x); }
__device__ __forceinline__ float flog(float x) { return __builtin_amdgcn_logf(x) * 0.6931471805599453f; }
__device__ __forceinline__ float sigmoidf_(float x) { return frcp(1.0f + __expf(-x)); }
__device__ __forceinline__ float siluf_(float x) { return x * sigmoidf_(x); }
__device__ __forceinline__ float gelu_tanh(float x) { const float u = 0.7978845608028654f * (x + 0.044715f * x * x * x); const float t = 1.0f - 2.0f * frcp(1.0f + __expf(2.0f * u)); return 0.5f * x * (1.0f + t); }
__device__ __forceinline__ float shx(float v, int mask, int lane) { return __int_as_float(__builtin_amdgcn_ds_bpermute((lane ^ mask) << 2, __float_as_int(v))); }
__device__ __forceinline__ float wave_sum(float v, int lane) {
#pragma unroll
    for (int o = 32; o >= 1; o >>= 1) v += shx(v, o, lane);
    return v;
}
__device__ __forceinline__ int obid() { int b = blockIdx.x; asm volatile("" : "+s"(b)); return b; }
__device__ __forceinline__ int otid() { int t = threadIdx.x; asm volatile("" : "+v"(t)); return t; }
#define WAIT_VM0() asm volatile("s_waitcnt vmcnt(0)" ::: "memory")
#define WAIT_LGKM0() asm volatile("s_waitcnt lgkmcnt(0)" ::: "memory")

#define XB_TMO      128
#define XB_XCNT(j)  (256  + 64 * (j))
#define XB_XSUB(j)  (1280 + 64 * (j))
#define XB_XGEN(j)  (2304 + 64 * (j))
#define XB_TOP      3328
#define XB_TOPGEN   3392
#define XCD_BAR_WORDS 3456
#define XB_SPIN_CAP (1u << 22)
__device__ __forceinline__ unsigned xb_ld(unsigned* p)              { return __hip_atomic_load(p, __ATOMIC_RELAXED, __HIP_MEMORY_SCOPE_AGENT); }
__device__ __forceinline__ unsigned xb_add(unsigned* p, unsigned v) { return __hip_atomic_fetch_add(p, v, __ATOMIC_RELAXED, __HIP_MEMORY_SCOPE_AGENT); }
__device__ __forceinline__ unsigned xb_xcc_id() { return (unsigned)__builtin_amdgcn_s_getreg((3 << 11) | 20) & 0xFu; }
#define XB_SPIN(cond, bar) do { unsigned _sp = 0; while (cond) { __builtin_amdgcn_s_sleep(1); \
    if ((++_sp & 255u) == 0u) { if (xb_ld(&(bar)[XB_TMO])) break; if (_sp > XB_SPIN_CAP) { atomicAdd(&(bar)[XB_TMO], 1u); break; } } } } while (0)
struct XcdBarrier { unsigned* bar; unsigned x; volatile LAS unsigned* st; };
__device__ __forceinline__ XcdBarrier xcd_barrier_post(unsigned* bar, volatile LAS unsigned* st) {
    XcdBarrier b; b.bar = bar; b.x = xb_xcc_id(); b.st = st;
    if (threadIdx.x == 0) (void)xb_add(&bar[XB_XCNT(b.x)], 1u);
    return b;
}
__device__ __forceinline__ void xcd_barrier_complete(unsigned* bar, unsigned x, unsigned& nloc, unsigned& nx) {
    const unsigned G = gridDim.x * gridDim.y * gridDim.z;
    unsigned sum, cnt, mine, sp = 0u;
    for (;;) {
        sum = 0u; cnt = 0u; mine = 0u;
#pragma unroll 1
        for (unsigned j = 0; j < 16; ++j) { const unsigned c = xb_ld(&bar[XB_XCNT(j)]); sum += c; cnt += (c > 0u) ? 1u : 0u; mine = (j == x) ? c : mine; }
        if (sum == G) break;
        __builtin_amdgcn_s_sleep(1);
        if ((++sp & 255u) == 0u) { if (xb_ld(&bar[XB_TMO])) break; if (sp > XB_SPIN_CAP) { atomicAdd(&bar[XB_TMO], 1u); break; } }
    }
    nloc = mine > 0u ? mine : 1u; nx = cnt > 0u ? cnt : 1u;
}
__device__ __forceinline__ void xcd_barrier(const XcdBarrier& b) {
    asm volatile("s_waitcnt vmcnt(0)" ::: "memory");
    __syncthreads();
    if (threadIdx.x == 0) {
        unsigned* bar = b.bar; unsigned bx = b.x;
        asm volatile("" : "+s"(bar), "+s"(bx));
        __builtin_amdgcn_s_waitcnt(0);
        unsigned nloc = b.st[0], nx = b.st[1];
        if (nloc == 0u) { xcd_barrier_complete(bar, bx, nloc, nx); b.st[0] = nloc; b.st[1] = nx; }
        const unsigned old = xb_add(&bar[XB_XSUB(bx)], 1u);
        const unsigned gen = old / nloc;
        if (old + 1u == (gen + 1u) * nloc) {
            __builtin_amdgcn_fence(__ATOMIC_RELEASE, "agent");
            asm volatile("s_waitcnt vmcnt(0)" ::: "memory");
            const unsigned og = xb_add(&bar[XB_TOP], 1u);
            const unsigned tg = og / nx;
            if (og + 1u == (tg + 1u) * nx) xb_add(&bar[XB_TOPGEN], 1u);
            else XB_SPIN(xb_ld(&bar[XB_TOPGEN]) == tg, bar);
            __builtin_amdgcn_fence(__ATOMIC_ACQUIRE, "agent");
            xb_add(&bar[XB_XGEN(bx)], 1u);
            asm volatile("s_waitcnt vmcnt(0)" ::: "memory");
        } else {
            XB_SPIN(xb_ld(&bar[XB_XGEN(bx)]) == gen, bar);
            __builtin_amdgcn_fence(__ATOMIC_ACQUIRE, "agent");
            asm volatile("s_waitcnt vmcnt(0)" ::: "memory");
        }
    }
    __syncthreads();
}

constexpr float MLA_QC = 0.07216878364870322f * 1.4426950408889634f, DIFF_QC = 0.125f * 1.4426950408889634f;
namespace gm {
constexpr int BM = 256, BK = 64, HALF = 128, HTB = HALF * BK * 2, STAGE_BYTES = 8 * HTB;
__device__ __forceinline__ int lds_byte(int r, int c) { const int st = (r >> 4) * 2 + (c >> 5), rr = r & 15, cc = c & 31, ob = rr * 64 + cc * 2; return st * 1024 + (ob ^ (((ob >> 9) & 1) << 5)); }
__device__ __forceinline__ void stage_rc(int b, int& R, int& C) { const int st = b / 1024, sb = b % 1024, swz = sb ^ (((sb >> 9) & 1) << 5); R = (st >> 1) * 16 + swz / 64; C = (st & 1) * 32 + (swz % 64) / 2; }
__device__ __forceinline__ int perm32(int rho) { const int n = rho >> 4, i = rho & 15; return 8 * (i >> 2) + 4 * n + (i & 3); }

struct Unit { const char* A; const char* B; unsigned lda2, ldb2; int nt; int pm, pn, tag; };

struct TileOrder {
    int nM, nN, nwg, G, c, wgm;
    __device__ __forceinline__ void init(int nM_, int nN_, int G_, int c_, int wgm_ = 8) { nM = nM_; nN = nN_; nwg = nM * nN; G = G_; c = c_; wgm = wgm_; }
    __device__ __forceinline__ bool tile(int i, int& pm, int& pn) const {
        const long L = (long)i * G + c; if (L >= nwg) return false;
        int wgid = (int)L; { const int q = nwg / 8, r = nwg % 8, xcd = wgid % 8, off = wgid / 8; wgid = (xcd < r ? xcd * (q + 1) : r * (q + 1) + (xcd - r) * q) + off; }
        const int nig = wgm * nN, gid = wgid / nig, fm = gid * wgm, gsz = (nM - fm) < wgm ? (nM - fm) : wgm;
        pm = fm + ((wgid % nig) % gsz); pn = (wgid % nig) / gsz; return true;
    }
};

typedef i32x4 AccI[2][2][4][2];
__device__ __forceinline__ void zero_acc(AccI& acc) {
#pragma unroll
    for (int a = 0; a < 2; ++a)
#pragma unroll
        for (int b = 0; b < 2; ++b)
#pragma unroll
            for (int m = 0; m < 4; ++m)
#pragma unroll
                for (int n = 0; n < 2; ++n) acc[a][b][m][n] = (i32x4){0, 0, 0, 0};
}
template <class E> struct is_mixed { static constexpr bool v = false; };
typedef f32x4 Acc[2][2][4][2];
__device__ __forceinline__ void zero_acc(Acc& acc) {
#pragma unroll
    for (int a = 0; a < 2; ++a)
#pragma unroll
        for (int b = 0; b < 2; ++b)
#pragma unroll
            for (int m = 0; m < 4; ++m)
#pragma unroll
                for (int n = 0; n < 2; ++n) acc[a][b][m][n] = (f32x4){0.f, 0.f, 0.f, 0.f};
}

template <bool HALFN, class Sched, class Epi>
__device__ __forceinline__ void gemm_stream(LAS unsigned char* lds, const Sched& S, Epi& E) {
    const int tid = otid(), wid = __builtin_amdgcn_readfirstlane(tid >> 6), lane = tid & 63, wr = wid >> 2, wc = wid & 3, fr = lane & 15, fq = lane >> 4;
    int R0, C0; stage_rc(tid * 16, R0, C0);
    const int Rb0 = Epi::PERM ? ((R0 & ~31) + perm32(R0 & 31)) : R0;
    const unsigned ldsw = (unsigned)wid * 1024u;
    const int aoff = lds_byte(wr * 64 + fr, fq * 8), boff = lds_byte(wc * 32 + fr, fq * 8);
#define GM_SA(b, h) (((b) * 2 + (h)) * HTB)
#define GM_SB(b, h) ((4 + (b) * 2 + (h)) * HTB)
#define GM_STAGE(bufoff, gbase, voff, ld2) do { _Pragma("unroll") for (int _i = 0; _i < 2; ++_i) \
        __builtin_amdgcn_global_load_lds((const unsigned*)((const char*)(gbase) + (size_t)_i * 64 * (ld2) + (voff)), (LAS unsigned*)(lds + (bufoff) + ldsw + _i * 8192), 16, 0, 0); } while (0)
#define GM_LDA(dst, b, h) do { _Pragma("unroll") for (int m = 0; m < 4; ++m) _Pragma("unroll") for (int k = 0; k < 2; ++k) dst[m][k] = *(const LAS bf16x8*)(lds + GM_SA(b, h) + aoff + m * 2048 + k * 1024); } while (0)
#define GM_LDB(dst, b, h) do { _Pragma("unroll") for (int n = 0; n < 2; ++n) _Pragma("unroll") for (int k = 0; k < 2; ++k) dst[n][k] = *(const LAS bf16x8*)(lds + GM_SB(b, h) + boff + n * 2048 + k * 1024); } while (0)
#define GM_MMA_I8(ai, bj, At, Bt) do { _Pragma("unroll") for (int m = 0; m < 4; ++m) _Pragma("unroll") for (int n = 0; n < 2; ++n) _Pragma("unroll") for (int k = 0; k < 2; ++k) \
        acc[ai][bj][m][n] = __builtin_bit_cast(typename Epi::AccT_elem, __builtin_amdgcn_mfma_i32_16x16x64_i8(__builtin_bit_cast(i32x4, Bt[n][k]), __builtin_bit_cast(i32x4, At[m][k]), __builtin_bit_cast(i32x4, acc[ai][bj][m][n]), 0, 0, 0)); } while (0)
#define GM_MMA_BF(ai, bj, At, Bt) do { _Pragma("unroll") for (int m = 0; m < 4; ++m) _Pragma("unroll") for (int n = 0; n < 2; ++n) _Pragma("unroll") for (int k = 0; k < 2; ++k) \
        acc[ai][bj][m][n] = __builtin_bit_cast(typename Epi::AccT_elem, __builtin_amdgcn_mfma_f32_16x16x32_bf16(Bt[n][k], At[m][k], __builtin_bit_cast(f32x4, acc[ai][bj][m][n]), 0, 0, 0)); } while (0)
#define GM_MMA(ai, bj, At, Bt) do { __builtin_amdgcn_s_setprio(1); \
        if constexpr (is_mixed<Epi>::v) { if (cur_i8) GM_MMA_I8(ai, bj, At, Bt); else GM_MMA_BF(ai, bj, At, Bt); } \
        else if constexpr (Epi::I8) GM_MMA_I8(ai, bj, At, Bt); else GM_MMA_BF(ai, bj, At, Bt); \
        __builtin_amdgcn_s_setprio(0); } while (0)
#define GM_WAIT_V(n) asm volatile("s_waitcnt vmcnt(" #n ")" ::: "memory")
#define GM_WAIT_L(n) asm volatile("s_waitcnt lgkmcnt(" #n ")" ::: "memory")
#define GM_BAR __builtin_amdgcn_s_barrier()
#define GM_SCHED __builtin_amdgcn_sched_barrier(0)
    Unit cur, nxt; int ui = 0;
    if (!S.next(0, cur)) return;
    typename Epi::AccT acc;
    bf16x8 At[4][2], B0[2][2], B1[2][2];
    unsigned voffA = (unsigned)R0 * cur.lda2 + (unsigned)C0 * 2u, voffB = (unsigned)Rb0 * cur.ldb2 + (unsigned)C0 * 2u;
    const char* cA = cur.A; const char* cB = cur.B;
    {
        const size_t hA = (size_t)HALF * cur.lda2, hB = (size_t)HALF * cur.ldb2;
        GM_STAGE(GM_SB(0, 0), cB, voffB, cur.ldb2); GM_STAGE(GM_SA(0, 0), cA, voffA, cur.lda2);
        if constexpr (!HALFN) GM_STAGE(GM_SB(0, 1), cB + hB, voffB, cur.ldb2);
        GM_STAGE(GM_SA(0, 1), cA + hA, voffA, cur.lda2);
        if (wr == 1) GM_BAR;
        if constexpr (HALFN) GM_WAIT_V(2); else GM_WAIT_V(4);
        GM_BAR;
        GM_STAGE(GM_SB(1, 0), cB + 128, voffB, cur.ldb2); GM_STAGE(GM_SA(1, 0), cA + 128, voffA, cur.lda2);
        if constexpr (!HALFN) GM_STAGE(GM_SB(1, 1), cB + hB + 128, voffB, cur.ldb2);
        if constexpr (HALFN) GM_WAIT_V(4); else GM_WAIT_V(6);
        GM_BAR;
    }
#define GM_UNIT(BJ) { \
        if constexpr (HALFN) { _Pragma("unroll") for (int _a = 0; _a < 2; ++_a) _Pragma("unroll") for (int _m = 0; _m < 4; ++_m) _Pragma("unroll") for (int _n = 0; _n < 2; ++_n) acc[_a][0][_m][_n] = (f32x4){0.f, 0.f, 0.f, 0.f}; } \
        else zero_acc(acc); \
        const bool cur_i8 = (cur.tag & 1) == 0; (void)cur_i8; \
        const bool has_next = S.next(ui + 1, nxt); \
        const char* nA = has_next ? nxt.A : cA; const char* nB = has_next ? nxt.B : cB; \
        const unsigned nlda2 = has_next ? nxt.lda2 : cur.lda2, nldb2 = has_next ? nxt.ldb2 : cur.ldb2; \
        const unsigned nvoffA = (unsigned)R0 * nlda2 + (unsigned)C0 * 2u, nvoffB = (unsigned)Rb0 * nldb2 + (unsigned)C0 * 2u; \
        const size_t hA = (size_t)HALF * cur.lda2, hB = (size_t)HALF * cur.ldb2, nhA = (size_t)HALF * nlda2, nhB = (size_t)HALF * nldb2; \
        const int nt = cur.nt; \
        for (int t = 0; t < nt; t += 2) { \
            const bool last = (t == nt - 2); \
            const char* a1 = cA + (size_t)(t + 1) * 128; \
            const char* a2 = last ? nA : cA + (size_t)(t + 2) * 128; const char* b2 = last ? nB : cB + (size_t)(t + 2) * 128; \
            const char* a3 = a2 + 128; const char* b3 = b2 + 128; \
            const unsigned vA2 = last ? nvoffA : voffA, vB2 = last ? nvoffB : voffB; \
            const unsigned lA2 = last ? nlda2 : cur.lda2, lB2 = last ? nldb2 : cur.ldb2; \
            const size_t hA2 = last ? nhA : hA, hB2 = last ? nhB : hB; \
              \
            GM_LDB(B0, 0, 0); GM_SCHED; GM_LDA(At, 0, 0); GM_STAGE(GM_SA(1, 1), a1 + hA, voffA, cur.lda2); \
            GM_WAIT_L(8); GM_BAR; GM_WAIT_L(0); GM_MMA(0, 0, At, B0); GM_BAR; GM_SCHED; \
              \
            if constexpr (!HALFN) GM_LDB(B1, 0, 1); \
            GM_STAGE(GM_SB(0, 0), b2, vB2, lB2); \
            GM_BAR; GM_WAIT_L(0); if constexpr (!HALFN) GM_MMA(0, 1, At, B1); GM_BAR; \
              \
            GM_LDA(At, 0, 1); GM_STAGE(GM_SA(0, 0), a2, vA2, lA2); \
            GM_BAR; GM_WAIT_L(0); GM_MMA(1, 0, At, B0); GM_BAR; GM_SCHED; \
              \
            if constexpr (!HALFN) { GM_STAGE(GM_SB(0, 1), b2 + hB2, vB2, lB2); GM_WAIT_V(6); } else { GM_WAIT_V(4); } \
            GM_BAR; if constexpr (!HALFN) GM_MMA(1, 1, At, B1); GM_BAR; \
              \
            GM_LDB(B0, 1, 0); GM_SCHED; GM_LDA(At, 1, 0); GM_STAGE(GM_SA(0, 1), a2 + hA2, vA2, lA2); \
            GM_WAIT_L(8); GM_BAR; GM_WAIT_L(0); GM_MMA(0, 0, At, B0); GM_BAR; GM_SCHED; \
              \
            if constexpr (!HALFN) GM_LDB(B1, 1, 1); \
            GM_STAGE(GM_SB(1, 0), b3, vB2, lB2); \
            GM_BAR; GM_WAIT_L(0); if constexpr (!HALFN) GM_MMA(0, 1, At, B1); GM_BAR; \
              \
            GM_LDA(At, 1, 1); GM_STAGE(GM_SA(1, 0), a3, vA2, lA2); \
            GM_BAR; GM_WAIT_L(0); GM_MMA(1, 0, At, B0); GM_BAR; GM_SCHED; \
              \
            if constexpr (!HALFN) { GM_STAGE(GM_SB(1, 1), b3 + hB2, vB2, lB2); GM_WAIT_V(6); } else { GM_WAIT_V(4); } \
            GM_BAR; if constexpr (!HALFN) GM_MMA(1, 1, At, B1); GM_BAR; \
        } \
        { const int tz_ = otid(); const int wz_ = __builtin_amdgcn_readfirstlane(tz_ >> 6), lz_ = tz_ & 63; E.template post<BJ>(acc, cur, wz_ >> 2, wz_ & 3, lz_ & 15, lz_ >> 4); } \
        if (!has_next) break; \
        cur = nxt; cA = nA; cB = nB; voffA = nvoffA; voffB = nvoffB; ++ui; \
    }
    for (;;) {
        GM_UNIT(0)
    }
    GM_WAIT_V(0);
    if (wr == 0) GM_BAR;
    GM_BAR;
#undef GM_UNIT
#undef GM_SA
#undef GM_SB
#undef GM_STAGE
#undef GM_LDA
#undef GM_LDB
#undef GM_MMA
#undef GM_MMA_I8
#undef GM_MMA_BF
#undef GM_WAIT_V
#undef GM_WAIT_L
#undef GM_BAR
#undef GM_SCHED
}
}

struct SchedPlain {
    gm::TileOrder T; const char* A; const char* B; unsigned lda2, ldb2; int nt;
    __device__ __forceinline__ bool next(int i, gm::Unit& u) const {
        int pm, pn; if (!T.tile(i, pm, pn)) return false;
        u.A = A + (size_t)pm * 256 * lda2; u.B = B + (size_t)pn * 256 * ldb2; u.lda2 = lda2; u.ldb2 = ldb2; u.nt = nt; u.pm = pm; u.pn = pn; u.tag = 0; return true;
    }
};
struct SchedSplitK {
    gm::TileOrder T; const char* A; const char* B; unsigned lda2, ldb2; int nt, xe, ns;
    __device__ __forceinline__ bool next(int i, gm::Unit& u) const {
        int pm, pn; u.lda2 = lda2; u.ldb2 = ldb2;
        if (T.tile(i, pm, pn)) { u.A = A + (size_t)pm * 256 * lda2; u.B = B + (size_t)pn * 256 * ldb2; u.nt = nt; u.pm = pm; u.pn = pn; u.tag = 0; return true; }
        if (xe < 0 || i != 4) return false;
        const int e = xe / ns, sl = xe % ns, ks = nt / ns; pm = 128 + (e & 1); pn = e >> 1;
        u.A = A + (size_t)pm * 256 * lda2 + (size_t)sl * ks * 128; u.B = B + (size_t)pn * 256 * ldb2 + (size_t)sl * ks * 128; u.nt = ks; u.pm = pm; u.pn = pn; u.tag = 1 + sl; return true;
    }
};
struct SchedMergeG {
    gm::TileOrder T; const char* h8; const char* wg; int n, xe;
    __device__ __forceinline__ bool next(int i, gm::Unit& u) const {
        int pm, pn; if (!T.tile(i, pm, pn)) { if (xe < 0 || i != 4) return false; pm = 128 + (xe & 1); pn = xe >> 1; }
        u.A = h8 + (size_t)pm * 256 * 2048; u.lda2 = 2048; u.nt = 16; u.B = wg + ((size_t)n * 2048 + (size_t)pn * 256) * 2048; u.ldb2 = 2048; u.pm = pm; u.pn = pn; u.tag = n; return true;
    }
};
struct SchedMergeY {
    gm::TileOrder T; const char* ybr; const char* wbr; int n, xe;
    __device__ __forceinline__ bool next(int i, gm::Unit& u) const {
        int pm, pn; if (!T.tile(i, pm, pn)) { if (xe < 0 || i != 4) return false; pm = 128 + (xe & 1); pn = xe >> 1; }
        u.A = ybr + (size_t)n * MALL * 1024 + (size_t)pm * 256 * 1024; u.lda2 = 1024; u.nt = 8; u.B = wbr + ((size_t)n * 2048 + (size_t)pn * 256) * 1024; u.ldb2 = 1024; u.pm = pm; u.pn = pn; u.tag = n; return true;
    }
};

struct EpiGateUp {
    static constexpr bool PERM = true, I8 = false; typedef gm::Acc AccT; typedef f32x4 AccT_elem; bf16_t* act;
    template <int BJ> __device__ __forceinline__ void post(gm::Acc& acc, const gm::Unit& u, int wr, int wc, int fr, int fq) {
        const int row0 = u.pm * 256 + wr * 64 + fr, col0 = u.pn * 128 + wc * 32 + 8 * fq;
#pragma unroll
        for (int ai = 0; ai < 2; ++ai)
#pragma unroll
            for (int m = 0; m < 4; ++m) {
                float v[8];
#pragma unroll
                for (int n = 0; n < 2; ++n)
#pragma unroll
                    for (int j = 0; j < 4; ++j) v[n * 4 + j] = siluf_(acc[ai][0][m][n][j]) * acc[ai][1][m][n][j];
                u32x4 w; w.x = cvt_pk_bf16(v[0], v[1]); w.y = cvt_pk_bf16(v[2], v[3]); w.z = cvt_pk_bf16(v[4], v[5]); w.w = cvt_pk_bf16(v[6], v[7]);
                *(u32x4*)(act + (size_t)(row0 + ai * 128 + m * 16) * DFF + col0) = w;
            }
    }
};
struct EpiGateUpI8 {
    static constexpr bool PERM = true, I8 = true; typedef gm::AccI AccT; typedef i32x4 AccT_elem; bf16_t* act; const float* hsc; const float* wsc;
    template <int BJ> __device__ __forceinline__ void post(gm::AccI& acc, const gm::Unit& u, int wr, int wc, int fr, int fq) {
        const int row0 = u.pm * 256 + wr * 64 + fr, col0 = u.pn * 128 + wc * 32 + 8 * fq, wrow = u.pn * 256 + wc * 32 + 8 * fq;
        float sg[8], su[8];
#pragma unroll
        for (int j = 0; j < 8; ++j) { sg[j] = wsc[wrow + j]; su[j] = wsc[wrow + 128 + j]; }
        float hsv[8];
#pragma unroll
        for (int i = 0; i < 8; ++i) hsv[i] = hsc[row0 + (i >> 2) * 128 + (i & 3) * 16];
#pragma unroll
        for (int ai = 0; ai < 2; ++ai)
#pragma unroll
            for (int m = 0; m < 4; ++m) {
                const int row = row0 + ai * 128 + m * 16; const float hs = hsv[ai * 4 + m];
                float v[8];
#pragma unroll
                for (int n = 0; n < 2; ++n)
#pragma unroll
                    for (int j = 0; j < 4; ++j) { const float g = (float)acc[ai][0][m][n][j] * (hs * sg[n * 4 + j]), up = (float)acc[ai][1][m][n][j] * (hs * su[n * 4 + j]); v[n * 4 + j] = siluf_(g) * up; }
                u32x4 w; w.x = cvt_pk_bf16(v[0], v[1]); w.y = cvt_pk_bf16(v[2], v[3]); w.z = cvt_pk_bf16(v[4], v[5]); w.w = cvt_pk_bf16(v[6], v[7]);
                *(u32x4*)(act + (size_t)row * DFF + col0) = w;
            }
    }
};
struct EpiStore {
    static constexpr bool PERM = true, I8 = false; typedef gm::Acc AccT; typedef f32x4 AccT_elem; bf16_t* O; int ldc;
    template <int BJ> __device__ __forceinline__ void post(gm::Acc& acc, const gm::Unit& u, int wr, int wc, int fr, int fq) {
        const int row0 = u.pm * 256 + wr * 64 + fr, col0 = u.pn * 256 + wc * 32 + 8 * fq;
#pragma unroll
        for (int ai = 0; ai < 2; ++ai)
#pragma unroll
            for (int m = 0; m < 4; ++m)
#pragma unroll
                for (int bj = 0; bj < 2; ++bj) {
                    const f32x4 a = acc[ai][bj][m][0], b = acc[ai][bj][m][1];
                    u32x4 w; w.x = cvt_pk_bf16(a[0], a[1]); w.y = cvt_pk_bf16(a[2], a[3]); w.z = cvt_pk_bf16(b[0], b[1]); w.w = cvt_pk_bf16(b[2], b[3]);
                    *(u32x4*)(O + (size_t)(row0 + ai * 128 + m * 16) * ldc + col0 + bj * 128) = w;
                }
    }
};
struct EpiStoreK {
    static constexpr bool PERM = true, I8 = false; typedef gm::Acc AccT; typedef f32x4 AccT_elem; bf16_t* O; float* yp;
    template <int BJ> __device__ __forceinline__ void post(gm::Acc& acc, const gm::Unit& u, int wr, int wc, int fr, int fq) {
        const int row0 = u.pm * 256 + wr * 64 + fr, col0 = u.pn * 256 + wc * 32 + 8 * fq;
        if (u.tag == 0) {
#pragma unroll
            for (int ai = 0; ai < 2; ++ai)
#pragma unroll
                for (int m = 0; m < 4; ++m)
#pragma unroll
                    for (int bj = 0; bj < 2; ++bj) {
                        const f32x4 a = acc[ai][bj][m][0], b = acc[ai][bj][m][1];
                        u32x4 w; w.x = cvt_pk_bf16(a[0], a[1]); w.y = cvt_pk_bf16(a[2], a[3]); w.z = cvt_pk_bf16(b[0], b[1]); w.w = cvt_pk_bf16(b[2], b[3]);
                        *(u32x4*)(O + (size_t)(row0 + ai * 128 + m * 16) * DM + col0 + bj * 128) = w;
                    }
        } else {
            float* base = yp + (size_t)(u.tag - 1) * MCTX * DM;
#pragma unroll
            for (int ai = 0; ai < 2; ++ai)
#pragma unroll
                for (int m = 0; m < 4; ++m)
#pragma unroll
                    for (int bj = 0; bj < 2; ++bj) { float* o = base + (size_t)(row0 - MLAT + ai * 128 + m * 16) * DM + col0 + bj * 128;
                        *(f32x4*)o = acc[ai][bj][m][0]; *(f32x4*)(o + 4) = acc[ai][bj][m][1]; }
        }
    }
};
__device__ __forceinline__ void job_splitk_reduce(const float* yp, bf16_t* y, int ns) {
    const int c = obid(), tid = otid(), G = gridDim.x;
    for (int idx = c * 512 + tid; idx < MCTX * 256; idx += G * 512) { const int row = idx >> 8, q = idx & 255; f32x4 a = {0.f, 0.f, 0.f, 0.f}, b = a;
#pragma unroll 1
        for (int sl = 0; sl < ns; ++sl) { const float* s = yp + ((size_t)sl * MCTX + row) * DM + q * 8; a += *(const f32x4*)s; b += *(const f32x4*)(s + 4); }
        u32x4 o; o.x = cvt_pk_bf16(a[0], a[1]); o.y = cvt_pk_bf16(a[2], a[3]); o.z = cvt_pk_bf16(b[0], b[1]); o.w = cvt_pk_bf16(b[2], b[3]);
        *(u32x4*)(y + (size_t)(MLAT + row) * DM + q * 8) = o; }
}
__device__ __forceinline__ void rope4(f32x4& x0, f32x4& x1, const float* rope, int pos, int fq) {
    const f32x4 t0 = *(const f32x4*)(rope + pos * 32 + 8 * fq), t1 = *(const f32x4*)(rope + pos * 32 + 8 * fq + 4);
    const float c[4] = {t0[0], t0[2], t1[0], t1[2]}, s[4] = {t0[1], t0[3], t1[1], t1[3]};
#pragma unroll
    for (int j = 0; j < 4; ++j) { const float a = x0[j], b = x1[j]; x0[j] = a * c[j] - b * s[j]; x1[j] = a * s[j] + b * c[j]; }
}
__device__ __forceinline__ void rope4v(f32x4& x0, f32x4& x1, const f32x4 t0, const f32x4 t1) {
    const float c[4] = {t0[0], t0[2], t1[0], t1[2]}, s[4] = {t0[1], t0[3], t1[1], t1[3]};
#pragma unroll
    for (int j = 0; j < 4; ++j) { const float a = x0[j], b = x1[j]; x0[j] = a * c[j] - b * s[j]; x1[j] = a * s[j] + b * c[j]; }
}
struct EpiProj {
    static constexpr bool PERM = false, I8 = true; typedef gm::AccI AccT; typedef i32x4 AccT_elem; bf16_t* ubuf; bf16_t* km; const float* rope; const float* hsc; const float* wps;
    template <int BJ> __device__ __forceinline__ void post(gm::AccI& acc, const gm::Unit& u, int wr, int wc, int fr, int fq) {
        const int pn = u.pn; const bool lat = u.pm < 128, ropet = (pn >= 6 && pn <= 9), akr = (pn == 23);
        const int row0 = u.pm * 256 + wr * 64 + fr;
        f32x4 wsv[2][2];
#pragma unroll
        for (int bj = 0; bj < 2; ++bj)
#pragma unroll
            for (int n = 0; n < 2; ++n) wsv[bj][n] = *(const f32x4*)(wps + pn * 256 + bj * 128 + wc * 32 + 16 * n + 4 * fq);
        float hsv[8];
#pragma unroll
        for (int i = 0; i < 8; ++i) hsv[i] = hsc[row0 + (i >> 2) * 128 + (i & 3) * 16];
        const bool dor = lat && (ropet || (akr && wc < 2));
#pragma unroll
        for (int ai = 0; ai < 2; ++ai) {
            f32x4 rt[4][2];
            if (dor) {
#pragma unroll
                for (int m = 0; m < 4; ++m) { const int s = (row0 + ai * 128 + m * 16) & (SEQ - 1), pos = (wc & 1) ? (s & 63) : (s >> 6);
                    rt[m][0] = *(const f32x4*)(rope + pos * 32 + 8 * fq); rt[m][1] = *(const f32x4*)(rope + pos * 32 + 8 * fq + 4); }
            }
#pragma unroll
            for (int m = 0; m < 4; ++m) {
                const int row = row0 + ai * 128 + m * 16; const float hs = hsv[ai * 4 + m] * ((pn == 6 || pn == 7) ? DIFF_QC : 1.0f);
#pragma unroll
                for (int bj = 0; bj < 2; ++bj) {
                    f32x4 x0, x1;
#pragma unroll
                    for (int j = 0; j < 4; ++j) { x0[j] = (float)acc[ai][bj][m][0][j] * (hs * wsv[bj][0][j]); x1[j] = (float)acc[ai][bj][m][1][j] * (hs * wsv[bj][1][j]); }
                    const bool akr_blk = akr && bj == 0 && wc < 2;
                    if (lat && (ropet || akr_blk)) rope4v(x0, x1, rt[m][0], rt[m][1]);
                    u32x2 w0, w1; w0.x = cvt_pk_bf16(x0[0], x0[1]); w0.y = cvt_pk_bf16(x0[2], x0[3]); w1.x = cvt_pk_bf16(x1[0], x1[1]); w1.y = cvt_pk_bf16(x1[2], x1[3]);
                    if (!akr) { bf16_t* o = ubuf + (size_t)row * NU + pn * 256 + bj * 128 + wc * 32 + 4 * fq; *(u32x2*)o = w0; *(u32x2*)(o + 16) = w1; }
                    else if (akr_blk) {
#pragma unroll
                        for (int h = 0; h < 4; ++h) { bf16_t* o = km + (size_t)row * 768 + h * 192 + 128 + wc * 32 + 4 * fq; *(u32x2*)o = w0; *(u32x2*)(o + 16) = w1; }
                    }
                }
            }
        }
    }
};
struct EpiQup {
    static constexpr bool PERM = false, I8 = false; typedef gm::Acc AccT; typedef f32x4 AccT_elem; bf16_t* qm; const float* rsq; const float* rope;
    template <int BJ> __device__ __forceinline__ void post(gm::Acc& acc, const gm::Unit& u, int wr, int wc, int fr, int fq) {
        const bool lat = u.pm < 128; const int row0 = u.pm * 256 + wr * 64 + fr;
        float rsv[8];
#pragma unroll
        for (int i = 0; i < 8; ++i) rsv[i] = rsq[row0 + (i >> 2) * 128 + (i & 3) * 16];
#pragma unroll
        for (int ai = 0; ai < 2; ++ai)
#pragma unroll
            for (int m = 0; m < 4; ++m) {
                const int row = row0 + ai * 128 + m * 16, s = row & (SEQ - 1); const float rs = rsv[ai * 4 + m] * MLA_QC;
#pragma unroll
                for (int bj = 0; bj < 2; ++bj) {
                    const int b32 = 8 * u.pn + 4 * bj + wc, m6 = b32 % 6;
                    f32x4 x0 = acc[ai][bj][m][0] * rs, x1 = acc[ai][bj][m][1] * rs;
                    if (lat && m6 >= 4) rope4(x0, x1, rope, (m6 == 5) ? (s & 63) : (s >> 6), fq);
                    u32x2 w0, w1; w0.x = cvt_pk_bf16(x0[0], x0[1]); w0.y = cvt_pk_bf16(x0[2], x0[3]); w1.x = cvt_pk_bf16(x1[0], x1[1]); w1.y = cvt_pk_bf16(x1[2], x1[3]);
                    bf16_t* o = qm + (size_t)row * 768 + b32 * 32 + 4 * fq; *(u32x2*)o = w0; *(u32x2*)(o + 16) = w1;
                }
            }
    }
};
struct EpiKVup {
    static constexpr bool PERM = true, I8 = false; typedef gm::Acc AccT; typedef f32x4 AccT_elem; bf16_t* km; bf16_t* vm; const float* rsk;
    template <int BJ> __device__ __forceinline__ void post(gm::Acc& acc, const gm::Unit& u, int wr, int wc, int fr, int fq) {
        const int row0 = u.pm * 256 + wr * 64 + fr, h = u.pn, c0 = wc * 32 + 8 * fq;
        float rsv[8];
#pragma unroll
        for (int i = 0; i < 8; ++i) rsv[i] = rsk[row0 + (i >> 2) * 128 + (i & 3) * 16];
#pragma unroll
        for (int ai = 0; ai < 2; ++ai)
#pragma unroll
            for (int m = 0; m < 4; ++m) {
                const int row = row0 + ai * 128 + m * 16; const float rs = rsv[ai * 4 + m];
#pragma unroll
                for (int bj = 0; bj < 2; ++bj) {
                    const f32x4 a = acc[ai][bj][m][0] * rs, b = acc[ai][bj][m][1] * rs;
                    u32x4 w; w.x = cvt_pk_bf16(a[0], a[1]); w.y = cvt_pk_bf16(a[2], a[3]); w.z = cvt_pk_bf16(b[0], b[1]); w.w = cvt_pk_bf16(b[2], b[3]);
                    if (bj == 0) *(u32x4*)(km + (size_t)row * 768 + h * 192 + c0) = w; else *(u32x4*)(vm + (size_t)row * 512 + h * 128 + c0) = w;
                }
            }
    }
};
struct EpiRG {
    static constexpr bool PERM = true, I8 = false; typedef gm::Acc AccT; typedef f32x4 AccT_elem; const bf16_t* xcv; bf16_t* la; bf16_t* bb; const float* b_r; const float* b_i; const float* sp;
    template <int BJ> __device__ __forceinline__ void post(gm::Acc& acc, const gm::Unit& u, int wr, int wc, int fr, int fq) {
        const int d = u.pn >> 2, w0 = (u.pn & 3) * 128 + wc * 32 + 8 * fq, row0 = u.pm * 256 + wr * 64 + fr;
        float br[8], bi[8], sv[8];
#pragma unroll
        for (int j = 0; j < 8; ++j) { br[j] = b_r[d * 512 + w0 + j]; bi[j] = b_i[d * 512 + w0 + j]; sv[j] = sp[d * 512 + w0 + j]; }
        u32x4 xwv[8];
#pragma unroll
        for (int i = 0; i < 8; ++i) xwv[i] = *(const u32x4*)(xcv + (size_t)(row0 + (i >> 2) * 128 + (i & 3) * 16) * 512 + w0);
#pragma unroll
        for (int ai = 0; ai < 2; ++ai)
#pragma unroll
            for (int m = 0; m < 4; ++m) {
                const int row = row0 + ai * 128 + m * 16;
                const u32x4 xw = xwv[ai * 4 + m];
                const float xv[8] = {bflo(xw.x), bfhi(xw.x), bflo(xw.y), bfhi(xw.y), bflo(xw.z), bfhi(xw.z), bflo(xw.w), bfhi(xw.w)};
                float lo[8], bo[8];
#pragma unroll
                for (int n = 0; n < 2; ++n)
#pragma unroll
                    for (int j = 0; j < 4; ++j) {
                        const int k = n * 4 + j;
                        const float r = sigmoidf_(acc[ai][0][m][n][j] + br[k]), ig = sigmoidf_(acc[ai][1][m][n][j] + bi[k]);
                        const float l_a = -8.0f * r * sv[k], x2 = 2.0f * l_a;
                        const float om = (x2 > -0.3f) ? (-x2 * (1.0f + x2 * (0.5f + x2 * (0.16666667f + x2 * (0.041666668f + x2 * 0.0083333338f))))) : (1.0f - __expf(x2));
                        lo[k] = l_a; bo[k] = __builtin_amdgcn_sqrtf(om) * ig * xv[k];
                    }
                u32x4 wl, wb;
                wl.x = cvt_pk_bf16(lo[0], lo[1]); wl.y = cvt_pk_bf16(lo[2], lo[3]); wl.z = cvt_pk_bf16(lo[4], lo[5]); wl.w = cvt_pk_bf16(lo[6], lo[7]);
                wb.x = cvt_pk_bf16(bo[0], bo[1]); wb.y = cvt_pk_bf16(bo[2], bo[3]); wb.z = cvt_pk_bf16(bo[4], bo[5]); wb.w = cvt_pk_bf16(bo[6], bo[7]);
                *(u32x4*)(la + (size_t)row * 1024 + d * 512 + w0) = wl; *(u32x4*)(bb + (size_t)row * 1024 + d * 512 + w0) = wb;
            }
    }
};
struct EpiMergeG {
    static constexpr bool PERM = true, I8 = true; typedef gm::AccI AccT; typedef i32x4 AccT_elem; bf16_t* gtmp; const float* mb; const float* hsc; const float* wgs; bool bal; bf16_t* gx;
    template <int BJ> __device__ __forceinline__ void post(gm::AccI& acc, const gm::Unit& u, int wr, int wc, int fr, int fq) {
        const int col0 = u.pn * 256 + wc * 32 + 8 * fq, row0 = u.pm * 256 + wr * 64 + fr, nbr = u.tag;
        const bool ex = bal && u.pm >= 128; bf16_t* go = ex ? gx : gtmp; const int orow0 = ex ? nbr * 512 + row0 - MLAT : row0;
        f32x4 bv[2][2], sv[2][2];
#pragma unroll
        for (int bj = 0; bj < 2; ++bj)
#pragma unroll
            for (int n = 0; n < 2; ++n) { bv[bj][n] = *(const f32x4*)(mb + nbr * DM + col0 + bj * 128 + 4 * n); sv[bj][n] = *(const f32x4*)(wgs + nbr * DM + col0 + bj * 128 + 4 * n); }
        float hsv[8];
#pragma unroll
        for (int i = 0; i < 8; ++i) hsv[i] = hsc[row0 + (i >> 2) * 128 + (i & 3) * 16];
#pragma unroll
        for (int ai = 0; ai < 2; ++ai)
#pragma unroll
            for (int m = 0; m < 4; ++m) { const float hs = hsv[ai * 4 + m];
#pragma unroll
                for (int bj = 0; bj < 2; ++bj) { float g[8];
#pragma unroll
                    for (int n = 0; n < 2; ++n)
#pragma unroll
                        for (int j = 0; j < 4; ++j) g[n * 4 + j] = sigmoidf_((float)acc[ai][bj][m][n][j] * (hs * sv[bj][n][j]) + bv[bj][n][j]);
                    u32x4 w; w.x = cvt_pk_bf16(g[0], g[1]); w.y = cvt_pk_bf16(g[2], g[3]); w.z = cvt_pk_bf16(g[4], g[5]); w.w = cvt_pk_bf16(g[6], g[7]);
                    *(u32x4*)(go + (size_t)(orow0 + ai * 128 + m * 16) * DM + col0 + bj * 128) = w; } }
    }
};
struct EpiMergeY {
    static constexpr bool PERM = true, I8 = false; typedef gm::Acc AccT; typedef f32x4 AccT_elem; bf16_t* mrg; const bf16_t* gtmp; bool bal; const bf16_t* gx; bf16_t* part;
    template <int BJ> __device__ __forceinline__ void post(gm::Acc& acc, const gm::Unit& u, int wr, int wc, int fr, int fq) {
        const int col0 = u.pn * 256 + wc * 32 + 8 * fq, row0 = u.pm * 256 + wr * 64 + fr, nbr = u.tag;
        const bool ex = bal && u.pm >= 128; const bf16_t* gi = ex ? gx : gtmp; bf16_t* mo = ex ? part : mrg; const int orow0 = ex ? nbr * 512 + row0 - MLAT : row0;
        const bool rd = nbr > 0 && !ex;
#pragma unroll
        for (int ai = 0; ai < 2; ++ai) {
            u32x4 gwv[4][2], mwv[4][2];
#pragma unroll
            for (int m = 0; m < 4; ++m)
#pragma unroll
                for (int bj = 0; bj < 2; ++bj) { const size_t off = (size_t)(orow0 + ai * 128 + m * 16) * DM + col0 + bj * 128;
                    gwv[m][bj] = *(const u32x4*)(gi + off); mwv[m][bj] = (u32x4){0u, 0u, 0u, 0u}; if (rd) mwv[m][bj] = *(const u32x4*)(mo + off); }
#pragma unroll
            for (int m = 0; m < 4; ++m)
#pragma unroll
                for (int bj = 0; bj < 2; ++bj) {
                    const size_t off = (size_t)(orow0 + ai * 128 + m * 16) * DM + col0 + bj * 128;
                    const u32x4 gw = gwv[m][bj], mw = mwv[m][bj];
                    const float g[8] = {bflo(gw.x), bfhi(gw.x), bflo(gw.y), bfhi(gw.y), bflo(gw.z), bfhi(gw.z), bflo(gw.w), bfhi(gw.w)};
                    float mm[8] = {bflo(mw.x), bfhi(mw.x), bflo(mw.y), bfhi(mw.y), bflo(mw.z), bfhi(mw.z), bflo(mw.w), bfhi(mw.w)};
#pragma unroll
                    for (int n = 0; n < 2; ++n)
#pragma unroll
                        for (int j = 0; j < 4; ++j) mm[n * 4 + j] += g[n * 4 + j] * acc[ai][bj][m][n][j];
                    u32x4 w; w.x = cvt_pk_bf16(mm[0], mm[1]); w.y = cvt_pk_bf16(mm[2], mm[3]); w.z = cvt_pk_bf16(mm[4], mm[5]); w.w = cvt_pk_bf16(mm[6], mm[7]);
                    *(u32x4*)(mo + off) = w;
                }
        }
    }
};


struct KP { const float* in[30]; float* out; unsigned char* ws; int ph_lo, ph_hi; };
typedef const __attribute__((address_space(4))) KP CKP;
__device__ __forceinline__ LAS unsigned char* lds_here(unsigned char* raw) { unsigned a = (unsigned)(uintptr_t)(LAS unsigned char*)raw; asm volatile("" : "+s"(a)); return (LAS unsigned char*)(uintptr_t)a; }
__device__ __forceinline__ CKP& kp_here() { CKP* q = (CKP*)__builtin_amdgcn_kernarg_segment_ptr(); asm volatile("" : "+s"(q)); return *q; }
enum { I_X = 0, I_C, I_CTX, I_CCTX, I_ADAW, I_ADAB, I_PRE, I_POST, I_WG, I_WU, I_WDN, I_WIN, I_QNORM, I_WUQ, I_KVNORM, I_WUKV, I_CONVW, I_CONVB, I_RGWR, I_RGBR, I_RGWI, I_RGBI, I_RGLAM,
       I_DLAM, I_SUBLN, I_HLB, I_HNORM, I_MB, I_WBR, I_WOUT };

__device__ __forceinline__ void job_mod(CKP& p, LAS unsigned char* lds) {
    LAS float* sl = (LAS float*)lds;
    LAS float* red = (LAS float*)(lds + 24576);
    const int tid = otid(), lane = tid & 63, wave = tid >> 6;
    for (int i = tid; i < 3 * DM; i += NTHR) { const int g = i / DM, k = i % DM; const float c = g < 2 ? p.in[I_C][g * DM + k] : p.in[I_CCTX][k]; sl[i] = siluf_(c); }
    __syncthreads();
    float* mod = (float*)(p.ws + WS_MOD);
    for (int u = obid(); u < NL * 288; u += gridDim.x) {
        const int l = u / 288, col = (u % 288) * 64 + lane;
        const float* w = p.in[I_ADAW] + (size_t)l * DM * (NMOD * DM) + col;
        float a0 = 0.f, a1 = 0.f, a2 = 0.f;
        const int k0 = wave * 256;
#pragma unroll 1
        for (int k1 = k0; k1 < k0 + 256; k1 += 32) { float wv[32];
#pragma unroll
            for (int q = 0; q < 32; ++q) wv[q] = w[(size_t)(k1 + q) * (NMOD * DM)];
            asm volatile("" ::: "memory");
#pragma unroll
            for (int q = 0; q < 32; ++q) { const int k = k1 + q; a0 += sl[k] * wv[q]; a1 += sl[DM + k] * wv[q]; a2 += sl[2 * DM + k] * wv[q]; } }
        red[(wave * 3 + 0) * 64 + lane] = a0; red[(wave * 3 + 1) * 64 + lane] = a1; red[(wave * 3 + 2) * 64 + lane] = a2;
        __syncthreads();
        if (tid < 192) { const int g = tid >> 6; float s = 0.f;
#pragma unroll
            for (int w8 = 0; w8 < 8; ++w8) s += red[(w8 * 3 + g) * 64 + lane];
            mod[(size_t)(l * 3 + g) * (NMOD * DM) + col] = s + p.in[I_ADAB][l * (NMOD * DM) + col]; }
        __syncthreads();
    }
}
__device__ __forceinline__ void job_tables(CKP& p) {
    const int tid = otid();
    if (obid() == 0) {
        float* rope = (float*)(p.ws + WS_ROPE);
        for (int i = tid; i < 4096; i += NTHR) { const int pos = i >> 4, f = i & 15; const float inv = powf(10000.0f, -(float)f / 16.0f); const float ang = (float)pos * inv; float s, c; sincosf(ang, &s, &c); rope[2 * i] = c; rope[2 * i + 1] = s; }
    }
    if (obid() == 1 % gridDim.x) {
        float* sc = (float*)(p.ws + WS_SCAL);
        if (tid < NL) { const float* lv = p.in[I_DLAM] + tid * 256; float s01 = 0.f, s23 = 0.f; for (int i = 0; i < 64; ++i) { s01 += lv[i] * lv[64 + i]; s23 += lv[128 + i] * lv[192 + i]; }
            sc[tid] = expf(s01) - expf(s23) + (0.8f - 0.6f * expf(-0.3f * (float)tid)); }
        for (int k = tid; k < 512; k += NTHR) {
            float mx = -1e30f; for (int l = 0; l < NL; ++l) mx = fmaxf(mx, p.in[I_HLB][l * 512 + k]);
            float den = 0.f; for (int l = 0; l < NL; ++l) den += expf(p.in[I_HLB][l * 512 + k] - mx);
            float cum = 0.f; for (int l = 0; l < NL; ++l) { if (l > 0) cum += expf(p.in[I_HLB][l * 512 + k] - mx) / den; sc[256 + l * 512 + k] = cum; }
        }
        for (int i = tid; i < NL * 1024; i += NTHR) { const float x = -p.in[I_RGLAM][i]; sc[2048 + i] = fmaxf(x, 0.f) + log1pf(expf(-fabsf(x))); }
    }
}

__device__ __forceinline__ void job_colmax(CKP& p) {
    unsigned* cmax = (unsigned*)(p.ws + WS_CMAX);
    const int tid = otid(), c4 = (tid & 63) * 4, wv = tid >> 6;
    for (int u = obid(); u < NL * 2 * 2 * 22 * 4; u += gridDim.x) {
        const int kc = u & 3, cb = (u >> 2) % 22, mat = u / (4 * 22), which = mat & 1, lf = mat >> 1;
        const float* w = (which ? p.in[I_WU] : p.in[I_WG]) + (size_t)lf * DM * DFF + (size_t)(kc * 512 + wv * 64) * DFF + cb * 256 + c4;
        u32x4 mx = {0u, 0u, 0u, 0u};
#pragma unroll 1
        for (int k0 = 0; k0 < 64; k0 += 16) { u32x4 v[16];
#pragma unroll
            for (int k = 0; k < 16; ++k) v[k] = *(const u32x4*)(w + (size_t)(k0 + k) * DFF);
            asm volatile("" ::: "memory");
#pragma unroll
            for (int k = 0; k < 16; ++k) { mx.x = max(mx.x, v[k].x & 0x7fffffffu); mx.y = max(mx.y, v[k].y & 0x7fffffffu); mx.z = max(mx.z, v[k].z & 0x7fffffffu); mx.w = max(mx.w, v[k].w & 0x7fffffffu); } }
        unsigned* dst = cmax + (size_t)(lf * 2 + which) * DFF + cb * 256 + c4;
        atomicMax(dst, mx.x); atomicMax(dst + 1, mx.y); atomicMax(dst + 2, mx.z); atomicMax(dst + 3, mx.w);
    }
    unsigned* cmax2 = (unsigned*)(p.ws + WS_CMAX2);
    for (int u = obid(); u < NL * 56 * 4; u += gridDim.x) {
        const int kc = u & 3, cb = (u >> 2) % 56, l = u / (4 * 56), cc = cb * 256 + c4;
        if (cc < DIN) {
            const float* w = p.in[I_WIN] + (size_t)l * DM * DIN + (size_t)(kc * 512 + wv * 64) * DIN + cc;
            u32x4 mx = {0u, 0u, 0u, 0u};
#pragma unroll 1
            for (int k0 = 0; k0 < 64; k0 += 16) { u32x4 v[16];
#pragma unroll
                for (int k = 0; k < 16; ++k) v[k] = *(const u32x4*)(w + (size_t)(k0 + k) * DIN);
                asm volatile("" ::: "memory");
#pragma unroll
                for (int k = 0; k < 16; ++k) { mx.x = max(mx.x, v[k].x & 0x7fffffffu); mx.y = max(mx.y, v[k].y & 0x7fffffffu); mx.z = max(mx.z, v[k].z & 0x7fffffffu); mx.w = max(mx.w, v[k].w & 0x7fffffffu); } }
            unsigned* dst = cmax2 + (size_t)l * 14336 + cc;
            atomicMax(dst, mx.x); atomicMax(dst + 1, mx.y); atomicMax(dst + 2, mx.z); atomicMax(dst + 3, mx.w);
        }
    }
}
struct CvtDesc { const float* src; const float* ks; bf16_t* dst; int ldsrc, c0, k0, lddst, n0; const unsigned* q8max; float* q8scale; };
__device__ __forceinline__ void cvt_load(const CvtDesc& d, int tid, f32x4 (&v)[2]) {
    const int r = tid >> 4, c4 = (tid & 15) * 4;
#pragma unroll
    for (int ps = 0; ps < 2; ++ps) { const int k = r + 32 * ps; v[ps] = (f32x4){0.f, 0.f, 0.f, 0.f};
        if (d.src) { v[ps] = *(const f32x4*)(d.src + (size_t)(d.k0 + k) * d.ldsrc + d.c0 + c4); if (d.ks) v[ps] = v[ps] * d.ks[d.k0 + k]; } }
}
__device__ __forceinline__ void cvt_store(LAS float* tile, const CvtDesc& d, int tid, const f32x4 (&v)[2]) {
    { const int r = tid >> 4, c4 = (tid & 15) * 4;
#pragma unroll
      for (int ps = 0; ps < 2; ++ps) { const int k = r + 32 * ps; tile[k * 65 + c4 + 0] = v[ps][0]; tile[k * 65 + c4 + 1] = v[ps][1]; tile[k * 65 + c4 + 2] = v[ps][2]; tile[k * 65 + c4 + 3] = v[ps][3]; } }
    __syncthreads();
    { const int n = tid >> 3, k8 = (tid & 7) * 8; float x[8];
#pragma unroll
      for (int i = 0; i < 8; ++i) x[i] = tile[(k8 + i) * 65 + n];
      if (d.q8max) {
          const float mx = fmaxf(__uint_as_float(d.q8max[n]), 1e-30f), inv = 127.0f / mx;
          int q[8];
#pragma unroll
          for (int i = 0; i < 8; ++i) q[i] = (int)rintf(x[i] * inv) & 0xff;
          u32x2 w; w.x = (unsigned)q[0] | ((unsigned)q[1] << 8) | ((unsigned)q[2] << 16) | ((unsigned)q[3] << 24); w.y = (unsigned)q[4] | ((unsigned)q[5] << 8) | ((unsigned)q[6] << 16) | ((unsigned)q[7] << 24);
          *(u32x2*)((signed char*)d.dst + (size_t)(d.n0 + n) * d.lddst + d.k0 + k8) = w;
          if (d.k0 == 0 && k8 == 0) d.q8scale[n] = mx * (1.0f / 127.0f);
      } else {
          u32x4 w; w.x = cvt_pk_bf16(x[0], x[1]); w.y = cvt_pk_bf16(x[2], x[3]); w.z = cvt_pk_bf16(x[4], x[5]); w.w = cvt_pk_bf16(x[6], x[7]);
          *(u32x4*)(d.dst + (size_t)(d.n0 + n) * d.lddst + d.k0 + k8) = w; } }
    __syncthreads();
}
constexpr int CV_N0 = 2 * 176 * 32, CV_N1 = 2 * 32 * 88, CV_N2 = 224 * 32, CV_N3 = 12 * 8, CV_N4 = 16 * 4, CV_N5 = 4 * 32 * 8, CV_N6 = 32 * 32, CV_N7 = 1024;
constexpr int CV_BLOCKS = CV_N0 + CV_N1 + CV_N2 + CV_N3 + CV_N4 + CV_N5 + CV_N6;
__device__ __forceinline__ CvtDesc cvt_desc(CKP& p, int l, int b) {
    unsigned char* ws = p.ws; CvtDesc d; d.ks = nullptr; d.q8max = nullptr; d.q8scale = nullptr;
    if (b < CV_N0) { const int f = b / (176 * 32), rem = b % (176 * 32), nb = rem / 32, kb = rem % 32, t = nb >> 2, q = nb & 3;
        d.src = (q < 2 ? p.in[I_WG] : p.in[I_WU]) + (size_t)(l * 2 + f) * DM * DFF; d.ldsrc = DFF; d.c0 = 128 * t + (q & 1) * 64; d.k0 = kb * 64; d.dst = (bf16_t*)(ws + WS_WGU + (size_t)f * 11264 * 2048); d.lddst = 2048; d.n0 = nb * 64;
        d.q8max = (const unsigned*)(ws + WS_CMAX) + (size_t)((l * 2 + f) * 2 + (q < 2 ? 0 : 1)) * DFF + d.c0; d.q8scale = (float*)(ws + WS_WSC) + (size_t)f * 11264 + d.n0; return d; }
    b -= CV_N0;
    if (b < CV_N1) { const int f = b / (32 * 88), rem = b % (32 * 88), nb = rem / 88, kb = rem % 88;
        d.src = p.in[I_WDN] + (size_t)(l * 2 + f) * DFF * DM; d.ldsrc = DM; d.c0 = nb * 64; d.k0 = kb * 64; d.dst = (bf16_t*)(ws + WS_WD) + (size_t)f * 2048 * 5632; d.lddst = 5632; d.n0 = nb * 64; return d; }
    b -= CV_N1;
    if (b < CV_N2) { const int nb = b / 32, kb = b % 32, j0 = nb * 64; int sc;
        if (j0 < 512) sc = j0; else if (j0 < 5632) sc = 832 + (j0 - 512); else if (j0 < 5888) sc = 512 + (j0 - 5632); else if (j0 < 5952) sc = 768 + (j0 - 5888); else if (j0 < 6144) sc = -1; else sc = 5952 + (j0 - 6144);
        d.src = sc < 0 ? nullptr : p.in[I_WIN] + (size_t)l * DM * DIN; d.ldsrc = DIN; d.c0 = sc < 0 ? 0 : sc; d.k0 = kb * 64; d.dst = (bf16_t*)(ws + WS_WIN); d.lddst = 2048; d.n0 = j0;
        d.q8max = (const unsigned*)(ws + WS_CMAX2) + (size_t)l * 14336 + (sc < 0 ? DIN : sc);
        d.q8scale = j0 < 6144 ? (float*)(ws + WS_WPS) + j0 : (float*)(ws + WS_WGS) + (j0 - 6144);
        return d; }
    b -= CV_N2;
    if (b < CV_N3) { const int nb = b / 8, kb = b % 8;
        d.src = p.in[I_WUQ] + (size_t)l * 512 * 768; d.ldsrc = 768; d.c0 = nb * 64; d.k0 = kb * 64; d.ks = p.in[I_QNORM] + l * 512; d.dst = (bf16_t*)(ws + WS_WUQ); d.lddst = 512; d.n0 = nb * 64; return d; }
    b -= CV_N3;
    if (b < CV_N4) { const int nb = b / 4, kb = b % 4;
        d.src = p.in[I_WUKV] + (size_t)l * 256 * 1024; d.ldsrc = 1024; d.c0 = nb * 64; d.k0 = kb * 64; d.ks = p.in[I_KVNORM] + l * 256; d.dst = (bf16_t*)(ws + WS_WUKV); d.lddst = 256; d.n0 = nb * 64; return d; }
    b -= CV_N4;
    if (b < CV_N5) { const int n = b / 256, rem = b % 256, nb = rem / 8, kb = rem % 8;
        d.src = p.in[I_WBR] + (size_t)(l * 4 + n) * 512 * DM; d.ldsrc = DM; d.c0 = nb * 64; d.k0 = kb * 64; d.dst = (bf16_t*)(ws + WS_WBR) + (size_t)n * 2048 * 512; d.lddst = 512; d.n0 = nb * 64; return d; }
    b -= CV_N5;
    { const int nb = b / 32, kb = b % 32;
        d.src = p.in[I_WOUT] + (size_t)l * DM * DM; d.ldsrc = DM; d.c0 = nb * 64; d.k0 = kb * 64; d.dst = (bf16_t*)(ws + WS_WOUT); d.lddst = 2048; d.n0 = nb * 64; return d; }
}
__device__ __forceinline__ void job_convert(CKP& p, LAS unsigned char* lds, int l) {
    LAS float* tile = (LAS float*)lds;
    const int tid = otid();
    {
        int u = obid();
        if (u < CV_BLOCKS) {
            f32x4 vc[2]; { const CvtDesc d0 = cvt_desc(p, l, u); cvt_load(d0, tid, vc); }
            for (;;) {
                const int un = u + gridDim.x; const bool more = un < CV_BLOCKS;
                f32x4 vn[2] = {vc[0], vc[1]};
                if (more) { const CvtDesc dn = cvt_desc(p, l, un); cvt_load(dn, tid, vn); }
                { const CvtDesc dc = cvt_desc(p, l, u); cvt_store(tile, dc, tid, vc); }
                if (!more) break;
                vc[0] = vn[0]; vc[1] = vn[1]; u = un;
            }
        }
    }
    for (int b = obid(); b < CV_N7; b += gridDim.x) {
        bf16_t* dst = (bf16_t*)(p.ws + WS_WRG);
#pragma unroll
        for (int e = 0; e < 2; ++e) { const int idx = b * 1024 + e * 512 + tid, o = idx >> 9, k = idx & 511;
            const int t8 = o >> 8, d = t8 >> 2, blk = t8 & 3, g = (o >> 7) & 1, i = o & 127, kin = k - blk * 128;
            float v = 0.f; if (kin >= 0 && kin < 128) v = (g ? p.in[I_RGWI] : p.in[I_RGWR])[((size_t)((l * 2 + d) * 4 + blk) * 128 + kin) * 128 + i];
            dst[idx] = f2bf(v); }
    }
}

struct RNArgs {
    const float* xs_lat; const float* xs_ctx; float* xd_lat; float* xd_ctx;
    const bf16_t* y; float wres;
    const float* modl_res; int jres; const float* postg;
    bool do_norm; const float* modl_norm; int jn; const float* preg; bf16_t* h; int nrows; signed char* h8; float* hsc;
};
__device__ __forceinline__ void job_resnorm(const RNArgs& a, LAS unsigned char* lds) {
    const int tid_ = otid(); const int lane = tid_ & 63, gw = obid() * 8 + (tid_ >> 6), nw = gridDim.x * 8;
    LAS float* PA = (LAS float*)lds; LAS float* PB = PA + 3 * DM; LAS float* PC = PB + 3 * DM;
    for (int i = tid_; i < 3 * DM; i += NTHR) { const int g = i / DM, c = i % DM;
        if (a.y) PA[i] = a.modl_res[(size_t)g * (NMOD * DM) + (3 * a.jres + 2) * DM + c] * a.postg[c];
        if (a.do_norm) { const float* sh = a.modl_norm + (size_t)g * (NMOD * DM) + (3 * a.jn) * DM; PB[i] = a.preg[c] * (sh[DM + c] + 1.0f); PC[i] = sh[c]; } }
    __syncthreads();
    f32x4 xq[8]; u32x2 yq[8];
#define RN_LOAD(R, X, Y) do { const int r_ = (R); const float* xs_ = r_ < MLAT ? a.xs_lat + (size_t)r_ * DM : a.xs_ctx + (size_t)(r_ - MLAT) * DM; \
        _Pragma("unroll") for (int i = 0; i < 8; ++i) X[i] = *(const f32x4*)(xs_ + i * 256 + lane * 4); \
        if (a.y) { _Pragma("unroll") for (int i = 0; i < 8; ++i) Y[i] = *(const u32x2*)(a.y + (size_t)r_ * DM + i * 256 + lane * 4); } } while (0)
    if (gw < a.nrows) RN_LOAD(gw, xq, yq);
    for (int r = gw; r < a.nrows; r += nw) {
        const int g = r < SEQ ? 0 : (r < MLAT ? 1 : 2); const bool lat = r < MLAT;
        f32x4 x[8]; u32x2 yr[8];
#pragma unroll
        for (int i = 0; i < 8; ++i) { x[i] = xq[i]; yr[i] = yq[i]; }
        RN_LOAD(r + nw < a.nrows ? r + nw : r, xq, yq);
        if (a.y) {
            f32x4 yv[8]; float ss = 0.f;
#pragma unroll
            for (int i = 0; i < 8; ++i) { const u32x2 w = yr[i]; yv[i] = (f32x4){bflo(w.x), bfhi(w.x), bflo(w.y), bfhi(w.y)}; ss += yv[i][0] * yv[i][0] + yv[i][1] * yv[i][1] + yv[i][2] * yv[i][2] + yv[i][3] * yv[i][3]; }
            ss = wave_sum(ss, lane);
            const float rr = a.wres * rsqrtf(ss * (1.0f / DM) + EPS);
            float* xd = lat ? a.xd_lat + (size_t)r * DM : a.xd_ctx + (size_t)(r - MLAT) * DM;
#pragma unroll
            for (int i = 0; i < 8; ++i) { const int c = i * 256 + lane * 4; const f32x4 gp = *(const LAS f32x4*)(PA + g * DM + c);
                x[i] = x[i] + gp * (yv[i] * rr); *(f32x4*)(xd + c) = x[i]; }
        }
        if (a.do_norm) {
            float ss = 0.f;
#pragma unroll
            for (int i = 0; i < 8; ++i) ss += x[i][0] * x[i][0] + x[i][1] * x[i][1] + x[i][2] * x[i][2] + x[i][3] * x[i][3];
            ss = wave_sum(ss, lane);
            const float rr = rsqrtf(ss * (1.0f / DM) + EPS);
            float mx = 0.f;
#pragma unroll
            for (int i = 0; i < 8; ++i) { const int c = i * 256 + lane * 4; const f32x4 ps = *(const LAS f32x4*)(PB + g * DM + c), hv = *(const LAS f32x4*)(PC + g * DM + c);
                x[i] = (x[i] * rr) * ps + hv; mx = fmaxf(mx, fmaxf(fmaxf(fabsf(x[i][0]), fabsf(x[i][1])), fmaxf(fabsf(x[i][2]), fabsf(x[i][3]))));
                if (a.h) { u32x2 w; w.x = cvt_pk_bf16(x[i][0], x[i][1]); w.y = cvt_pk_bf16(x[i][2], x[i][3]); *(u32x2*)(a.h + (size_t)r * DM + c) = w; } }
            if (a.h8) {
#pragma unroll
                for (int o = 32; o >= 1; o >>= 1) mx = fmaxf(mx, shx(mx, o, lane));
                mx = fmaxf(mx, 1e-30f); const float inv = 127.0f / mx;
                if (lane == 0) a.hsc[r] = mx * (1.0f / 127.0f);
#pragma unroll
                for (int i = 0; i < 8; ++i) { const unsigned q0 = (unsigned)((int)rintf(x[i][0] * inv) & 0xff), q1 = (unsigned)((int)rintf(x[i][1] * inv) & 0xff), q2 = (unsigned)((int)rintf(x[i][2] * inv) & 0xff), q3 = (unsigned)((int)rintf(x[i][3] * inv) & 0xff);
                    *(unsigned*)(a.h8 + (size_t)r * DM + i * 256 + lane * 4) = q0 | (q1 << 8) | (q2 << 16) | (q3 << 24); }
            }
        }
    }
    __syncthreads();
#undef RN_LOAD
}

__device__ __forceinline__ void job_stats_conv(CKP& p, int l) {
    const bf16_t* ubuf = (const bf16_t*)(p.ws + WS_R1); float* rsq = (float*)(p.ws + WS_RSQ); float* rsk = rsq + MALL; bf16_t* xcv = (bf16_t*)(p.ws + WS_XCV);
    const int tid_ = otid(); const int lane = tid_ & 63, gw = obid() * 8 + (tid_ >> 6), nw = gridDim.x * 8;
    float cw[4][8], cb[8];
#pragma unroll
    for (int j = 0; j < 4; ++j)
#pragma unroll
        for (int i = 0; i < 8; ++i) cw[j][i] = p.in[I_CONVW][(l * 4 + j) * 512 + lane * 8 + i];
#pragma unroll
    for (int i = 0; i < 8; ++i) cb[i] = p.in[I_CONVB][l * 512 + lane * 8 + i];
    for (int r = gw; r < MALL; r += nw) {
        const bf16_t* ur = ubuf + (size_t)r * NU;
        const bool lat = r < MLAT; const int s = lat ? (r & (SEQ - 1)) : ((r - MLAT) & (CTXL - 1)), len = lat ? SEQ : CTXL;
        const u32x4 w = *(const u32x4*)(ur + U_AQ + lane * 8); const u32x4 w2 = *(const u32x4*)(ur + U_AKV + (lane & 31) * 8);
        u32x4 wt[4]; float okf[4];
#pragma unroll
        for (int j = 0; j < 4; ++j) { const int sj = s + j - 2; const bool ok = sj >= 0 && sj < len; okf[j] = ok ? 1.0f : 0.0f;
            wt[j] = *(const u32x4*)(ur + (ptrdiff_t)(ok ? j - 2 : 0) * NU + U_BX + lane * 8); }
        asm volatile("" ::: "memory");
        {
            float ss = 0.f;
            { const float v[8] = {bflo(w.x), bfhi(w.x), bflo(w.y), bfhi(w.y), bflo(w.z), bfhi(w.z), bflo(w.w), bfhi(w.w)};
#pragma unroll
              for (int i = 0; i < 8; ++i) ss += v[i] * v[i]; }
            ss = wave_sum(ss, lane);
            float s2 = 0.f;
            { const float v[8] = {bflo(w2.x), bfhi(w2.x), bflo(w2.y), bfhi(w2.y), bflo(w2.z), bfhi(w2.z), bflo(w2.w), bfhi(w2.w)};
#pragma unroll
              for (int i = 0; i < 8; ++i) s2 += v[i] * v[i]; }
            s2 = lane < 32 ? s2 : 0.f;
            s2 = wave_sum(s2, lane);
            if (lane == 0) { rsq[r] = rsqrtf(ss * (1.0f / 512.0f) + EPS); rsk[r] = rsqrtf(s2 * (1.0f / 256.0f) + EPS); }
        }
        {
            float acc[8];
#pragma unroll
            for (int i = 0; i < 8; ++i) acc[i] = cb[i];
#pragma unroll
            for (int j = 0; j < 4; ++j) { const u32x4 wj = wt[j];
                const float v[8] = {bflo(wj.x), bfhi(wj.x), bflo(wj.y), bfhi(wj.y), bflo(wj.z), bfhi(wj.z), bflo(wj.w), bfhi(wj.w)};
#pragma unroll
                for (int i = 0; i < 8; ++i) acc[i] += (cw[j][i] * okf[j]) * v[i]; }
            u32x4 o; o.x = cvt_pk_bf16(acc[0], acc[1]); o.y = cvt_pk_bf16(acc[2], acc[3]); o.z = cvt_pk_bf16(acc[4], acc[5]); o.w = cvt_pk_bf16(acc[6], acc[7]);
            *(u32x4*)(xcv + (size_t)r * 512 + lane * 8) = o;
        }
    }
}

__device__ __forceinline__ void job_rg_scan1(CKP& p) {
    const bf16_t* la = (const bf16_t*)(p.ws + WS_LA); const bf16_t* bb = (const bf16_t*)(p.ws + WS_BB); f32x2* rgs = (f32x2*)(p.ws + WS_RGS);
    const int w = otid();
    for (int u = obid(); u < NRT * 2; u += gridDim.x) {
        const int pm = u >> 1, d = u & 1;
        const bf16_t* lp = la + (size_t)pm * 256 * 1024 + d * 512 + w; const bf16_t* bp = bb + (size_t)pm * 256 * 1024 + d * 512 + w;
        float H = 0.f, sl = 0.f;
#pragma unroll 1
        for (int i0 = 0; i0 < 256; i0 += 32) { bf16_t lr[32], br[32];
#pragma unroll
            for (int q = 0; q < 32; ++q) { const int t = d ? 255 - (i0 + q) : i0 + q; lr[q] = lp[(size_t)t * 1024]; br[q] = bp[(size_t)t * 1024]; }
            asm volatile("" ::: "memory");
#pragma unroll
            for (int q = 0; q < 32; ++q) { const float lv = bf2f(lr[q]); H = __expf(lv) * H + bf2f(br[q]); sl += lv; } }
        rgs[(size_t)u * 512 + w] = (f32x2){__expf(sl), H};
    }
}
__device__ __forceinline__ void job_rg_out(CKP& p, int ntiles) {
    const bf16_t* la = (const bf16_t*)(p.ws + WS_LA); const bf16_t* bb = (const bf16_t*)(p.ws + WS_BB); const f32x2* rgs = (const f32x2*)(p.ws + WS_RGS);
    bf16_t* hf = (bf16_t*)(p.ws + WS_XCV); const bf16_t* ubuf = (const bf16_t*)(p.ws + WS_R1); bf16_t* yb = (bf16_t*)(p.ws + WS_YBR) + (size_t)1 * MALL * 512;
    const int w = otid();
    for (int u = obid(); u < ntiles; u += gridDim.x) {
        const int pm = (int)gridDim.x > ntiles ? u : u;
        const bool isctx = pm >= 128; const int b = isctx ? pm - 128 : (pm >> 6);
        float h = 0.f;
        if (!isctx) { h = rgs[(size_t)((128 + b) * 2 + 0) * 512 + w][1];
#pragma unroll 1
            for (int q0 = b * 64; q0 < pm; q0 += 16) { f32x2 sv[16];
#pragma unroll
                for (int k = 0; k < 16; ++k) { const int q = q0 + k < pm ? q0 + k : pm - 1; sv[k] = rgs[(size_t)(q * 2 + 0) * 512 + w]; }
                asm volatile("" ::: "memory");
#pragma unroll
                for (int k = 0; k < 16; ++k) if (q0 + k < pm) h = sv[k][0] * h + sv[k][1]; } }
        const size_t r0 = (size_t)pm * 256;
#pragma unroll 1
        for (int t0 = 0; t0 < 256; t0 += 64) { bf16_t lr[64], br[64];
#pragma unroll
            for (int k = 0; k < 64; ++k) { lr[k] = la[(r0 + t0 + k) * 1024 + w]; br[k] = bb[(r0 + t0 + k) * 1024 + w]; }
            asm volatile("" ::: "memory");
#pragma unroll
            for (int k = 0; k < 64; ++k) { h = __expf(bf2f(lr[k])) * h + bf2f(br[k]); hf[(r0 + t0 + k) * 512 + w] = f2bf(h); } }
        float hb = 0.f;
        if (!isctx) { hb = rgs[(size_t)((128 + b) * 2 + 1) * 512 + w][1];
#pragma unroll 1
            for (int q0 = b * 64 + 63; q0 > pm; q0 -= 16) { f32x2 sv[16];
#pragma unroll
                for (int k = 0; k < 16; ++k) { const int q = q0 - k > pm ? q0 - k : pm + 1; sv[k] = rgs[(size_t)(q * 2 + 1) * 512 + w]; }
                asm volatile("" ::: "memory");
#pragma unroll
                for (int k = 0; k < 16; ++k) if (q0 - k > pm) hb = sv[k][0] * hb + sv[k][1]; } }
#pragma unroll 1
        for (int i0 = 0; i0 < 256; i0 += 32) { bf16_t lr[32], br[32], gr[32], fr[32];
#pragma unroll
            for (int k = 0; k < 32; ++k) { const size_t t = r0 + 255 - i0 - k; lr[k] = la[t * 1024 + 512 + w]; br[k] = bb[t * 1024 + 512 + w]; gr[k] = ubuf[t * NU + U_BG + w]; fr[k] = hf[t * 512 + w]; }
#pragma unroll
            for (int k = 0; k < 32; ++k) { const size_t t = r0 + 255 - i0 - k; hb = __expf(bf2f(lr[k])) * hb + bf2f(br[k]); yb[t * 512 + w] = f2bf((bf2f(fr[k]) + hb) * gelu_tanh(bf2f(gr[k]))); } }
    }
}

namespace at {
constexpr float THR2 = 8.f * 1.4426950408889634f;
__device__ __forceinline__ int crow(int r, int hi) { return (r & 3) + 8 * (r >> 2) + 4 * hi; }
__device__ __forceinline__ unsigned cvtpk(float lo, float hi) { return cvt_pk_bf16(lo, hi); }
__device__ __forceinline__ int v_rd_base(int lane) { return ((lane & 3) << 3) | (((lane >> 2) & 3) << 6) | (((lane >> 4) & 1) << 5) | (((lane >> 5) & 1) << 8); }
constexpr int v_rd_off(int d0, int ks, int half) { return d0 * 512 + ks * 4096 + half * 2048; }
template <int OFF> __device__ __forceinline__ s16x4 tr_read(unsigned vb) { s16x4 r; asm volatile("ds_read_b64_tr_b16 %0, %1 offset:%2" : "=&v"(r) : "v"(vb), "i"(OFF) : "memory"); return r; }
template <int D0> __device__ __forceinline__ void pv_one(f32x16& od, unsigned vb, bf16x8 pa0, bf16x8 pa1, bf16x8 pa2, bf16x8 pa3) {
    const s16x4 l0 = tr_read<v_rd_off(D0, 0, 0)>(vb), h0 = tr_read<v_rd_off(D0, 0, 1)>(vb), l1 = tr_read<v_rd_off(D0, 1, 0)>(vb), h1 = tr_read<v_rd_off(D0, 1, 1)>(vb);
    const s16x4 l2 = tr_read<v_rd_off(D0, 2, 0)>(vb), h2 = tr_read<v_rd_off(D0, 2, 1)>(vb), l3 = tr_read<v_rd_off(D0, 3, 0)>(vb), h3 = tr_read<v_rd_off(D0, 3, 1)>(vb);
    asm volatile("s_waitcnt lgkmcnt(0)" ::: "memory"); __builtin_amdgcn_sched_barrier(0);
#define AT_PK(L, H) (bf16x8){L[0], L[1], L[2], L[3], H[0], H[1], H[2], H[3]}
    od = __builtin_amdgcn_mfma_f32_32x32x16_bf16(pa0, AT_PK(l0, h0), od, 0, 0, 0);
    od = __builtin_amdgcn_mfma_f32_32x32x16_bf16(pa1, AT_PK(l1, h1), od, 0, 0, 0);
    od = __builtin_amdgcn_mfma_f32_32x32x16_bf16(pa2, AT_PK(l2, h2), od, 0, 0, 0);
    od = __builtin_amdgcn_mfma_f32_32x32x16_bf16(pa3, AT_PK(l3, h3), od, 0, 0, 0);
#undef AT_PK
}
struct VFrag { s16x4 l[4], h[4]; };
template <int D0> __device__ __forceinline__ void rd_v(VFrag& f, const LAS unsigned char* vbp) {
#pragma unroll
    for (int ks = 0; ks < 4; ++ks) {
        f.l[ks] = __builtin_amdgcn_ds_read_tr16_b64_v4i16((LAS s16x4*)(vbp + v_rd_off(D0, ks, 0)));
        f.h[ks] = __builtin_amdgcn_ds_read_tr16_b64_v4i16((LAS s16x4*)(vbp + v_rd_off(D0, ks, 1))); }
}
__device__ __forceinline__ void mm_pv(f32x16& od, const VFrag& f, bf16x8 pa0, bf16x8 pa1, bf16x8 pa2, bf16x8 pa3) {
#define AT_PK(L, H) (bf16x8){L[0], L[1], L[2], L[3], H[0], H[1], H[2], H[3]}
    od = __builtin_amdgcn_mfma_f32_32x32x16_bf16(pa0, AT_PK(f.l[0], f.h[0]), od, 0, 0, 0);
    od = __builtin_amdgcn_mfma_f32_32x32x16_bf16(pa1, AT_PK(f.l[1], f.h[1]), od, 0, 0, 0);
    od = __builtin_amdgcn_mfma_f32_32x32x16_bf16(pa2, AT_PK(f.l[2], f.h[2]), od, 0, 0, 0);
    od = __builtin_amdgcn_mfma_f32_32x32x16_bf16(pa3, AT_PK(f.l[3], f.h[3]), od, 0, 0, 0);
#undef AT_PK
}
__device__ __forceinline__ f32x16 mfma_srcc(bf16x8 a, bf16x8 b, const f32x16& c) { f32x16 d; asm("v_mfma_f32_32x32x16_bf16 %0, %1, %2, %3" : "=&v"(d) : "v"(a), "v"(b), "v"(c)); return d; }
struct KeyMap { int ctx_row0, lat_row0, nctx, nt; __device__ __forceinline__ int row(int j) const { return j < nctx ? ctx_row0 + 64 * j : lat_row0 + 64 * (j - nctx); } };

template <int DQK>
__device__ __forceinline__ void attn_body(LAS unsigned char* lds, const bf16_t* Qg, int ldq, int q0, const bf16_t* Kg, int ldk, const bf16_t* Vg, int ldv, const KeyMap km,
                                          f32x16 (&o)[4], float& l_out) {
    constexpr int RB = DQK * 2, CPR = RB / 16, NKI = 64 * RB / 8192, KBYTES = 64 * RB, VOFF = 3 * KBYTES, SCR = VOFF + 4 * 16384, ND0 = DQK / 16;
    static_assert(SCR + 2048 <= LDS_MISC, "attention LDS");
    const int tid = otid(), wid = __builtin_amdgcn_readfirstlane(tid >> 6), lane = tid & 63, r32 = lane & 31, hi = lane >> 5, half = wid >> 2;
    LAS float* wsl = (LAS float*)(lds + SCR) + wid * 64; LAS float* al_l = wsl;
    unsigned koff[NKI], voff[2];
#pragma unroll
    for (int i = 0; i < NKI; ++i) { const int q = i * 512 + wid * 64 + lane, row = q / CPR, cp = q % CPR, ch = cp ^ ((row >> 1) & 7); koff[i] = (unsigned)row * (unsigned)(ldk * 2) + (unsigned)ch * 16u; }
#pragma unroll
    for (int i = 0; i < 2; ++i) { const int q = i * 512 + wid * 64 + lane, sub = q >> 5, wi = q & 31, k = (sub >> 2) * 8 + (wi >> 2), c = (sub & 3) * 32 + (wi & 3) * 8;
        voff[i] = (unsigned)k * (unsigned)(ldv * 2) + (unsigned)c * 2u; }
    const int NT = km.nt;
#define AT_ISSUE(j, sk, sv) do { const int _j = (j) < NT ? (j) : NT - 1; const int _kr = km.row(_j); const char* _kb = (const char*)Kg + (size_t)_kr * ldk * 2; const char* _vb = (const char*)Vg + (size_t)_kr * ldv * 2; \
        _Pragma("unroll") for (int _i = 0; _i < NKI; ++_i) __builtin_amdgcn_global_load_lds((const unsigned*)(_kb + koff[_i]), (LAS unsigned*)(lds + (sk) * KBYTES + _i * 8192 + wid * 1024), 16, 0, 0); \
        _Pragma("unroll") for (int _i = 0; _i < 2; ++_i) __builtin_amdgcn_global_load_lds((const unsigned*)(_vb + voff[_i]), (LAS unsigned*)(lds + VOFF + (sv) * 16384 + _i * 8192 + wid * 1024), 16, 0, 0); } while (0)
    bf16x8 qr[ND0];
    { const bf16_t* Qw = Qg + (size_t)(q0 + wid * 32 + r32) * ldq + hi * 8;
#pragma unroll
      for (int d0 = 0; d0 < ND0; ++d0) qr[d0] = *(const bf16x8*)(Qw + d0 * 16); }
    float m_reg = 0.f, l_reg = 0.f;
    f32x16 cm;
#pragma unroll
    for (int r = 0; r < 16; ++r) cm[r] = 0.f;
#pragma unroll
    for (int d = 0; d < 4; ++d)
#pragma unroll
        for (int r = 0; r < 16; ++r) o[d][r] = 0.f;
    const unsigned ksw = (unsigned)((r32 >> 1) & 7), kb0 = (unsigned)r32 * RB, vrb = (unsigned)v_rd_base(lane);
    bf16x8 pa0, pa1, pa2, pa3;
#define AT_PV(sv) do { const unsigned vb = (unsigned)(uintptr_t)(lds + VOFF + (sv) * 16384) + vrb; \
        pv_one<0>(o[0], vb, pa0, pa1, pa2, pa3); pv_one<1>(o[1], vb, pa0, pa1, pa2, pa3); pv_one<2>(o[2], vb, pa0, pa1, pa2, pa3); pv_one<3>(o[3], vb, pa0, pa1, pa2, pa3); } while (0)
    AT_ISSUE(0, 0, 0); AT_ISSUE(1, 1, 1);
    if constexpr (NKI == 3) asm volatile("s_waitcnt vmcnt(5)" ::: "memory"); else asm volatile("s_waitcnt vmcnt(3)" ::: "memory");
    if (half) { __builtin_amdgcn_s_barrier(); }
    int sk = 0, sv = 0;
    for (int j = 0; j < NT; ++j) {
        __builtin_amdgcn_s_barrier(); asm volatile("" ::: "memory");
        __builtin_amdgcn_s_setprio(1);
#define AT_SB __builtin_amdgcn_sched_barrier(0)
#define AT_RK(d0, KF) do { const unsigned cb = (((unsigned)(2 * (d0) + hi)) ^ ksw) << 4; KF[0] = *(const LAS bf16x8*)(Ks + cb); KF[1] = *(const LAS bf16x8*)(Ks + 32 * RB + cb); } while (0)
        const LAS unsigned char* Ks = lds + sk * KBYTES + kb0;
        bf16x8 kf[2][2];
        if (j > 0) {
            const LAS unsigned char* vbp = lds + VOFF + ((sv + 3) & 3) * 16384 + vrb;
            VFrag fa, fb;
            rd_v<0>(fa, vbp); rd_v<1>(fb, vbp); AT_SB;
            mm_pv(o[0], fa, pa0, pa1, pa2, pa3); AT_SB;
            rd_v<2>(fa, vbp); AT_SB;
            mm_pv(o[1], fb, pa0, pa1, pa2, pa3); AT_SB;
            rd_v<3>(fb, vbp); AT_SB;
            mm_pv(o[2], fa, pa0, pa1, pa2, pa3); AT_SB;
            AT_RK(0, kf[0]); AT_SB;
            mm_pv(o[3], fb, pa0, pa1, pa2, pa3); AT_SB;
        } else { AT_RK(0, kf[0]); AT_SB; }
        f32x16 p0, p1;
        AT_RK(1, kf[1]); AT_SB;
        p0 = mfma_srcc(kf[0][0], qr[0], cm); p1 = mfma_srcc(kf[0][1], qr[0], cm); AT_SB;
#pragma unroll
        for (int d0 = 1; d0 < ND0; ++d0) {
            if (d0 + 1 < ND0) { AT_RK(d0 + 1, kf[(d0 + 1) & 1]); AT_SB; }
            p0 = __builtin_amdgcn_mfma_f32_32x32x16_bf16(kf[d0 & 1][0], qr[d0], p0, 0, 0, 0);
            p1 = __builtin_amdgcn_mfma_f32_32x32x16_bf16(kf[d0 & 1][1], qr[d0], p1, 0, 0, 0); AT_SB;
        }
#undef AT_RK
#undef AT_SB
        asm volatile("s_waitcnt vmcnt(0)" ::: "memory");
        __builtin_amdgcn_s_setprio(0);
        __builtin_amdgcn_s_barrier(); asm volatile("" ::: "memory");
        { const int sk2 = sk == 0 ? 2 : sk - 1; AT_ISSUE(j + 2, sk2, (sv + 2) & 3); }
        float pmax = p0[0];
#pragma unroll
        for (int r = 1; r < 16; ++r) pmax = fmaxf(pmax, p0[r]);
#pragma unroll
        for (int r = 0; r < 16; ++r) pmax = fmaxf(pmax, p1[r]);
        { auto rr = __builtin_amdgcn_permlane32_swap(__float_as_uint(pmax), __float_as_uint(pmax), false, false); pmax = fmaxf(__uint_as_float(rr[0]), __uint_as_float(rr[1])); }
        float alpha = 1.f;
        if (__builtin_expect(j == 0 || !__all(pmax <= THR2), 0)) {
            const float delta = j == 0 ? pmax : fmaxf(pmax, 0.f);
            if (j != 0) alpha = __builtin_amdgcn_exp2f(-delta);
            m_reg += delta;
#pragma unroll
            for (int r = 0; r < 16; ++r) { p0[r] -= delta; p1[r] -= delta; cm[r] = -m_reg; }
        }
#pragma unroll
        for (int r = 0; r < 16; ++r) { p0[r] = __builtin_amdgcn_exp2f(p0[r]); p1[r] = __builtin_amdgcn_exp2f(p1[r]); }
        float ps = 0.f;
#pragma unroll
        for (int r = 0; r < 16; ++r) ps += p0[r] + p1[r];
        l_reg = l_reg * alpha + ps;
#define AT_PK4(P, BASE, OUT) do { u32x4 w = {cvtpk(P[BASE + 0], P[BASE + 1]), cvtpk(P[BASE + 2], P[BASE + 3]), cvtpk(P[BASE + 4], P[BASE + 5]), cvtpk(P[BASE + 6], P[BASE + 7])}; OUT = *reinterpret_cast<bf16x8*>(&w); } while (0)
        AT_PK4(p0, 0, pa0); AT_PK4(p0, 8, pa1); AT_PK4(p1, 0, pa2); AT_PK4(p1, 8, pa3);
#undef AT_PK4
        if (__any(alpha < 1.f)) {
            if (hi == 0) al_l[r32] = alpha;
            asm volatile("s_waitcnt lgkmcnt(0)" ::: "memory");
            float av[16];
#pragma unroll
            for (int r = 0; r < 16; ++r) av[r] = al_l[crow(r, hi)];
#pragma unroll
            for (int d = 0; d < 4; ++d)
#pragma unroll
                for (int r = 0; r < 16; ++r) o[d][r] *= av[r];
        }
        sk = sk == 2 ? 0 : sk + 1; sv = (sv + 1) & 3;
    }
    __builtin_amdgcn_s_barrier(); asm volatile("" ::: "memory");
    AT_PV((sv + 3) & 3);
    if (!half) __builtin_amdgcn_s_barrier();
    asm volatile("s_waitcnt vmcnt(0)" ::: "memory");
    __builtin_amdgcn_s_barrier();
    asm volatile("" ::: "memory");
    { auto rr = __builtin_amdgcn_permlane32_swap(__float_as_uint(l_reg), __float_as_uint(l_reg), false, false); l_out = __uint_as_float(rr[0]) + __uint_as_float(rr[1]); }
#undef AT_ISSUE
#undef AT_PV
}
__device__ __forceinline__ void row_inv_l(LAS unsigned char* lds_scratch, float l_reg, float (&rli)[16]) {
    const int tid = otid(), wid = tid >> 6, lane = tid & 63, r32 = lane & 31, hi = lane >> 5;
    LAS float* li_l = (LAS float*)lds_scratch + wid * 64 + 32;
    if (hi == 0) li_l[r32] = l_reg;
    asm volatile("s_waitcnt lgkmcnt(0)" ::: "memory");
#pragma unroll
    for (int r = 0; r < 16; ++r) rli[r] = __builtin_amdgcn_rcpf(li_l[crow(r, hi)]);
}
}

__device__ __forceinline__ void attn_unit_mla(CKP& p, LAS unsigned char* lds, int q0, int h, const at::KeyMap km) {
    const bf16_t* qm = (const bf16_t*)(p.ws + WS_QM); const bf16_t* kmb = (const bf16_t*)(p.ws + WS_KM); const bf16_t* vmb = (const bf16_t*)(p.ws + WS_VM); bf16_t* ya = (bf16_t*)(p.ws + WS_YBR);
    f32x16 o[4]; float l;
    at::attn_body<192>(lds, qm + h * 192, 768, q0, kmb + h * 192, 768, vmb + h * 128, 512, km, o, l);
    float rli[16]; at::row_inv_l(lds + 3 * 64 * 384 + 4 * 16384, l, rli);
    const int tid_ = otid(); const int wid = tid_ >> 6, lane = tid_ & 63, r32 = lane & 31, hi = lane >> 5;
    bf16_t* yw = ya + (size_t)(q0 + wid * 32) * 512 + h * 128 + r32;
#pragma unroll
    for (int r = 0; r < 16; ++r) { const int orow = at::crow(r, hi);
#pragma unroll
        for (int d0 = 0; d0 < 4; ++d0) yw[(size_t)orow * 512 + d0 * 32] = f2bf(o[d0][r] * rli[r]); }
}
__device__ __forceinline__ void attn_unit_diff(CKP& p, LAS unsigned char* lds, int l_idx, int q0, int h, const at::KeyMap km) {
    const bf16_t* ubuf = (const bf16_t*)(p.ws + WS_R1); bf16_t* yc = (bf16_t*)(p.ws + WS_YBR) + (size_t)2 * MALL * 512;
    const float lam = ((const float*)(p.ws + WS_SCAL))[l_idx]; const float lam_init = 0.8f - 0.6f * expf(-0.3f * (float)l_idx);
    f32x16 o[4]; float l; float rli[16];
    at::attn_body<64>(lds, ubuf + U_CQ + (2 * h) * 64, NU, q0, ubuf + U_CK + (2 * h) * 64, NU, ubuf + U_CV + h * 128, NU, km, o, l);
    at::row_inv_l(lds + 3 * 64 * 128 + 4 * 16384, l, rli);
    const int tid_ = otid(); const int wid = tid_ >> 6, lane = tid_ & 63, r32 = lane & 31, hi = lane >> 5;
    bf16_t* yw = yc + (size_t)(q0 + wid * 32) * 512 + h * 128 + r32;
#pragma unroll
    for (int r = 0; r < 16; ++r) { const int orow = at::crow(r, hi);
#pragma unroll
        for (int d0 = 0; d0 < 4; ++d0) yw[(size_t)orow * 512 + d0 * 32] = f2bf(o[d0][r] * rli[r]); }
    at::attn_body<64>(lds, ubuf + U_CQ + (2 * h + 1) * 64, NU, q0, ubuf + U_CK + (2 * h + 1) * 64, NU, ubuf + U_CV + h * 128, NU, km, o, l);
    at::row_inv_l(lds + 3 * 64 * 128 + 4 * 16384, l, rli);
    { const int t2 = otid(); yw = yc + (size_t)(q0 + (t2 >> 6) * 32) * 512 + h * 128 + (t2 & 31); }
    float ss[16];
#pragma unroll
    for (int r = 0; r < 16; ++r) { const int orow = at::crow(r, hi); float s = 0.f;
#pragma unroll
        for (int d = 0; d < 4; ++d) { const float v = bf2f(yw[(size_t)orow * 512 + d * 32]) - lam * (o[d][r] * rli[r]); o[d][r] = v; s += v * v; }
        ss[r] = s; }
#pragma unroll
    for (int r = 0; r < 16; ++r) {
#pragma unroll
        for (int x = 16; x >= 1; x >>= 1) ss[r] += shx(ss[r], x, lane); }
    const float* sub = p.in[I_SUBLN] + l_idx * 128; float sg[4];
#pragma unroll
    for (int d = 0; d < 4; ++d) sg[d] = sub[d * 32 + r32] * (1.0f - lam_init);
#pragma unroll
    for (int r = 0; r < 16; ++r) { const int orow = at::crow(r, hi); const float rn = rsqrtf(ss[r] * (1.0f / 128.0f) + EPS);
#pragma unroll
        for (int d0 = 0; d0 < 4; ++d0) yw[(size_t)orow * 512 + d0 * 32] = f2bf(o[d0][r] * rn * sg[d0]); }
}

__device__ __forceinline__ void lds_barrier() { asm volatile("s_waitcnt lgkmcnt(0)" ::: "memory"); __builtin_amdgcn_s_barrier(); asm volatile("" ::: "memory"); }
namespace hg {
__device__ __forceinline__ bf16x8 gather8(const LAS bf16_t* p, int stride) { bf16x8 r;
#pragma unroll
    for (int i = 0; i < 8; ++i) r[i] = (short)p[i * stride];
    return r; }
__device__ __forceinline__ void gates16(const bf16_t* zp  , float lbk, int dd, float (&gi)[16], float (&kf)[16], float& tot) {
    float g[16];
#pragma unroll
    for (int i = 0; i < 16; ++i) { const float z = bf2f(zp[(size_t)i * NU]); const float sg = sigmoidf_(z); g[i] = flog(lbk + (1.0f - lbk) * sg); kf[i] = (1.0f - lbk) * frcp(1.0f + __expf(z)); }
    float run = 0.f;
    if (dd == 0) {
#pragma unroll
        for (int i = 0; i < 16; ++i) { run += g[i]; gi[i] = run; }
    } else {
#pragma unroll
        for (int i = 15; i >= 0; --i) { run += g[i]; gi[i] = run; }
    }
    tot = run;
}
__device__ __forceinline__ void gates16r(const bf16_t (&zr)[16], float lbk, int dd, float (&gi)[16], float (&kf)[16], float& tot) {
    float g[16];
#pragma unroll
    for (int i = 0; i < 16; ++i) { const float z = bf2f(zr[i]); const float sg = sigmoidf_(z); g[i] = flog(lbk + (1.0f - lbk) * sg); kf[i] = (1.0f - lbk) * frcp(1.0f + __expf(z)); }
    float run = 0.f;
    if (dd == 0) {
#pragma unroll
        for (int i = 0; i < 16; ++i) { run += g[i]; gi[i] = run; }
    } else {
#pragma unroll
        for (int i = 15; i >= 0; --i) { run += g[i]; gi[i] = run; }
    }
    tot = run;
}
__device__ __forceinline__ void pack16_store(LAS bf16_t* dst, const float (&v)[16]) {
    u32x4 a, b; a.x = cvt_pk_bf16(v[0], v[1]); a.y = cvt_pk_bf16(v[2], v[3]); a.z = cvt_pk_bf16(v[4], v[5]); a.w = cvt_pk_bf16(v[6], v[7]);
    b.x = cvt_pk_bf16(v[8], v[9]); b.y = cvt_pk_bf16(v[10], v[11]); b.z = cvt_pk_bf16(v[12], v[13]); b.w = cvt_pk_bf16(v[14], v[15]);
    *(LAS u32x4*)dst = a; *(LAS u32x4*)(dst + 8) = b;
}
__device__ __forceinline__ void stage_vT(LAS bf16_t* VsT, const bf16_t* vp  , int v, int part) {
    unsigned short h[16];
#pragma unroll
    for (int i = 0; i < 16; ++i) h[i] = vp[(size_t)i * NU];
    u32x4 a, b; a.x = h[0] | ((unsigned)h[1] << 16); a.y = h[2] | ((unsigned)h[3] << 16); a.z = h[4] | ((unsigned)h[5] << 16); a.w = h[6] | ((unsigned)h[7] << 16);
    b.x = h[8] | ((unsigned)h[9] << 16); b.y = h[10] | ((unsigned)h[11] << 16); b.z = h[12] | ((unsigned)h[13] << 16); b.w = h[14] | ((unsigned)h[15] << 16);
    *(LAS u32x4*)(VsT + v * 72 + part * 16) = a; *(LAS u32x4*)(VsT + v * 72 + part * 16 + 8) = b;
}
__device__ __forceinline__ void pass1_unit(CKP& p, LAS unsigned char* lds, const float* lb, int cid, int hh) {
    const bf16_t* ubuf = (const bf16_t*)(p.ws + WS_R1); bf16_t* HS = (bf16_t*)(p.ws + WS_YBUF); float* HD = (float*)(p.ws + WS_HD);
    LAS bf16_t* VsT = (LAS bf16_t*)lds; LAS bf16_t* KtT = (LAS bf16_t*)(lds + 18432); LAS float* ptot = (LAS float*)(lds + 36864);
    const int tid = otid(), wid = tid >> 6, lane = tid & 63, row0 = cid * 64;
    const int k = tid & 127, part = tid >> 7; const float lbk = lb[hh * 128 + k];
    bf16_t zf[16], zb[16];
    { const bf16_t* zp = ubuf + (size_t)(row0 + part * 16) * NU + hh * 128 + k;
#pragma unroll
      for (int i = 0; i < 16; ++i) { zf[i] = zp[(size_t)i * NU + U_DFF]; zb[i] = zp[(size_t)i * NU + U_DFB]; } }
    stage_vT(VsT, ubuf + (size_t)(row0 + part * 16) * NU + U_DI + hh * 128 + k, k, part);
#pragma unroll 1
    for (int dd = 0; dd < 2; ++dd) {
        float gi[16], kf[16], tot;
        { bf16_t zr[16];
#pragma unroll
          for (int i = 0; i < 16; ++i) zr[i] = dd ? zb[i] : zf[i];
          gates16r(zr, lbk, dd, gi, kf, tot); }
        ptot[part * 128 + k] = tot;
        lds_barrier();
        float off = 0.f, gt = 0.f;
#pragma unroll
        for (int q = 0; q < 4; ++q) { const float v = ptot[q * 128 + k]; gt += v; if (dd == 0 ? (q < part) : (q > part)) off += v; }
#pragma unroll
        for (int i = 0; i < 16; ++i) kf[i] = kf[i] * __expf(gt - (off + gi[i]));
        pack16_store(KtT + k * 72 + part * 16, kf);
        if (part == 0) HD[(size_t)((cid * 4 + hh) * 2 + dd) * 128 + k] = __expf(gt);
        lds_barrier();
        {
            const int l15 = lane & 15, kg = lane >> 4;
            bf16x8 vf[2];
#pragma unroll
            for (int ks = 0; ks < 2; ++ks) vf[ks] = *(const LAS bf16x8*)(VsT + (wid * 16 + l15) * 72 + ks * 32 + kg * 8);
            bf16_t* dst = HS + ((size_t)((cid * 4 + hh) * 2 + dd) * 128 + wid * 16 + l15) * 128;
            bf16x8 kfr[8][2];
#pragma unroll
            for (int kb = 0; kb < 8; ++kb)
#pragma unroll
                for (int ks = 0; ks < 2; ++ks) kfr[kb][ks] = *(const LAS bf16x8*)(KtT + (kb * 16 + l15) * 72 + ks * 32 + kg * 8);
            asm volatile("" ::: "memory");
#pragma unroll
            for (int kb = 0; kb < 8; ++kb) {
                f32x4 c = {0.f, 0.f, 0.f, 0.f};
#pragma unroll
                for (int ks = 0; ks < 2; ++ks) c = __builtin_amdgcn_mfma_f32_16x16x32_bf16(kfr[kb][ks], vf[ks], c, 0, 0, 0);
                u32x2 w; w.x = cvt_pk_bf16(c[0], c[1]); w.y = cvt_pk_bf16(c[2], c[3]);
                *(u32x2*)(dst + kb * 16 + kg * 4) = w;
            }
        }
        lds_barrier();
    }
}
__device__ __forceinline__ void carry_unit(CKP& p, int u) {
    bf16_t* HS = (bf16_t*)(p.ws + WS_YBUF); const float* HD = (const float*)(p.ws + WS_HD);
    const int combo = u >> 4, sub = u & 15, b = combo >> 3, hh = (combo >> 1) & 3, dd = combo & 1;
    const int tid_ = otid(); const int v = sub * 8 + (tid_ >> 6), k = 2 * (tid_ & 63);
    float s0 = 0.f, s1 = 0.f;
#pragma unroll 1
    for (int s0i = 0; s0i < 260; s0i += 52) {
        unsigned uw[52]; f32x2 d2[52];
#pragma unroll
        for (int q = 0; q < 52; ++q) { const int st = s0i + q;
            const int cid = dd == 0 ? (st < 4 ? 512 + b * 4 + st : b * 256 + (st - 4)) : (st < 4 ? 512 + b * 4 + (3 - st) : b * 256 + (259 - st));
            const size_t base = (size_t)((cid * 4 + hh) * 2 + dd) * 128;
            uw[q] = *(const unsigned*)(HS + (base + v) * 128 + k); d2[q] = *(const f32x2*)(HD + base + k); }
#pragma unroll
        for (int q = 0; q < 52; ++q) { const int st = s0i + q;
            const int cid = dd == 0 ? (st < 4 ? 512 + b * 4 + st : b * 256 + (st - 4)) : (st < 4 ? 512 + b * 4 + (3 - st) : b * 256 + (259 - st));
            const size_t base = (size_t)((cid * 4 + hh) * 2 + dd) * 128;
            *(unsigned*)(HS + (base + v) * 128 + k) = cvt_pk_bf16(s0, s1);
            s0 = d2[q][0] * s0 + bflo(uw[q]); s1 = d2[q][1] * s1 + bfhi(uw[q]); }
    }
}
constexpr int O_QS = 0, O_KF = 17408, O_VS = 34816, O_GS = 53248, O_ST = 87040, O_AS = 121856, O_R = 140288, O_PT = 142336, O_RS = 144384;
static_assert(O_RS + 512 <= LDS_MISC, "HGRN LDS");
__device__ __forceinline__ void out_unit(CKP& p, LAS unsigned char* lds, const float* lb, const float* gnorm, int cid, int hh) {
    const bf16_t* ubuf = (const bf16_t*)(p.ws + WS_R1); const bf16_t* HS = (const bf16_t*)(p.ws + WS_YBUF); bf16_t* yd = (bf16_t*)(p.ws + WS_YBR) + (size_t)3 * MALL * 512;
    LAS bf16_t* qs = (LAS bf16_t*)(lds + O_QS); LAS bf16_t* kfs = (LAS bf16_t*)(lds + O_KF); LAS bf16_t* Vs = (LAS bf16_t*)(lds + O_VS); LAS float* Gs = (LAS float*)(lds + O_GS);
    LAS bf16_t* St = (LAS bf16_t*)(lds + O_ST); LAS float* Rr = (LAS float*)(lds + O_R); LAS float* ptot = (LAS float*)(lds + O_PT); LAS float* rss = (LAS float*)(lds + O_RS);
    const int tid = otid(), wid = tid >> 6, lane = tid & 63, row0 = cid * 64, l15 = lane & 15, kg = lane >> 4;
    LAS bf16_t* Asc = (LAS bf16_t*)(lds + O_AS) + wid * (16 * 72);
    const int k = tid & 127, part = tid >> 7; const float lbk = lb[hh * 128 + k];
    bf16_t zf[16], zb[16]; u32x4 sin0[4], sin1[4];
    { const bf16_t* zp = ubuf + (size_t)(row0 + part * 16) * NU + hh * 128 + k;
#pragma unroll
      for (int i = 0; i < 16; ++i) { zf[i] = zp[(size_t)i * NU + U_DFF]; zb[i] = zp[(size_t)i * NU + U_DFB]; }
      const int v_ = tid >> 2, seg_ = tid & 3; const bf16_t* src = HS + ((size_t)((cid * 4 + hh) * 2) * 128 + v_) * 128 + seg_ * 32;
#pragma unroll
      for (int i = 0; i < 4; ++i) { sin0[i] = *(const u32x4*)(src + i * 8); sin1[i] = *(const u32x4*)(src + (size_t)128 * 128 + i * 8); } }
    stage_vT(Vs, ubuf + (size_t)(row0 + part * 16) * NU + U_DI + hh * 128 + k, k, part);
#pragma unroll
    for (int i = 0; i < 16; ++i) { const int t = part * 16 + i; qs[t * 136 + k] = f2bf(siluf_(bf2f(ubuf[(size_t)(row0 + t) * NU + U_DQ + hh * 128 + k]))); }
    const int bi = wid >> 1, vh = wid & 1;
    f32x4 o[4];
#pragma unroll
    for (int nb = 0; nb < 4; ++nb) o[nb] = (f32x4){0.f, 0.f, 0.f, 0.f};
#pragma unroll 1
    for (int dd = 0; dd < 2; ++dd) {
        {
            float gi[16], kf[16], tot;
            { bf16_t zr[16];
#pragma unroll
              for (int i = 0; i < 16; ++i) zr[i] = dd ? zb[i] : zf[i];
              gates16r(zr, lbk, dd, gi, kf, tot); }
            ptot[part * 128 + k] = tot;
            lds_barrier();
            float off = 0.f;
#pragma unroll
            for (int q = 0; q < 4; ++q) { const float v = ptot[q * 128 + k]; if (dd == 0 ? (q < part) : (q > part)) off += v; }
#pragma unroll
            for (int i = 0; i < 16; ++i) { const int t = part * 16 + i; Gs[t * 132 + k] = off + gi[i]; kfs[t * 136 + k] = f2bf(kf[i]); }
            Rr[part * 128 + k] = off;
        }
        {
            const int v = tid >> 2, seg = tid & 3;
#pragma unroll
            for (int i = 0; i < 4; ++i) *(LAS u32x4*)(St + v * 136 + seg * 32 + i * 8) = dd ? sin1[i] : sin0[i];
        }
        lds_barrier();
        const int ti = bi * 16 + l15;
        u32x4 awq[4];
#pragma unroll
        for (int ks = 0; ks < 4; ++ks) { const int kc = ks * 32 + kg * 8;
            const u32x4 qw = *(const LAS u32x4*)(qs + ti * 136 + kc);
            const f32x4 g0 = *(const LAS f32x4*)(Gs + ti * 132 + kc), g1 = *(const LAS f32x4*)(Gs + ti * 132 + kc + 4), r0 = *(const LAS f32x4*)(Rr + bi * 128 + kc), r1 = *(const LAS f32x4*)(Rr + bi * 128 + kc + 4);
            const float qv[8] = {bflo(qw.x), bfhi(qw.x), bflo(qw.y), bfhi(qw.y), bflo(qw.z), bfhi(qw.z), bflo(qw.w), bfhi(qw.w)}; float qa[8];
#pragma unroll
            for (int e = 0; e < 4; ++e) { qa[e] = qv[e] * __expf(g0[e] - r0[e]); qa[4 + e] = qv[4 + e] * __expf(g1[e] - r1[e]); }
            awq[ks].x = cvt_pk_bf16(qa[0], qa[1]); awq[ks].y = cvt_pk_bf16(qa[2], qa[3]); awq[ks].z = cvt_pk_bf16(qa[4], qa[5]); awq[ks].w = cvt_pk_bf16(qa[6], qa[7]); }
#pragma unroll 1
        for (int j = 0; j < 4; ++j) {
            const bool use = dd == 0 ? (j <= bi) : (j >= bi);
            f32x4 c = {0.f, 0.f, 0.f, 0.f};
            if (use) {
                const int sj = j * 16 + l15;
#pragma unroll
                for (int ks = 0; ks < 4; ++ks) {
                    const int kc = ks * 32 + kg * 8;
                    const u32x4 kw = *(const LAS u32x4*)(kfs + sj * 136 + kc);
                    const f32x4 h0 = *(const LAS f32x4*)(Gs + sj * 132 + kc), h1 = *(const LAS f32x4*)(Gs + sj * 132 + kc + 4);
                    const f32x4 r0 = *(const LAS f32x4*)(Rr + bi * 128 + kc), r1 = *(const LAS f32x4*)(Rr + bi * 128 + kc + 4);
                    const float kv[8] = {bflo(kw.x), bfhi(kw.x), bflo(kw.y), bfhi(kw.y), bflo(kw.z), bfhi(kw.z), bflo(kw.w), bfhi(kw.w)};
                    float ka[8];
#pragma unroll
                    for (int e = 0; e < 4; ++e) { ka[e] = kv[e] * __expf(r0[e] - h0[e]); ka[4 + e] = kv[4 + e] * __expf(r1[e] - h1[e]); }
                    u32x4 aw = awq[ks], bw;
                    bw.x = cvt_pk_bf16(ka[0], ka[1]); bw.y = cvt_pk_bf16(ka[2], ka[3]); bw.z = cvt_pk_bf16(ka[4], ka[5]); bw.w = cvt_pk_bf16(ka[6], ka[7]);
                    c = __builtin_amdgcn_mfma_f32_16x16x32_bf16(*reinterpret_cast<bf16x8*>(&aw), *reinterpret_cast<bf16x8*>(&bw), c, 0, 0, 0);
                }
                if (j == bi) {
#pragma unroll
                    for (int e = 0; e < 4; ++e) { const int tl = 4 * kg + e; const bool keep = dd == 0 ? (l15 <= tl) : (l15 >= tl); c[e] = keep ? c[e] : 0.f; }
                }
            }
#pragma unroll
            for (int e = 0; e < 4; ++e) Asc[(4 * kg + e) * 72 + j * 16 + l15] = f2bf(c[e]);
        }
        bf16x8 af[2], qf[4];
#pragma unroll
        for (int ks = 0; ks < 2; ++ks) af[ks] = *(const LAS bf16x8*)(Asc + l15 * 72 + ks * 32 + kg * 8);
#pragma unroll
        for (int ks = 0; ks < 4; ++ks) { const int kc = ks * 32 + kg * 8;
            const u32x4 qw = *(const LAS u32x4*)(qs + ti * 136 + kc); const f32x4 g0 = *(const LAS f32x4*)(Gs + ti * 132 + kc), g1 = *(const LAS f32x4*)(Gs + ti * 132 + kc + 4);
            u32x4 aw; aw.x = cvt_pk_bf16(bflo(qw.x) * __expf(g0[0]), bfhi(qw.x) * __expf(g0[1])); aw.y = cvt_pk_bf16(bflo(qw.y) * __expf(g0[2]), bfhi(qw.y) * __expf(g0[3]));
            aw.z = cvt_pk_bf16(bflo(qw.z) * __expf(g1[0]), bfhi(qw.z) * __expf(g1[1])); aw.w = cvt_pk_bf16(bflo(qw.w) * __expf(g1[2]), bfhi(qw.w) * __expf(g1[3]));
            qf[ks] = *reinterpret_cast<bf16x8*>(&aw); }
#pragma unroll
        for (int nb = 0; nb < 4; ++nb) { const int vcol = vh * 64 + nb * 16 + l15;
            bf16x8 vf[2], sf[4];
#pragma unroll
            for (int ks = 0; ks < 2; ++ks) vf[ks] = *(const LAS bf16x8*)(Vs + vcol * 72 + ks * 32 + kg * 8);
#pragma unroll
            for (int ks = 0; ks < 4; ++ks) sf[ks] = *(const LAS bf16x8*)(St + vcol * 136 + ks * 32 + kg * 8);
            asm volatile("" ::: "memory");
#pragma unroll
            for (int ks = 0; ks < 2; ++ks) o[nb] = __builtin_amdgcn_mfma_f32_16x16x32_bf16(af[ks], vf[ks], o[nb], 0, 0, 0);
#pragma unroll
            for (int ks = 0; ks < 4; ++ks) o[nb] = __builtin_amdgcn_mfma_f32_16x16x32_bf16(qf[ks], sf[ks], o[nb], 0, 0, 0);
        }
        lds_barrier();
    }
    bf16_t ogr[4][4]; float gn[4];
#pragma unroll
    for (int e = 0; e < 4; ++e)
#pragma unroll
        for (int nb = 0; nb < 4; ++nb) ogr[e][nb] = ubuf[(size_t)(row0 + bi * 16 + 4 * kg + e) * NU + U_DG + hh * 128 + vh * 64 + nb * 16 + l15];
#pragma unroll
    for (int nb = 0; nb < 4; ++nb) gn[nb] = gnorm[vh * 64 + nb * 16 + l15];
    float ss[4];
#pragma unroll
    for (int e = 0; e < 4; ++e) { float s = 0.f;
#pragma unroll
        for (int nb = 0; nb < 4; ++nb) s += o[nb][e] * o[nb][e];
#pragma unroll
        for (int x = 8; x >= 1; x >>= 1) s += shx(s, x, lane);
        ss[e] = s; }
    if (l15 == 0) {
#pragma unroll
        for (int e = 0; e < 4; ++e) rss[vh * 64 + bi * 16 + 4 * kg + e] = ss[e]; }
    lds_barrier();
#pragma unroll
    for (int e = 0; e < 4; ++e) { const int tl = bi * 16 + 4 * kg + e; const float tot = rss[tl] + rss[64 + tl]; const float rn = rsqrtf(tot * (1.0f / 128.0f) + EPS);
        const size_t row = (size_t)(row0 + tl);
#pragma unroll
        for (int nb = 0; nb < 4; ++nb) { const int v = vh * 64 + nb * 16 + l15; const float og = bf2f(ogr[e][nb]);
            yd[row * 512 + hh * 128 + v] = f2bf(o[nb][e] * rn * gn[nb] * siluf_(og)); } }
    lds_barrier();
}
}

constexpr int PH_PER_LAYER = 14, N_PHASES = 1 + PH_PER_LAYER * NL + 1;
#ifndef MK_LAUNCHES
#define MK_LAUNCHES 1
#endif

__global__ void __launch_bounds__(NTHR, 2) fwd_kernel(KP karg) {
    extern __shared__ __attribute__((aligned(16))) unsigned char lds_raw[];
    LAS unsigned char* lds0 = (LAS unsigned char*)lds_raw;
    const int tid = otid(), G = gridDim.x, c = obid();
    volatile LAS unsigned* bst = (volatile LAS unsigned*)(lds0 + LDS_MISC);
    if (tid < 4) bst[tid] = 0u;
    __syncthreads();
    const int lo = karg.ph_lo, hi = karg.ph_hi;
    const bool fused = (MK_LAUNCHES == 1) || (hi - lo) > 1;
    XcdBarrier bar; bar.bar = (unsigned*)(karg.ws + WS_CTL); bar.x = 0; bar.st = bst;
    if (fused) bar = xcd_barrier_post((unsigned*)(karg.ws + WS_CTL), bst);
#ifndef ONLY_PH
#define ONLY_PH (-1)
#endif
#ifndef SUBMASK
#define SUBMASK 0xff
#endif
#define SUB(b) ((SUBMASK >> (b)) & 1)
#define EN(x) (ONLY_PH < 0 || ONLY_PH == (x))
#ifndef REPX
#define REPX (-1)
#define REPN 1
#endif
#define REPEAT(x) _Pragma("unroll 1") for (int rep_ = 0; rep_ < (REPX == (x) ? REPN : 1); ++rep_)
#define IN(k) ((MK_LAUNCHES == 1) || (lo <= (k) && (k) < hi))
#define INL(x) (EN(x) && IN(pb + (x)))
#define SEAM(k) do { if (IN((k) + 1)) xcd_barrier(bar); } while (0)

#define PH_LOCALS CKP& p = kp_here(); const int c = obid(); unsigned char* ws = p.ws; LAS unsigned char* lds = lds_here(lds_raw); \
    float* mod = (float*)(ws + WS_MOD); const float* rope = (const float*)(ws + WS_ROPE); const float* scal = (const float*)(ws + WS_SCAL); \
    bf16_t* hbuf = (bf16_t*)(ws + WS_HBUF); bf16_t* act = (bf16_t*)(ws + WS_R1); bf16_t* ubuf = (bf16_t*)(ws + WS_R1); bf16_t* mrg = (bf16_t*)(ws + WS_R1); bf16_t* ybuf = (bf16_t*)(ws + WS_YBUF); \
    float* xc = (float*)(ws + WS_XC); const float* modl = mod + (size_t)l * 3 * NMOD * DM; \
    (void)rope; (void)scal; (void)hbuf; (void)act; (void)ubuf; (void)mrg; (void)ybuf; (void)xc; (void)modl;

    if (EN(100) && IN(0)) { CKP& p = kp_here(); LAS unsigned char* lds = lds_here(lds_raw); job_tables(p); job_colmax(p); job_mod(p, lds); SEAM(0); }

#pragma unroll 1
    for (int l = 0; l < NL; ++l) {
        const int pb = 1 + PH_PER_LAYER * l; const bool need_ctx = l < NL - 1; const int nrt = need_ctx ? NRT : 128;
        if (INL(0)) { PH_LOCALS
            RNArgs a{};
            if (l == 0) { a.xs_lat = p.in[I_X]; a.xs_ctx = p.in[I_CTX]; a.xd_lat = p.out; a.xd_ctx = xc; a.y = nullptr; }
            else { a.xs_lat = p.out; a.xs_ctx = xc; a.xd_lat = p.out; a.xd_ctx = xc; a.y = ybuf; a.wres = 0.5f; a.modl_res = mod + (size_t)(l - 1) * 3 * NMOD * DM; a.jres = 2; a.postg = p.in[I_POST] + ((l - 1) * 3 + 2) * DM; }
            a.do_norm = true; a.modl_norm = modl; a.jn = 0; a.preg = p.in[I_PRE] + (l * 3 + 0) * DM; a.h = nullptr; a.h8 = (signed char*)hbuf; a.nrows = MALL; a.hsc = (float*)(ws + WS_HSC);
            job_resnorm(a, lds);
            job_convert(p, lds, l);
            SEAM(pb + 0);
        }
        if (INL(1)) { PH_LOCALS
            SchedPlain S; S.T.init(NRT, 44, G, c); S.A = (const char*)hbuf; S.B = (const char*)(ws + WS_WGU); S.lda2 = DM; S.ldb2 = DM; S.nt = DM / 128;
            REPEAT(1) { EpiGateUpI8 E{act, (const float*)(ws + WS_HSC), (const float*)(ws + WS_WSC)}; gm::gemm_stream<false>(lds, S, E); } SEAM(pb + 1);
        }
        if (INL(2)) { PH_LOCALS
            const bool spl = G == 256 && MK_LAUNCHES == 1; float* ypart = (float*)(ws + WS_QM);
            SchedSplitK S; S.T.init(spl ? 128 : NRT, 8, G, c, 4); S.A = (const char*)act; S.B = (const char*)(ws + WS_WD); S.lda2 = DFF * 2; S.ldb2 = DFF * 2; S.nt = DFF / 64; S.ns = 11; S.xe = (spl && c < 176) ? c : -1;
            REPEAT(2) { EpiStoreK E{ybuf, ypart}; gm::gemm_stream<false>(lds, S, E); } SEAM(pb + 2);
            if (spl) { job_splitk_reduce(ypart, ybuf, 11); xcd_barrier(bar); }
        }
        if (INL(3)) { PH_LOCALS
            RNArgs a{};
            if (l == 0) { a.xs_lat = p.in[I_X]; a.xs_ctx = p.in[I_CTX]; } else { a.xs_lat = p.out; a.xs_ctx = xc; }
            a.xd_lat = p.out; a.xd_ctx = xc; a.y = ybuf; a.wres = 0.5f; a.modl_res = modl; a.jres = 0; a.postg = p.in[I_POST] + (l * 3 + 0) * DM;
            a.do_norm = true; a.modl_norm = modl; a.jn = 1; a.preg = p.in[I_PRE] + (l * 3 + 1) * DM; a.h = nullptr; a.h8 = (signed char*)(ws + WS_H8); a.hsc = (float*)(ws + WS_HSC2); a.nrows = MALL;
            job_resnorm(a, lds); SEAM(pb + 3);
        }
        if (INL(4)) { PH_LOCALS
            SchedPlain S; S.T.init(NRT, 24, G, c); S.A = (const char*)(ws + WS_H8); S.B = (const char*)(ws + WS_WIN); S.lda2 = DM; S.ldb2 = DM; S.nt = DM / 128;
            REPEAT(4) { EpiProj E{ubuf, (bf16_t*)(ws + WS_KM), rope, (const float*)(ws + WS_HSC2), (const float*)(ws + WS_WPS)}; gm::gemm_stream<false>(lds, S, E); } SEAM(pb + 4);
        }
        if (INL(5)) { PH_LOCALS job_stats_conv(p, l); SEAM(pb + 5); }
        if (INL(6)) { PH_LOCALS
            if (SUB(0)) { SchedPlain S; S.T.init(NRT, 3, G, c); S.A = (const char*)(ubuf + U_AQ); S.B = (const char*)(ws + WS_WUQ); S.lda2 = NU * 2; S.ldb2 = 512 * 2; S.nt = 8;
              EpiQup E{(bf16_t*)(ws + WS_QM), (const float*)(ws + WS_RSQ), rope}; gm::gemm_stream<false>(lds, S, E); }
            if (SUB(1)) { SchedPlain S; S.T.init(NRT, 4, G, G == 256 ? (c + 120) & 255 : c); S.A = (const char*)(ubuf + U_AKV); S.B = (const char*)(ws + WS_WUKV); S.lda2 = NU * 2; S.ldb2 = 256 * 2; S.nt = 4;
              EpiKVup E{(bf16_t*)(ws + WS_KM), (bf16_t*)(ws + WS_VM), (const float*)(ws + WS_RSQ) + MALL}; gm::gemm_stream<false>(lds, S, E); }
            if (SUB(2)) { SchedPlain S; S.T.init(NRT, 8, G, G == 256 ? (c + 112) & 255 : c); S.A = (const char*)(ws + WS_XCV); S.B = (const char*)(ws + WS_WRG); S.lda2 = 512 * 2; S.ldb2 = 512 * 2; S.nt = 8;
              EpiRG E{(const bf16_t*)(ws + WS_XCV), (bf16_t*)(ws + WS_LA), (bf16_t*)(ws + WS_BB), p.in[I_RGBR] + l * 1024, p.in[I_RGBI] + l * 1024, scal + 2048 + l * 1024}; gm::gemm_stream<false>(lds, S, E); }
            if (SUB(3)) for (int u = (G == 256 ? (c + 96) & 255 : c); u < 520 * 4; u += G) hg::pass1_unit(p, lds, scal + 256 + l * 512, u >> 2, u & 3);
            SEAM(pb + 6);
        }
        if (INL(7)) { PH_LOCALS job_rg_scan1(p); for (int u = c; u < 256; u += G) hg::carry_unit(p, u); SEAM(pb + 7); }
        if (INL(8)) { PH_LOCALS {
            REPEAT(81) if (SUB(0)) job_rg_out(p, nrt);
            REPEAT(82) if (SUB(1)) { const int ncu = need_ctx ? 520 * 4 : 512 * 4;
                if (G > nrt + 16) {
                    if (c < nrt) { for (int i = 0; i < 7; ++i) { const int u = c + i * nrt; hg::out_unit(p, lds, scal + 256 + l * 512, p.in[I_HNORM] + l * 128, u >> 2, u & 3); } }
                    else for (int u = 7 * nrt + (c - nrt); u < ncu; u += G - nrt) hg::out_unit(p, lds, scal + 256 + l * 512, p.in[I_HNORM] + l * 128, u >> 2, u & 3);
                } else for (int u = c; u < ncu; u += G) hg::out_unit(p, lds, scal + 256 + l * 512, p.in[I_HNORM] + l * 128, u >> 2, u & 3); }
            if (SUB(4) && need_ctx) for (int t = (G == 256 ? (c + 16) & 255 : c); t < 16; t += G) { const int bh = t & 7, b = bh >> 2, h = bh & 3; at::KeyMap km{MLAT + b * CTXL, 0, 4, 4};
                if (t < 8) attn_unit_mla(p, lds, MLAT + b * CTXL, h, km); else attn_unit_diff(p, lds, l, MLAT + b * CTXL, h, km); }
            REPEAT(83) if (SUB(2)) for (int t = c; t < 512; t += G) { const int bh = t & 7, qb = t >> 3, b = bh >> 2, h = bh & 3; at::KeyMap km{MLAT + b * CTXL, b * SEQ, 4, 260}; attn_unit_mla(p, lds, b * SEQ + qb * 256, h, km); }
            REPEAT(84) if (SUB(3)) for (int t = c; t < 512; t += G) { const int bh = t & 7, qb = t >> 3, b = bh >> 2, h = bh & 3; at::KeyMap km{MLAT + b * CTXL, b * SEQ, 4, 260}; attn_unit_diff(p, lds, l, b * SEQ + qb * 256, h, km); }
            }
            SEAM(pb + 8);
        }
        if (INL(9)) { PH_LOCALS
            const bool bal = need_ctx && G == 256 && MK_LAUNCHES == 1;
            bf16_t* part = mrg + (size_t)2 * MALL * DM; bf16_t* gx = part + (size_t)4 * MCTX * DM;
            EpiMergeG EG{mrg + (size_t)MALL * DM, p.in[I_MB] + l * 4 * DM, (const float*)(ws + WS_HSC2), (const float*)(ws + WS_WGS), bal, gx};
            EpiMergeY EY{mrg, mrg + (size_t)MALL * DM, bal, gx, part};
            REPEAT(9) {
#pragma unroll 1
            for (int n = 0; n < 4; ++n) { const int xe = (bal && c >= 16 * n && c < 16 * n + 16) ? c - 16 * n : -1, nrm = bal ? 128 : nrt;
                { SchedMergeG S; S.T.init(nrm, 8, G, c); S.h8 = (const char*)(ws + WS_H8); S.wg = (const char*)(ws + WS_WIN) + (size_t)NU * DM; S.n = n; S.xe = xe; gm::gemm_stream<false>(lds, S, EG); }
                { SchedMergeY S; S.T.init(nrm, 8, G, c); S.ybr = (const char*)(ws + WS_YBR); S.wbr = (const char*)(ws + WS_WBR); S.n = n; S.xe = xe; gm::gemm_stream<false>(lds, S, EY); }
            } }
            SEAM(pb + 9);
            if (bal) {
                const int tid = otid();
                for (int idx = c * 512 + tid; idx < MCTX * 256; idx += G * 512) { const int row = idx >> 8, q = idx & 255; float sm[8] = {0.f, 0.f, 0.f, 0.f, 0.f, 0.f, 0.f, 0.f};
#pragma unroll
                    for (int n = 0; n < 4; ++n) { const u32x4 w = *(const u32x4*)(part + ((size_t)n * MCTX + row) * DM + q * 8);
                        sm[0] += bflo(w.x); sm[1] += bfhi(w.x); sm[2] += bflo(w.y); sm[3] += bfhi(w.y); sm[4] += bflo(w.z); sm[5] += bfhi(w.z); sm[6] += bflo(w.w); sm[7] += bfhi(w.w); }
                    u32x4 o; o.x = cvt_pk_bf16(sm[0], sm[1]); o.y = cvt_pk_bf16(sm[2], sm[3]); o.z = cvt_pk_bf16(sm[4], sm[5]); o.w = cvt_pk_bf16(sm[6], sm[7]);
                    *(u32x4*)(mrg + (size_t)(MLAT + row) * DM + q * 8) = o; }
                xcd_barrier(bar);
            }
        }
        if (INL(10)) { PH_LOCALS
            const bool spl = need_ctx && G == 256 && MK_LAUNCHES == 1; float* ypart = (float*)(ws + WS_R1 + (size_t)MALL * DFF * 2);
            SchedSplitK S; S.T.init(spl ? 128 : nrt, 8, G, c, 4); S.A = (const char*)mrg; S.B = (const char*)(ws + WS_WOUT); S.lda2 = DM * 2; S.ldb2 = DM * 2; S.nt = DM / 64; S.ns = 8; S.xe = (spl && c < 128) ? c : -1;
            EpiStoreK E{ybuf, ypart}; gm::gemm_stream<false>(lds, S, E); SEAM(pb + 10);
            if (spl) { job_splitk_reduce(ypart, ybuf, 8); xcd_barrier(bar); }
        }
        if (INL(11)) { PH_LOCALS
            RNArgs a{}; a.xs_lat = p.out; a.xs_ctx = xc; a.xd_lat = p.out; a.xd_ctx = xc; a.y = ybuf; a.wres = 1.0f; a.modl_res = modl; a.jres = 1; a.postg = p.in[I_POST] + (l * 3 + 1) * DM;
            a.do_norm = true; a.modl_norm = modl; a.jn = 2; a.preg = p.in[I_PRE] + (l * 3 + 2) * DM; a.h = nullptr; a.h8 = (signed char*)hbuf; a.nrows = nrt * 256; a.hsc = (float*)(ws + WS_HSC);
            job_resnorm(a, lds); SEAM(pb + 11);
        }
        if (INL(12)) { PH_LOCALS
            SchedPlain S; S.T.init(nrt, 44, G, c); S.A = (const char*)hbuf; S.B = (const char*)(ws + WS_WGU) + (size_t)11264 * 2048; S.lda2 = DM; S.ldb2 = DM; S.nt = DM / 128;
            EpiGateUpI8 E{act, (const float*)(ws + WS_HSC), (const float*)(ws + WS_WSC) + 11264}; gm::gemm_stream<false>(lds, S, E); SEAM(pb + 12);
        }
        if (INL(13)) { PH_LOCALS
            const bool spl = need_ctx && G == 256 && MK_LAUNCHES == 1; float* ypart = (float*)(ws + WS_QM);
            SchedSplitK S; S.T.init(spl ? 128 : nrt, 8, G, c, 4); S.A = (const char*)act; S.B = (const char*)(ws + WS_WD) + (size_t)2048 * 5632 * 2; S.lda2 = DFF * 2; S.ldb2 = DFF * 2; S.nt = DFF / 64; S.ns = 11; S.xe = (spl && c < 176) ? c : -1;
            EpiStoreK E{ybuf, ypart}; gm::gemm_stream<false>(lds, S, E); SEAM(pb + 13);
            if (spl) { job_splitk_reduce(ypart, ybuf, 11); xcd_barrier(bar); }
        }
    }
    if (EN(101) && IN(N_PHASES - 1)) {
        const int l = NL - 1; PH_LOCALS
        RNArgs a{}; a.xs_lat = p.out; a.xs_ctx = xc; a.xd_lat = p.out; a.xd_ctx = xc; a.y = ybuf; a.wres = 0.5f; a.modl_res = mod + (size_t)l * 3 * NMOD * DM; a.jres = 2; a.postg = p.in[I_POST] + (l * 3 + 2) * DM;
        a.do_norm = false; a.modl_norm = a.modl_res; a.jn = 0; a.preg = nullptr; a.h = nullptr; a.nrows = MLAT;
        job_resnorm(a, lds);
    }
#undef PH_LOCALS
#undef IN
#undef INL
#undef EN
#undef SEAM
}


#ifdef DBG_K
__global__ void dbg_dump(float* out, const unsigned char* ws, size_t off, size_t nelem, int is_bf16) {
    const size_t N = (size_t)MLAT * DM;
    for (size_t i = (size_t)obid() * blockDim.x + threadIdx.x; i < N; i += (size_t)gridDim.x * blockDim.x) {
        float s = 0.f;
        for (size_t j = i; j < nelem; j += N) s += is_bf16 ? bf2f(((const bf16_t*)(ws + off))[j]) : ((const float*)(ws + off))[j];
        out[i] = (s - s == 0.f) ? s : 12345.0f;
    }
}
#endif

extern "C" void kernel_launch(void* const* d_in, const int* in_sizes, int n_in, void* d_out, int out_size, void* d_ws, size_t ws_size, hipStream_t stream) {
    static int grid = 0;
    if (grid == 0) {
        if (n_in != 30 || out_size != MLAT * DM || ws_size < WS_END) { fprintf(stderr, "kernel_launch: unexpected shapes: n_in %d out %d ws %zu (need %zu)\n", n_in, out_size, ws_size, (size_t)WS_END); grid = -1; return; }
        int dev = 0, cus = 0;
        if (hipGetDevice(&dev) != hipSuccess || hipDeviceGetAttribute(&cus, hipDeviceAttributeMultiprocessorCount, dev) != hipSuccess) { grid = -1; return; }
        if (hipFuncSetAttribute((const void*)fwd_kernel, hipFuncAttributeMaxDynamicSharedMemorySize, LDS_BYTES) != hipSuccess) { fprintf(stderr, "kernel_launch: hipFuncSetAttribute failed\n"); grid = -1; return; }
        int per_cu = 0; (void)hipOccupancyMaxActiveBlocksPerMultiprocessor(&per_cu, (const void*)fwd_kernel, NTHR, LDS_BYTES); (void)hipGetLastError();
        grid = cus;
    }
    if (grid < 0) return;
    (void)hipMemsetAsync((char*)d_ws + WS_CTL, 0, WS_ZERO_BYTES, stream);
    KP p{};
    for (int i = 0; i < 30; ++i) p.in[i] = (const float*)d_in[i];
    p.out = (float*)d_out; p.ws = (unsigned char*)d_ws;
#ifdef DBG_K
    for (int k = 0; k < DBG_K; ++k) { p.ph_lo = k; p.ph_hi = k + 1; hipLaunchKernelGGL(fwd_kernel, dim3(grid), dim3(NTHR), LDS_BYTES, stream, p); }
    hipLaunchKernelGGL(dbg_dump, dim3(2048), dim3(256), 0, stream, (float*)d_out, (const unsigned char*)d_ws, (size_t)(DBG_OFF), (size_t)(DBG_N), (int)(DBG_BF));
#elif MK_LAUNCHES == 1
    p.ph_lo = 0; p.ph_hi = N_PHASES;
    hipLaunchKernelGGL(fwd_kernel, dim3(grid), dim3(NTHR), LDS_BYTES, stream, p);
#else
    for (int k = 0; k < N_PHASES; ++k) { p.ph_lo = k; p.ph_hi = k + 1; hipLaunchKernelGGL(fwd_kernel, dim3(grid), dim3(NTHR), LDS_BYTES, stream, p); }
#endif
}
```
